# Optimizing an MI355X kernel written in HIP

```python
import jax, jax.numpy as jnp
from jax import lax
import numpy as np

D_MODEL = 2048
BATCH = 4
SEQ = 2048
DEPTH = 1

D_FF = 5632
PLE_DIM = 256
HGRN_WIDTH = D_MODEL // 2
HGRN_HEAD_DIM = 128
HGRN_HEADS = HGRN_WIDTH // HGRN_HEAD_DIM
CHUNK = 64
LRU_WIDTH = D_MODEL - HGRN_WIDTH
LRU_BLOCKS = 8
LRU_BLOCK_DIM = LRU_WIDTH // LRU_BLOCKS
CONV_WIDTH = 4
LRU_C = 8.0
EPS = 1e-6
IN_COLS = 4 * HGRN_WIDTH + 2 * LRU_WIDTH

kernel_name = "hymba_hgrn2_rglru_macaron_block"


def rmsnorm(x, g):
    xf = x.astype(jnp.float32)
    y = xf * lax.rsqrt(jnp.mean(xf * xf, axis=-1, keepdims=True) + EPS)
    return (y * g.astype(jnp.float32)).astype(x.dtype)


def swiglu(h, w_gate, w_up, w_down):
    return (jax.nn.silu(h @ w_gate) * (h @ w_up)) @ w_down


def hgrn2_chunkwise(q, k, v, logf):
    Bn, S, H, dk = q.shape
    dv = v.shape[-1]
    n = S // CHUNK

    def to_chunks(t):
        return t.reshape(Bn, n, CHUNK, H, t.shape[-1]).transpose(1, 0, 3, 2, 4)

    causal = jnp.tril(jnp.ones((CHUNK, CHUNK), dtype=bool))

    def step(state, inp):
        qc, kc, vc, lf = inp
        b = jnp.cumsum(lf, axis=2)
        o_inter = jnp.einsum('bhtk,bhkv->bhtv', qc * jnp.exp(b), state)
        diff = b[:, :, :, None, :] - b[:, :, None, :, :]
        decay = jnp.exp(jnp.where(causal[:, :, None], diff, -jnp.inf))
        scores = jnp.einsum('bhtk,bhtsk,bhsk->bhts', qc, decay, kc)
        o = o_inter + jnp.einsum('bhts,bhsv->bhtv', scores, vc)
        b_last = b[:, :, -1:, :]
        new_state = jnp.exp(b_last[:, :, 0, :])[..., None] * state + jnp.einsum(
            'bhsk,bhsv->bhkv', kc * jnp.exp(b_last - b), vc)
        return new_state, o

    s0 = jnp.zeros((Bn, H, dk, dv), jnp.float32)
    _, o = lax.scan(step, s0, (to_chunks(q), to_chunks(k), to_chunks(v), to_chunks(logf)))
    return o.transpose(1, 0, 3, 2, 4).reshape(Bn, S, H, dv)


def hgrn2_group(q, f_pre, i, g, lb, g_norm):
    Bn, S, _ = q.shape
    shp = (Bn, S, HGRN_HEADS, HGRN_HEAD_DIM)
    f = lb + (1.0 - lb) * jax.nn.sigmoid(f_pre.astype(jnp.float32))
    logf = jnp.log(f)
    k = 1.0 - f
    o = hgrn2_chunkwise(q.astype(jnp.float32).reshape(shp), k.reshape(shp),
                        i.astype(jnp.float32).reshape(shp), logf.reshape(shp))
    o = rmsnorm(o, g_norm) * jax.nn.silu(g.astype(jnp.float32).reshape(shp))
    return o.reshape(Bn, S, HGRN_WIDTH).astype(q.dtype)


def rglru_group(xb, gate, conv_w, conv_b, w_a, b_a, w_x, b_x, lam):
    Bn, S, _ = xb.shape
    xf = xb.astype(jnp.float32)
    xc = lax.conv_general_dilated(
        xf, conv_w.astype(jnp.float32)[:, None, :], window_strides=(1,),
        padding=[(CONV_WIDTH - 1, 0)], dimension_numbers=('NWC', 'WIO', 'NWC'),
        feature_group_count=LRU_WIDTH) + conv_b.astype(jnp.float32)
    xr = xc.reshape(Bn, S, LRU_BLOCKS, LRU_BLOCK_DIM)
    blk = (LRU_BLOCKS, LRU_BLOCK_DIM)
    r = jax.nn.sigmoid(jnp.einsum('bsnc,ncd->bsnd', xr, w_a.astype(jnp.float32))
                       + b_a.astype(jnp.float32).reshape(blk))
    ig = jax.nn.sigmoid(jnp.einsum('bsnc,ncd->bsnd', xr, w_x.astype(jnp.float32))
                        + b_x.astype(jnp.float32).reshape(blk))
    log_a = -LRU_C * r * jax.nn.softplus(-lam.astype(jnp.float32).reshape(blk))
    a = jnp.exp(log_a)
    u = jnp.sqrt(-jnp.expm1(2.0 * log_a)) * (ig * xr)

    def combine(c1, c2):
        a1, b1 = c1
        a2, b2 = c2
        return a1 * a2, a2 * b1 + b2

    _, h = lax.associative_scan(combine, (a, u), axis=1)
    y = h.reshape(Bn, S, LRU_WIDTH) * jax.nn.gelu(gate.astype(jnp.float32))
    return y.astype(xb.dtype)


def setup_inputs(seed: int = 0) -> dict:
    key = jax.random.key(seed)
    ks = jax.random.split(key, 32)
    f32 = jnp.float32

    def nrm(k, shape, fan_in):
        return jax.random.normal(k, shape, f32) * (fan_in ** -0.5)

    def gain(k, shape):
        return 1.0 + 0.05 * jax.random.normal(k, shape, f32)

    def small(k, shape):
        return 0.01 * jax.random.normal(k, shape, f32)

    a8 = jax.random.uniform(ks[20], (DEPTH, LRU_WIDTH), f32, 0.9, 0.999)
    a_base = a8 ** (1.0 / LRU_C)
    lam = jnp.log(a_base) - jnp.log1p(-a_base)

    return {
        "x": jax.random.normal(ks[0], (BATCH, SEQ, D_MODEL), f32),
        "p": jax.random.normal(ks[1], (DEPTH, BATCH, SEQ, PLE_DIM), f32),
        "ffn1_norm": gain(ks[2], (DEPTH, D_MODEL)),
        "ffn1_w_gate": nrm(ks[3], (DEPTH, D_MODEL, D_FF), D_MODEL),
        "ffn1_w_up": nrm(ks[4], (DEPTH, D_MODEL, D_FF), D_MODEL),
        "ffn1_w_down": nrm(ks[5], (DEPTH, D_FF, D_MODEL), D_FF),
        "mix_norm": gain(ks[6], (DEPTH, D_MODEL)),
        "w_in": nrm(ks[7], (DEPTH, D_MODEL, IN_COLS), D_MODEL),
        "hgrn_lower_bounds": 0.5 * jax.random.normal(ks[8], (DEPTH + 1, HGRN_WIDTH), f32),
        "hgrn_g_norm": gain(ks[9], (DEPTH, HGRN_HEAD_DIM)),
        "conv_w": nrm(ks[10], (DEPTH, CONV_WIDTH, LRU_WIDTH), CONV_WIDTH),
        "conv_b": small(ks[11], (DEPTH, LRU_WIDTH)),
        "lru_w_a": nrm(ks[12], (DEPTH, LRU_BLOCKS, LRU_BLOCK_DIM, LRU_BLOCK_DIM), LRU_BLOCK_DIM),
        "lru_b_a": small(ks[13], (DEPTH, LRU_WIDTH)),
        "lru_w_x": nrm(ks[14], (DEPTH, LRU_BLOCKS, LRU_BLOCK_DIM, LRU_BLOCK_DIM), LRU_BLOCK_DIM),
        "lru_b_x": small(ks[15], (DEPTH, LRU_WIDTH)),
        "lru_lambda": lam,
        "w_out": nrm(ks[16], (DEPTH, D_MODEL, D_MODEL), D_MODEL),
        "ffn2_norm": gain(ks[17], (DEPTH, D_MODEL)),
        "ffn2_w_gate": nrm(ks[18], (DEPTH, D_MODEL, D_FF), D_MODEL),
        "ffn2_w_up": nrm(ks[19], (DEPTH, D_MODEL, D_FF), D_MODEL),
        "ffn2_w_down": nrm(ks[21], (DEPTH, D_FF, D_MODEL), D_FF),
        "ple_norm": gain(ks[22], (DEPTH, D_MODEL)),
        "ple_w_gate": nrm(ks[23], (DEPTH, D_MODEL, D_MODEL), D_MODEL),
        "ple_b_gate": small(ks[24], (DEPTH, D_MODEL)),
        "ple_w_proj": nrm(ks[25], (DEPTH, PLE_DIM, D_MODEL), PLE_DIM),
        "final_norm": gain(ks[26], (D_MODEL,)),
    }


def reference(x, p, ffn1_norm, ffn1_w_gate, ffn1_w_up, ffn1_w_down, mix_norm, w_in,
              hgrn_lower_bounds, hgrn_g_norm, conv_w, conv_b, lru_w_a, lru_b_a, lru_w_x,
              lru_b_x, lru_lambda, w_out, ffn2_norm, ffn2_w_gate, ffn2_w_up, ffn2_w_down,
              ple_norm, ple_w_gate, ple_b_gate, ple_w_proj, final_norm):
    lb_all = jnp.cumsum(jax.nn.softmax(hgrn_lower_bounds.astype(jnp.float32), axis=0), axis=0)
    H1, H2, H3, H4 = HGRN_WIDTH, 2 * HGRN_WIDTH, 3 * HGRN_WIDTH, 4 * HGRN_WIDTH
    for l in range(DEPTH):
        h = rmsnorm(x, ffn1_norm[l])
        x = x + 0.5 * swiglu(h, ffn1_w_gate[l], ffn1_w_up[l], ffn1_w_down[l])

        h = rmsnorm(x, mix_norm[l])
        z = h @ w_in[l]
        o_hgrn = hgrn2_group(z[..., :H1], z[..., H1:H2], z[..., H2:H3], z[..., H3:H4],
                             lb_all[l], hgrn_g_norm[l])
        o_lru = rglru_group(z[..., H4:H4 + LRU_WIDTH], z[..., H4 + LRU_WIDTH:],
                            conv_w[l], conv_b[l], lru_w_a[l], lru_b_a[l],
                            lru_w_x[l], lru_b_x[l], lru_lambda[l])
        x = x + jnp.concatenate([o_hgrn, o_lru], axis=-1) @ w_out[l]

        h = rmsnorm(x, ffn2_norm[l])
        x = x + 0.5 * swiglu(h, ffn2_w_gate[l], ffn2_w_up[l], ffn2_w_down[l])

        h = rmsnorm(x, ple_norm[l])
        gate = jax.nn.sigmoid(h @ ple_w_gate[l] + ple_b_gate[l])
        x = x + gate * (p[l] @ ple_w_proj[l])
    return rmsnorm(x, final_norm)
```

```cpp
#include <hip/hip_runtime.h>
#include <cstdio>
#include <cstdint>
#ifndef SIMPLE_MIXER
#define SIMPLE_MIXER 1
#endif
#ifndef N_LAUNCHES
#define N_LAUNCHES 12
#endif
#define MIXER_PHASE_4
#define MIXER_PHASE_5
#define MIXER_PHASE_6
namespace pg8 {
#define PG8_LAS __attribute__((address_space(3)))
typedef unsigned short bf16_t;
typedef short bf16x8 __attribute__((ext_vector_type(8)));
typedef float f32x4 __attribute__((ext_vector_type(4)));
typedef unsigned u32x4 __attribute__((ext_vector_type(4)));
constexpr int BM = 256, BK = 64, HALF = 128, HTB = HALF * BK * 2  , STAGE_BYTES = 8 * HTB, NXCD = 8, WGM = 8;

__host__ __device__ __forceinline__ int lds_byte(int r, int c) { const int st = (r >> 4) * 2 + (c >> 5), rr = r & 15, cc = c & 31, ob = rr * 64 + cc * 2; return st * 1024 + (ob ^ (((ob >> 9) & 1) << 5)); }
__host__ __device__ __forceinline__ void stage_rc(int b, int& R, int& C) { const int st = b / 1024, sb = b % 1024, swz = sb ^ (((sb >> 9) & 1) << 5); R = (st >> 1) * 16 + swz / 64; C = (st & 1) * 32 + (swz % 64) / 2; }
__host__ __device__ __forceinline__ int perm32(int rho) { const int n = rho >> 4, i = rho & 15; return 8 * (i >> 2) + 4 * n + (i & 3); }

struct Unit { int pm, pn; };
struct Gemm { const bf16_t* A; const bf16_t* Bt; int M, N, K; };

struct StaticOrder {
    int nM, nN, nwg, G, c;
    __host__ __device__ void init(int M, int N, int G_, int c_) { nM = M / BM; nN = N / BM; nwg = nM * nN; G = G_; c = c_; }
    __host__ __device__ bool next(int i, Unit& u) const {
        const long L = (long)i * G + c; if (L >= nwg) return false;
        int wgid = (int)L; { const int q = nwg / NXCD, r = nwg % NXCD, xcd = wgid % NXCD, off = wgid / NXCD; wgid = (xcd < r ? xcd * (q + 1) : r * (q + 1) + (xcd - r) * q) + off; }
        const int nig = WGM * nN, gid = wgid / nig, fm = gid * WGM, gsz = (nM - fm) < WGM ? (nM - fm) : WGM;
        u.pm = fm + ((wgid % nig) % gsz); u.pn = (wgid % nig) / gsz; return true;
    }
    __device__ __forceinline__ void a_ready(const Unit&) const {}
    __device__ __forceinline__ void done(const Unit&) const {}
};
__device__ __forceinline__ unsigned cvt_pk_bf16(float lo, float hi) { unsigned r; asm volatile("v_cvt_pk_bf16_f32 %0, %1, %2" : "=v"(r) : "v"(lo), "v"(hi)); return r; }
typedef unsigned u32x2 __attribute__((ext_vector_type(2)));
constexpr int DM = 2048;
constexpr int NSSQ = 32;
__device__ __forceinline__ float sigmoid_f(float x) { return __builtin_amdgcn_rcpf(1.0f + __expf(-x)); }
__device__ __forceinline__ float silu_f(float x) { return x * sigmoid_f(x); }
__device__ __forceinline__ float gelu_tanh_f(float x) { return x * sigmoid_f(1.5957691216057308f * (x + 0.044715f * x * x * x)); }
__device__ __forceinline__ float row_rstd(const float* ssq, int row, int fq) {
    const f32x4* p = (const f32x4*)(ssq + (size_t)row * NSSQ + fq * 8);
    const f32x4 a = p[0], b = p[1];
    float s = ((a[0] + a[1]) + (a[2] + a[3])) + ((b[0] + b[1]) + (b[2] + b[3]));
    s += __shfl_xor(s, 16); s += __shfl_xor(s, 32);
    return 1.0f / sqrtf(s * (1.0f / (float)DM) + 1e-6f);
}

struct EpiSwiGLU {
    static constexpr bool PERM = true, AFTER_DRAIN = false;
    bf16_t* O; int ldo; const float* ssq;
    __device__ __forceinline__ void operator()(const f32x4 (&acc)[2][2][4][2], const Unit& u, int wr, int wc, int fr, int fq) const {
        const int row0 = u.pm * BM + wr * 64 + fr, col0 = u.pn * HALF + wc * 32 + 8 * fq;
#pragma unroll
        for (int ai = 0; ai < 2; ++ai)
#pragma unroll
            for (int m = 0; m < 4; ++m) {
                const int row = row0 + ai * HALF + m * 16; const float rs = row_rstd(ssq, row, fq);
                float h[8];
#pragma unroll
                for (int n = 0; n < 2; ++n)
#pragma unroll
                    for (int j = 0; j < 4; ++j) { const float g = acc[ai][0][m][n][j] * rs, up = acc[ai][1][m][n][j] * rs; h[n * 4 + j] = silu_f(g) * up; }
                u32x4 w; w.x = cvt_pk_bf16(h[0], h[1]); w.y = cvt_pk_bf16(h[2], h[3]); w.z = cvt_pk_bf16(h[4], h[5]); w.w = cvt_pk_bf16(h[6], h[7]);
                *(u32x4*)(O + (size_t)row * ldo + col0) = w;
            }
    }
};
struct EpiResid {
    static constexpr bool PERM = false, AFTER_DRAIN = false;
    const float* src; float* dst; bf16_t* xb; float* ssq_out; float scale;
    __device__ __forceinline__ void operator()(const f32x4 (&acc)[2][2][4][2], const Unit& u, int wr, int wc, int fr, int fq) const {
        const int row0 = u.pm * BM + wr * 64 + fr, col0 = u.pn * BM + wc * 32 + 4 * fq;
#pragma unroll
        for (int ai = 0; ai < 2; ++ai)
#pragma unroll
            for (int m = 0; m < 4; ++m) {
                const int row = row0 + ai * HALF + m * 16; float ss = 0.f;
#pragma unroll
                for (int bj = 0; bj < 2; ++bj)
#pragma unroll
                    for (int n = 0; n < 2; ++n) { const size_t off = (size_t)row * DM + col0 + bj * HALF + n * 16;
                        const f32x4 o = *(const f32x4*)(src + off) + acc[ai][bj][m][n] * scale;
                        *(f32x4*)(dst + off) = o; u32x2 w; w.x = cvt_pk_bf16(o[0], o[1]); w.y = cvt_pk_bf16(o[2], o[3]); *(u32x2*)(xb + off) = w;
                        ss += (o[0] * o[0] + o[1] * o[1]) + (o[2] * o[2] + o[3] * o[3]); }
                ss += __shfl_xor(ss, 16); ss += __shfl_xor(ss, 32);
                if (fq == 0) ssq_out[(size_t)row * NSSQ + u.pn * 4 + wc] = ss;
            }
    }
};
struct EpiZ {
    static constexpr bool PERM = true, AFTER_DRAIN = false;
    const float* ssq; const float* hlb;
    bf16_t* mixa;
    float* logf; bf16_t* vv; bf16_t* sg; bf16_t* lrx;
    __device__ __forceinline__ void operator()(const f32x4 (&acc)[2][2][4][2], const Unit& u, int wr, int wc, int fr, int fq) const {
        const int seg = u.pn >> 2;
        const int row0 = u.pm * BM + wr * 64 + fr, cs0 = (u.pn & 3) * BM + wc * 32 + 8 * fq;
        float lbv[2][8];
        if (seg == 1) {
#pragma unroll
            for (int bj = 0; bj < 2; ++bj)
#pragma unroll
                for (int e = 0; e < 8; ++e) { const int c = cs0 + bj * HALF + e; lbv[bj][e] = sigmoid_f(hlb[c] - hlb[1024 + c]); }
        }
#pragma unroll
        for (int ai = 0; ai < 2; ++ai)
#pragma unroll
            for (int m = 0; m < 4; ++m) {
                const int row = row0 + ai * HALF + m * 16; const float rs = row_rstd(ssq, row, fq);
#pragma unroll
                for (int bj = 0; bj < 2; ++bj) {
                    const int cs = cs0 + bj * HALF;
                    float z[8];
#pragma unroll
                    for (int n = 0; n < 2; ++n)
#pragma unroll
                        for (int j = 0; j < 4; ++j) z[n * 4 + j] = acc[ai][bj][m][n][j] * rs;
                    if (seg == 1) {
                        float lf[8];
#pragma unroll
                        for (int e = 0; e < 8; ++e) { const float lb = lbv[bj][e]; lf[e] = __logf(lb + (1.0f - lb) * sigmoid_f(z[e])); }
                        float* p = logf + (size_t)row * 1024 + cs;
                        *(f32x4*)p = (f32x4){lf[0], lf[1], lf[2], lf[3]}; *(f32x4*)(p + 4) = (f32x4){lf[4], lf[5], lf[6], lf[7]};
                    } else {
                        if (seg == 3) {
#pragma unroll
                            for (int e = 0; e < 8; ++e) z[e] = silu_f(z[e]);
                        } else if (seg == 5) {
#pragma unroll
                            for (int e = 0; e < 8; ++e) z[e] = gelu_tanh_f(z[e]);
                        }
                        u32x4 w; w.x = cvt_pk_bf16(z[0], z[1]); w.y = cvt_pk_bf16(z[2], z[3]); w.z = cvt_pk_bf16(z[4], z[5]); w.w = cvt_pk_bf16(z[6], z[7]);
                        bf16_t* p;
                        if (seg == 0) p = mixa + (size_t)row * 2048 + cs;
                        else if (seg == 5) p = mixa + (size_t)row * 2048 + 1024 + cs;
                        else if (seg == 2) p = vv + (size_t)row * 1024 + cs;
                        else if (seg == 3) p = sg + (size_t)row * 1024 + cs;
                        else p = lrx + (size_t)row * 1024 + cs;
                        *(u32x4*)p = w;
                    }
                }
            }
    }
};
struct EpiPP {
    static constexpr bool PERM = false, AFTER_DRAIN = false;
    float* PP;
    __device__ __forceinline__ void operator()(const f32x4 (&acc)[2][2][4][2], const Unit& u, int wr, int wc, int fr, int fq) const {
        const int row0 = u.pm * BM + wr * 64 + fr, col0 = u.pn * BM + wc * 32 + 4 * fq;
#pragma unroll
        for (int ai = 0; ai < 2; ++ai)
#pragma unroll
            for (int m = 0; m < 4; ++m) { float* rowp = PP + (size_t)(row0 + ai * HALF + m * 16) * DM + col0;
#pragma unroll
                for (int bj = 0; bj < 2; ++bj)
#pragma unroll
                    for (int n = 0; n < 2; ++n) *(f32x4*)(rowp + bj * HALF + n * 16) = acc[ai][bj][m][n]; }
    }
};
struct EpiPLE {
    static constexpr bool PERM = false, AFTER_DRAIN = false;
    const float* ssq_in; const float* bg; const float* PP; float* X; float* ssq_out;
    __device__ __forceinline__ void operator()(const f32x4 (&acc)[2][2][4][2], const Unit& u, int wr, int wc, int fr, int fq) const {
        const int row0 = u.pm * BM + wr * 64 + fr, col0 = u.pn * BM + wc * 32 + 4 * fq;
#pragma unroll
        for (int ai = 0; ai < 2; ++ai)
#pragma unroll
            for (int m = 0; m < 4; ++m) {
                const int row = row0 + ai * HALF + m * 16; const float rs = row_rstd(ssq_in, row, fq); float ss = 0.f;
#pragma unroll
                for (int bj = 0; bj < 2; ++bj)
#pragma unroll
                    for (int n = 0; n < 2; ++n) { const int c = col0 + bj * HALF + n * 16; const size_t off = (size_t)row * DM + c;
                        const f32x4 b4 = *(const f32x4*)(bg + c), pp = *(const f32x4*)(PP + off), old = *(const f32x4*)(X + off), a = acc[ai][bj][m][n];
                        f32x4 o;
#pragma unroll
                        for (int j = 0; j < 4; ++j) o[j] = old[j] + sigmoid_f(a[j] * rs + b4[j]) * pp[j];
                        *(f32x4*)(X + off) = o; ss += (o[0] * o[0] + o[1] * o[1]) + (o[2] * o[2] + o[3] * o[3]);
                        asm volatile("" ::: "memory"); }
                ss += __shfl_xor(ss, 16); ss += __shfl_xor(ss, 32);
                if (fq == 0) ssq_out[(size_t)row * NSSQ + u.pn * 4 + wc] = ss;
            }
    }
};

template <class Epi, class Sched, bool ALIGN_EPI = false, bool SP2 = false>
__device__ __forceinline__ void gemm_phase(PG8_LAS unsigned char* lds, const Gemm g, const Sched& S, const Epi& E) {
    int tid_ = threadIdx.x; asm volatile("" : "+v"(tid_));
    const int tid = tid_, wid = __builtin_amdgcn_readfirstlane(tid >> 6), lane = tid & 63, wr = wid >> 2, wc = wid & 3, fr = lane & 15, fq = lane >> 4;
    const int K = g.K, nt = K / BK;
    unsigned voffA[2], voffB[2];
#pragma unroll
    for (int i = 0; i < 2; ++i) { int R, C; stage_rc(tid * 16 + i * 8192, R, C); const int Rb = Epi::PERM ? ((R & ~31) + perm32(R & 31)) : R;
        voffA[i] = (unsigned)(R * K + C) * 2u; voffB[i] = (unsigned)(Rb * K + C) * 2u; }
    const size_t kstep = (size_t)(BK * 2);
    const size_t hstep = (size_t)HALF * K * 2;
    const size_t tstep = 2 * hstep;
    const unsigned ldsw = (unsigned)wid * 1024u;
    const int aoff = lds_byte(wr * 64 + fr, fq * 8), boff = lds_byte(wc * 32 + fr, fq * 8);
#define PG8_SA(b, h) (((b) * 2 + (h)) * HTB)
#define PG8_SB(b, h) ((4 + (b) * 2 + (h)) * HTB)
#define PG8_STAGE(bufoff, gbase, voff) do { _Pragma("unroll") for (int _i = 0; _i < 2; ++_i) \
        __builtin_amdgcn_global_load_lds((const unsigned*)((const char*)(gbase) + (voff)[_i]), (PG8_LAS unsigned*)(lds + (bufoff) + ldsw + _i * 8192), 16, 0, 0); } while (0)
#define PG8_LDA(dst, b, h) do { _Pragma("unroll") for (int m = 0; m < 4; ++m) _Pragma("unroll") for (int k = 0; k < 2; ++k) dst[m][k] = *(const PG8_LAS bf16x8*)(lds + PG8_SA(b, h) + aoff + m * 2048 + k * 1024); } while (0)
#define PG8_LDB(dst, b, h) do { _Pragma("unroll") for (int n = 0; n < 2; ++n) _Pragma("unroll") for (int k = 0; k < 2; ++k) dst[n][k] = *(const PG8_LAS bf16x8*)(lds + PG8_SB(b, h) + boff + n * 2048 + k * 1024); } while (0)
#define PG8_MMA(ai, bj, At, Bt) do { __builtin_amdgcn_s_setprio(1); _Pragma("unroll") for (int m = 0; m < 4; ++m) _Pragma("unroll") for (int n = 0; n < 2; ++n) _Pragma("unroll") for (int k = 0; k < 2; ++k) \
        acc[ai][bj][m][n] = __builtin_amdgcn_mfma_f32_16x16x32_bf16(Bt[n][k], At[m][k], acc[ai][bj][m][n], 0, 0, 0); __builtin_amdgcn_s_setprio(0); } while (0)
#define PG8_WAIT_V(n) asm volatile("s_waitcnt vmcnt(" #n ")" ::: "memory")
#define PG8_WAIT_L(n) asm volatile("s_waitcnt lgkmcnt(" #n ")" ::: "memory")
#define PG8_BAR __builtin_amdgcn_s_barrier()
#define PG8_SCHED __builtin_amdgcn_sched_barrier(0)
    Unit cur, nxt; int ui = 0;
    if (!S.next(0, cur)) return;
    f32x4 acc[2][2][4][2];
#pragma unroll
    for (int a = 0; a < 2; ++a)
#pragma unroll
        for (int b = 0; b < 2; ++b)
#pragma unroll
            for (int m = 0; m < 4; ++m)
#pragma unroll
                for (int n = 0; n < 2; ++n) acc[a][b][m][n] = (f32x4){0.f, 0.f, 0.f, 0.f};
    bf16x8 At[4][2], B0[2][2], B1[2][2];
    const char* cA = (const char*)g.A + (size_t)cur.pm * tstep; const char* cB = (const char*)g.Bt + (size_t)cur.pn * tstep;
    S.a_ready(cur);
    if constexpr (SP2) {
        PG8_STAGE(PG8_SB(0, 0), cB, voffB); PG8_STAGE(PG8_SB(0, 1), cB + hstep, voffB); PG8_STAGE(PG8_SA(0, 0), cA, voffA); PG8_STAGE(PG8_SA(0, 1), cA + hstep, voffA);
        if (wr == 1) PG8_BAR;
        PG8_WAIT_V(2); PG8_BAR;
        PG8_STAGE(PG8_SB(1, 0), cB + kstep, voffB); PG8_STAGE(PG8_SA(1, 0), cA + kstep, voffA); PG8_STAGE(PG8_SB(1, 1), cB + hstep + kstep, voffB);
        PG8_WAIT_V(6); PG8_BAR;
    } else {
        PG8_STAGE(PG8_SB(0, 0), cB, voffB); PG8_STAGE(PG8_SA(0, 0), cA, voffA); PG8_STAGE(PG8_SB(0, 1), cB + hstep, voffB); PG8_STAGE(PG8_SA(0, 1), cA + hstep, voffA);
        if (wr == 1) PG8_BAR;
        PG8_WAIT_V(4); PG8_BAR;
        PG8_STAGE(PG8_SB(1, 0), cB + kstep, voffB); PG8_STAGE(PG8_SA(1, 0), cA + kstep, voffA); PG8_STAGE(PG8_SB(1, 1), cB + hstep + kstep, voffB);
        PG8_WAIT_V(6); PG8_BAR;
    }
    for (;;) {
        const bool has_next = S.next(ui + 1, nxt);
        const char* nA = has_next ? (const char*)g.A + (size_t)nxt.pm * tstep : cA; const char* nB = has_next ? (const char*)g.Bt + (size_t)nxt.pn * tstep : cB;
        for (int t = 0; t < nt; t += 2) {
            const bool last = (t == nt - 2);
            const char* a1 = cA + (size_t)(t + 1) * kstep;
            const char* a2 = last ? nA : cA + (size_t)(t + 2) * kstep; const char* b2 = last ? nB : cB + (size_t)(t + 2) * kstep;
            const char* a3 = a2 + kstep; const char* b3 = b2 + kstep;
            if (last && has_next) S.a_ready(nxt);
            if constexpr (SP2) {
            PG8_LDB(B0, 0, 0); PG8_LDB(B1, 0, 1); PG8_SCHED; PG8_LDA(At, 0, 0); PG8_STAGE(PG8_SA(1, 1), a1 + hstep, voffA);
            PG8_WAIT_V(8); PG8_WAIT_L(0); PG8_BAR; PG8_MMA(0, 0, At, B0); PG8_MMA(0, 1, At, B1); PG8_BAR; PG8_SCHED;
            PG8_LDA(At, 0, 1); PG8_STAGE(PG8_SB(0, 0), b2, voffB); PG8_STAGE(PG8_SB(0, 1), b2 + hstep, voffB); PG8_STAGE(PG8_SA(0, 0), a2, voffA);
            PG8_WAIT_V(8); PG8_WAIT_L(0); PG8_BAR; PG8_MMA(1, 0, At, B0); PG8_MMA(1, 1, At, B1); PG8_BAR; PG8_SCHED;
            PG8_LDB(B0, 1, 0); PG8_LDB(B1, 1, 1); PG8_SCHED; PG8_LDA(At, 1, 0); PG8_STAGE(PG8_SA(0, 1), a2 + hstep, voffA);
            PG8_WAIT_V(8); PG8_WAIT_L(0); PG8_BAR; PG8_MMA(0, 0, At, B0); PG8_MMA(0, 1, At, B1); PG8_BAR; PG8_SCHED;
            PG8_LDA(At, 1, 1); PG8_STAGE(PG8_SB(1, 0), b3, voffB); PG8_STAGE(PG8_SB(1, 1), b3 + hstep, voffB); PG8_STAGE(PG8_SA(1, 0), a3, voffA);
            PG8_WAIT_V(8); PG8_WAIT_L(0); PG8_BAR; PG8_MMA(1, 0, At, B0); PG8_MMA(1, 1, At, B1); PG8_BAR; PG8_SCHED;
            } else {
            PG8_LDB(B0, 0, 0); PG8_SCHED; PG8_LDA(At, 0, 0); PG8_STAGE(PG8_SA(1, 1), a1 + hstep, voffA);
            PG8_WAIT_L(8); PG8_BAR; PG8_WAIT_L(0); PG8_MMA(0, 0, At, B0); PG8_BAR; PG8_SCHED;
            PG8_LDB(B1, 0, 1); PG8_STAGE(PG8_SB(0, 0), b2, voffB);
            PG8_BAR; PG8_WAIT_L(0); PG8_MMA(0, 1, At, B1); PG8_BAR;
            PG8_LDA(At, 0, 1); PG8_STAGE(PG8_SA(0, 0), a2, voffA);
            PG8_BAR; PG8_WAIT_L(0); PG8_MMA(1, 0, At, B0); PG8_BAR; PG8_SCHED;
            PG8_STAGE(PG8_SB(0, 1), b2 + hstep, voffB);
            PG8_WAIT_V(6); PG8_BAR; PG8_MMA(1, 1, At, B1); PG8_BAR;
            PG8_LDB(B0, 1, 0); PG8_SCHED; PG8_LDA(At, 1, 0); PG8_STAGE(PG8_SA(0, 1), a2 + hstep, voffA);
            PG8_WAIT_L(8); PG8_BAR; PG8_WAIT_L(0); PG8_MMA(0, 0, At, B0); PG8_BAR; PG8_SCHED;
            PG8_LDB(B1, 1, 1); PG8_STAGE(PG8_SB(1, 0), b3, voffB);
            PG8_BAR; PG8_WAIT_L(0); PG8_MMA(0, 1, At, B1); PG8_BAR;
            PG8_LDA(At, 1, 1); PG8_STAGE(PG8_SA(1, 0), a3, voffA);
            PG8_BAR; PG8_WAIT_L(0); PG8_MMA(1, 0, At, B0); PG8_BAR; PG8_SCHED;
            PG8_STAGE(PG8_SB(1, 1), b3 + hstep, voffB);
            PG8_WAIT_V(6); PG8_BAR; PG8_MMA(1, 1, At, B1); PG8_BAR;
            }
        }
        if constexpr (ALIGN_EPI) { if (wr == 0) PG8_BAR; }
        if constexpr (!Epi::AFTER_DRAIN) { E(acc, cur, wr, wc, fr, fq); S.done(cur); }
        if (!has_next) break;
#pragma unroll
        for (int a = 0; a < 2; ++a)
#pragma unroll
            for (int b = 0; b < 2; ++b)
#pragma unroll
                for (int m = 0; m < 4; ++m)
#pragma unroll
                    for (int n = 0; n < 2; ++n) acc[a][b][m][n] = (f32x4){0.f, 0.f, 0.f, 0.f};
        cur = nxt; cA = nA; cB = nB; ++ui;
        if constexpr (ALIGN_EPI) { if (wr == 1) PG8_BAR; }
    }
    PG8_WAIT_V(0);
    if constexpr (!ALIGN_EPI) { if (wr == 0) PG8_BAR; }
    PG8_BAR;
    if constexpr (Epi::AFTER_DRAIN) { E.fused(acc, cur, wr, wc, fr, fq, lds, wid, lane); S.done(cur); }
#undef PG8_SA
#undef PG8_SB
#undef PG8_STAGE
#undef PG8_LDA
#undef PG8_LDB
#undef PG8_MMA
#undef PG8_WAIT_V
#undef PG8_WAIT_L
#undef PG8_BAR
#undef PG8_SCHED
}
}
#define GAS __attribute__((address_space(1)))
#define LAS __attribute__((address_space(3)))
typedef unsigned short bf16;
typedef unsigned v4u __attribute__((ext_vector_type(4)));
typedef float f32x4 __attribute__((ext_vector_type(4)));
typedef short bf16x8 __attribute__((ext_vector_type(8)));
typedef GAS unsigned gu32;
typedef GAS unsigned long long gu64;
#define RLX_AGENT __ATOMIC_RELAXED, __HIP_MEMORY_SCOPE_AGENT
#define LDS_WAIT() asm volatile("s_waitcnt lgkmcnt(0)" ::: "memory")
#define VM_WAIT() asm volatile("s_waitcnt vmcnt(0)" ::: "memory")
__device__ __forceinline__ unsigned long long rt() { return __builtin_amdgcn_s_memrealtime(); }
__device__ __forceinline__ unsigned f2bf(float f) { unsigned u = __builtin_bit_cast(unsigned, f); return (u + 0x7fffu + ((u >> 16) & 1u)) >> 16; }
__device__ __forceinline__ unsigned pk2(float lo, float hi) { return f2bf(lo) | (f2bf(hi) << 16); }

#define XB_TMO      128
#define XB_XCNT(j)  (256  + 64 * (j))
#define XB_XSUB(j)  (1280 + 64 * (j))
#define XB_XGEN(j)  (2304 + 64 * (j))
#define XB_TOP      3328
#define XB_TOPGEN   3392
#define XCD_BAR_WORDS 3456
#define XB_SPIN_CAP (1u << 18)

__device__ __forceinline__ unsigned xb_ld(unsigned* p)              { return __hip_atomic_load(p, __ATOMIC_RELAXED, __HIP_MEMORY_SCOPE_AGENT); }
__device__ __forceinline__ unsigned xb_add(unsigned* p, unsigned v) { return __hip_atomic_fetch_add(p, v, __ATOMIC_RELAXED, __HIP_MEMORY_SCOPE_AGENT); }
__device__ __forceinline__ unsigned xb_xcc_id() { return (unsigned)__builtin_amdgcn_s_getreg((3 << 11) | 20) & 0xFu; }
#define XB_SPIN(cond, bar) do { unsigned _sp = 0; while (cond) { __builtin_amdgcn_s_sleep(1); \
    if ((++_sp & 255u) == 0u) { if (xb_ld(&(bar)[XB_TMO])) break; if (_sp > XB_SPIN_CAP) { atomicAdd(&(bar)[XB_TMO], 1u); break; } } } } while (0)

struct XcdBarrier {
    unsigned* bar; unsigned x;
    volatile LAS unsigned* st;
};

__device__ __forceinline__ XcdBarrier xcd_barrier_post(unsigned* bar, volatile LAS unsigned* st) {
    XcdBarrier b; b.bar = bar; b.x = xb_xcc_id(); b.st = st;
    if (threadIdx.x == 0) (void)xb_add(&bar[XB_XCNT(b.x)], 1u);
    return b;
}
__device__ __forceinline__ void xcd_barrier_complete(unsigned* bar, unsigned x, unsigned& nloc, unsigned& nx) {
    const unsigned G = gridDim.x * gridDim.y * gridDim.z;
    unsigned sum, cnt, mine, sp = 0u;
    for (;;) {
        sum = 0u; cnt = 0u; mine = 0u;
#pragma unroll
        for (unsigned j = 0; j < 16; ++j) { const unsigned c = xb_ld(&bar[XB_XCNT(j)]); sum += c; cnt += (c > 0u) ? 1u : 0u; mine = (j == x) ? c : mine; }
        if (sum == G) break;
        __builtin_amdgcn_s_sleep(1);
        if ((++sp & 255u) == 0u) { if (xb_ld(&bar[XB_TMO])) break; if (sp > XB_SPIN_CAP) { atomicAdd(&bar[XB_TMO], 1u); break; } }
    }
    nloc = mine > 0u ? mine : 1u; nx = cnt > 0u ? cnt : 1u;
}

__device__ __forceinline__ void xcd_barrier(const XcdBarrier& b) {
    asm volatile("s_waitcnt vmcnt(0)" ::: "memory");
    __syncthreads();
    if (threadIdx.x == 0) {
        unsigned* bar = b.bar;
        __builtin_amdgcn_s_waitcnt(0);
        unsigned nloc = b.st[0], nx = b.st[1];
        if (nloc == 0u) { xcd_barrier_complete(bar, b.x, nloc, nx); b.st[0] = nloc; b.st[1] = nx; }
        const unsigned old = xb_add(&bar[XB_XSUB(b.x)], 1u);
        const unsigned gen = old / nloc;
        if (old + 1u == (gen + 1u) * nloc) {
            __builtin_amdgcn_fence(__ATOMIC_RELEASE, "agent");
            asm volatile("s_waitcnt vmcnt(0)" ::: "memory");
            const unsigned og = xb_add(&bar[XB_TOP], 1u);
            const unsigned tg = og / nx;
            if (og + 1u == (tg + 1u) * nx) xb_add(&bar[XB_TOPGEN], 1u);
            else XB_SPIN(xb_ld(&bar[XB_TOPGEN]) == tg, bar);
            __builtin_amdgcn_fence(__ATOMIC_ACQUIRE, "agent");
            xb_add(&bar[XB_XGEN(b.x)], 1u);
            asm volatile("s_waitcnt vmcnt(0)" ::: "memory");
        } else {
            XB_SPIN(xb_ld(&bar[XB_XGEN(b.x)]) == gen, bar);
            __builtin_amdgcn_fence(__ATOMIC_ACQUIRE, "agent");
            asm volatile("s_waitcnt vmcnt(0)" ::: "memory");
        }
    }
    __syncthreads();
}

constexpr int NWAVES = 8;
constexpr int BATCH = 4, SEQ = 2048, D = 2048, DFF = 5632, NGU = 2 * DFF, NIN = 6144, PLE = 256;
constexpr int HW = 1024, LW = 1024, HEADS = 8, HD = 128, CHUNK = 64, NCH = SEQ / CHUNK;
constexpr int M = BATCH * SEQ;
constexpr float EPS = 1e-6f;
constexpr int N_IN = 27;
enum In { I_X = 0, I_P, I_F1N, I_F1G, I_F1U, I_F1D, I_MIXN, I_WIN, I_HLB, I_HGN, I_CW, I_CB, I_LWA, I_LBA, I_LWX, I_LBX, I_LAM, I_WOUT,
          I_F2N, I_F2G, I_F2U, I_F2D, I_PLN, I_PWG, I_PBG, I_PWP, I_FN };

constexpr size_t MiB = 1u << 20;
constexpr size_t WS_CTL = 0, CTL_ZERO_BYTES = 1 * MiB;
constexpr size_t WS_SSQA = 1 * MiB, WS_SSQB = 2 * MiB, WS_DEC = 3 * MiB;
constexpr size_t WS_WAT = 3 * MiB + 512 * 1024, WS_WXT = 3 * MiB + 768 * 1024;
constexpr size_t WS_WPROJ = 4 * MiB, WS_PB = 5 * MiB;
constexpr size_t WS_WGU1 = 9 * MiB, WS_WD1 = 53 * MiB, WS_WINT = 75 * MiB, WS_WOUT = 99 * MiB, WS_WGU2 = 107 * MiB, WS_WD2 = 151 * MiB, WS_WPG = 173 * MiB;
constexpr size_t WS_XB = 181 * MiB;
constexpr size_t WS_ACT = 213 * MiB;
constexpr size_t WS_LOGF = WS_ACT, WS_V = WS_ACT + 32 * MiB, WS_SG = WS_ACT + 48 * MiB, WS_LRX = WS_ACT + 64 * MiB, WS_PP = WS_ACT;
constexpr size_t WS_MIXA = 301 * MiB;
constexpr size_t WS_KVT = 333 * MiB;
constexpr size_t WS_END = 397 * MiB;
static_assert(WS_WGU1 + (size_t)NGU * D * 2 <= WS_WD1 && WS_WD1 + (size_t)D * DFF * 2 <= WS_WINT && WS_WINT + (size_t)NIN * D * 2 <= WS_WOUT && WS_WOUT + (size_t)D * D * 2 <= WS_WGU2 &&
              WS_WGU2 + (size_t)NGU * D * 2 <= WS_WD2 && WS_WD2 + (size_t)D * DFF * 2 <= WS_WPG && WS_WPG + (size_t)D * D * 2 <= WS_XB && WS_XB + (size_t)M * D * 2 <= WS_ACT &&
              WS_ACT + (size_t)M * DFF * 2 <= WS_MIXA && WS_MIXA + (size_t)M * 2048 * 2 <= WS_KVT && WS_KVT + (size_t)BATCH * HEADS * NCH * HD * HD * 4 <= WS_END &&
              WS_LRX + (size_t)M * 1024 * 2 <= WS_MIXA && WS_PP + (size_t)M * D * 4 <= WS_MIXA && WS_PB + (size_t)M * PLE * 2 <= WS_WGU1 && WS_WPROJ + (size_t)D * PLE * 2 <= WS_PB, "d_ws map");
constexpr int CW_BAR = 4096;

constexpr int RING_OFF = 0, RING_BYTES = 131072;
constexpr int LDSCTL_OFF = RING_BYTES, MISC_OFF = LDSCTL_OFF + 320;
constexpr int LDS_BYTES = 147456;
static_assert(MISC_OFF + 128 <= LDS_BYTES, "LDS map");


struct Frame {
    LAS unsigned char* lds;
    volatile LAS unsigned* MISC;
    gu32* ctl;
    int tid, lane, wave;
    int vcu, G;
    const float* in[N_IN]; float* out; unsigned char* ws;
};
__device__ __forceinline__ float bf2f(bf16 b) { return __builtin_bit_cast(float, (unsigned)b << 16); }
__device__ __forceinline__ float wave_sum(float v) {
#pragma unroll
    for (int o = 1; o < 64; o <<= 1) v += __shfl_xor(v, o);
    return v;
}
__device__ __forceinline__ void p0_transpose_item(const float* W, int ldw, int K, int src_col0, bf16* WT, int dst_row0, const float* gain, LAS float* scr, int kb, int lane) {
    const int k0 = 64 * kb;
#pragma unroll 8
    for (int i = 0; i < 32; ++i) { const int kk = 2 * i + (lane >> 5); float v = W[(size_t)(k0 + kk) * ldw + src_col0 + (lane & 31)]; if (gain) v *= gain[k0 + kk]; scr[kk * 33 + (lane & 31)] = v; }
    LDS_WAIT(); asm volatile("" ::: "memory");
    const int c = lane & 7;
#pragma unroll
    for (int j = 0; j < 4; ++j) { const int n = (lane >> 3) + 8 * j; const LAS float* s = scr + (8 * c) * 33 + n;
        v4u o; o.x = pk2(s[0 * 33], s[1 * 33]); o.y = pk2(s[2 * 33], s[3 * 33]); o.z = pk2(s[4 * 33], s[5 * 33]); o.w = pk2(s[6 * 33], s[7 * 33]);
        *(GAS v4u*)(WT + (size_t)(dst_row0 + n) * K + k0 + 8 * c) = o; }
    LDS_WAIT(); asm volatile("" ::: "memory");
}
__device__ __forceinline__ bool p0_plain(int& r, const float* W, int K, int N, bf16* WT, const float* gain, LAS float* scr, int lane) {
    const int items = (N / 32) * (K / 64);
    if (r < items) { const int nb = r / (K / 64), kb = r % (K / 64); p0_transpose_item(W, N, K, 32 * nb, WT, 32 * nb, gain, scr, kb, lane); return true; }
    r -= items; return false;
}
__device__ __forceinline__ bool p0_gateup(int& r, const float* Wg, const float* Wu, bf16* WT, const float* gain, LAS float* scr, int lane) {
    const int items = (NGU / 32) * (D / 64);
    if (r < items) { const int rb = r / (D / 64), kb = r % (D / 64), t = rb >> 3, j = rb & 7;
        p0_transpose_item(j < 4 ? Wg : Wu, DFF, D, 128 * t + 32 * (j & 3), WT, 32 * rb, gain, scr, kb, lane); return true; }
    r -= items; return false;
}
__device__ __forceinline__ void p0_prologue(Frame& F) {
    LAS float* scr = (LAS float*)(F.lds + RING_OFF + F.wave * 16384);
    const int gw = F.vcu * NWAVES + F.wave, NGW = F.G * NWAVES;
    unsigned char* ws = F.ws;
    for (int m = gw; m < M; m += NGW) {
        const GAS f32x4* xr = (const GAS f32x4*)(F.in[I_X] + (size_t)m * D) + F.lane;
        GAS unsigned long long* o8 = (GAS unsigned long long*)((bf16*)(ws + WS_XB) + (size_t)m * D) + F.lane;
        float s = 0.f;
#pragma unroll
        for (int j = 0; j < 8; ++j) { const f32x4 v = xr[64 * j]; s += (v.x * v.x + v.y * v.y) + (v.z * v.z + v.w * v.w);
            o8[64 * j] = (unsigned long long)pk2(v.x, v.y) | ((unsigned long long)pk2(v.z, v.w) << 32); }
        s = wave_sum(s);
        if (F.lane < 32) ((float*)(ws + WS_SSQA))[(size_t)m * 32 + F.lane] = (F.lane == 0) ? s : 0.f;
    }
    for (int m = gw; m < M; m += NGW) {
        const f32x4 v = ((const GAS f32x4*)(F.in[I_P] + (size_t)m * PLE))[F.lane];
        ((GAS unsigned long long*)((bf16*)(ws + WS_PB) + (size_t)m * PLE))[F.lane] = (unsigned long long)pk2(v.x, v.y) | ((unsigned long long)pk2(v.z, v.w) << 32);
    }
    constexpr int NITEMS = 2 * (NGU / 32) * (D / 64) + 2 * (D / 32) * (DFF / 64) + (NIN / 32) * (D / 64) + 2 * (D / 32) * (D / 64) + (D / 32) * (PLE / 64) + 16 * (128 / 32) * (128 / 64);
    for (int it = gw; it < NITEMS; it += NGW) {
        int r = it;
        if (p0_gateup(r, F.in[I_F1G], F.in[I_F1U], (bf16*)(ws + WS_WGU1), F.in[I_F1N], scr, F.lane)) continue;
        if (p0_plain(r, F.in[I_F1D], DFF, D, (bf16*)(ws + WS_WD1), nullptr, scr, F.lane)) continue;
        if (p0_plain(r, F.in[I_WIN], D, NIN, (bf16*)(ws + WS_WINT), F.in[I_MIXN], scr, F.lane)) continue;
        if (p0_plain(r, F.in[I_WOUT], D, D, (bf16*)(ws + WS_WOUT), nullptr, scr, F.lane)) continue;
        if (p0_gateup(r, F.in[I_F2G], F.in[I_F2U], (bf16*)(ws + WS_WGU2), F.in[I_F2N], scr, F.lane)) continue;
        if (p0_plain(r, F.in[I_F2D], DFF, D, (bf16*)(ws + WS_WD2), nullptr, scr, F.lane)) continue;
        if (p0_plain(r, F.in[I_PWG], D, D, (bf16*)(ws + WS_WPG), F.in[I_PLN], scr, F.lane)) continue;
        if (p0_plain(r, F.in[I_PWP], PLE, D, (bf16*)(ws + WS_WPROJ), nullptr, scr, F.lane)) continue;
        { const int blk = r >> 3, q = r & 7;
          const float* W = (blk < 8 ? F.in[I_LWA] : F.in[I_LWX]) + (size_t)(blk & 7) * 128 * 128;
          bf16* WT = (bf16*)(ws + (blk < 8 ? WS_WAT : WS_WXT)) + (size_t)(blk & 7) * 128 * 128;
          p0_transpose_item(W, 128, 128, 32 * (q >> 1), WT, 32 * (q >> 1), nullptr, scr, q & 1, F.lane); }
    }
}
__device__ __forceinline__ void final_norm(Frame& F, const float* ssq) {
    const int gw = F.vcu * NWAVES + F.wave, NGW = F.G * NWAVES;
    const GAS f32x4* gf = (const GAS f32x4*)F.in[I_FN] + F.lane;
    for (int m = gw; m < M; m += NGW) {
        float s = (F.lane < 32) ? ssq[(size_t)m * 32 + F.lane] : 0.f;
        s = wave_sum(s);
        const float rstd = 1.0f / sqrtf(s * (1.0f / D) + EPS);
        GAS f32x4* xr = (GAS f32x4*)(F.out + (size_t)m * D) + F.lane;
#pragma unroll
        for (int j = 0; j < 8; ++j) { f32x4 v = xr[64 * j]; const f32x4 g = gf[64 * j]; v = v * rstd * g; xr[64 * j] = v; }
    }
}

constexpr int N_PHASES = 12;
struct Args { const float* in[N_IN]; float* out; unsigned char* ws; int ph_lo, ph_hi, li, pad; };
__global__ void __launch_bounds__(NWAVES * 64, 2) mega_fwd(Args args) {
    extern __shared__ __attribute__((aligned(16))) unsigned char lds[];
    Frame F;
    F.lds = (LAS unsigned char*)lds;
    F.MISC = (volatile LAS unsigned*)(F.lds + MISC_OFF);
    F.tid = threadIdx.x; F.lane = F.tid & 63; F.wave = __builtin_amdgcn_readfirstlane(F.tid >> 6);
    F.G = gridDim.x; { const int bx = blockIdx.x; F.vcu = (F.G % 8 == 0) ? (bx % 8) * (F.G / 8) + bx / 8 : bx; }
#pragma unroll
    for (int i = 0; i < N_IN; ++i) F.in[i] = args.in[i];
    F.out = args.out; F.ws = args.ws;
    unsigned char* ws = args.ws;
    F.ctl = (gu32*)(ws + WS_CTL);
    for (int u = F.tid; u < (LDS_BYTES - LDSCTL_OFF) / 4; u += NWAVES * 64) ((LAS unsigned*)(F.lds + LDSCTL_OFF))[u] = 0u;
    __syncthreads();
    const int lo = args.ph_lo, hi = args.ph_hi;
    const bool multi = (hi - lo) > 1;
    XcdBarrier bar; bar.bar = (unsigned*)(F.ctl + CW_BAR) + args.li * XCD_BAR_WORDS; bar.x = 0; bar.st = nullptr;
    if (multi) bar = xcd_barrier_post((unsigned*)(F.ctl + CW_BAR) + args.li * XCD_BAR_WORDS, F.MISC + 8);

    bf16* const XB = (bf16*)(ws + WS_XB); bf16* const ACT = (bf16*)(ws + WS_ACT); bf16* const MIXA = (bf16*)(ws + WS_MIXA);
    float* const SSQA = (float*)(ws + WS_SSQA); float* const SSQB = (float*)(ws + WS_SSQB);


#define IN(k) (lo <= (k) && (k) < hi)
#define SEAM(k) do { if (IN(k) && IN((k) + 1)) xcd_barrier(bar); } while (0)
#define GEMM_SWIGLU(WOFF) do { pg8::Gemm g{XB, (const bf16*)(ws + (WOFF)), M, NGU, D}; pg8::StaticOrder S; S.init(M, NGU, F.G, (int)blockIdx.x); \
        pg8::EpiSwiGLU E{ACT, DFF, SSQA}; pg8::gemm_phase<pg8::EpiSwiGLU, pg8::StaticOrder, true, true>(F.lds + RING_OFF, g, S, E); } while (0)
#define GEMM_RESID(AP, WOFF, KK, SRC, SSQO, SC) do { pg8::Gemm g{(AP), (const bf16*)(ws + (WOFF)), M, D, (KK)}; pg8::StaticOrder S; S.init(M, D, F.G, (int)blockIdx.x); \
        pg8::EpiResid E{(SRC), F.out, XB, (SSQO), (SC)}; pg8::gemm_phase<pg8::EpiResid, pg8::StaticOrder, true, true>(F.lds + RING_OFF, g, S, E); } while (0)

    if (IN(0)) { p0_prologue(F); SEAM(0); }
    if (IN(1)) { GEMM_SWIGLU(WS_WGU1); SEAM(1); }
    if (IN(2)) { GEMM_RESID(ACT, WS_WD1, DFF, F.in[I_X], SSQB, 0.5f); SEAM(2); }
    if (IN(3)) {
        pg8::Gemm g{XB, (const bf16*)(ws + WS_WINT), M, NIN, D}; pg8::StaticOrder S; S.init(M, NIN, F.G, (int)blockIdx.x);
        pg8::EpiZ E{SSQB, F.in[I_HLB], MIXA, (float*)(ws + WS_LOGF), (bf16*)(ws + WS_V), (bf16*)(ws + WS_SG), (bf16*)(ws + WS_LRX)};
        pg8::gemm_phase<pg8::EpiZ, pg8::StaticOrder, true, true>(F.lds + RING_OFF, g, S, E);
        SEAM(3); }
    if (IN(4)) { MIXER_PHASE_4 SEAM(4); }
    if (IN(5)) { MIXER_PHASE_5 SEAM(5); }
    if (IN(6)) { MIXER_PHASE_6 SEAM(6); }
    if (IN(7)) { GEMM_RESID(MIXA, WS_WOUT, D, F.out, SSQA, 1.0f); SEAM(7); }
    if (IN(8)) { GEMM_SWIGLU(WS_WGU2); SEAM(8); }
    if (IN(9)) { GEMM_RESID(ACT, WS_WD2, DFF, F.out, SSQB, 0.5f); SEAM(9); }
    if (IN(10)) {
        { pg8::Gemm g{(const bf16*)(ws + WS_PB), (const bf16*)(ws + WS_WPROJ), M, D, PLE}; pg8::StaticOrder S; S.init(M, D, F.G, (int)blockIdx.x);
          pg8::EpiPP E{(float*)(ws + WS_PP)};
          pg8::gemm_phase<pg8::EpiPP, pg8::StaticOrder, true, true>(F.lds + RING_OFF, g, S, E); }
        { pg8::Gemm g{XB, (const bf16*)(ws + WS_WPG), M, D, D}; pg8::StaticOrder S; S.init(M, D, F.G, (int)blockIdx.x);
          pg8::EpiPLE E{SSQB, F.in[I_PBG], (const float*)(ws + WS_PP), F.out, SSQA};
          pg8::gemm_phase<pg8::EpiPLE, pg8::StaticOrder, true, true>(F.lds + RING_OFF, g, S, E); }
        SEAM(10); }
    if (IN(11)) { final_norm(F, SSQA); }
#undef IN
#undef SEAM
}

#if SIMPLE_MIXER
__global__ void __launch_bounds__(64) k_simple_hgrn(const float* logf, const bf16* mixa, const bf16* vv, float* oh) {
    __shared__ float sf[128], sk[128], sq[128];
    const int bh = blockIdx.x >> 1, vh = blockIdx.x & 1, b = bh >> 3, h = bh & 7, lane = threadIdx.x, v = vh * 64 + lane;
    float S[128];
#pragma unroll
    for (int k = 0; k < 128; ++k) S[k] = 0.f;
    for (int t = 0; t < SEQ; ++t) {
        const size_t row = (size_t)b * SEQ + t;
        for (int kk = lane; kk < 128; kk += 64) { const float f = __expf(logf[row * 1024 + h * 128 + kk]); sf[kk] = f; sk[kk] = 1.f - f; sq[kk] = bf2f(mixa[row * 2048 + h * 128 + kk]); }
        __syncthreads();
        const float vt = bf2f(vv[row * 1024 + h * 128 + v]); float o = 0.f;
#pragma unroll
        for (int k = 0; k < 128; ++k) { S[k] = sf[k] * S[k] + sk[k] * vt; o += S[k] * sq[k]; }
        oh[row * 1024 + h * 128 + v] = o;
        __syncthreads();
    }
}
__global__ void __launch_bounds__(256) k_simple_hnorm(const float* oh, const bf16* sg, const float* gn, bf16* mixa) {
    const int gw = (blockIdx.x * 256 + threadIdx.x) >> 6, lane = threadIdx.x & 63;
    if (gw >= M * HEADS) return;
    const int row = gw >> 3, h = gw & 7;
    const float o0 = oh[(size_t)row * 1024 + h * 128 + lane], o1 = oh[(size_t)row * 1024 + h * 128 + 64 + lane];
    const float ss = wave_sum(o0 * o0 + o1 * o1);
    const float r = 1.0f / sqrtf(ss * (1.0f / 128.0f) + EPS);
    mixa[(size_t)row * 2048 + h * 128 + lane] = (bf16)f2bf(o0 * r * gn[lane] * bf2f(sg[(size_t)row * 1024 + h * 128 + lane]));
    mixa[(size_t)row * 2048 + h * 128 + 64 + lane] = (bf16)f2bf(o1 * r * gn[64 + lane] * bf2f(sg[(size_t)row * 1024 + h * 128 + 64 + lane]));
}
__global__ void __launch_bounds__(256) k_simple_lru_a(const bf16* lrx, const float* cw, const float* cb, const float* wa, const float* ba, const float* wx, const float* bx, const float* lam, float* LA, float* LU) {
    __shared__ float xc[1024];
    const int row = blockIdx.x, tt = row % SEQ, tid = threadIdx.x;
    for (int c = tid; c < 1024; c += 256) { float s = cb[c];
        for (int j = 0; j < 4; ++j) { const int ts = tt - 3 + j; if (ts >= 0) s += cw[j * 1024 + c] * bf2f(lrx[(size_t)(row - 3 + j) * 1024 + c]); }
        xc[c] = s; }
    __syncthreads();
    for (int d = tid; d < 1024; d += 256) { const int n = d >> 7, dd = d & 127; float r = ba[d], g = bx[d];
        for (int c = 0; c < 128; ++c) { const float x = xc[n * 128 + c]; r += x * wa[((size_t)n * 128 + c) * 128 + dd]; g += x * wx[((size_t)n * 128 + c) * 128 + dd]; }
        r = 1.0f / (1.0f + __expf(-r)); g = 1.0f / (1.0f + __expf(-g));
        const float log_a = -8.0f * r * log1pf(__expf(-lam[d]));
        LA[(size_t)row * 1024 + d] = __expf(log_a); LU[(size_t)row * 1024 + d] = sqrtf(-expm1f(2.0f * log_a)) * g * xc[d]; }
}
__global__ void __launch_bounds__(256) k_simple_lru_b(const float* LA, const float* LU, bf16* mixa) {
    const int gi = blockIdx.x * 256 + threadIdx.x, b = gi >> 10, c = gi & 1023; float h = 0.f;
#pragma unroll 8
    for (int t = 0; t < SEQ; ++t) { const size_t row = (size_t)b * SEQ + t; h = LA[row * 1024 + c] * h + LU[row * 1024 + c];
        bf16* p = mixa + row * 2048 + 1024 + c; *p = (bf16)f2bf(h * bf2f(*p)); }
}
#endif

extern "C" void kernel_launch(void* const* d_in, const int* in_sizes, int n_in, void* d_out, int out_size, void* d_ws, size_t ws_size, hipStream_t stream) {
    static int grid = 0;
    if (grid == 0) {
        if (n_in != N_IN || in_sizes[0] != M * D || out_size != M * D || ws_size < WS_END) { fprintf(stderr, "kernel_launch: unexpected problem (n_in %d, in0 %d, out %d, ws %zu); nothing launched\n", n_in, n_in > 0 ? in_sizes[0] : -1, out_size, ws_size); grid = -1; return; }
        int dev = 0, cus = 0, per_cu = 0;
        if (hipGetDevice(&dev) != hipSuccess || hipDeviceGetAttribute(&cus, hipDeviceAttributeMultiprocessorCount, dev) != hipSuccess) { grid = -1; return; }
        if (hipFuncSetAttribute((const void*)mega_fwd, hipFuncAttributeMaxDynamicSharedMemorySize, LDS_BYTES) != hipSuccess) { fprintf(stderr, "kernel_launch: hipFuncSetAttribute failed\n"); grid = -1; return; }
        if (hipOccupancyMaxActiveBlocksPerMultiprocessor(&per_cu, (const void*)mega_fwd, NWAVES * 64, LDS_BYTES) != hipSuccess || per_cu < 1)
            fprintf(stderr, "kernel_launch: note: occupancy query reports %d workgroups per CU\n", per_cu);
        (void)hipGetLastError();
        grid = cus;
    }
    if (grid < 0) return;
    if (hipMemsetAsync((char*)d_ws + WS_CTL, 0, CTL_ZERO_BYTES, stream) != hipSuccess) return;
    Args a{};
    for (int i = 0; i < N_IN; ++i) a.in[i] = (const float*)d_in[i];
    a.out = (float*)d_out; a.ws = (unsigned char*)d_ws;
    unsigned char* ws = (unsigned char*)d_ws;
    auto launch = [&](int lo, int hi, int li) { a.ph_lo = lo; a.ph_hi = hi; a.li = li; hipLaunchKernelGGL(mega_fwd, dim3(grid), dim3(NWAVES * 64), LDS_BYTES, stream, a); };
#if SIMPLE_MIXER
    for (int ph = 0; ph <= 3; ++ph) launch(ph, ph + 1, 0);
    {   float* OH = (float*)(ws + WS_XB); float* LA = (float*)(ws + WS_KVT); float* LU = LA + (size_t)M * 1024;
        hipLaunchKernelGGL(k_simple_hgrn, dim3(64), dim3(64), 0, stream, (const float*)(ws + WS_LOGF), (const bf16*)(ws + WS_MIXA), (const bf16*)(ws + WS_V), OH);
        hipLaunchKernelGGL(k_simple_hnorm, dim3(M * HEADS / 4), dim3(256), 0, stream, (const float*)OH, (const bf16*)(ws + WS_SG), (const float*)d_in[I_HGN], (bf16*)(ws + WS_MIXA));
        hipLaunchKernelGGL(k_simple_lru_a, dim3(M), dim3(256), 0, stream, (const bf16*)(ws + WS_LRX), (const float*)d_in[I_CW], (const float*)d_in[I_CB], (const float*)d_in[I_LWA], (const float*)d_in[I_LBA],
                           (const float*)d_in[I_LWX], (const float*)d_in[I_LBX], (const float*)d_in[I_LAM], LA, LU);
        hipLaunchKernelGGL(k_simple_lru_b, dim3(BATCH * 1024 / 256), dim3(256), 0, stream, (const float*)LA, (const float*)LU, (bf16*)(ws + WS_MIXA)); }
    for (int ph = 7; ph < N_PHASES; ++ph) launch(ph, ph + 1, 0);
#else
#if N_LAUNCHES == 1
    launch(0, N_PHASES, 0);
#else
    for (int ph = 0; ph < N_PHASES; ++ph) launch(ph, ph + 1, 0);
#endif
#endif
}
```

```cpp
#include <hip/hip_runtime.h>
#include <cstdio>
#include <cstdint>
#ifndef SIMPLE_HGRN
#define SIMPLE_HGRN 0
#endif
#ifndef SIMPLE_LRU
#define SIMPLE_LRU 0
#endif
#ifndef N_LAUNCHES
#define N_LAUNCHES 1
#endif
#if SIMPLE_HGRN
#define MIXER_PHASE_4
#define MIXER_PHASE_6
#define MIXER_SCAN
#else
#define MIXER_PHASE_4 hgrn_local_phase(F);
#define MIXER_PHASE_6 hgrn_out_phase(F);
#define MIXER_SCAN hgrn_scan_phase(F);
#endif
#if SIMPLE_LRU
#define MIXER_LRU
#else
#define MIXER_LRU lru_phase(F);
#endif
#define MIXER_PHASE_5 MIXER_SCAN MIXER_LRU
namespace pg8 {
#define PG8_LAS __attribute__((address_space(3)))
typedef unsigned short bf16_t;
typedef short bf16x8 __attribute__((ext_vector_type(8)));
typedef float f32x4 __attribute__((ext_vector_type(4)));
typedef unsigned u32x4 __attribute__((ext_vector_type(4)));
constexpr int BM = 256, BK = 64, HALF = 128, HTB = HALF * BK * 2  , STAGE_BYTES = 8 * HTB, NXCD = 8, WGM = 8;

__host__ __device__ __forceinline__ int lds_byte(int r, int c) { const int st = (r >> 4) * 2 + (c >> 5), rr = r & 15, cc = c & 31, ob = rr * 64 + cc * 2; return st * 1024 + (ob ^ (((ob >> 9) & 1) << 5)); }
__host__ __device__ __forceinline__ void stage_rc(int b, int& R, int& C) { const int st = b / 1024, sb = b % 1024, swz = sb ^ (((sb >> 9) & 1) << 5); R = (st >> 1) * 16 + swz / 64; C = (st & 1) * 32 + (swz % 64) / 2; }
__host__ __device__ __forceinline__ int perm32(int rho) { const int n = rho >> 4, i = rho & 15; return 8 * (i >> 2) + 4 * n + (i & 3); }

struct Unit { int pm, pn; };
struct Gemm { const bf16_t* A; const bf16_t* Bt; int M, N, K; };

struct StaticOrder {
    int nM, nN, nwg, G, c;
    __host__ __device__ void init(int M, int N, int G_, int c_) { nM = M / BM; nN = N / BM; nwg = nM * nN; G = G_; c = c_; }
    __host__ __device__ bool next(int i, Unit& u) const {
        const long L = (long)i * G + c; if (L >= nwg) return false;
        int wgid = (int)L; { const int q = nwg / NXCD, r = nwg % NXCD, xcd = wgid % NXCD, off = wgid / NXCD; wgid = (xcd < r ? xcd * (q + 1) : r * (q + 1) + (xcd - r) * q) + off; }
        const int nig = WGM * nN, gid = wgid / nig, fm = gid * WGM, gsz = (nM - fm) < WGM ? (nM - fm) : WGM;
        u.pm = fm + ((wgid % nig) % gsz); u.pn = (wgid % nig) / gsz; return true;
    }
    __device__ __forceinline__ void a_ready(const Unit&) const {}
    __device__ __forceinline__ void done(const Unit&) const {}
};
__device__ __forceinline__ unsigned cvt_pk_bf16(float lo, float hi) { unsigned r; asm volatile("v_cvt_pk_bf16_f32 %0, %1, %2" : "=v"(r) : "v"(lo), "v"(hi)); return r; }
typedef unsigned u32x2 __attribute__((ext_vector_type(2)));
constexpr int DM = 2048;
constexpr int NSSQ = 32;
__device__ __forceinline__ float sigmoid_f(float x) { return __builtin_amdgcn_rcpf(1.0f + __expf(-x)); }
__device__ __forceinline__ float silu_f(float x) { return x * sigmoid_f(x); }
__device__ __forceinline__ float gelu_tanh_f(float x) { return x * sigmoid_f(1.5957691216057308f * (x + 0.044715f * x * x * x)); }
__device__ __forceinline__ float row_rstd(const float* ssq, int row, int fq) {
    const f32x4* p = (const f32x4*)(ssq + (size_t)row * NSSQ + fq * 8);
    const f32x4 a = p[0], b = p[1];
    float s = ((a[0] + a[1]) + (a[2] + a[3])) + ((b[0] + b[1]) + (b[2] + b[3]));
    s += __shfl_xor(s, 16); s += __shfl_xor(s, 32);
    return 1.0f / sqrtf(s * (1.0f / (float)DM) + 1e-6f);
}

struct EpiSwiGLU {
    static constexpr bool PERM = true, AFTER_DRAIN = false;
    bf16_t* O; int ldo; const float* ssq;
    __device__ __forceinline__ void operator()(const f32x4 (&acc)[2][2][4][2], const Unit& u, int wr, int wc, int fr, int fq) const {
        const int row0 = u.pm * BM + wr * 64 + fr, col0 = u.pn * HALF + wc * 32 + 8 * fq;
#pragma unroll
        for (int ai = 0; ai < 2; ++ai)
#pragma unroll
            for (int m = 0; m < 4; ++m) {
                const int row = row0 + ai * HALF + m * 16; const float rs = row_rstd(ssq, row, fq);
                float h[8];
#pragma unroll
                for (int n = 0; n < 2; ++n)
#pragma unroll
                    for (int j = 0; j < 4; ++j) { const float g = acc[ai][0][m][n][j] * rs, up = acc[ai][1][m][n][j] * rs; h[n * 4 + j] = silu_f(g) * up; }
                u32x4 w; w.x = cvt_pk_bf16(h[0], h[1]); w.y = cvt_pk_bf16(h[2], h[3]); w.z = cvt_pk_bf16(h[4], h[5]); w.w = cvt_pk_bf16(h[6], h[7]);
                *(u32x4*)(O + (size_t)row * ldo + col0) = w;
            }
    }
};
struct EpiResid {
    static constexpr bool PERM = false, AFTER_DRAIN = false;
    const float* src; float* dst; bf16_t* xb; float* ssq_out; float scale;
    __device__ __forceinline__ void operator()(const f32x4 (&acc)[2][2][4][2], const Unit& u, int wr, int wc, int fr, int fq) const {
        const int row0 = u.pm * BM + wr * 64 + fr, col0 = u.pn * BM + wc * 32 + 4 * fq;
#pragma unroll
        for (int ai = 0; ai < 2; ++ai)
#pragma unroll
            for (int m = 0; m < 4; ++m) {
                const int row = row0 + ai * HALF + m * 16; float ss = 0.f;
#pragma unroll
                for (int bj = 0; bj < 2; ++bj)
#pragma unroll
                    for (int n = 0; n < 2; ++n) { const size_t off = (size_t)row * DM + col0 + bj * HALF + n * 16;
                        const f32x4 o = *(const f32x4*)(src + off) + acc[ai][bj][m][n] * scale;
                        *(f32x4*)(dst + off) = o; u32x2 w; w.x = cvt_pk_bf16(o[0], o[1]); w.y = cvt_pk_bf16(o[2], o[3]); *(u32x2*)(xb + off) = w;
                        ss += (o[0] * o[0] + o[1] * o[1]) + (o[2] * o[2] + o[3] * o[3]); }
                ss += __shfl_xor(ss, 16); ss += __shfl_xor(ss, 32);
                if (fq == 0) ssq_out[(size_t)row * NSSQ + u.pn * 4 + wc] = ss;
            }
    }
};
struct EpiZ {
    static constexpr bool PERM = true, AFTER_DRAIN = false;
    const float* ssq; const float* hlb;
    bf16_t* mixa;
    float* logf; bf16_t* vv; bf16_t* sg; bf16_t* lrx;
    __device__ __forceinline__ void operator()(const f32x4 (&acc)[2][2][4][2], const Unit& u, int wr, int wc, int fr, int fq) const {
        const int seg = u.pn >> 2;
        const int row0 = u.pm * BM + wr * 64 + fr, cs0 = (u.pn & 3) * BM + wc * 32 + 8 * fq;
        float lbv[2][8];
        if (seg == 1) {
#pragma unroll
            for (int bj = 0; bj < 2; ++bj)
#pragma unroll
                for (int e = 0; e < 8; ++e) { const int c = cs0 + bj * HALF + e; lbv[bj][e] = sigmoid_f(hlb[c] - hlb[1024 + c]); }
        }
#pragma unroll
        for (int ai = 0; ai < 2; ++ai)
#pragma unroll
            for (int m = 0; m < 4; ++m) {
                const int row = row0 + ai * HALF + m * 16; const float rs = row_rstd(ssq, row, fq);
#pragma unroll
                for (int bj = 0; bj < 2; ++bj) {
                    const int cs = cs0 + bj * HALF;
                    float z[8];
#pragma unroll
                    for (int n = 0; n < 2; ++n)
#pragma unroll
                        for (int j = 0; j < 4; ++j) z[n * 4 + j] = acc[ai][bj][m][n][j] * rs;
                    if (seg == 1) {
                        float lf[8];
#pragma unroll
                        for (int e = 0; e < 8; ++e) { const float lb = lbv[bj][e]; lf[e] = __logf(lb + (1.0f - lb) * sigmoid_f(z[e])); }
                        float* p = logf + (size_t)row * 1024 + cs;
                        *(f32x4*)p = (f32x4){lf[0], lf[1], lf[2], lf[3]}; *(f32x4*)(p + 4) = (f32x4){lf[4], lf[5], lf[6], lf[7]};
                    } else {
                        if (seg == 3) {
#pragma unroll
                            for (int e = 0; e < 8; ++e) z[e] = silu_f(z[e]);
                        } else if (seg == 5) {
#pragma unroll
                            for (int e = 0; e < 8; ++e) z[e] = gelu_tanh_f(z[e]);
                        }
                        u32x4 w; w.x = cvt_pk_bf16(z[0], z[1]); w.y = cvt_pk_bf16(z[2], z[3]); w.z = cvt_pk_bf16(z[4], z[5]); w.w = cvt_pk_bf16(z[6], z[7]);
                        bf16_t* p;
                        if (seg == 0) p = mixa + (size_t)row * 2048 + cs;
                        else if (seg == 5) p = mixa + (size_t)row * 2048 + 1024 + cs;
                        else if (seg == 2) p = vv + (size_t)row * 1024 + cs;
                        else if (seg == 3) p = sg + (size_t)row * 1024 + cs;
                        else p = lrx + (size_t)row * 1024 + cs;
                        *(u32x4*)p = w;
                    }
                }
            }
    }
};
struct EpiPP {
    static constexpr bool PERM = false, AFTER_DRAIN = false;
    float* PP;
    __device__ __forceinline__ void operator()(const f32x4 (&acc)[2][2][4][2], const Unit& u, int wr, int wc, int fr, int fq) const {
        const int row0 = u.pm * BM + wr * 64 + fr, col0 = u.pn * BM + wc * 32 + 4 * fq;
#pragma unroll
        for (int ai = 0; ai < 2; ++ai)
#pragma unroll
            for (int m = 0; m < 4; ++m) { float* rowp = PP + (size_t)(row0 + ai * HALF + m * 16) * DM + col0;
#pragma unroll
                for (int bj = 0; bj < 2; ++bj)
#pragma unroll
                    for (int n = 0; n < 2; ++n) *(f32x4*)(rowp + bj * HALF + n * 16) = acc[ai][bj][m][n]; }
    }
};
struct EpiPLE {
    static constexpr bool PERM = false, AFTER_DRAIN = false;
    const float* ssq_in; const float* bg; const float* PP; float* X; float* ssq_out;
    __device__ __forceinline__ void operator()(const f32x4 (&acc)[2][2][4][2], const Unit& u, int wr, int wc, int fr, int fq) const {
        const int row0 = u.pm * BM + wr * 64 + fr, col0 = u.pn * BM + wc * 32 + 4 * fq;
#pragma unroll
        for (int ai = 0; ai < 2; ++ai)
#pragma unroll
            for (int m = 0; m < 4; ++m) {
                const int row = row0 + ai * HALF + m * 16; const float rs = row_rstd(ssq_in, row, fq); float ss = 0.f;
#pragma unroll
                for (int bj = 0; bj < 2; ++bj)
#pragma unroll
                    for (int n = 0; n < 2; ++n) { const int c = col0 + bj * HALF + n * 16; const size_t off = (size_t)row * DM + c;
                        const f32x4 b4 = *(const f32x4*)(bg + c), pp = *(const f32x4*)(PP + off), old = *(const f32x4*)(X + off), a = acc[ai][bj][m][n];
                        f32x4 o;
#pragma unroll
                        for (int j = 0; j < 4; ++j) o[j] = old[j] + sigmoid_f(a[j] * rs + b4[j]) * pp[j];
                        *(f32x4*)(X + off) = o; ss += (o[0] * o[0] + o[1] * o[1]) + (o[2] * o[2] + o[3] * o[3]);
                        asm volatile("" ::: "memory"); }
                ss += __shfl_xor(ss, 16); ss += __shfl_xor(ss, 32);
                if (fq == 0) ssq_out[(size_t)row * NSSQ + u.pn * 4 + wc] = ss;
            }
    }
};

template <class Epi, class Sched, bool ALIGN_EPI = false, bool SP2 = false>
__device__ __forceinline__ void gemm_phase(PG8_LAS unsigned char* lds, const Gemm g, const Sched& S, const Epi& E) {
    int tid_ = threadIdx.x; asm volatile("" : "+v"(tid_));
    const int tid = tid_, wid = __builtin_amdgcn_readfirstlane(tid >> 6), lane = tid & 63, wr = wid >> 2, wc = wid & 3, fr = lane & 15, fq = lane >> 4;
    const int K = g.K, nt = K / BK;
    unsigned voffA[2], voffB[2];
#pragma unroll
    for (int i = 0; i < 2; ++i) { int R, C; stage_rc(tid * 16 + i * 8192, R, C); const int Rb = Epi::PERM ? ((R & ~31) + perm32(R & 31)) : R;
        voffA[i] = (unsigned)(R * K + C) * 2u; voffB[i] = (unsigned)(Rb * K + C) * 2u; }
    const size_t kstep = (size_t)(BK * 2);
    const size_t hstep = (size_t)HALF * K * 2;
    const size_t tstep = 2 * hstep;
    const unsigned ldsw = (unsigned)wid * 1024u;
    const int aoff = lds_byte(wr * 64 + fr, fq * 8), boff = lds_byte(wc * 32 + fr, fq * 8);
#define PG8_SA(b, h) (((b) * 2 + (h)) * HTB)
#define PG8_SB(b, h) ((4 + (b) * 2 + (h)) * HTB)
#define PG8_STAGE(bufoff, gbase, voff) do { _Pragma("unroll") for (int _i = 0; _i < 2; ++_i) \
        __builtin_amdgcn_global_load_lds((const unsigned*)((const char*)(gbase) + (voff)[_i]), (PG8_LAS unsigned*)(lds + (bufoff) + ldsw + _i * 8192), 16, 0, 0); } while (0)
#define PG8_LDA(dst, b, h) do { _Pragma("unroll") for (int m = 0; m < 4; ++m) _Pragma("unroll") for (int k = 0; k < 2; ++k) dst[m][k] = *(const PG8_LAS bf16x8*)(lds + PG8_SA(b, h) + aoff + m * 2048 + k * 1024); } while (0)
#define PG8_LDB(dst, b, h) do { _Pragma("unroll") for (int n = 0; n < 2; ++n) _Pragma("unroll") for (int k = 0; k < 2; ++k) dst[n][k] = *(const PG8_LAS bf16x8*)(lds + PG8_SB(b, h) + boff + n * 2048 + k * 1024); } while (0)
#define PG8_MMA(ai, bj, At, Bt) do { __builtin_amdgcn_s_setprio(1); _Pragma("unroll") for (int m = 0; m < 4; ++m) _Pragma("unroll") for (int n = 0; n < 2; ++n) _Pragma("unroll") for (int k = 0; k < 2; ++k) \
        acc[ai][bj][m][n] = __builtin_amdgcn_mfma_f32_16x16x32_bf16(Bt[n][k], At[m][k], acc[ai][bj][m][n], 0, 0, 0); __builtin_amdgcn_s_setprio(0); } while (0)
#define PG8_WAIT_V(n) asm volatile("s_waitcnt vmcnt(" #n ")" ::: "memory")
#define PG8_WAIT_L(n) asm volatile("s_waitcnt lgkmcnt(" #n ")" ::: "memory")
#define PG8_BAR __builtin_amdgcn_s_barrier()
#define PG8_SCHED __builtin_amdgcn_sched_barrier(0)
    Unit cur, nxt; int ui = 0;
    if (!S.next(0, cur)) return;
    f32x4 acc[2][2][4][2];
#pragma unroll
    for (int a = 0; a < 2; ++a)
#pragma unroll
        for (int b = 0; b < 2; ++b)
#pragma unroll
            for (int m = 0; m < 4; ++m)
#pragma unroll
                for (int n = 0; n < 2; ++n) acc[a][b][m][n] = (f32x4){0.f, 0.f, 0.f, 0.f};
    bf16x8 At[4][2], B0[2][2], B1[2][2];
    const char* cA = (const char*)g.A + (size_t)cur.pm * tstep; const char* cB = (const char*)g.Bt + (size_t)cur.pn * tstep;
    S.a_ready(cur);
    if constexpr (SP2) {
        PG8_STAGE(PG8_SB(0, 0), cB, voffB); PG8_STAGE(PG8_SB(0, 1), cB + hstep, voffB); PG8_STAGE(PG8_SA(0, 0), cA, voffA); PG8_STAGE(PG8_SA(0, 1), cA + hstep, voffA);
        if (wr == 1) PG8_BAR;
        PG8_WAIT_V(2); PG8_BAR;
        PG8_STAGE(PG8_SB(1, 0), cB + kstep, voffB); PG8_STAGE(PG8_SA(1, 0), cA + kstep, voffA); PG8_STAGE(PG8_SB(1, 1), cB + hstep + kstep, voffB);
        PG8_WAIT_V(6); PG8_BAR;
    } else {
        PG8_STAGE(PG8_SB(0, 0), cB, voffB); PG8_STAGE(PG8_SA(0, 0), cA, voffA); PG8_STAGE(PG8_SB(0, 1), cB + hstep, voffB); PG8_STAGE(PG8_SA(0, 1), cA + hstep, voffA);
        if (wr == 1) PG8_BAR;
        PG8_WAIT_V(4); PG8_BAR;
        PG8_STAGE(PG8_SB(1, 0), cB + kstep, voffB); PG8_STAGE(PG8_SA(1, 0), cA + kstep, voffA); PG8_STAGE(PG8_SB(1, 1), cB + hstep + kstep, voffB);
        PG8_WAIT_V(6); PG8_BAR;
    }
    for (;;) {
        const bool has_next = S.next(ui + 1, nxt);
        const char* nA = has_next ? (const char*)g.A + (size_t)nxt.pm * tstep : cA; const char* nB = has_next ? (const char*)g.Bt + (size_t)nxt.pn * tstep : cB;
        for (int t = 0; t < nt; t += 2) {
            const bool last = (t == nt - 2);
            const char* a1 = cA + (size_t)(t + 1) * kstep;
            const char* a2 = last ? nA : cA + (size_t)(t + 2) * kstep; const char* b2 = last ? nB : cB + (size_t)(t + 2) * kstep;
            const char* a3 = a2 + kstep; const char* b3 = b2 + kstep;
            if (last && has_next) S.a_ready(nxt);
            if constexpr (SP2) {
            PG8_LDB(B0, 0, 0); PG8_LDB(B1, 0, 1); PG8_SCHED; PG8_LDA(At, 0, 0); PG8_STAGE(PG8_SA(1, 1), a1 + hstep, voffA);
            PG8_WAIT_V(8); PG8_WAIT_L(0); PG8_BAR; PG8_MMA(0, 0, At, B0); PG8_MMA(0, 1, At, B1); PG8_BAR; PG8_SCHED;
            PG8_LDA(At, 0, 1); PG8_STAGE(PG8_SB(0, 0), b2, voffB); PG8_STAGE(PG8_SB(0, 1), b2 + hstep, voffB); PG8_STAGE(PG8_SA(0, 0), a2, voffA);
            PG8_WAIT_V(8); PG8_WAIT_L(0); PG8_BAR; PG8_MMA(1, 0, At, B0); PG8_MMA(1, 1, At, B1); PG8_BAR; PG8_SCHED;
            PG8_LDB(B0, 1, 0); PG8_LDB(B1, 1, 1); PG8_SCHED; PG8_LDA(At, 1, 0); PG8_STAGE(PG8_SA(0, 1), a2 + hstep, voffA);
            PG8_WAIT_V(8); PG8_WAIT_L(0); PG8_BAR; PG8_MMA(0, 0, At, B0); PG8_MMA(0, 1, At, B1); PG8_BAR; PG8_SCHED;
            PG8_LDA(At, 1, 1); PG8_STAGE(PG8_SB(1, 0), b3, voffB); PG8_STAGE(PG8_SB(1, 1), b3 + hstep, voffB); PG8_STAGE(PG8_SA(1, 0), a3, voffA);
            PG8_WAIT_V(8); PG8_WAIT_L(0); PG8_BAR; PG8_MMA(1, 0, At, B0); PG8_MMA(1, 1, At, B1); PG8_BAR; PG8_SCHED;
            } else {
            PG8_LDB(B0, 0, 0); PG8_SCHED; PG8_LDA(At, 0, 0); PG8_STAGE(PG8_SA(1, 1), a1 + hstep, voffA);
            PG8_WAIT_L(8); PG8_BAR; PG8_WAIT_L(0); PG8_MMA(0, 0, At, B0); PG8_BAR; PG8_SCHED;
            PG8_LDB(B1, 0, 1); PG8_STAGE(PG8_SB(0, 0), b2, voffB);
            PG8_BAR; PG8_WAIT_L(0); PG8_MMA(0, 1, At, B1); PG8_BAR;
            PG8_LDA(At, 0, 1); PG8_STAGE(PG8_SA(0, 0), a2, voffA);
            PG8_BAR; PG8_WAIT_L(0); PG8_MMA(1, 0, At, B0); PG8_BAR; PG8_SCHED;
            PG8_STAGE(PG8_SB(0, 1), b2 + hstep, voffB);
            PG8_WAIT_V(6); PG8_BAR; PG8_MMA(1, 1, At, B1); PG8_BAR;
            PG8_LDB(B0, 1, 0); PG8_SCHED; PG8_LDA(At, 1, 0); PG8_STAGE(PG8_SA(0, 1), a2 + hstep, voffA);
            PG8_WAIT_L(8); PG8_BAR; PG8_WAIT_L(0); PG8_MMA(0, 0, At, B0); PG8_BAR; PG8_SCHED;
            PG8_LDB(B1, 1, 1); PG8_STAGE(PG8_SB(1, 0), b3, voffB);
            PG8_BAR; PG8_WAIT_L(0); PG8_MMA(0, 1, At, B1); PG8_BAR;
            PG8_LDA(At, 1, 1); PG8_STAGE(PG8_SA(1, 0), a3, voffA);
            PG8_BAR; PG8_WAIT_L(0); PG8_MMA(1, 0, At, B0); PG8_BAR; PG8_SCHED;
            PG8_STAGE(PG8_SB(1, 1), b3 + hstep, voffB);
            PG8_WAIT_V(6); PG8_BAR; PG8_MMA(1, 1, At, B1); PG8_BAR;
            }
        }
        if constexpr (ALIGN_EPI) { if (wr == 0) PG8_BAR; }
        if constexpr (!Epi::AFTER_DRAIN) { E(acc, cur, wr, wc, fr, fq); S.done(cur); }
        if (!has_next) break;
#pragma unroll
        for (int a = 0; a < 2; ++a)
#pragma unroll
            for (int b = 0; b < 2; ++b)
#pragma unroll
                for (int m = 0; m < 4; ++m)
#pragma unroll
                    for (int n = 0; n < 2; ++n) acc[a][b][m][n] = (f32x4){0.f, 0.f, 0.f, 0.f};
        cur = nxt; cA = nA; cB = nB; ++ui;
        if constexpr (ALIGN_EPI) { if (wr == 1) PG8_BAR; }
    }
    PG8_WAIT_V(0);
    if constexpr (!ALIGN_EPI) { if (wr == 0) PG8_BAR; }
    PG8_BAR;
    if constexpr (Epi::AFTER_DRAIN) { E.fused(acc, cur, wr, wc, fr, fq, lds, wid, lane); S.done(cur); }
#undef PG8_SA
#undef PG8_SB
#undef PG8_STAGE
#undef PG8_LDA
#undef PG8_LDB
#undef PG8_MMA
#undef PG8_WAIT_V
#undef PG8_WAIT_L
#undef PG8_BAR
#undef PG8_SCHED
}
}
#define GAS __attribute__((address_space(1)))
#define LAS __attribute__((address_space(3)))
typedef unsigned short bf16;
typedef unsigned v4u __attribute__((ext_vector_type(4)));
typedef float f32x4 __attribute__((ext_vector_type(4)));
typedef short bf16x8 __attribute__((ext_vector_type(8)));
typedef GAS unsigned gu32;
typedef GAS unsigned long long gu64;
#define RLX_AGENT __ATOMIC_RELAXED, __HIP_MEMORY_SCOPE_AGENT
#define LDS_WAIT() asm volatile("s_waitcnt lgkmcnt(0)" ::: "memory")
#define VM_WAIT() asm volatile("s_waitcnt vmcnt(0)" ::: "memory")
__device__ __forceinline__ unsigned long long rt() { return __builtin_amdgcn_s_memrealtime(); }
__device__ __forceinline__ unsigned f2bf(float f) { unsigned u = __builtin_bit_cast(unsigned, f); return (u + 0x7fffu + ((u >> 16) & 1u)) >> 16; }
__device__ __forceinline__ unsigned pk2(float lo, float hi) { return f2bf(lo) | (f2bf(hi) << 16); }

#define XB_TMO      128
#define XB_XCNT(j)  (256  + 64 * (j))
#define XB_XSUB(j)  (1280 + 64 * (j))
#define XB_XGEN(j)  (2304 + 64 * (j))
#define XB_TOP      3328
#define XB_TOPGEN   3392
#define XCD_BAR_WORDS 3456
#define XB_SPIN_CAP (1u << 18)

__device__ __forceinline__ unsigned xb_ld(unsigned* p)              { return __hip_atomic_load(p, __ATOMIC_RELAXED, __HIP_MEMORY_SCOPE_AGENT); }
__device__ __forceinline__ unsigned xb_add(unsigned* p, unsigned v) { return __hip_atomic_fetch_add(p, v, __ATOMIC_RELAXED, __HIP_MEMORY_SCOPE_AGENT); }
__device__ __forceinline__ unsigned xb_xcc_id() { return (unsigned)__builtin_amdgcn_s_getreg((3 << 11) | 20) & 0xFu; }
#define XB_SPIN(cond, bar) do { unsigned _sp = 0; while (cond) { __builtin_amdgcn_s_sleep(1); \
    if ((++_sp & 255u) == 0u) { if (xb_ld(&(bar)[XB_TMO])) break; if (_sp > XB_SPIN_CAP) { atomicAdd(&(bar)[XB_TMO], 1u); break; } } } } while (0)

struct XcdBarrier {
    unsigned* bar; unsigned x;
    volatile LAS unsigned* st;
};

__device__ __forceinline__ XcdBarrier xcd_barrier_post(unsigned* bar, volatile LAS unsigned* st) {
    XcdBarrier b; b.bar = bar; b.x = xb_xcc_id(); b.st = st;
    if (threadIdx.x == 0) (void)xb_add(&bar[XB_XCNT(b.x)], 1u);
    return b;
}
__device__ __forceinline__ void xcd_barrier_complete(unsigned* bar, unsigned x, unsigned& nloc, unsigned& nx) {
    const unsigned G = gridDim.x * gridDim.y * gridDim.z;
    unsigned sum, cnt, mine, sp = 0u;
    for (;;) {
        sum = 0u; cnt = 0u; mine = 0u;
#pragma unroll
        for (unsigned j = 0; j < 16; ++j) { const unsigned c = xb_ld(&bar[XB_XCNT(j)]); sum += c; cnt += (c > 0u) ? 1u : 0u; mine = (j == x) ? c : mine; }
        if (sum == G) break;
        __builtin_amdgcn_s_sleep(1);
        if ((++sp & 255u) == 0u) { if (xb_ld(&bar[XB_TMO])) break; if (sp > XB_SPIN_CAP) { atomicAdd(&bar[XB_TMO], 1u); break; } }
    }
    nloc = mine > 0u ? mine : 1u; nx = cnt > 0u ? cnt : 1u;
}

__device__ __forceinline__ void xcd_barrier(const XcdBarrier& b) {
    asm volatile("s_waitcnt vmcnt(0)" ::: "memory");
    __syncthreads();
    if (threadIdx.x == 0) {
        unsigned* bar = b.bar;
        __builtin_amdgcn_s_waitcnt(0);
        unsigned nloc = b.st[0], nx = b.st[1];
        if (nloc == 0u) { xcd_barrier_complete(bar, b.x, nloc, nx); b.st[0] = nloc; b.st[1] = nx; }
        const unsigned old = xb_add(&bar[XB_XSUB(b.x)], 1u);
        const unsigned gen = old / nloc;
        if (old + 1u == (gen + 1u) * nloc) {
            __builtin_amdgcn_fence(__ATOMIC_RELEASE, "agent");
            asm volatile("s_waitcnt vmcnt(0)" ::: "memory");
            const unsigned og = xb_add(&bar[XB_TOP], 1u);
            const unsigned tg = og / nx;
            if (og + 1u == (tg + 1u) * nx) xb_add(&bar[XB_TOPGEN], 1u);
            else XB_SPIN(xb_ld(&bar[XB_TOPGEN]) == tg, bar);
            __builtin_amdgcn_fence(__ATOMIC_ACQUIRE, "agent");
            xb_add(&bar[XB_XGEN(b.x)], 1u);
            asm volatile("s_waitcnt vmcnt(0)" ::: "memory");
        } else {
            XB_SPIN(xb_ld(&bar[XB_XGEN(b.x)]) == gen, bar);
            __builtin_amdgcn_fence(__ATOMIC_ACQUIRE, "agent");
            asm volatile("s_waitcnt vmcnt(0)" ::: "memory");
        }
    }
    __syncthreads();
}

constexpr int NWAVES = 8;
constexpr int BATCH = 4, SEQ = 2048, D = 2048, DFF = 5632, NGU = 2 * DFF, NIN = 6144, PLE = 256;
constexpr int HW = 1024, LW = 1024, HEADS = 8, HD = 128, CHUNK = 64, NCH = SEQ / CHUNK;
constexpr int M = BATCH * SEQ;
constexpr float EPS = 1e-6f;
constexpr int N_IN = 27;
enum In { I_X = 0, I_P, I_F1N, I_F1G, I_F1U, I_F1D, I_MIXN, I_WIN, I_HLB, I_HGN, I_CW, I_CB, I_LWA, I_LBA, I_LWX, I_LBX, I_LAM, I_WOUT,
          I_F2N, I_F2G, I_F2U, I_F2D, I_PLN, I_PWG, I_PBG, I_PWP, I_FN };

constexpr size_t MiB = 1u << 20;
constexpr size_t WS_CTL = 0, CTL_ZERO_BYTES = 1 * MiB;
constexpr size_t WS_SSQA = 1 * MiB, WS_SSQB = 2 * MiB, WS_DEC = 3 * MiB;
constexpr size_t WS_WAT = 3 * MiB + 512 * 1024, WS_WXT = 3 * MiB + 768 * 1024;
constexpr size_t WS_WPROJ = 4 * MiB, WS_PB = 5 * MiB;
constexpr size_t WS_WGU1 = 9 * MiB, WS_WD1 = 53 * MiB, WS_WINT = 75 * MiB, WS_WOUT = 99 * MiB, WS_WGU2 = 107 * MiB, WS_WD2 = 151 * MiB, WS_WPG = 173 * MiB;
constexpr size_t WS_XB = 181 * MiB;
constexpr size_t WS_ACT = 213 * MiB;
constexpr size_t WS_LOGF = WS_ACT, WS_V = WS_ACT + 32 * MiB, WS_SG = WS_ACT + 48 * MiB, WS_LRX = WS_ACT + 64 * MiB, WS_PP = WS_ACT;
constexpr size_t WS_MIXA = 301 * MiB;
constexpr size_t WS_KVT = 333 * MiB;
constexpr size_t WS_END = 397 * MiB;
static_assert(WS_WGU1 + (size_t)NGU * D * 2 <= WS_WD1 && WS_WD1 + (size_t)D * DFF * 2 <= WS_WINT && WS_WINT + (size_t)NIN * D * 2 <= WS_WOUT && WS_WOUT + (size_t)D * D * 2 <= WS_WGU2 &&
              WS_WGU2 + (size_t)NGU * D * 2 <= WS_WD2 && WS_WD2 + (size_t)D * DFF * 2 <= WS_WPG && WS_WPG + (size_t)D * D * 2 <= WS_XB && WS_XB + (size_t)M * D * 2 <= WS_ACT &&
              WS_ACT + (size_t)M * DFF * 2 <= WS_MIXA && WS_MIXA + (size_t)M * 2048 * 2 <= WS_KVT && WS_KVT + (size_t)BATCH * HEADS * NCH * HD * HD * 4 <= WS_END &&
              WS_LRX + (size_t)M * 1024 * 2 <= WS_MIXA && WS_PP + (size_t)M * D * 4 <= WS_MIXA && WS_PB + (size_t)M * PLE * 2 <= WS_WGU1 && WS_WPROJ + (size_t)D * PLE * 2 <= WS_PB, "d_ws map");
constexpr int CW_BAR = 4096;

constexpr int RING_OFF = 0, RING_BYTES = 131072;
constexpr int LDSCTL_OFF = RING_BYTES, MISC_OFF = LDSCTL_OFF + 320;
constexpr int LDS_BYTES = 147456;
static_assert(MISC_OFF + 128 <= LDS_BYTES, "LDS map");


struct Frame {
    LAS unsigned char* lds;
    volatile LAS unsigned* MISC;
    gu32* ctl;
    int tid, lane, wave;
    int vcu, G;
    const float* in[N_IN]; float* out; unsigned char* ws;
};
__device__ __forceinline__ float bf2f(bf16 b) { return __builtin_bit_cast(float, (unsigned)b << 16); }
__device__ __forceinline__ float wave_sum(float v) {
#pragma unroll
    for (int o = 1; o < 64; o <<= 1) v += __shfl_xor(v, o);
    return v;
}
__device__ __forceinline__ void p0_transpose_item(const float* W, int ldw, int K, int src_col0, bf16* WT, int dst_row0, const float* gain, LAS float* scr, int kb, int lane) {
    const int k0 = 64 * kb;
#pragma unroll 8
    for (int i = 0; i < 32; ++i) { const int kk = 2 * i + (lane >> 5); float v = W[(size_t)(k0 + kk) * ldw + src_col0 + (lane & 31)]; if (gain) v *= gain[k0 + kk]; scr[kk * 33 + (lane & 31)] = v; }
    LDS_WAIT(); asm volatile("" ::: "memory");
    const int c = lane & 7;
#pragma unroll
    for (int j = 0; j < 4; ++j) { const int n = (lane >> 3) + 8 * j; const LAS float* s = scr + (8 * c) * 33 + n;
        v4u o; o.x = pk2(s[0 * 33], s[1 * 33]); o.y = pk2(s[2 * 33], s[3 * 33]); o.z = pk2(s[4 * 33], s[5 * 33]); o.w = pk2(s[6 * 33], s[7 * 33]);
        *(GAS v4u*)(WT + (size_t)(dst_row0 + n) * K + k0 + 8 * c) = o; }
    LDS_WAIT(); asm volatile("" ::: "memory");
}
__device__ __forceinline__ bool p0_plain(int& r, const float* W, int K, int N, bf16* WT, const float* gain, LAS float* scr, int lane) {
    const int items = (N / 32) * (K / 64);
    if (r < items) { const int nb = r / (K / 64), kb = r % (K / 64); p0_transpose_item(W, N, K, 32 * nb, WT, 32 * nb, gain, scr, kb, lane); return true; }
    r -= items; return false;
}
__device__ __forceinline__ bool p0_gateup(int& r, const float* Wg, const float* Wu, bf16* WT, const float* gain, LAS float* scr, int lane) {
    const int items = (NGU / 32) * (D / 64);
    if (r < items) { const int rb = r / (D / 64), kb = r % (D / 64), t = rb >> 3, j = rb & 7;
        p0_transpose_item(j < 4 ? Wg : Wu, DFF, D, 128 * t + 32 * (j & 3), WT, 32 * rb, gain, scr, kb, lane); return true; }
    r -= items; return false;
}
__device__ __forceinline__ void p0_prologue(Frame& F) {
    LAS float* scr = (LAS float*)(F.lds + RING_OFF + F.wave * 16384);
    const int gw = F.vcu * NWAVES + F.wave, NGW = F.G * NWAVES;
    unsigned char* ws = F.ws;
    for (int m = gw; m < M; m += NGW) {
        const GAS f32x4* xr = (const GAS f32x4*)(F.in[I_X] + (size_t)m * D) + F.lane;
        GAS unsigned long long* o8 = (GAS unsigned long long*)((bf16*)(ws + WS_XB) + (size_t)m * D) + F.lane;
        float s = 0.f;
#pragma unroll
        for (int j = 0; j < 8; ++j) { const f32x4 v = xr[64 * j]; s += (v.x * v.x + v.y * v.y) + (v.z * v.z + v.w * v.w);
            o8[64 * j] = (unsigned long long)pk2(v.x, v.y) | ((unsigned long long)pk2(v.z, v.w) << 32); }
        s = wave_sum(s);
        if (F.lane < 32) ((float*)(ws + WS_SSQA))[(size_t)m * 32 + F.lane] = (F.lane == 0) ? s : 0.f;
    }
    for (int m = gw; m < M; m += NGW) {
        const f32x4 v = ((const GAS f32x4*)(F.in[I_P] + (size_t)m * PLE))[F.lane];
        ((GAS unsigned long long*)((bf16*)(ws + WS_PB) + (size_t)m * PLE))[F.lane] = (unsigned long long)pk2(v.x, v.y) | ((unsigned long long)pk2(v.z, v.w) << 32);
    }
    constexpr int NITEMS = 2 * (NGU / 32) * (D / 64) + 2 * (D / 32) * (DFF / 64) + (NIN / 32) * (D / 64) + 2 * (D / 32) * (D / 64) + (D / 32) * (PLE / 64) + 16 * (128 / 32) * (128 / 64);
    for (int it = gw; it < NITEMS; it += NGW) {
        int r = it;
        if (p0_gateup(r, F.in[I_F1G], F.in[I_F1U], (bf16*)(ws + WS_WGU1), F.in[I_F1N], scr, F.lane)) continue;
        if (p0_plain(r, F.in[I_F1D], DFF, D, (bf16*)(ws + WS_WD1), nullptr, scr, F.lane)) continue;
        if (p0_plain(r, F.in[I_WIN], D, NIN, (bf16*)(ws + WS_WINT), F.in[I_MIXN], scr, F.lane)) continue;
        if (p0_plain(r, F.in[I_WOUT], D, D, (bf16*)(ws + WS_WOUT), nullptr, scr, F.lane)) continue;
        if (p0_gateup(r, F.in[I_F2G], F.in[I_F2U], (bf16*)(ws + WS_WGU2), F.in[I_F2N], scr, F.lane)) continue;
        if (p0_plain(r, F.in[I_F2D], DFF, D, (bf16*)(ws + WS_WD2), nullptr, scr, F.lane)) continue;
        if (p0_plain(r, F.in[I_PWG], D, D, (bf16*)(ws + WS_WPG), F.in[I_PLN], scr, F.lane)) continue;
        if (p0_plain(r, F.in[I_PWP], PLE, D, (bf16*)(ws + WS_WPROJ), nullptr, scr, F.lane)) continue;
        { const int blk = r >> 3, q = r & 7;
          const float* W = (blk < 8 ? F.in[I_LWA] : F.in[I_LWX]) + (size_t)(blk & 7) * 128 * 128;
          bf16* WT = (bf16*)(ws + (blk < 8 ? WS_WAT : WS_WXT)) + (size_t)(blk & 7) * 128 * 128;
          p0_transpose_item(W, 128, 128, 32 * (q >> 1), WT, 32 * (q >> 1), nullptr, scr, q & 1, F.lane); }
    }
}
__device__ __forceinline__ void final_norm(Frame& F, const float* ssq) {
    const int gw = F.vcu * NWAVES + F.wave, NGW = F.G * NWAVES;
    const GAS f32x4* gf = (const GAS f32x4*)F.in[I_FN] + F.lane;
    for (int m = gw; m < M; m += NGW) {
        float s = (F.lane < 32) ? ssq[(size_t)m * 32 + F.lane] : 0.f;
        s = wave_sum(s);
        const float rstd = 1.0f / sqrtf(s * (1.0f / D) + EPS);
        GAS f32x4* xr = (GAS f32x4*)(F.out + (size_t)m * D) + F.lane;
#pragma unroll
        for (int j = 0; j < 8; ++j) { f32x4 v = xr[64 * j]; const f32x4 g = gf[64 * j]; v = v * rstd * g; xr[64 * j] = v; }
    }
}


typedef float mf32x4 __attribute__((ext_vector_type(4)));
typedef short mbf16x8 __attribute__((ext_vector_type(8)));
typedef unsigned mu32x2 __attribute__((ext_vector_type(2)));
constexpr int TS = 72;
constexpr int QS = 136;
constexpr int NITEM = BATCH * HEADS * NCH;
__device__ __forceinline__ mbf16x8 lds_frag(const LAS bf16* p) { return *(const LAS mbf16x8*)p; }
__device__ __forceinline__ unsigned bf1(float x) { return pg8::cvt_pk_bf16(x, 0.f) & 0xffffu; }
#define MFMA16(a, b, c) __builtin_amdgcn_mfma_f32_16x16x32_bf16((a), (b), (c), 0, 0, 0)

__device__ __forceinline__ void hgrn_local_phase(Frame& F) {
    LAS bf16* kstT = (LAS bf16*)(F.lds);
    LAS bf16* vT = (LAS bf16*)(F.lds + 18432);
    LAS float* qtot = (LAS float*)(F.lds + 36864);
    int tid_ = threadIdx.x; asm volatile("" : "+v"(tid_));
    const int tid = tid_, k = tid & 127, sq = tid >> 7, lane = tid & 63, w = F.wave, fr = lane & 15, fq = lane >> 4;
    const float* LOGF = (const float*)(F.ws + WS_LOGF); const bf16* V = (const bf16*)(F.ws + WS_V);
    float* KVT = (float*)(F.ws + WS_KVT); float* DEC = (float*)(F.ws + WS_DEC);
    for (int item = blockIdx.x; item < NITEM; item += F.G) {
        const int c = item & 31, bh = item >> 5, h = bh & 7, b = bh >> 3;
        const size_t g0 = ((size_t)b * SEQ + c * 64 + sq * 16) * 1024 + h * 128 + k;
        float lf[16]; unsigned vr[16];
#pragma unroll
        for (int i = 0; i < 16; ++i) { lf[i] = LOGF[g0 + (size_t)i * 1024]; vr[i] = V[g0 + (size_t)i * 1024]; }
        float bb[16]; float run = 0.f;
#pragma unroll
        for (int i = 0; i < 16; ++i) { run += lf[i]; bb[i] = run; }
        qtot[sq * 128 + k] = run;
        __syncthreads();
        float pre = 0.f, tot = 0.f;
#pragma unroll
        for (int j = 0; j < 4; ++j) { const float tq = qtot[j * 128 + k]; pre += (j < sq) ? tq : 0.f; tot += tq; }
        unsigned pk[8], pv[8];
#pragma unroll
        for (int i = 0; i < 8; ++i) {
            const float e0 = (1.0f - __expf(lf[2 * i])) * __expf(tot - (pre + bb[2 * i])), e1 = (1.0f - __expf(lf[2 * i + 1])) * __expf(tot - (pre + bb[2 * i + 1]));
            pk[i] = pg8::cvt_pk_bf16(e0, e1); pv[i] = vr[2 * i] | (vr[2 * i + 1] << 16); }
        *(LAS v4u*)(kstT + k * TS + sq * 16) = (v4u){pk[0], pk[1], pk[2], pk[3]}; *(LAS v4u*)(kstT + k * TS + sq * 16 + 8) = (v4u){pk[4], pk[5], pk[6], pk[7]};
        *(LAS v4u*)(vT + k * TS + sq * 16) = (v4u){pv[0], pv[1], pv[2], pv[3]}; *(LAS v4u*)(vT + k * TS + sq * 16 + 8) = (v4u){pv[4], pv[5], pv[6], pv[7]};
        if (sq == 0) DEC[(size_t)item * 128 + k] = __expf(tot);
        __syncthreads();
        const mbf16x8 b0 = lds_frag(vT + (16 * w + fr) * TS + 8 * fq), b1 = lds_frag(vT + (16 * w + fr) * TS + 32 + 8 * fq);
        float* outp = KVT + (size_t)item * 16384 + (size_t)(16 * w + fr) * 128 + 4 * fq;
#pragma unroll
        for (int kt = 0; kt < 8; ++kt) {
            mf32x4 acc = {0.f, 0.f, 0.f, 0.f};
            acc = MFMA16(lds_frag(kstT + (16 * kt + fr) * TS + 8 * fq), b0, acc);
            acc = MFMA16(lds_frag(kstT + (16 * kt + fr) * TS + 32 + 8 * fq), b1, acc);
            *(mf32x4*)(outp + 16 * kt) = acc;
        }
        __syncthreads();
    }
}

__device__ __forceinline__ void hgrn_scan_phase(Frame& F) {
    const float* KVT = (const float*)(F.ws + WS_KVT); const float* DEC = (const float*)(F.ws + WS_DEC); bf16* ST = (bf16*)(F.ws + WS_XB);
    int tid_ = threadIdx.x; asm volatile("" : "+v"(tid_));
    for (int idx = blockIdx.x * (NWAVES * 64) + tid_; idx < BATCH * HEADS * 128 * 32; idx += F.G * NWAVES * 64) {
        const int k4 = idx & 31, v = (idx >> 5) & 127, bh = idx >> 12;
        mf32x4 S = {0.f, 0.f, 0.f, 0.f};
#pragma unroll 4
        for (int c = 0; c < NCH; ++c) {
            const int item = bh * NCH + c; const size_t off = (size_t)item * 16384 + v * 128 + 4 * k4;
            mu32x2 o; o.x = pg8::cvt_pk_bf16(S[0], S[1]); o.y = pg8::cvt_pk_bf16(S[2], S[3]); *(mu32x2*)(ST + off) = o;
            const mf32x4 kv = *(const mf32x4*)(KVT + off), d = *(const mf32x4*)(DEC + (size_t)item * 128 + 4 * k4);
            S = d * S + kv;
        }
    }
}

__device__ __forceinline__ void hgrn_out_phase(Frame& F) {
    LAS bf16* QT = (LAS bf16*)(F.lds);
    LAS bf16* KT = (LAS bf16*)(F.lds + 17408);
    LAS bf16* QI = (LAS bf16*)(F.lds + 34816);
    LAS bf16* vT = (LAS bf16*)(F.lds + 52224);
    LAS bf16* P = (LAS bf16*)(F.lds + 70656);
    LAS float* qtot = (LAS float*)(F.lds + 79872);
    LAS float* ssq = (LAS float*)(F.lds + 81920);
    int tid_ = threadIdx.x; asm volatile("" : "+v"(tid_));
    const int tid = tid_, k = tid & 127, sq = tid >> 7, lane = tid & 63, w = F.wave, fr = lane & 15, fq = lane >> 4, rb = w & 3, ch = w >> 2;
    const float* LOGF = (const float*)(F.ws + WS_LOGF); const bf16* V = (const bf16*)(F.ws + WS_V); const bf16* SG = (const bf16*)(F.ws + WS_SG);
    const bf16* ST = (const bf16*)(F.ws + WS_XB); bf16* MIXA = (bf16*)(F.ws + WS_MIXA);
    for (int item = blockIdx.x; item < NITEM; item += F.G) {
        const int c = item & 31, bh = item >> 5, h = bh & 7, b = bh >> 3;
        const size_t r0 = (size_t)b * SEQ + c * 64;
        {
            const size_t g0 = (r0 + sq * 16) * 1024 + h * 128 + k, gq = (r0 + sq * 16) * 2048 + h * 128 + k;
            float lf[16]; unsigned vr[16], qr[16];
#pragma unroll
            for (int i = 0; i < 16; ++i) { lf[i] = LOGF[g0 + (size_t)i * 1024]; vr[i] = V[g0 + (size_t)i * 1024]; qr[i] = MIXA[gq + (size_t)i * 2048]; }
            float bb[16]; float run = 0.f;
#pragma unroll
            for (int i = 0; i < 16; ++i) { run += lf[i]; bb[i] = run; }
            qtot[sq * 128 + k] = run;
            __syncthreads();
            float pre = 0.f;
#pragma unroll
            for (int j = 0; j < 4; ++j) { const float tq = qtot[j * 128 + k]; pre += (j < sq) ? tq : 0.f; }
            const float bm = qtot[k] + qtot[128 + k], ebm = __expf(bm);
            unsigned pv[8];
#pragma unroll
            for (int i = 0; i < 16; ++i) {
                const float d = fminf(fmaxf(pre + bb[i] - bm, -60.f), 60.f), e1 = __expf(d), e2 = __builtin_amdgcn_rcpf(e1);
                const float qf = bf2f((bf16)qr[i]), qt = qf * e1, kk = (1.0f - __expf(lf[i])) * e2;
                const int s = sq * 16 + i;
                QT[s * QS + k] = (bf16)bf1(qt); QI[s * QS + k] = (bf16)bf1(qt * ebm); KT[s * QS + k] = (bf16)bf1(kk);
            }
#pragma unroll
            for (int i = 0; i < 8; ++i) pv[i] = vr[2 * i] | (vr[2 * i + 1] << 16);
            *(LAS v4u*)(vT + k * TS + sq * 16) = (v4u){pv[0], pv[1], pv[2], pv[3]}; *(LAS v4u*)(vT + k * TS + sq * 16 + 8) = (v4u){pv[4], pv[5], pv[6], pv[7]};
        }
        __syncthreads();
        const int t0 = 16 * rb;
        {
            mbf16x8 bq[4];
#pragma unroll
            for (int ks = 0; ks < 4; ++ks) bq[ks] = lds_frag(QT + (t0 + fr) * QS + 32 * ks + 8 * fq);
#pragma unroll
            for (int j = 0; j < 2; ++j) {
                const int s0 = 32 * ch + 16 * j; mf32x4 acc = {0.f, 0.f, 0.f, 0.f};
#pragma unroll
                for (int ks = 0; ks < 4; ++ks) acc = MFMA16(lds_frag(KT + (s0 + fr) * QS + 32 * ks + 8 * fq), bq[ks], acc);
                const int t = t0 + fr, sb = s0 + 4 * fq;
#pragma unroll
                for (int r = 0; r < 4; ++r) acc[r] = (sb + r <= t) ? acc[r] : 0.f;
                mu32x2 o; o.x = pg8::cvt_pk_bf16(acc[0], acc[1]); o.y = pg8::cvt_pk_bf16(acc[2], acc[3]);
                *(LAS mu32x2*)(P + t * TS + sb) = o;
            }
        }
        __syncthreads();
        mf32x4 o4[4];
        {
            mbf16x8 bqi[4], bp[2];
#pragma unroll
            for (int ks = 0; ks < 4; ++ks) bqi[ks] = lds_frag(QI + (t0 + fr) * QS + 32 * ks + 8 * fq);
#pragma unroll
            for (int ss = 0; ss < 2; ++ss) bp[ss] = lds_frag(P + (t0 + fr) * TS + 32 * ss + 8 * fq);
            float sum = 0.f;
#pragma unroll
            for (int j = 0; j < 4; ++j) {
                const int v0 = 64 * ch + 16 * j; mf32x4 acc = {0.f, 0.f, 0.f, 0.f};
                const bf16* sp = ST + (size_t)item * 16384 + (size_t)(v0 + fr) * 128 + 8 * fq;
#pragma unroll
                for (int ks = 0; ks < 4; ++ks) acc = MFMA16(*(const mbf16x8*)(sp + 32 * ks), bqi[ks], acc);
#pragma unroll
                for (int ss = 0; ss < 2; ++ss) acc = MFMA16(lds_frag(vT + (v0 + fr) * TS + 32 * ss + 8 * fq), bp[ss], acc);
                o4[j] = acc; sum += (acc[0] * acc[0] + acc[1] * acc[1]) + (acc[2] * acc[2] + acc[3] * acc[3]);
            }
            sum += __shfl_xor(sum, 16); sum += __shfl_xor(sum, 32);
            if (fq == 0) ssq[ch * 64 + t0 + fr] = sum;
        }
        __syncthreads();
        {
            const float rn = 1.0f / sqrtf((ssq[t0 + fr] + ssq[64 + t0 + fr]) * (1.0f / 128.0f) + EPS);
            const size_t row = r0 + t0 + fr;
#pragma unroll
            for (int j = 0; j < 4; ++j) {
                const int v = 64 * ch + 16 * j + 4 * fq;
                const mf32x4 gn = *(const mf32x4*)(F.in[I_HGN] + v);
                const mu32x2 sgp = *(const mu32x2*)(SG + row * 1024 + h * 128 + v);
                const float s0 = bf2f((bf16)(sgp.x & 0xffffu)), s1 = bf2f((bf16)(sgp.x >> 16)), s2 = bf2f((bf16)(sgp.y & 0xffffu)), s3 = bf2f((bf16)(sgp.y >> 16));
                mu32x2 o; o.x = pg8::cvt_pk_bf16(o4[j][0] * rn * gn[0] * s0, o4[j][1] * rn * gn[1] * s1); o.y = pg8::cvt_pk_bf16(o4[j][2] * rn * gn[2] * s2, o4[j][3] * rn * gn[3] * s3);
                *(mu32x2*)(MIXA + row * 2048 + h * 128 + v) = o;
            }
        }
        __syncthreads();
    }
}

__device__ __forceinline__ void lru_phase(Frame& F) {
    LAS bf16* A = (LAS bf16*)(F.lds);
    LAS float* XS = (LAS float*)(F.lds + 69632);
    LAS float* LA = (LAS float*)(F.lds + 86016);
    LAS float* LU = (LAS float*)(F.lds + 103424);
    LAS float* SEGA = (LAS float*)(F.lds + 120832);
    LAS float* SEGH = (LAS float*)(F.lds + 122880);
    LAS float* CARRY = (LAS float*)(F.lds + 124928);
    int tid_ = threadIdx.x; asm volatile("" : "+v"(tid_));
    const int tid = tid_, lane = tid & 63, w = F.wave, fr = lane & 15, fq = lane >> 4;
    const int cg = tid & 15, rr0 = tid >> 4;
    const int d = tid & 15, seg = tid >> 4;
    const bf16* LRX = (const bf16*)(F.ws + WS_LRX); bf16* MIXA = (bf16*)(F.ws + WS_MIXA);
    const bf16* WAT = (const bf16*)(F.ws + WS_WAT); const bf16* WXT = (const bf16*)(F.ws + WS_WXT);
    for (int item = blockIdx.x; item < BATCH * 64; item += F.G) {
        const int b = item >> 6, n = (item >> 3) & 7, sl = item & 7;
        const int cbase = n * 128 + 8 * cg;
        float cwv[4][8], cbv[8];
#pragma unroll
        for (int e = 0; e < 8; ++e) { cbv[e] = F.in[I_CB][cbase + e];
#pragma unroll
            for (int j = 0; j < 4; ++j) cwv[j][e] = F.in[I_CW][j * 1024 + cbase + e]; }
        mbf16x8 waf[4], wxf[4];
#pragma unroll
        for (int ks = 0; ks < 4; ++ks) { const size_t o = ((size_t)n * 128 + sl * 16 + fr) * 128 + 32 * ks + 8 * fq; waf[ks] = *(const mbf16x8*)(WAT + o); wxf[ks] = *(const mbf16x8*)(WXT + o); }
        const int cgl = n * 128 + sl * 16 + fr;
        const float ba = F.in[I_LBA][cgl], bx = F.in[I_LBX][cgl], spl = log1pf(__expf(-F.in[I_LAM][cgl]));
        if (tid < 16) CARRY[tid] = 0.f;
        for (int mc = 0; mc < 8; ++mc) {
            const size_t rowbase = (size_t)b * SEQ + mc * 256;
            {
                v4u xr[11];
#pragma unroll
                for (int j = 0; j < 11; ++j) { const int tl = mc * 256 + 8 * rr0 - 3 + j;
                    if (tl >= 0) xr[j] = *(const v4u*)(LRX + ((size_t)b * SEQ + tl) * 1024 + cbase); else xr[j] = (v4u){0u, 0u, 0u, 0u}; }
#pragma unroll
                for (int i = 0; i < 8; ++i) {
                    float xc[8];
#pragma unroll
                    for (int e = 0; e < 8; ++e) xc[e] = cbv[e];
#pragma unroll
                    for (int j = 0; j < 4; ++j) { const v4u x = xr[i + j];
                        const unsigned wd[4] = {x.x, x.y, x.z, x.w};
#pragma unroll
                        for (int e = 0; e < 8; ++e) { const float xv = __builtin_bit_cast(float, (e & 1) ? (wd[e >> 1] & 0xffff0000u) : (wd[e >> 1] << 16)); xc[e] += cwv[j][e] * xv; } }
                    const int lr = 8 * rr0 + i;
                    *(LAS v4u*)(A + lr * QS + 8 * cg) = (v4u){pg8::cvt_pk_bf16(xc[0], xc[1]), pg8::cvt_pk_bf16(xc[2], xc[3]), pg8::cvt_pk_bf16(xc[4], xc[5]), pg8::cvt_pk_bf16(xc[6], xc[7])};
                    if ((cg >> 1) == sl) { LAS float* xp = XS + lr * 16 + (cg & 1) * 8; *(LAS mf32x4*)xp = (mf32x4){xc[0], xc[1], xc[2], xc[3]}; *(LAS mf32x4*)(xp + 4) = (mf32x4){xc[4], xc[5], xc[6], xc[7]}; }
                }
            }
            __syncthreads();
#pragma unroll
            for (int rt = 0; rt < 2; ++rt) {
                const int rowt = 32 * w + 16 * rt; mf32x4 ar = {0.f, 0.f, 0.f, 0.f}, ai = {0.f, 0.f, 0.f, 0.f};
#pragma unroll
                for (int ks = 0; ks < 4; ++ks) { const mbf16x8 a = lds_frag(A + (rowt + fr) * QS + 32 * ks + 8 * fq); ar = MFMA16(a, waf[ks], ar); ai = MFMA16(a, wxf[ks], ai); }
#pragma unroll
                for (int r = 0; r < 4; ++r) { const int row = rowt + 4 * fq + r;
                    const float rg = pg8::sigmoid_f(ar[r] + ba), ig = pg8::sigmoid_f(ai[r] + bx), la = -8.0f * rg * spl;
                    LA[row * 17 + fr] = __expf(la); LU[row * 17 + fr] = sqrtf(-expm1f(2.0f * la)) * ig * XS[row * 16 + fr]; }
            }
            __syncthreads();
            float aa[8], uu[8]; float Ap = 1.f, Hp = 0.f;
#pragma unroll
            for (int i = 0; i < 8; ++i) { aa[i] = LA[(8 * seg + i) * 17 + d]; uu[i] = LU[(8 * seg + i) * 17 + d]; Hp = aa[i] * Hp + uu[i]; Ap *= aa[i]; }
            SEGA[seg * 16 + d] = Ap; SEGH[seg * 16 + d] = Hp;
            __syncthreads();
            float hin = CARRY[(mc & 1) * 16 + d];
            for (int s2 = 0; s2 < seg; ++s2) hin = SEGA[s2 * 16 + d] * hin + SEGH[s2 * 16 + d];
            bf16* yp = MIXA + (rowbase + 8 * seg) * 2048 + 1024 + n * 128 + sl * 16 + d;
#pragma unroll
            for (int i = 0; i < 8; ++i) { hin = aa[i] * hin + uu[i]; yp[(size_t)i * 2048] = (bf16)bf1(hin * bf2f(yp[(size_t)i * 2048])); }
            if (seg == 31) CARRY[((mc + 1) & 1) * 16 + d] = hin;
        }
        __syncthreads();
    }
}
constexpr int N_PHASES = 12;
struct Args { const float* in[N_IN]; float* out; unsigned char* ws; int ph_lo, ph_hi, li, pad; };
__global__ void __launch_bounds__(NWAVES * 64, 2) mega_fwd(Args args) {
    extern __shared__ __attribute__((aligned(16))) unsigned char lds[];
    Frame F;
    F.lds = (LAS unsigned char*)lds;
    F.MISC = (volatile LAS unsigned*)(F.lds + MISC_OFF);
    F.tid = threadIdx.x; F.lane = F.tid & 63; F.wave = __builtin_amdgcn_readfirstlane(F.tid >> 6);
    F.G = gridDim.x; { const int bx = blockIdx.x; F.vcu = (F.G % 8 == 0) ? (bx % 8) * (F.G / 8) + bx / 8 : bx; }
#pragma unroll
    for (int i = 0; i < N_IN; ++i) F.in[i] = args.in[i];
    F.out = args.out; F.ws = args.ws;
    unsigned char* ws = args.ws;
    F.ctl = (gu32*)(ws + WS_CTL);
    for (int u = F.tid; u < (LDS_BYTES - LDSCTL_OFF) / 4; u += NWAVES * 64) ((LAS unsigned*)(F.lds + LDSCTL_OFF))[u] = 0u;
    __syncthreads();
    const int lo = args.ph_lo, hi = args.ph_hi;
    const bool multi = (hi - lo) > 1;
    XcdBarrier bar; bar.bar = (unsigned*)(F.ctl + CW_BAR) + args.li * XCD_BAR_WORDS; bar.x = 0; bar.st = nullptr;
    if (multi) bar = xcd_barrier_post((unsigned*)(F.ctl + CW_BAR) + args.li * XCD_BAR_WORDS, F.MISC + 8);

    bf16* const XB = (bf16*)(ws + WS_XB); bf16* const ACT = (bf16*)(ws + WS_ACT); bf16* const MIXA = (bf16*)(ws + WS_MIXA);
    float* const SSQA = (float*)(ws + WS_SSQA); float* const SSQB = (float*)(ws + WS_SSQB);


#define IN(k) (lo <= (k) && (k) < hi)
#define SEAM(k) do { if (IN(k) && IN((k) + 1)) xcd_barrier(bar); } while (0)
#define GEMM_SWIGLU(WOFF) do { pg8::Gemm g{XB, (const bf16*)(ws + (WOFF)), M, NGU, D}; pg8::StaticOrder S; S.init(M, NGU, F.G, (int)blockIdx.x); \
        pg8::EpiSwiGLU E{ACT, DFF, SSQA}; pg8::gemm_phase<pg8::EpiSwiGLU, pg8::StaticOrder, true, true>(F.lds + RING_OFF, g, S, E); } while (0)
#define GEMM_RESID(AP, WOFF, KK, SRC, SSQO, SC) do { pg8::Gemm g{(AP), (const bf16*)(ws + (WOFF)), M, D, (KK)}; pg8::StaticOrder S; S.init(M, D, F.G, (int)blockIdx.x); \
        pg8::EpiResid E{(SRC), F.out, XB, (SSQO), (SC)}; pg8::gemm_phase<pg8::EpiResid, pg8::StaticOrder, true, true>(F.lds + RING_OFF, g, S, E); } while (0)

    if (IN(0)) { p0_prologue(F); SEAM(0); }
    if (IN(1)) { GEMM_SWIGLU(WS_WGU1); SEAM(1); }
    if (IN(2)) { GEMM_RESID(ACT, WS_WD1, DFF, F.in[I_X], SSQB, 0.5f); SEAM(2); }
    if (IN(3)) {
        pg8::Gemm g{XB, (const bf16*)(ws + WS_WINT), M, NIN, D}; pg8::StaticOrder S; S.init(M, NIN, F.G, (int)blockIdx.x);
        pg8::EpiZ E{SSQB, F.in[I_HLB], MIXA, (float*)(ws + WS_LOGF), (bf16*)(ws + WS_V), (bf16*)(ws + WS_SG), (bf16*)(ws + WS_LRX)};
        pg8::gemm_phase<pg8::EpiZ, pg8::StaticOrder, true, true>(F.lds + RING_OFF, g, S, E);
        SEAM(3); }
    if (IN(4)) { MIXER_PHASE_4 SEAM(4); }
    if (IN(5)) { MIXER_PHASE_5 SEAM(5); }
    if (IN(6)) { MIXER_PHASE_6 SEAM(6); }
    if (IN(7)) { GEMM_RESID(MIXA, WS_WOUT, D, F.out, SSQA, 1.0f); SEAM(7); }
    if (IN(8)) { GEMM_SWIGLU(WS_WGU2); SEAM(8); }
    if (IN(9)) { GEMM_RESID(ACT, WS_WD2, DFF, F.out, SSQB, 0.5f); SEAM(9); }
    if (IN(10)) {
        { pg8::Gemm g{(const bf16*)(ws + WS_PB), (const bf16*)(ws + WS_WPROJ), M, D, PLE}; pg8::StaticOrder S; S.init(M, D, F.G, (int)blockIdx.x);
          pg8::EpiPP E{(float*)(ws + WS_PP)};
          pg8::gemm_phase<pg8::EpiPP, pg8::StaticOrder, true, true>(F.lds + RING_OFF, g, S, E); }
        { pg8::Gemm g{XB, (const bf16*)(ws + WS_WPG), M, D, D}; pg8::StaticOrder S; S.init(M, D, F.G, (int)blockIdx.x);
          pg8::EpiPLE E{SSQB, F.in[I_PBG], (const float*)(ws + WS_PP), F.out, SSQA};
          pg8::gemm_phase<pg8::EpiPLE, pg8::StaticOrder, true, true>(F.lds + RING_OFF, g, S, E); }
        SEAM(10); }
    if (IN(11)) { final_norm(F, SSQA); }
#undef IN
#undef SEAM
}

#if SIMPLE_HGRN
__global__ void __launch_bounds__(64) k_simple_hgrn(const float* logf, const bf16* mixa, const bf16* vv, float* oh) {
    __shared__ float sf[128], sk[128], sq[128];
    const int bh = blockIdx.x >> 1, vh = blockIdx.x & 1, b = bh >> 3, h = bh & 7, lane = threadIdx.x, v = vh * 64 + lane;
    float S[128];
#pragma unroll
    for (int k = 0; k < 128; ++k) S[k] = 0.f;
    for (int t = 0; t < SEQ; ++t) {
        const size_t row = (size_t)b * SEQ + t;
        for (int kk = lane; kk < 128; kk += 64) { const float f = __expf(logf[row * 1024 + h * 128 + kk]); sf[kk] = f; sk[kk] = 1.f - f; sq[kk] = bf2f(mixa[row * 2048 + h * 128 + kk]); }
        __syncthreads();
        const float vt = bf2f(vv[row * 1024 + h * 128 + v]); float o = 0.f;
#pragma unroll
        for (int k = 0; k < 128; ++k) { S[k] = sf[k] * S[k] + sk[k] * vt; o += S[k] * sq[k]; }
        oh[row * 1024 + h * 128 + v] = o;
        __syncthreads();
    }
}
__global__ void __launch_bounds__(256) k_simple_hnorm(const float* oh, const bf16* sg, const float* gn, bf16* mixa) {
    const int gw = (blockIdx.x * 256 + threadIdx.x) >> 6, lane = threadIdx.x & 63;
    if (gw >= M * HEADS) return;
    const int row = gw >> 3, h = gw & 7;
    const float o0 = oh[(size_t)row * 1024 + h * 128 + lane], o1 = oh[(size_t)row * 1024 + h * 128 + 64 + lane];
    const float ss = wave_sum(o0 * o0 + o1 * o1);
    const float r = 1.0f / sqrtf(ss * (1.0f / 128.0f) + EPS);
    mixa[(size_t)row * 2048 + h * 128 + lane] = (bf16)f2bf(o0 * r * gn[lane] * bf2f(sg[(size_t)row * 1024 + h * 128 + lane]));
    mixa[(size_t)row * 2048 + h * 128 + 64 + lane] = (bf16)f2bf(o1 * r * gn[64 + lane] * bf2f(sg[(size_t)row * 1024 + h * 128 + 64 + lane]));
}
#endif
#if SIMPLE_LRU
__global__ void __launch_bounds__(256) k_simple_lru_a(const bf16* lrx, const float* cw, const float* cb, const float* wa, const float* ba, const float* wx, const float* bx, const float* lam, float* LA, float* LU) {
    __shared__ float xc[1024];
    const int row = blockIdx.x, tt = row % SEQ, tid = threadIdx.x;
    for (int c = tid; c < 1024; c += 256) { float s = cb[c];
        for (int j = 0; j < 4; ++j) { const int ts = tt - 3 + j; if (ts >= 0) s += cw[j * 1024 + c] * bf2f(lrx[(size_t)(row - 3 + j) * 1024 + c]); }
        xc[c] = s; }
    __syncthreads();
    for (int d = tid; d < 1024; d += 256) { const int n = d >> 7, dd = d & 127; float r = ba[d], g = bx[d];
        for (int c = 0; c < 128; ++c) { const float x = xc[n * 128 + c]; r += x * wa[((size_t)n * 128 + c) * 128 + dd]; g += x * wx[((size_t)n * 128 + c) * 128 + dd]; }
        r = 1.0f / (1.0f + __expf(-r)); g = 1.0f / (1.0f + __expf(-g));
        const float log_a = -8.0f * r * log1pf(__expf(-lam[d]));
        LA[(size_t)row * 1024 + d] = __expf(log_a); LU[(size_t)row * 1024 + d] = sqrtf(-expm1f(2.0f * log_a)) * g * xc[d]; }
}
__global__ void __launch_bounds__(256) k_simple_lru_b(const float* LA, const float* LU, bf16* mixa) {
    const int gi = blockIdx.x * 256 + threadIdx.x, b = gi >> 10, c = gi & 1023; float h = 0.f;
#pragma unroll 8
    for (int t = 0; t < SEQ; ++t) { const size_t row = (size_t)b * SEQ + t; h = LA[row * 1024 + c] * h + LU[row * 1024 + c];
        bf16* p = mixa + row * 2048 + 1024 + c; *p = (bf16)f2bf(h * bf2f(*p)); }
}
#endif

extern "C" void kernel_launch(void* const* d_in, const int* in_sizes, int n_in, void* d_out, int out_size, void* d_ws, size_t ws_size, hipStream_t stream) {
    static int grid = 0;
    if (grid == 0) {
        if (n_in != N_IN || in_sizes[0] != M * D || out_size != M * D || ws_size < WS_END) { fprintf(stderr, "kernel_launch: unexpected problem (n_in %d, in0 %d, out %d, ws %zu); nothing launched\n", n_in, n_in > 0 ? in_sizes[0] : -1, out_size, ws_size); grid = -1; return; }
        int dev = 0, cus = 0, per_cu = 0;
        if (hipGetDevice(&dev) != hipSuccess || hipDeviceGetAttribute(&cus, hipDeviceAttributeMultiprocessorCount, dev) != hipSuccess) { grid = -1; return; }
        if (hipFuncSetAttribute((const void*)mega_fwd, hipFuncAttributeMaxDynamicSharedMemorySize, LDS_BYTES) != hipSuccess) { fprintf(stderr, "kernel_launch: hipFuncSetAttribute failed\n"); grid = -1; return; }
        if (hipOccupancyMaxActiveBlocksPerMultiprocessor(&per_cu, (const void*)mega_fwd, NWAVES * 64, LDS_BYTES) != hipSuccess || per_cu < 1)
            fprintf(stderr, "kernel_launch: note: occupancy query reports %d workgroups per CU\n", per_cu);
        (void)hipGetLastError();
        grid = cus;
    }
    if (grid < 0) return;
    if (hipMemsetAsync((char*)d_ws + WS_CTL, 0, CTL_ZERO_BYTES, stream) != hipSuccess) return;
    Args a{};
    for (int i = 0; i < N_IN; ++i) a.in[i] = (const float*)d_in[i];
    a.out = (float*)d_out; a.ws = (unsigned char*)d_ws;
    unsigned char* ws = (unsigned char*)d_ws;
    auto launch = [&](int lo, int hi, int li) { a.ph_lo = lo; a.ph_hi = hi; a.li = li; hipLaunchKernelGGL(mega_fwd, dim3(grid), dim3(NWAVES * 64), LDS_BYTES, stream, a); };
#if SIMPLE_HGRN || SIMPLE_LRU
    launch(0, 4, 0);
#if SIMPLE_HGRN
    {   float* OH = (float*)(ws + WS_XB);
        hipLaunchKernelGGL(k_simple_hgrn, dim3(64), dim3(64), 0, stream, (const float*)(ws + WS_LOGF), (const bf16*)(ws + WS_MIXA), (const bf16*)(ws + WS_V), OH);
        hipLaunchKernelGGL(k_simple_hnorm, dim3(M * HEADS / 4), dim3(256), 0, stream, (const float*)OH, (const bf16*)(ws + WS_SG), (const float*)d_in[I_HGN], (bf16*)(ws + WS_MIXA)); }
#endif
#if SIMPLE_LRU
    {   float* LA = (float*)(ws + WS_KVT); float* LU = LA + (size_t)M * 1024;
        hipLaunchKernelGGL(k_simple_lru_a, dim3(M), dim3(256), 0, stream, (const bf16*)(ws + WS_LRX), (const float*)d_in[I_CW], (const float*)d_in[I_CB], (const float*)d_in[I_LWA], (const float*)d_in[I_LBA],
                           (const float*)d_in[I_LWX], (const float*)d_in[I_LBX], (const float*)d_in[I_LAM], LA, LU);
        hipLaunchKernelGGL(k_simple_lru_b, dim3(BATCH * 1024 / 256), dim3(256), 0, stream, (const float*)LA, (const float*)LU, (bf16*)(ws + WS_MIXA)); }
#endif
    launch(4, N_PHASES, 1);
#else
#if N_LAUNCHES == 1
    launch(0, N_PHASES, 0);
#else
    for (int ph = 0; ph < N_PHASES; ++ph) launch(ph, ph + 1, 0);
#endif
#endif
}
```

```cpp
#include <hip/hip_runtime.h>
#include <cstdio>
#include <cstdint>
#ifndef SIMPLE_HGRN
#define SIMPLE_HGRN 0
#endif
#ifndef SIMPLE_LRU
#define SIMPLE_LRU 0
#endif
#ifndef N_LAUNCHES
#define N_LAUNCHES 1
#endif
#if SIMPLE_HGRN
#define MIXER_PHASE_4
#define MIXER_PHASE_6
#define MIXER_SCAN
#else
#define MIXER_PHASE_4 hgrn_local_phase(F);
#define MIXER_PHASE_6 hgrn_out_phase(F);
#define MIXER_SCAN hgrn_scan_phase(F);
#endif
#if SIMPLE_LRU
#define MIXER_LRU
#else
#define MIXER_LRU lru_phase(F);
#endif
#define MIXER_PHASE_5 MIXER_SCAN MIXER_LRU
namespace pg8 {
#define PG8_LAS __attribute__((address_space(3)))
typedef unsigned short bf16_t;
typedef short bf16x8 __attribute__((ext_vector_type(8)));
typedef float f32x4 __attribute__((ext_vector_type(4)));
typedef unsigned u32x4 __attribute__((ext_vector_type(4)));
constexpr int BM = 256, BK = 64, HALF = 128, HTB = HALF * BK * 2  , STAGE_BYTES = 8 * HTB, NXCD = 8, WGM = 8;

__host__ __device__ __forceinline__ int lds_byte(int r, int c) { const int st = (r >> 4) * 2 + (c >> 5), rr = r & 15, cc = c & 31, ob = rr * 64 + cc * 2; return st * 1024 + (ob ^ (((ob >> 9) & 1) << 5)); }
__host__ __device__ __forceinline__ void stage_rc(int b, int& R, int& C) { const int st = b / 1024, sb = b % 1024, swz = sb ^ (((sb >> 9) & 1) << 5); R = (st >> 1) * 16 + swz / 64; C = (st & 1) * 32 + (swz % 64) / 2; }
__host__ __device__ __forceinline__ int perm32(int rho) { const int n = rho >> 4, i = rho & 15; return 8 * (i >> 2) + 4 * n + (i & 3); }

struct Unit { int pm, pn; };
struct Gemm { const bf16_t* A; const bf16_t* Bt; int M, N, K; };

struct StaticOrder {
    int nM, nN, nwg, G, c;
    __host__ __device__ void init(int M, int N, int G_, int c_) { nM = M / BM; nN = N / BM; nwg = nM * nN; G = G_; c = c_; }
    __host__ __device__ bool next(int i, Unit& u) const {
        const long L = (long)i * G + c; if (L >= nwg) return false;
        int wgid = (int)L; { const int q = nwg / NXCD, r = nwg % NXCD, xcd = wgid % NXCD, off = wgid / NXCD; wgid = (xcd < r ? xcd * (q + 1) : r * (q + 1) + (xcd - r) * q) + off; }
        const int nig = WGM * nN, gid = wgid / nig, fm = gid * WGM, gsz = (nM - fm) < WGM ? (nM - fm) : WGM;
        u.pm = fm + ((wgid % nig) % gsz); u.pn = (wgid % nig) / gsz; return true;
    }
    __device__ __forceinline__ void a_ready(const Unit&) const {}
    __device__ __forceinline__ void done(const Unit&) const {}
};
__device__ __forceinline__ unsigned cvt_pk_bf16(float lo, float hi) { unsigned r; asm volatile("v_cvt_pk_bf16_f32 %0, %1, %2" : "=v"(r) : "v"(lo), "v"(hi)); return r; }
typedef unsigned u32x2 __attribute__((ext_vector_type(2)));
constexpr int DM = 2048;
constexpr int NSSQ = 32;
__device__ __forceinline__ float sigmoid_f(float x) { return __builtin_amdgcn_rcpf(1.0f + __expf(-x)); }
__device__ __forceinline__ float silu_f(float x) { return x * sigmoid_f(x); }
__device__ __forceinline__ float gelu_tanh_f(float x) { return x * sigmoid_f(1.5957691216057308f * (x + 0.044715f * x * x * x)); }
__device__ __forceinline__ float row_rstd(const float* ssq, int row, int fq) {
    const f32x4* p = (const f32x4*)(ssq + (size_t)row * NSSQ + fq * 8);
    const f32x4 a = p[0], b = p[1];
    float s = ((a[0] + a[1]) + (a[2] + a[3])) + ((b[0] + b[1]) + (b[2] + b[3]));
    s += __shfl_xor(s, 16); s += __shfl_xor(s, 32);
    return 1.0f / sqrtf(s * (1.0f / (float)DM) + 1e-6f);
}

struct EpiSwiGLU {
    static constexpr bool PERM = true, AFTER_DRAIN = false;
    bf16_t* O; int ldo; const float* ssq;
    __device__ __forceinline__ void operator()(const f32x4 (&acc)[2][2][4][2], const Unit& u, int wr, int wc, int fr, int fq) const {
        const int row0 = u.pm * BM + wr * 64 + fr, col0 = u.pn * HALF + wc * 32 + 8 * fq;
#pragma unroll
        for (int ai = 0; ai < 2; ++ai)
#pragma unroll
            for (int m = 0; m < 4; ++m) {
                const int row = row0 + ai * HALF + m * 16; const float rs = row_rstd(ssq, row, fq);
                float h[8];
#pragma unroll
                for (int n = 0; n < 2; ++n)
#pragma unroll
                    for (int j = 0; j < 4; ++j) { const float g = acc[ai][0][m][n][j] * rs, up = acc[ai][1][m][n][j] * rs; h[n * 4 + j] = silu_f(g) * up; }
                u32x4 w; w.x = cvt_pk_bf16(h[0], h[1]); w.y = cvt_pk_bf16(h[2], h[3]); w.z = cvt_pk_bf16(h[4], h[5]); w.w = cvt_pk_bf16(h[6], h[7]);
                *(u32x4*)(O + (size_t)row * ldo + col0) = w;
            }
    }
};
struct EpiResid {
    static constexpr bool PERM = false, AFTER_DRAIN = false;
    const float* src; float* dst; bf16_t* xb; float* ssq_out; float scale;
    __device__ __forceinline__ void operator()(const f32x4 (&acc)[2][2][4][2], const Unit& u, int wr, int wc, int fr, int fq) const {
        const int row0 = u.pm * BM + wr * 64 + fr, col0 = u.pn * BM + wc * 32 + 4 * fq;
#pragma unroll
        for (int ai = 0; ai < 2; ++ai)
#pragma unroll
            for (int m = 0; m < 4; ++m) {
                const int row = row0 + ai * HALF + m * 16; float ss = 0.f;
#pragma unroll
                for (int bj = 0; bj < 2; ++bj)
#pragma unroll
                    for (int n = 0; n < 2; ++n) { const size_t off = (size_t)row * DM + col0 + bj * HALF + n * 16;
                        const f32x4 o = *(const f32x4*)(src + off) + acc[ai][bj][m][n] * scale;
                        *(f32x4*)(dst + off) = o; u32x2 w; w.x = cvt_pk_bf16(o[0], o[1]); w.y = cvt_pk_bf16(o[2], o[3]); *(u32x2*)(xb + off) = w;
                        ss += (o[0] * o[0] + o[1] * o[1]) + (o[2] * o[2] + o[3] * o[3]); }
                ss += __shfl_xor(ss, 16); ss += __shfl_xor(ss, 32);
                if (fq == 0) ssq_out[(size_t)row * NSSQ + u.pn * 4 + wc] = ss;
            }
    }
};
struct EpiZ {
    static constexpr bool PERM = true, AFTER_DRAIN = false;
    const float* ssq; const float* hlb;
    bf16_t* mixa;
    float* logf; bf16_t* vv; bf16_t* sg; bf16_t* lrx;
    __device__ __forceinline__ void operator()(const f32x4 (&acc)[2][2][4][2], const Unit& u, int wr, int wc, int fr, int fq) const {
        const int seg = u.pn >> 2;
        const int row0 = u.pm * BM + wr * 64 + fr, cs0 = (u.pn & 3) * BM + wc * 32 + 8 * fq;
        float lbv[2][8];
        if (seg == 1) {
#pragma unroll
            for (int bj = 0; bj < 2; ++bj)
#pragma unroll
                for (int e = 0; e < 8; ++e) { const int c = cs0 + bj * HALF + e; lbv[bj][e] = sigmoid_f(hlb[c] - hlb[1024 + c]); }
        }
#pragma unroll
        for (int ai = 0; ai < 2; ++ai)
#pragma unroll
            for (int m = 0; m < 4; ++m) {
                const int row = row0 + ai * HALF + m * 16; const float rs = row_rstd(ssq, row, fq);
#pragma unroll
                for (int bj = 0; bj < 2; ++bj) {
                    const int cs = cs0 + bj * HALF;
                    float z[8];
#pragma unroll
                    for (int n = 0; n < 2; ++n)
#pragma unroll
                        for (int j = 0; j < 4; ++j) z[n * 4 + j] = acc[ai][bj][m][n][j] * rs;
                    if (seg == 1) {
                        float lf[8];
#pragma unroll
                        for (int e = 0; e < 8; ++e) { const float lb = lbv[bj][e]; lf[e] = __logf(lb + (1.0f - lb) * sigmoid_f(z[e])); }
                        float* p = logf + (size_t)row * 1024 + cs;
                        *(f32x4*)p = (f32x4){lf[0], lf[1], lf[2], lf[3]}; *(f32x4*)(p + 4) = (f32x4){lf[4], lf[5], lf[6], lf[7]};
                    } else {
                        if (seg == 3) {
#pragma unroll
                            for (int e = 0; e < 8; ++e) z[e] = silu_f(z[e]);
                        } else if (seg == 5) {
#pragma unroll
                            for (int e = 0; e < 8; ++e) z[e] = gelu_tanh_f(z[e]);
                        }
                        u32x4 w; w.x = cvt_pk_bf16(z[0], z[1]); w.y = cvt_pk_bf16(z[2], z[3]); w.z = cvt_pk_bf16(z[4], z[5]); w.w = cvt_pk_bf16(z[6], z[7]);
                        bf16_t* p;
                        if (seg == 0) p = mixa + (size_t)row * 2048 + cs;
                        else if (seg == 5) p = mixa + (size_t)row * 2048 + 1024 + cs;
                        else if (seg == 2) p = vv + (size_t)row * 1024 + cs;
                        else if (seg == 3) p = sg + (size_t)row * 1024 + cs;
                        else p = lrx + (size_t)row * 1024 + cs;
                        *(u32x4*)p = w;
                    }
                }
            }
    }
};
struct EpiPP {
    static constexpr bool PERM = false, AFTER_DRAIN = false;
    float* PP;
    __device__ __forceinline__ void operator()(const f32x4 (&acc)[2][2][4][2], const Unit& u, int wr, int wc, int fr, int fq) const {
        const int row0 = u.pm * BM + wr * 64 + fr, col0 = u.pn * BM + wc * 32 + 4 * fq;
#pragma unroll
        for (int ai = 0; ai < 2; ++ai)
#pragma unroll
            for (int m = 0; m < 4; ++m) { float* rowp = PP + (size_t)(row0 + ai * HALF + m * 16) * DM + col0;
#pragma unroll
                for (int bj = 0; bj < 2; ++bj)
#pragma unroll
                    for (int n = 0; n < 2; ++n) *(f32x4*)(rowp + bj * HALF + n * 16) = acc[ai][bj][m][n]; }
    }
};
struct EpiPLE {
    static constexpr bool PERM = false, AFTER_DRAIN = false;
    const float* ssq_in; const float* bg; const float* PP; float* X; float* ssq_out;
    __device__ __forceinline__ void operator()(const f32x4 (&acc)[2][2][4][2], const Unit& u, int wr, int wc, int fr, int fq) const {
        const int row0 = u.pm * BM + wr * 64 + fr, col0 = u.pn * BM + wc * 32 + 4 * fq;
#pragma unroll
        for (int ai = 0; ai < 2; ++ai)
#pragma unroll
            for (int m = 0; m < 4; ++m) {
                const int row = row0 + ai * HALF + m * 16; const float rs = row_rstd(ssq_in, row, fq); float ss = 0.f;
#pragma unroll
                for (int bj = 0; bj < 2; ++bj)
#pragma unroll
                    for (int n = 0; n < 2; ++n) { const int c = col0 + bj * HALF + n * 16; const size_t off = (size_t)row * DM + c;
                        const f32x4 b4 = *(const f32x4*)(bg + c), pp = *(const f32x4*)(PP + off), old = *(const f32x4*)(X + off), a = acc[ai][bj][m][n];
                        f32x4 o;
#pragma unroll
                        for (int j = 0; j < 4; ++j) o[j] = old[j] + sigmoid_f(a[j] * rs + b4[j]) * pp[j];
                        *(f32x4*)(X + off) = o; ss += (o[0] * o[0] + o[1] * o[1]) + (o[2] * o[2] + o[3] * o[3]);
                        asm volatile("" ::: "memory"); }
                ss += __shfl_xor(ss, 16); ss += __shfl_xor(ss, 32);
                if (fq == 0) ssq_out[(size_t)row * NSSQ + u.pn * 4 + wc] = ss;
            }
    }
};

template <class Epi, class Sched, bool ALIGN_EPI = false, bool SP2 = false>
__device__ __forceinline__ void gemm_phase(PG8_LAS unsigned char* lds, const Gemm g, const Sched& S, const Epi& E) {
    int tid_ = threadIdx.x; asm volatile("" : "+v"(tid_));
    const int tid = tid_, wid = __builtin_amdgcn_readfirstlane(tid >> 6), lane = tid & 63, wr = wid >> 2, wc = wid & 3, fr = lane & 15, fq = lane >> 4;
    const int K = g.K, nt = K / BK;
    unsigned voffA[2], voffB[2];
#pragma unroll
    for (int i = 0; i < 2; ++i) { int R, C; stage_rc(tid * 16 + i * 8192, R, C); const int Rb = Epi::PERM ? ((R & ~31) + perm32(R & 31)) : R;
        voffA[i] = (unsigned)(R * K + C) * 2u; voffB[i] = (unsigned)(Rb * K + C) * 2u; }
    const size_t kstep = (size_t)(BK * 2);
    const size_t hstep = (size_t)HALF * K * 2;
    const size_t tstep = 2 * hstep;
    const unsigned ldsw = (unsigned)wid * 1024u;
    const int aoff = lds_byte(wr * 64 + fr, fq * 8), boff = lds_byte(wc * 32 + fr, fq * 8);
#define PG8_SA(b, h) (((b) * 2 + (h)) * HTB)
#define PG8_SB(b, h) ((4 + (b) * 2 + (h)) * HTB)
#define PG8_STAGE(bufoff, gbase, voff) do { _Pragma("unroll") for (int _i = 0; _i < 2; ++_i) \
        __builtin_amdgcn_global_load_lds((const unsigned*)((const char*)(gbase) + (voff)[_i]), (PG8_LAS unsigned*)(lds + (bufoff) + ldsw + _i * 8192), 16, 0, 0); } while (0)
#define PG8_LDA(dst, b, h) do { _Pragma("unroll") for (int m = 0; m < 4; ++m) _Pragma("unroll") for (int k = 0; k < 2; ++k) dst[m][k] = *(const PG8_LAS bf16x8*)(lds + PG8_SA(b, h) + aoff + m * 2048 + k * 1024); } while (0)
#define PG8_LDB(dst, b, h) do { _Pragma("unroll") for (int n = 0; n < 2; ++n) _Pragma("unroll") for (int k = 0; k < 2; ++k) dst[n][k] = *(const PG8_LAS bf16x8*)(lds + PG8_SB(b, h) + boff + n * 2048 + k * 1024); } while (0)
#define PG8_MMA(ai, bj, At, Bt) do { __builtin_amdgcn_s_setprio(1); _Pragma("unroll") for (int m = 0; m < 4; ++m) _Pragma("unroll") for (int n = 0; n < 2; ++n) _Pragma("unroll") for (int k = 0; k < 2; ++k) \
        acc[ai][bj][m][n] = __builtin_amdgcn_mfma_f32_16x16x32_bf16(Bt[n][k], At[m][k], acc[ai][bj][m][n], 0, 0, 0); __builtin_amdgcn_s_setprio(0); } while (0)
#define PG8_WAIT_V(n) asm volatile("s_waitcnt vmcnt(" #n ")" ::: "memory")
#define PG8_WAIT_L(n) asm volatile("s_waitcnt lgkmcnt(" #n ")" ::: "memory")
#define PG8_BAR __builtin_amdgcn_s_barrier()
#define PG8_SCHED __builtin_amdgcn_sched_barrier(0)
    Unit cur, nxt; int ui = 0;
    if (!S.next(0, cur)) return;
    f32x4 acc[2][2][4][2];
#pragma unroll
    for (int a = 0; a < 2; ++a)
#pragma unroll
        for (int b = 0; b < 2; ++b)
#pragma unroll
            for (int m = 0; m < 4; ++m)
#pragma unroll
                for (int n = 0; n < 2; ++n) acc[a][b][m][n] = (f32x4){0.f, 0.f, 0.f, 0.f};
    bf16x8 At[4][2], B0[2][2], B1[2][2];
    const char* cA = (const char*)g.A + (size_t)cur.pm * tstep; const char* cB = (const char*)g.Bt + (size_t)cur.pn * tstep;
    S.a_ready(cur);
    if constexpr (SP2) {
        PG8_STAGE(PG8_SB(0, 0), cB, voffB); PG8_STAGE(PG8_SB(0, 1), cB + hstep, voffB); PG8_STAGE(PG8_SA(0, 0), cA, voffA); PG8_STAGE(PG8_SA(0, 1), cA + hstep, voffA);
        if (wr == 1) PG8_BAR;
        PG8_WAIT_V(2); PG8_BAR;
        PG8_STAGE(PG8_SB(1, 0), cB + kstep, voffB); PG8_STAGE(PG8_SA(1, 0), cA + kstep, voffA); PG8_STAGE(PG8_SB(1, 1), cB + hstep + kstep, voffB);
        PG8_WAIT_V(6); PG8_BAR;
    } else {
        PG8_STAGE(PG8_SB(0, 0), cB, voffB); PG8_STAGE(PG8_SA(0, 0), cA, voffA); PG8_STAGE(PG8_SB(0, 1), cB + hstep, voffB); PG8_STAGE(PG8_SA(0, 1), cA + hstep, voffA);
        if (wr == 1) PG8_BAR;
        PG8_WAIT_V(4); PG8_BAR;
        PG8_STAGE(PG8_SB(1, 0), cB + kstep, voffB); PG8_STAGE(PG8_SA(1, 0), cA + kstep, voffA); PG8_STAGE(PG8_SB(1, 1), cB + hstep + kstep, voffB);
        PG8_WAIT_V(6); PG8_BAR;
    }
    for (;;) {
        const bool has_next = S.next(ui + 1, nxt);
        const char* nA = has_next ? (const char*)g.A + (size_t)nxt.pm * tstep : cA; const char* nB = has_next ? (const char*)g.Bt + (size_t)nxt.pn * tstep : cB;
        for (int t = 0; t < nt; t += 2) {
            const bool last = (t == nt - 2);
            const char* a1 = cA + (size_t)(t + 1) * kstep;
            const char* a2 = last ? nA : cA + (size_t)(t + 2) * kstep; const char* b2 = last ? nB : cB + (size_t)(t + 2) * kstep;
            const char* a3 = a2 + kstep; const char* b3 = b2 + kstep;
            if (last && has_next) S.a_ready(nxt);
            if constexpr (SP2) {
            PG8_LDB(B0, 0, 0); PG8_LDB(B1, 0, 1); PG8_SCHED; PG8_LDA(At, 0, 0); PG8_STAGE(PG8_SA(1, 1), a1 + hstep, voffA);
            PG8_WAIT_V(8); PG8_WAIT_L(0); PG8_BAR; PG8_MMA(0, 0, At, B0); PG8_MMA(0, 1, At, B1); PG8_BAR; PG8_SCHED;
            PG8_LDA(At, 0, 1); PG8_STAGE(PG8_SB(0, 0), b2, voffB); PG8_STAGE(PG8_SB(0, 1), b2 + hstep, voffB); PG8_STAGE(PG8_SA(0, 0), a2, voffA);
            PG8_WAIT_V(8); PG8_WAIT_L(0); PG8_BAR; PG8_MMA(1, 0, At, B0); PG8_MMA(1, 1, At, B1); PG8_BAR; PG8_SCHED;
            PG8_LDB(B0, 1, 0); PG8_LDB(B1, 1, 1); PG8_SCHED; PG8_LDA(At, 1, 0); PG8_STAGE(PG8_SA(0, 1), a2 + hstep, voffA);
            PG8_WAIT_V(8); PG8_WAIT_L(0); PG8_BAR; PG8_MMA(0, 0, At, B0); PG8_MMA(0, 1, At, B1); PG8_BAR; PG8_SCHED;
            PG8_LDA(At, 1, 1); PG8_STAGE(PG8_SB(1, 0), b3, voffB); PG8_STAGE(PG8_SB(1, 1), b3 + hstep, voffB); PG8_STAGE(PG8_SA(1, 0), a3, voffA);
            PG8_WAIT_V(8); PG8_WAIT_L(0); PG8_BAR; PG8_MMA(1, 0, At, B0); PG8_MMA(1, 1, At, B1); PG8_BAR; PG8_SCHED;
            } else {
            PG8_LDB(B0, 0, 0); PG8_SCHED; PG8_LDA(At, 0, 0); PG8_STAGE(PG8_SA(1, 1), a1 + hstep, voffA);
            PG8_WAIT_L(8); PG8_BAR; PG8_WAIT_L(0); PG8_MMA(0, 0, At, B0); PG8_BAR; PG8_SCHED;
            PG8_LDB(B1, 0, 1); PG8_STAGE(PG8_SB(0, 0), b2, voffB);
            PG8_BAR; PG8_WAIT_L(0); PG8_MMA(0, 1, At, B1); PG8_BAR;
            PG8_LDA(At, 0, 1); PG8_STAGE(PG8_SA(0, 0), a2, voffA);
            PG8_BAR; PG8_WAIT_L(0); PG8_MMA(1, 0, At, B0); PG8_BAR; PG8_SCHED;
            PG8_STAGE(PG8_SB(0, 1), b2 + hstep, voffB);
            PG8_WAIT_V(6); PG8_BAR; PG8_MMA(1, 1, At, B1); PG8_BAR;
            PG8_LDB(B0, 1, 0); PG8_SCHED; PG8_LDA(At, 1, 0); PG8_STAGE(PG8_SA(0, 1), a2 + hstep, voffA);
            PG8_WAIT_L(8); PG8_BAR; PG8_WAIT_L(0); PG8_MMA(0, 0, At, B0); PG8_BAR; PG8_SCHED;
            PG8_LDB(B1, 1, 1); PG8_STAGE(PG8_SB(1, 0), b3, voffB);
            PG8_BAR; PG8_WAIT_L(0); PG8_MMA(0, 1, At, B1); PG8_BAR;
            PG8_LDA(At, 1, 1); PG8_STAGE(PG8_SA(1, 0), a3, voffA);
            PG8_BAR; PG8_WAIT_L(0); PG8_MMA(1, 0, At, B0); PG8_BAR; PG8_SCHED;
            PG8_STAGE(PG8_SB(1, 1), b3 + hstep, voffB);
            PG8_WAIT_V(6); PG8_BAR; PG8_MMA(1, 1, At, B1); PG8_BAR;
            }
        }
        if constexpr (ALIGN_EPI) { if (wr == 0) PG8_BAR; }
        if constexpr (!Epi::AFTER_DRAIN) { E(acc, cur, wr, wc, fr, fq); S.done(cur); }
        if (!has_next) break;
#pragma unroll
        for (int a = 0; a < 2; ++a)
#pragma unroll
            for (int b = 0; b < 2; ++b)
#pragma unroll
                for (int m = 0; m < 4; ++m)
#pragma unroll
                    for (int n = 0; n < 2; ++n) acc[a][b][m][n] = (f32x4){0.f, 0.f, 0.f, 0.f};
        cur = nxt; cA = nA; cB = nB; ++ui;
        if constexpr (ALIGN_EPI) { if (wr == 1) PG8_BAR; }
    }
    PG8_WAIT_V(0);
    if constexpr (!ALIGN_EPI) { if (wr == 0) PG8_BAR; }
    PG8_BAR;
    if constexpr (Epi::AFTER_DRAIN) { E.fused(acc, cur, wr, wc, fr, fq, lds, wid, lane); S.done(cur); }
#undef PG8_SA
#undef PG8_SB
#undef PG8_STAGE
#undef PG8_LDA
#undef PG8_LDB
#undef PG8_MMA
#undef PG8_WAIT_V
#undef PG8_WAIT_L
#undef PG8_BAR
#undef PG8_SCHED
}
}
#define GAS __attribute__((address_space(1)))
#define LAS __attribute__((address_space(3)))
typedef unsigned short bf16;
typedef unsigned v4u __attribute__((ext_vector_type(4)));
typedef float f32x4 __attribute__((ext_vector_type(4)));
typedef short bf16x8 __attribute__((ext_vector_type(8)));
typedef GAS unsigned gu32;
typedef GAS unsigned long long gu64;
#define RLX_AGENT __ATOMIC_RELAXED, __HIP_MEMORY_SCOPE_AGENT
#define LDS_WAIT() asm volatile("s_waitcnt lgkmcnt(0)" ::: "memory")
#define VM_WAIT() asm volatile("s_waitcnt vmcnt(0)" ::: "memory")
__device__ __forceinline__ unsigned long long rt() { return __builtin_amdgcn_s_memrealtime(); }
__device__ __forceinline__ unsigned f2bf(float f) { unsigned u = __builtin_bit_cast(unsigned, f); return (u + 0x7fffu + ((u >> 16) & 1u)) >> 16; }
__device__ __forceinline__ unsigned pk2(float lo, float hi) { return f2bf(lo) | (f2bf(hi) << 16); }

#define XB_TMO      128
#define XB_XCNT(j)  (256  + 64 * (j))
#define XB_XSUB(j)  (1280 + 64 * (j))
#define XB_XGEN(j)  (2304 + 64 * (j))
#define XB_TOP      3328
#define XB_TOPGEN   3392
#define XCD_BAR_WORDS 3456
#define XB_SPIN_CAP (1u << 18)

__device__ __forceinline__ unsigned xb_ld(unsigned* p)              { return __hip_atomic_load(p, __ATOMIC_RELAXED, __HIP_MEMORY_SCOPE_AGENT); }
__device__ __forceinline__ unsigned xb_add(unsigned* p, unsigned v) { return __hip_atomic_fetch_add(p, v, __ATOMIC_RELAXED, __HIP_MEMORY_SCOPE_AGENT); }
__device__ __forceinline__ unsigned xb_xcc_id() { return (unsigned)__builtin_amdgcn_s_getreg((3 << 11) | 20) & 0xFu; }
#define XB_SPIN(cond, bar) do { unsigned _sp = 0; while (cond) { __builtin_amdgcn_s_sleep(1); \
    if ((++_sp & 255u) == 0u) { if (xb_ld(&(bar)[XB_TMO])) break; if (_sp > XB_SPIN_CAP) { atomicAdd(&(bar)[XB_TMO], 1u); break; } } } } while (0)

struct XcdBarrier {
    unsigned* bar; unsigned x;
    volatile LAS unsigned* st;
};

__device__ __forceinline__ XcdBarrier xcd_barrier_post(unsigned* bar, volatile LAS unsigned* st) {
    XcdBarrier b; b.bar = bar; b.x = xb_xcc_id(); b.st = st;
    if (threadIdx.x == 0) (void)xb_add(&bar[XB_XCNT(b.x)], 1u);
    return b;
}
__device__ __forceinline__ void xcd_barrier_complete(unsigned* bar, unsigned x, unsigned& nloc, unsigned& nx) {
    const unsigned G = gridDim.x * gridDim.y * gridDim.z;
    unsigned sum, cnt, mine, sp = 0u;
    for (;;) {
        sum = 0u; cnt = 0u; mine = 0u;
#pragma unroll
        for (unsigned j = 0; j < 16; ++j) { const unsigned c = xb_ld(&bar[XB_XCNT(j)]); sum += c; cnt += (c > 0u) ? 1u : 0u; mine = (j == x) ? c : mine; }
        if (sum == G) break;
        __builtin_amdgcn_s_sleep(1);
        if ((++sp & 255u) == 0u) { if (xb_ld(&bar[XB_TMO])) break; if (sp > XB_SPIN_CAP) { atomicAdd(&bar[XB_TMO], 1u); break; } }
    }
    nloc = mine > 0u ? mine : 1u; nx = cnt > 0u ? cnt : 1u;
}

__device__ __forceinline__ void xcd_barrier(const XcdBarrier& b) {
    asm volatile("s_waitcnt vmcnt(0)" ::: "memory");
    __syncthreads();
    if (threadIdx.x == 0) {
        unsigned* bar = b.bar;
        __builtin_amdgcn_s_waitcnt(0);
        unsigned nloc = b.st[0], nx = b.st[1];
        if (nloc == 0u) { xcd_barrier_complete(bar, b.x, nloc, nx); b.st[0] = nloc; b.st[1] = nx; }
        const unsigned old = xb_add(&bar[XB_XSUB(b.x)], 1u);
        const unsigned gen = old / nloc;
        if (old + 1u == (gen + 1u) * nloc) {
            __builtin_amdgcn_fence(__ATOMIC_RELEASE, "agent");
            asm volatile("s_waitcnt vmcnt(0)" ::: "memory");
            const unsigned og = xb_add(&bar[XB_TOP], 1u);
            const unsigned tg = og / nx;
            if (og + 1u == (tg + 1u) * nx) xb_add(&bar[XB_TOPGEN], 1u);
            else XB_SPIN(xb_ld(&bar[XB_TOPGEN]) == tg, bar);
            __builtin_amdgcn_fence(__ATOMIC_ACQUIRE, "agent");
            xb_add(&bar[XB_XGEN(b.x)], 1u);
            asm volatile("s_waitcnt vmcnt(0)" ::: "memory");
        } else {
            XB_SPIN(xb_ld(&bar[XB_XGEN(b.x)]) == gen, bar);
            __builtin_amdgcn_fence(__ATOMIC_ACQUIRE, "agent");
            asm volatile("s_waitcnt vmcnt(0)" ::: "memory");
        }
    }
    __syncthreads();
}

constexpr int NWAVES = 8;
constexpr int BATCH = 4, SEQ = 2048, D = 2048, DFF = 5632, NGU = 2 * DFF, NIN = 6144, PLE = 256;
constexpr int HW = 1024, LW = 1024, HEADS = 8, HD = 128, CHUNK = 64, NCH = SEQ / CHUNK;
constexpr int M = BATCH * SEQ;
constexpr float EPS = 1e-6f;
constexpr int N_IN = 27;
enum In { I_X = 0, I_P, I_F1N, I_F1G, I_F1U, I_F1D, I_MIXN, I_WIN, I_HLB, I_HGN, I_CW, I_CB, I_LWA, I_LBA, I_LWX, I_LBX, I_LAM, I_WOUT,
          I_F2N, I_F2G, I_F2U, I_F2D, I_PLN, I_PWG, I_PBG, I_PWP, I_FN };

constexpr size_t MiB = 1u << 20;
constexpr size_t WS_CTL = 0, CTL_ZERO_BYTES = 1 * MiB;
constexpr size_t WS_SSQA = 1 * MiB, WS_SSQB = 2 * MiB, WS_DEC = 3 * MiB;
constexpr size_t WS_WAT = 3 * MiB + 512 * 1024, WS_WXT = 3 * MiB + 768 * 1024;
constexpr size_t WS_WPROJ = 4 * MiB, WS_PB = 5 * MiB;
constexpr size_t WS_WGU1 = 9 * MiB, WS_WD1 = 53 * MiB, WS_WINT = 75 * MiB, WS_WOUT = 99 * MiB, WS_WGU2 = 107 * MiB, WS_WD2 = 151 * MiB, WS_WPG = 173 * MiB;
constexpr size_t WS_XB = 181 * MiB;
constexpr size_t WS_ACT = 213 * MiB;
constexpr size_t WS_LOGF = WS_ACT, WS_V = WS_ACT + 32 * MiB, WS_SG = WS_ACT + 48 * MiB, WS_LRX = WS_ACT + 64 * MiB, WS_PP = WS_ACT;
constexpr size_t WS_MIXA = 301 * MiB;
constexpr size_t WS_KVT = 333 * MiB;
constexpr size_t WS_END = 397 * MiB;
static_assert(WS_WGU1 + (size_t)NGU * D * 2 <= WS_WD1 && WS_WD1 + (size_t)D * DFF * 2 <= WS_WINT && WS_WINT + (size_t)NIN * D * 2 <= WS_WOUT && WS_WOUT + (size_t)D * D * 2 <= WS_WGU2 &&
              WS_WGU2 + (size_t)NGU * D * 2 <= WS_WD2 && WS_WD2 + (size_t)D * DFF * 2 <= WS_WPG && WS_WPG + (size_t)D * D * 2 <= WS_XB && WS_XB + (size_t)M * D * 2 <= WS_ACT &&
              WS_ACT + (size_t)M * DFF * 2 <= WS_MIXA && WS_MIXA + (size_t)M * 2048 * 2 <= WS_KVT && WS_KVT + (size_t)BATCH * HEADS * NCH * HD * HD * 4 <= WS_END &&
              WS_LRX + (size_t)M * 1024 * 2 <= WS_MIXA && WS_PP + (size_t)M * D * 4 <= WS_MIXA && WS_PB + (size_t)M * PLE * 2 <= WS_WGU1 && WS_WPROJ + (size_t)D * PLE * 2 <= WS_PB, "d_ws map");
constexpr int CW_BAR = 4096;

constexpr int RING_OFF = 0, RING_BYTES = 131072;
constexpr int LDSCTL_OFF = 147456 - 512, MISC_OFF = LDSCTL_OFF + 320;
constexpr int LDS_BYTES = 147456;
static_assert(MISC_OFF + 128 <= LDS_BYTES, "LDS map");


struct Frame {
    LAS unsigned char* lds;
    volatile LAS unsigned* MISC;
    gu32* ctl;
    int tid, lane, wave;
    int vcu, G;
    const float* in[N_IN]; float* out; unsigned char* ws;
};
__device__ __forceinline__ float bf2f(bf16 b) { return __builtin_bit_cast(float, (unsigned)b << 16); }
__device__ __forceinline__ float wave_sum(float v) {
#pragma unroll
    for (int o = 1; o < 64; o <<= 1) v += __shfl_xor(v, o);
    return v;
}
__device__ __forceinline__ void p0_transpose_item(const float* W, int ldw, int K, int src_col0, bf16* WT, int dst_row0, const float* gain, LAS float* scr, int kb, int lane) {
    const int k0 = 64 * kb, kq = lane >> 4, nq = lane & 15;
    f32x4 v[16];
#pragma unroll
    for (int i = 0; i < 16; ++i) v[i] = *(const GAS f32x4*)(W + (size_t)(k0 + 4 * i + kq) * ldw + src_col0 + 4 * nq);
    if (gain) {
#pragma unroll
        for (int i = 0; i < 16; ++i) v[i] = v[i] * gain[k0 + 4 * i + kq];
    }
#pragma unroll
    for (int i = 0; i < 16; ++i) { LAS float* s = scr + (4 * i + kq) * 65 + 4 * nq; s[0] = v[i].x; s[1] = v[i].y; s[2] = v[i].z; s[3] = v[i].w; }
    LDS_WAIT(); asm volatile("" ::: "memory");
    const int c = lane & 7;
#pragma unroll
    for (int j = 0; j < 8; ++j) { const int n = (lane >> 3) + 8 * j; const LAS float* s = scr + (8 * c) * 65 + n;
        v4u o; o.x = pk2(s[0 * 65], s[1 * 65]); o.y = pk2(s[2 * 65], s[3 * 65]); o.z = pk2(s[4 * 65], s[5 * 65]); o.w = pk2(s[6 * 65], s[7 * 65]);
        *(GAS v4u*)(WT + (size_t)(dst_row0 + n) * K + k0 + 8 * c) = o; }
    LDS_WAIT(); asm volatile("" ::: "memory");
}
__device__ __forceinline__ bool p0_plain(int& r, const float* W, int K, int N, bf16* WT, const float* gain, LAS float* scr, int lane) {
    const int items = (N / 64) * (K / 64);
    if (r < items) { const int nb = r / (K / 64), kb = r % (K / 64); p0_transpose_item(W, N, K, 64 * nb, WT, 64 * nb, gain, scr, kb, lane); return true; }
    r -= items; return false;
}
__device__ __forceinline__ bool p0_gateup(int& r, const float* Wg, const float* Wu, bf16* WT, const float* gain, LAS float* scr, int lane) {
    const int items = (NGU / 64) * (D / 64);
    if (r < items) { const int rb = r / (D / 64), kb = r % (D / 64), t = rb >> 2, j = rb & 3;
        p0_transpose_item(j < 2 ? Wg : Wu, DFF, D, 128 * t + 64 * (j & 1), WT, 64 * rb, gain, scr, kb, lane); return true; }
    r -= items; return false;
}
__device__ __forceinline__ void p0_prologue(Frame& F) {
    LAS float* scr = (LAS float*)(F.lds + RING_OFF + F.wave * 16640);
    const int gw = F.vcu * NWAVES + F.wave, NGW = F.G * NWAVES;
    unsigned char* ws = F.ws;
    for (int m = gw; m < M; m += NGW) {
        const GAS f32x4* xr = (const GAS f32x4*)(F.in[I_X] + (size_t)m * D) + F.lane;
        GAS unsigned long long* o8 = (GAS unsigned long long*)((bf16*)(ws + WS_XB) + (size_t)m * D) + F.lane;
        float s = 0.f;
#pragma unroll
        for (int j = 0; j < 8; ++j) { const f32x4 v = xr[64 * j]; s += (v.x * v.x + v.y * v.y) + (v.z * v.z + v.w * v.w);
            o8[64 * j] = (unsigned long long)pk2(v.x, v.y) | ((unsigned long long)pk2(v.z, v.w) << 32); }
        s = wave_sum(s);
        if (F.lane < 32) ((float*)(ws + WS_SSQA))[(size_t)m * 32 + F.lane] = (F.lane == 0) ? s : 0.f;
    }
    for (int m = gw; m < M; m += NGW) {
        const f32x4 v = ((const GAS f32x4*)(F.in[I_P] + (size_t)m * PLE))[F.lane];
        ((GAS unsigned long long*)((bf16*)(ws + WS_PB) + (size_t)m * PLE))[F.lane] = (unsigned long long)pk2(v.x, v.y) | ((unsigned long long)pk2(v.z, v.w) << 32);
    }
    constexpr int NITEMS = 2 * (NGU / 64) * (D / 64) + 2 * (D / 64) * (DFF / 64) + (NIN / 64) * (D / 64) + 2 * (D / 64) * (D / 64) + (D / 64) * (PLE / 64) + 16 * (128 / 64) * (128 / 64);
    for (int it = gw; it < NITEMS; it += NGW) {
        int r = it;
        if (p0_gateup(r, F.in[I_F1G], F.in[I_F1U], (bf16*)(ws + WS_WGU1), F.in[I_F1N], scr, F.lane)) continue;
        if (p0_plain(r, F.in[I_F1D], DFF, D, (bf16*)(ws + WS_WD1), nullptr, scr, F.lane)) continue;
        if (p0_plain(r, F.in[I_WIN], D, NIN, (bf16*)(ws + WS_WINT), F.in[I_MIXN], scr, F.lane)) continue;
        if (p0_plain(r, F.in[I_WOUT], D, D, (bf16*)(ws + WS_WOUT), nullptr, scr, F.lane)) continue;
        if (p0_gateup(r, F.in[I_F2G], F.in[I_F2U], (bf16*)(ws + WS_WGU2), F.in[I_F2N], scr, F.lane)) continue;
        if (p0_plain(r, F.in[I_F2D], DFF, D, (bf16*)(ws + WS_WD2), nullptr, scr, F.lane)) continue;
        if (p0_plain(r, F.in[I_PWG], D, D, (bf16*)(ws + WS_WPG), F.in[I_PLN], scr, F.lane)) continue;
        if (p0_plain(r, F.in[I_PWP], PLE, D, (bf16*)(ws + WS_WPROJ), nullptr, scr, F.lane)) continue;
        { const int blk = r >> 2, q = r & 3;
          const float* W = (blk < 8 ? F.in[I_LWA] : F.in[I_LWX]) + (size_t)(blk & 7) * 128 * 128;
          bf16* WT = (bf16*)(ws + (blk < 8 ? WS_WAT : WS_WXT)) + (size_t)(blk & 7) * 128 * 128;
          p0_transpose_item(W, 128, 128, 64 * (q >> 1), WT, 64 * (q >> 1), nullptr, scr, q & 1, F.lane); }
    }
}
__device__ __forceinline__ void final_norm(Frame& F, const float* ssq) {
    const int gw = F.vcu * NWAVES + F.wave, NGW = F.G * NWAVES;
    const GAS f32x4* gf = (const GAS f32x4*)F.in[I_FN] + F.lane;
    for (int m = gw; m < M; m += NGW) {
        float s = (F.lane < 32) ? ssq[(size_t)m * 32 + F.lane] : 0.f;
        s = wave_sum(s);
        const float rstd = 1.0f / sqrtf(s * (1.0f / D) + EPS);
        GAS f32x4* xr = (GAS f32x4*)(F.out + (size_t)m * D) + F.lane;
#pragma unroll
        for (int j = 0; j < 8; ++j) { f32x4 v = xr[64 * j]; const f32x4 g = gf[64 * j]; v = v * rstd * g; xr[64 * j] = v; }
    }
}


typedef float mf32x4 __attribute__((ext_vector_type(4)));
typedef short mbf16x8 __attribute__((ext_vector_type(8)));
typedef unsigned mu32x2 __attribute__((ext_vector_type(2)));
constexpr int TS = 72;
constexpr int QS = 136;
constexpr int NITEM = BATCH * HEADS * NCH;
__device__ __forceinline__ mbf16x8 lds_frag(const LAS bf16* p) { return *(const LAS mbf16x8*)p; }
__device__ __forceinline__ unsigned bf1(float x) { return pg8::cvt_pk_bf16(x, 0.f) & 0xffffu; }
#define MFMA16(a, b, c) __builtin_amdgcn_mfma_f32_16x16x32_bf16((a), (b), (c), 0, 0, 0)

__device__ __forceinline__ void hgrn_local_phase(Frame& F) {
    LAS bf16* kstT = (LAS bf16*)(F.lds);
    LAS bf16* vT = (LAS bf16*)(F.lds + 18432);
    LAS float* qtot = (LAS float*)(F.lds + 36864);
    int tid_ = threadIdx.x; asm volatile("" : "+v"(tid_));
    const int tid = tid_, k = tid & 127, sq = tid >> 7, lane = tid & 63, w = F.wave, fr = lane & 15, fq = lane >> 4;
    const float* LOGF = (const float*)(F.ws + WS_LOGF); const bf16* V = (const bf16*)(F.ws + WS_V);
    float* KVT = (float*)(F.ws + WS_KVT); float* DEC = (float*)(F.ws + WS_DEC);
    for (int item = blockIdx.x; item < NITEM; item += F.G) {
        const int c = item & 31, bh = item >> 5, h = bh & 7, b = bh >> 3;
        const size_t g0 = ((size_t)b * SEQ + c * 64 + sq * 16) * 1024 + h * 128 + k;
        float lf[16]; unsigned vr[16];
#pragma unroll
        for (int i = 0; i < 16; ++i) { lf[i] = LOGF[g0 + (size_t)i * 1024]; vr[i] = V[g0 + (size_t)i * 1024]; }
        float bb[16]; float run = 0.f;
#pragma unroll
        for (int i = 0; i < 16; ++i) { run += lf[i]; bb[i] = run; }
        qtot[sq * 128 + k] = run;
        __syncthreads();
        float pre = 0.f, tot = 0.f;
#pragma unroll
        for (int j = 0; j < 4; ++j) { const float tq = qtot[j * 128 + k]; pre += (j < sq) ? tq : 0.f; tot += tq; }
        unsigned pk[8], pv[8];
#pragma unroll
        for (int i = 0; i < 8; ++i) {
            const float e0 = (1.0f - __expf(lf[2 * i])) * __expf(tot - (pre + bb[2 * i])), e1 = (1.0f - __expf(lf[2 * i + 1])) * __expf(tot - (pre + bb[2 * i + 1]));
            pk[i] = pg8::cvt_pk_bf16(e0, e1); pv[i] = vr[2 * i] | (vr[2 * i + 1] << 16); }
        *(LAS v4u*)(kstT + k * TS + sq * 16) = (v4u){pk[0], pk[1], pk[2], pk[3]}; *(LAS v4u*)(kstT + k * TS + sq * 16 + 8) = (v4u){pk[4], pk[5], pk[6], pk[7]};
        *(LAS v4u*)(vT + k * TS + sq * 16) = (v4u){pv[0], pv[1], pv[2], pv[3]}; *(LAS v4u*)(vT + k * TS + sq * 16 + 8) = (v4u){pv[4], pv[5], pv[6], pv[7]};
        if (sq == 0) DEC[(size_t)item * 128 + k] = __expf(tot);
        __syncthreads();
        const mbf16x8 b0 = lds_frag(vT + (16 * w + fr) * TS + 8 * fq), b1 = lds_frag(vT + (16 * w + fr) * TS + 32 + 8 * fq);
        float* outp = KVT + (size_t)item * 16384 + (size_t)(16 * w + fr) * 128 + 4 * fq;
#pragma unroll
        for (int kt = 0; kt < 8; ++kt) {
            mf32x4 acc = {0.f, 0.f, 0.f, 0.f};
            acc = MFMA16(lds_frag(kstT + (16 * kt + fr) * TS + 8 * fq), b0, acc);
            acc = MFMA16(lds_frag(kstT + (16 * kt + fr) * TS + 32 + 8 * fq), b1, acc);
            *(mf32x4*)(outp + 16 * kt) = acc;
        }
        __syncthreads();
    }
}

__device__ __forceinline__ void hgrn_scan_phase(Frame& F) {
    const float* KVT = (const float*)(F.ws + WS_KVT); const float* DEC = (const float*)(F.ws + WS_DEC); bf16* ST = (bf16*)(F.ws + WS_XB);
    int tid_ = threadIdx.x; asm volatile("" : "+v"(tid_));
    for (int idx = blockIdx.x * (NWAVES * 64) + tid_; idx < BATCH * HEADS * 128 * 32; idx += F.G * NWAVES * 64) {
        const int k4 = idx & 31, v = (idx >> 5) & 127, bh = idx >> 12;
        mf32x4 S = {0.f, 0.f, 0.f, 0.f};
#pragma unroll 4
        for (int c = 0; c < NCH; ++c) {
            const int item = bh * NCH + c; const size_t off = (size_t)item * 16384 + v * 128 + 4 * k4;
            mu32x2 o; o.x = pg8::cvt_pk_bf16(S[0], S[1]); o.y = pg8::cvt_pk_bf16(S[2], S[3]); *(mu32x2*)(ST + off) = o;
            const mf32x4 kv = *(const mf32x4*)(KVT + off), d = *(const mf32x4*)(DEC + (size_t)item * 128 + 4 * k4);
            S = d * S + kv;
        }
    }
}

__device__ __forceinline__ void hgrn_out_phase(Frame& F) {
    LAS bf16* QT = (LAS bf16*)(F.lds);
    LAS bf16* KT = (LAS bf16*)(F.lds + 17408);
    LAS bf16* QI = (LAS bf16*)(F.lds + 34816);
    LAS bf16* vT = (LAS bf16*)(F.lds + 52224);
    LAS bf16* P = (LAS bf16*)(F.lds + 70656);
    LAS float* qtot = (LAS float*)(F.lds + 79872);
    LAS float* ssq = (LAS float*)(F.lds + 81920);
    int tid_ = threadIdx.x; asm volatile("" : "+v"(tid_));
    const int tid = tid_, k = tid & 127, sq = tid >> 7, lane = tid & 63, w = F.wave, fr = lane & 15, fq = lane >> 4, rb = w & 3, ch = w >> 2;
    const float* LOGF = (const float*)(F.ws + WS_LOGF); const bf16* V = (const bf16*)(F.ws + WS_V); const bf16* SG = (const bf16*)(F.ws + WS_SG);
    const bf16* ST = (const bf16*)(F.ws + WS_XB); bf16* MIXA = (bf16*)(F.ws + WS_MIXA);
    for (int item = blockIdx.x; item < NITEM; item += F.G) {
        const int c = item & 31, bh = item >> 5, h = bh & 7, b = bh >> 3;
        const size_t r0 = (size_t)b * SEQ + c * 64;
        {
            const size_t g0 = (r0 + sq * 16) * 1024 + h * 128 + k, gq = (r0 + sq * 16) * 2048 + h * 128 + k;
            float lf[16]; unsigned vr[16], qr[16];
#pragma unroll
            for (int i = 0; i < 16; ++i) { lf[i] = LOGF[g0 + (size_t)i * 1024]; vr[i] = V[g0 + (size_t)i * 1024]; qr[i] = MIXA[gq + (size_t)i * 2048]; }
            float bb[16]; float run = 0.f;
#pragma unroll
            for (int i = 0; i < 16; ++i) { run += lf[i]; bb[i] = run; }
            qtot[sq * 128 + k] = run;
            __syncthreads();
            float pre = 0.f;
#pragma unroll
            for (int j = 0; j < 4; ++j) { const float tq = qtot[j * 128 + k]; pre += (j < sq) ? tq : 0.f; }
            const float bm = qtot[k] + qtot[128 + k], ebm = __expf(bm);
            unsigned pv[8];
#pragma unroll
            for (int i = 0; i < 16; ++i) {
                const float d = fminf(fmaxf(pre + bb[i] - bm, -60.f), 60.f), e1 = __expf(d), e2 = __builtin_amdgcn_rcpf(e1);
                const float qf = bf2f((bf16)qr[i]), qt = qf * e1, kk = (1.0f - __expf(lf[i])) * e2;
                const int s = sq * 16 + i;
                QT[s * QS + k] = (bf16)bf1(qt); QI[s * QS + k] = (bf16)bf1(qt * ebm); KT[s * QS + k] = (bf16)bf1(kk);
            }
#pragma unroll
            for (int i = 0; i < 8; ++i) pv[i] = vr[2 * i] | (vr[2 * i + 1] << 16);
            *(LAS v4u*)(vT + k * TS + sq * 16) = (v4u){pv[0], pv[1], pv[2], pv[3]}; *(LAS v4u*)(vT + k * TS + sq * 16 + 8) = (v4u){pv[4], pv[5], pv[6], pv[7]};
        }
        __syncthreads();
        const int t0 = 16 * rb;
        {
            mbf16x8 bq[4];
#pragma unroll
            for (int ks = 0; ks < 4; ++ks) bq[ks] = lds_frag(QT + (t0 + fr) * QS + 32 * ks + 8 * fq);
#pragma unroll
            for (int j = 0; j < 2; ++j) {
                const int s0 = 32 * ch + 16 * j; mf32x4 acc = {0.f, 0.f, 0.f, 0.f};
#pragma unroll
                for (int ks = 0; ks < 4; ++ks) acc = MFMA16(lds_frag(KT + (s0 + fr) * QS + 32 * ks + 8 * fq), bq[ks], acc);
                const int t = t0 + fr, sb = s0 + 4 * fq;
#pragma unroll
                for (int r = 0; r < 4; ++r) acc[r] = (sb + r <= t) ? acc[r] : 0.f;
                mu32x2 o; o.x = pg8::cvt_pk_bf16(acc[0], acc[1]); o.y = pg8::cvt_pk_bf16(acc[2], acc[3]);
                *(LAS mu32x2*)(P + t * TS + sb) = o;
            }
        }
        __syncthreads();
        mf32x4 o4[4];
        {
            mbf16x8 bqi[4], bp[2];
#pragma unroll
            for (int ks = 0; ks < 4; ++ks) bqi[ks] = lds_frag(QI + (t0 + fr) * QS + 32 * ks + 8 * fq);
#pragma unroll
            for (int ss = 0; ss < 2; ++ss) bp[ss] = lds_frag(P + (t0 + fr) * TS + 32 * ss + 8 * fq);
            float sum = 0.f;
#pragma unroll
            for (int j = 0; j < 4; ++j) {
                const int v0 = 64 * ch + 16 * j; mf32x4 acc = {0.f, 0.f, 0.f, 0.f};
                const bf16* sp = ST + (size_t)item * 16384 + (size_t)(v0 + fr) * 128 + 8 * fq;
#pragma unroll
                for (int ks = 0; ks < 4; ++ks) acc = MFMA16(*(const mbf16x8*)(sp + 32 * ks), bqi[ks], acc);
#pragma unroll
                for (int ss = 0; ss < 2; ++ss) acc = MFMA16(lds_frag(vT + (v0 + fr) * TS + 32 * ss + 8 * fq), bp[ss], acc);
                o4[j] = acc; sum += (acc[0] * acc[0] + acc[1] * acc[1]) + (acc[2] * acc[2] + acc[3] * acc[3]);
            }
            sum += __shfl_xor(sum, 16); sum += __shfl_xor(sum, 32);
            if (fq == 0) ssq[ch * 64 + t0 + fr] = sum;
        }
        __syncthreads();
        {
            const float rn = 1.0f / sqrtf((ssq[t0 + fr] + ssq[64 + t0 + fr]) * (1.0f / 128.0f) + EPS);
            const size_t row = r0 + t0 + fr;
#pragma unroll
            for (int j = 0; j < 4; ++j) {
                const int v = 64 * ch + 16 * j + 4 * fq;
                const mf32x4 gn = *(const mf32x4*)(F.in[I_HGN] + v);
                const mu32x2 sgp = *(const mu32x2*)(SG + row * 1024 + h * 128 + v);
                const float s0 = bf2f((bf16)(sgp.x & 0xffffu)), s1 = bf2f((bf16)(sgp.x >> 16)), s2 = bf2f((bf16)(sgp.y & 0xffffu)), s3 = bf2f((bf16)(sgp.y >> 16));
                mu32x2 o; o.x = pg8::cvt_pk_bf16(o4[j][0] * rn * gn[0] * s0, o4[j][1] * rn * gn[1] * s1); o.y = pg8::cvt_pk_bf16(o4[j][2] * rn * gn[2] * s2, o4[j][3] * rn * gn[3] * s3);
                *(mu32x2*)(MIXA + row * 2048 + h * 128 + v) = o;
            }
        }
        __syncthreads();
    }
}

__device__ __forceinline__ void lru_phase(Frame& F) {
    LAS bf16* A = (LAS bf16*)(F.lds);
    LAS float* XS = (LAS float*)(F.lds + 69632);
    LAS float* LA = (LAS float*)(F.lds + 86016);
    LAS float* LU = (LAS float*)(F.lds + 103424);
    LAS float* SEGA = (LAS float*)(F.lds + 120832);
    LAS float* SEGH = (LAS float*)(F.lds + 122880);
    LAS float* CARRY = (LAS float*)(F.lds + 124928);
    int tid_ = threadIdx.x; asm volatile("" : "+v"(tid_));
    const int tid = tid_, lane = tid & 63, w = F.wave, fr = lane & 15, fq = lane >> 4;
    const int cg = tid & 15, rr0 = tid >> 4;
    const int d = tid & 15, seg = tid >> 4;
    const bf16* LRX = (const bf16*)(F.ws + WS_LRX); bf16* MIXA = (bf16*)(F.ws + WS_MIXA);
    const bf16* WAT = (const bf16*)(F.ws + WS_WAT); const bf16* WXT = (const bf16*)(F.ws + WS_WXT);
    for (int item = blockIdx.x; item < BATCH * 64; item += F.G) {
        const int b = item >> 6, n = (item >> 3) & 7, sl = item & 7;
        const int cbase = n * 128 + 8 * cg;
        float cwv[4][8], cbv[8];
#pragma unroll
        for (int e = 0; e < 8; ++e) { cbv[e] = F.in[I_CB][cbase + e];
#pragma unroll
            for (int j = 0; j < 4; ++j) cwv[j][e] = F.in[I_CW][j * 1024 + cbase + e]; }
        mbf16x8 waf[4], wxf[4];
#pragma unroll
        for (int ks = 0; ks < 4; ++ks) { const size_t o = ((size_t)n * 128 + sl * 16 + fr) * 128 + 32 * ks + 8 * fq; waf[ks] = *(const mbf16x8*)(WAT + o); wxf[ks] = *(const mbf16x8*)(WXT + o); }
        const int cgl = n * 128 + sl * 16 + fr;
        const float ba = F.in[I_LBA][cgl], bx = F.in[I_LBX][cgl], spl = log1pf(__expf(-F.in[I_LAM][cgl]));
        if (tid < 16) CARRY[tid] = 0.f;
        for (int mc = 0; mc < 8; ++mc) {
            const size_t rowbase = (size_t)b * SEQ + mc * 256;
            {
                v4u xr[11];
#pragma unroll
                for (int j = 0; j < 11; ++j) { const int tl = mc * 256 + 8 * rr0 - 3 + j;
                    if (tl >= 0) xr[j] = *(const v4u*)(LRX + ((size_t)b * SEQ + tl) * 1024 + cbase); else xr[j] = (v4u){0u, 0u, 0u, 0u}; }
#pragma unroll
                for (int i = 0; i < 8; ++i) {
                    float xc[8];
#pragma unroll
                    for (int e = 0; e < 8; ++e) xc[e] = cbv[e];
#pragma unroll
                    for (int j = 0; j < 4; ++j) { const v4u x = xr[i + j];
                        const unsigned wd[4] = {x.x, x.y, x.z, x.w};
#pragma unroll
                        for (int e = 0; e < 8; ++e) { const float xv = __builtin_bit_cast(float, (e & 1) ? (wd[e >> 1] & 0xffff0000u) : (wd[e >> 1] << 16)); xc[e] += cwv[j][e] * xv; } }
                    const int lr = 8 * rr0 + i;
                    *(LAS v4u*)(A + lr * QS + 8 * cg) = (v4u){pg8::cvt_pk_bf16(xc[0], xc[1]), pg8::cvt_pk_bf16(xc[2], xc[3]), pg8::cvt_pk_bf16(xc[4], xc[5]), pg8::cvt_pk_bf16(xc[6], xc[7])};
                    if ((cg >> 1) == sl) { LAS float* xp = XS + lr * 16 + (cg & 1) * 8; *(LAS mf32x4*)xp = (mf32x4){xc[0], xc[1], xc[2], xc[3]}; *(LAS mf32x4*)(xp + 4) = (mf32x4){xc[4], xc[5], xc[6], xc[7]}; }
                }
            }
            __syncthreads();
#pragma unroll
            for (int rt = 0; rt < 2; ++rt) {
                const int rowt = 32 * w + 16 * rt; mf32x4 ar = {0.f, 0.f, 0.f, 0.f}, ai = {0.f, 0.f, 0.f, 0.f};
#pragma unroll
                for (int ks = 0; ks < 4; ++ks) { const mbf16x8 a = lds_frag(A + (rowt + fr) * QS + 32 * ks + 8 * fq); ar = MFMA16(a, waf[ks], ar); ai = MFMA16(a, wxf[ks], ai); }
#pragma unroll
                for (int r = 0; r < 4; ++r) { const int row = rowt + 4 * fq + r;
                    const float rg = pg8::sigmoid_f(ar[r] + ba), ig = pg8::sigmoid_f(ai[r] + bx), la = -8.0f * rg * spl;
                    LA[row * 17 + fr] = __expf(la); LU[row * 17 + fr] = sqrtf(-expm1f(2.0f * la)) * ig * XS[row * 16 + fr]; }
            }
            __syncthreads();
            float aa[8], uu[8]; float Ap = 1.f, Hp = 0.f;
#pragma unroll
            for (int i = 0; i < 8; ++i) { aa[i] = LA[(8 * seg + i) * 17 + d]; uu[i] = LU[(8 * seg + i) * 17 + d]; Hp = aa[i] * Hp + uu[i]; Ap *= aa[i]; }
            SEGA[seg * 16 + d] = Ap; SEGH[seg * 16 + d] = Hp;
            __syncthreads();
            float hin = CARRY[(mc & 1) * 16 + d];
            for (int s2 = 0; s2 < seg; ++s2) hin = SEGA[s2 * 16 + d] * hin + SEGH[s2 * 16 + d];
            bf16* yp = MIXA + (rowbase + 8 * seg) * 2048 + 1024 + n * 128 + sl * 16 + d;
#pragma unroll
            for (int i = 0; i < 8; ++i) { hin = aa[i] * hin + uu[i]; yp[(size_t)i * 2048] = (bf16)bf1(hin * bf2f(yp[(size_t)i * 2048])); }
            if (seg == 31) CARRY[((mc + 1) & 1) * 16 + d] = hin;
        }
        __syncthreads();
    }
}
constexpr int N_PHASES = 12;
struct Args { const float* in[N_IN]; float* out; unsigned char* ws; int ph_lo, ph_hi, li, pad; };
__global__ void __launch_bounds__(NWAVES * 64, 2) mega_fwd(Args args) {
    extern __shared__ __attribute__((aligned(16))) unsigned char lds[];
    Frame F;
    F.lds = (LAS unsigned char*)lds;
    F.MISC = (volatile LAS unsigned*)(F.lds + MISC_OFF);
    F.tid = threadIdx.x; F.lane = F.tid & 63; F.wave = __builtin_amdgcn_readfirstlane(F.tid >> 6);
    F.G = gridDim.x; { const int bx = blockIdx.x; F.vcu = (F.G % 8 == 0) ? (bx % 8) * (F.G / 8) + bx / 8 : bx; }
#pragma unroll
    for (int i = 0; i < N_IN; ++i) F.in[i] = args.in[i];
    F.out = args.out; F.ws = args.ws;
    unsigned char* ws = args.ws;
    F.ctl = (gu32*)(ws + WS_CTL);
    for (int u = F.tid; u < (LDS_BYTES - LDSCTL_OFF) / 4; u += NWAVES * 64) ((LAS unsigned*)(F.lds + LDSCTL_OFF))[u] = 0u;
    __syncthreads();
    const int lo = args.ph_lo, hi = args.ph_hi;
    const bool multi = (hi - lo) > 1;
    XcdBarrier bar; bar.bar = (unsigned*)(F.ctl + CW_BAR) + args.li * XCD_BAR_WORDS; bar.x = 0; bar.st = nullptr;
    if (multi) bar = xcd_barrier_post((unsigned*)(F.ctl + CW_BAR) + args.li * XCD_BAR_WORDS, F.MISC + 8);

    bf16* const XB = (bf16*)(ws + WS_XB); bf16* const ACT = (bf16*)(ws + WS_ACT); bf16* const MIXA = (bf16*)(ws + WS_MIXA);
    float* const SSQA = (float*)(ws + WS_SSQA); float* const SSQB = (float*)(ws + WS_SSQB);


#define IN(k) (lo <= (k) && (k) < hi)
#define SEAM(k) do { if (IN(k) && IN((k) + 1)) xcd_barrier(bar); } while (0)
#define GEMM_SWIGLU(WOFF) do { pg8::Gemm g{XB, (const bf16*)(ws + (WOFF)), M, NGU, D}; pg8::StaticOrder S; S.init(M, NGU, F.G, (int)blockIdx.x); \
        pg8::EpiSwiGLU E{ACT, DFF, SSQA}; pg8::gemm_phase<pg8::EpiSwiGLU, pg8::StaticOrder, true, true>(F.lds + RING_OFF, g, S, E); } while (0)
#define GEMM_RESID(AP, WOFF, KK, SRC, SSQO, SC) do { pg8::Gemm g{(AP), (const bf16*)(ws + (WOFF)), M, D, (KK)}; pg8::StaticOrder S; S.init(M, D, F.G, (int)blockIdx.x); \
        pg8::EpiResid E{(SRC), F.out, XB, (SSQO), (SC)}; pg8::gemm_phase<pg8::EpiResid, pg8::StaticOrder, true, true>(F.lds + RING_OFF, g, S, E); } while (0)

    if (IN(0)) { p0_prologue(F); SEAM(0); }
    if (IN(1)) { GEMM_SWIGLU(WS_WGU1); SEAM(1); }
    if (IN(2)) { GEMM_RESID(ACT, WS_WD1, DFF, F.in[I_X], SSQB, 0.5f); SEAM(2); }
    if (IN(3)) {
        pg8::Gemm g{XB, (const bf16*)(ws + WS_WINT), M, NIN, D}; pg8::StaticOrder S; S.init(M, NIN, F.G, (int)blockIdx.x);
        pg8::EpiZ E{SSQB, F.in[I_HLB], MIXA, (float*)(ws + WS_LOGF), (bf16*)(ws + WS_V), (bf16*)(ws + WS_SG), (bf16*)(ws + WS_LRX)};
        pg8::gemm_phase<pg8::EpiZ, pg8::StaticOrder, true, true>(F.lds + RING_OFF, g, S, E);
        SEAM(3); }
    if (IN(4)) { MIXER_PHASE_4 SEAM(4); }
    if (IN(5)) { MIXER_PHASE_5 SEAM(5); }
    if (IN(6)) { MIXER_PHASE_6 SEAM(6); }
    if (IN(7)) { GEMM_RESID(MIXA, WS_WOUT, D, F.out, SSQA, 1.0f); SEAM(7); }
    if (IN(8)) { GEMM_SWIGLU(WS_WGU2); SEAM(8); }
    if (IN(9)) { GEMM_RESID(ACT, WS_WD2, DFF, F.out, SSQB, 0.5f); SEAM(9); }
    if (IN(10)) {
        { pg8::Gemm g{(const bf16*)(ws + WS_PB), (const bf16*)(ws + WS_WPROJ), M, D, PLE}; pg8::StaticOrder S; S.init(M, D, F.G, (int)blockIdx.x);
          pg8::EpiPP E{(float*)(ws + WS_PP)};
          pg8::gemm_phase<pg8::EpiPP, pg8::StaticOrder, true, true>(F.lds + RING_OFF, g, S, E); }
        { pg8::Gemm g{XB, (const bf16*)(ws + WS_WPG), M, D, D}; pg8::StaticOrder S; S.init(M, D, F.G, (int)blockIdx.x);
          pg8::EpiPLE E{SSQB, F.in[I_PBG], (const float*)(ws + WS_PP), F.out, SSQA};
          pg8::gemm_phase<pg8::EpiPLE, pg8::StaticOrder, true, true>(F.lds + RING_OFF, g, S, E); }
        SEAM(10); }
    if (IN(11)) { final_norm(F, SSQA); }
#undef IN
#undef SEAM
}

#if SIMPLE_HGRN
__global__ void __launch_bounds__(64) k_simple_hgrn(const float* logf, const bf16* mixa, const bf16* vv, float* oh) {
    __shared__ float sf[128], sk[128], sq[128];
    const int bh = blockIdx.x >> 1, vh = blockIdx.x & 1, b = bh >> 3, h = bh & 7, lane = threadIdx.x, v = vh * 64 + lane;
    float S[128];
#pragma unroll
    for (int k = 0; k < 128; ++k) S[k] = 0.f;
    for (int t = 0; t < SEQ; ++t) {
        const size_t row = (size_t)b * SEQ + t;
        for (int kk = lane; kk < 128; kk += 64) { const float f = __expf(logf[row * 1024 + h * 128 + kk]); sf[kk] = f; sk[kk] = 1.f - f; sq[kk] = bf2f(mixa[row * 2048 + h * 128 + kk]); }
        __syncthreads();
        const float vt = bf2f(vv[row * 1024 + h * 128 + v]); float o = 0.f;
#pragma unroll
        for (int k = 0; k < 128; ++k) { S[k] = sf[k] * S[k] + sk[k] * vt; o += S[k] * sq[k]; }
        oh[row * 1024 + h * 128 + v] = o;
        __syncthreads();
    }
}
__global__ void __launch_bounds__(256) k_simple_hnorm(const float* oh, const bf16* sg, const float* gn, bf16* mixa) {
    const int gw = (blockIdx.x * 256 + threadIdx.x) >> 6, lane = threadIdx.x & 63;
    if (gw >= M * HEADS) return;
    const int row = gw >> 3, h = gw & 7;
    const float o0 = oh[(size_t)row * 1024 + h * 128 + lane], o1 = oh[(size_t)row * 1024 + h * 128 + 64 + lane];
    const float ss = wave_sum(o0 * o0 + o1 * o1);
    const float r = 1.0f / sqrtf(ss * (1.0f / 128.0f) + EPS);
    mixa[(size_t)row * 2048 + h * 128 + lane] = (bf16)f2bf(o0 * r * gn[lane] * bf2f(sg[(size_t)row * 1024 + h * 128 + lane]));
    mixa[(size_t)row * 2048 + h * 128 + 64 + lane] = (bf16)f2bf(o1 * r * gn[64 + lane] * bf2f(sg[(size_t)row * 1024 + h * 128 + 64 + lane]));
}
#endif
#if SIMPLE_LRU
__global__ void __launch_bounds__(256) k_simple_lru_a(const bf16* lrx, const float* cw, const float* cb, const float* wa, const float* ba, const float* wx, const float* bx, const float* lam, float* LA, float* LU) {
    __shared__ float xc[1024];
    const int row = blockIdx.x, tt = row % SEQ, tid = threadIdx.x;
    for (int c = tid; c < 1024; c += 256) { float s = cb[c];
        for (int j = 0; j < 4; ++j) { const int ts = tt - 3 + j; if (ts >= 0) s += cw[j * 1024 + c] * bf2f(lrx[(size_t)(row - 3 + j) * 1024 + c]); }
        xc[c] = s; }
    __syncthreads();
    for (int d = tid; d < 1024; d += 256) { const int n = d >> 7, dd = d & 127; float r = ba[d], g = bx[d];
        for (int c = 0; c < 128; ++c) { const float x = xc[n * 128 + c]; r += x * wa[((size_t)n * 128 + c) * 128 + dd]; g += x * wx[((size_t)n * 128 + c) * 128 + dd]; }
        r = 1.0f / (1.0f + __expf(-r)); g = 1.0f / (1.0f + __expf(-g));
        const float log_a = -8.0f * r * log1pf(__expf(-lam[d]));
        LA[(size_t)row * 1024 + d] = __expf(log_a); LU[(size_t)row * 1024 + d] = sqrtf(-expm1f(2.0f * log_a)) * g * xc[d]; }
}
__global__ void __launch_bounds__(256) k_simple_lru_b(const float* LA, const float* LU, bf16* mixa) {
    const int gi = blockIdx.x * 256 + threadIdx.x, b = gi >> 10, c = gi & 1023; float h = 0.f;
#pragma unroll 8
    for (int t = 0; t < SEQ; ++t) { const size_t row = (size_t)b * SEQ + t; h = LA[row * 1024 + c] * h + LU[row * 1024 + c];
        bf16* p = mixa + row * 2048 + 1024 + c; *p = (bf16)f2bf(h * bf2f(*p)); }
}
#endif

extern "C" void kernel_launch(void* const* d_in, const int* in_sizes, int n_in, void* d_out, int out_size, void* d_ws, size_t ws_size, hipStream_t stream) {
    static int grid = 0;
    if (grid == 0) {
        if (n_in != N_IN || in_sizes[0] != M * D || out_size != M * D || ws_size < WS_END) { fprintf(stderr, "kernel_launch: unexpected problem (n_in %d, in0 %d, out %d, ws %zu); nothing launched\n", n_in, n_in > 0 ? in_sizes[0] : -1, out_size, ws_size); grid = -1; return; }
        int dev = 0, cus = 0, per_cu = 0;
        if (hipGetDevice(&dev) != hipSuccess || hipDeviceGetAttribute(&cus, hipDeviceAttributeMultiprocessorCount, dev) != hipSuccess) { grid = -1; return; }
        if (hipFuncSetAttribute((const void*)mega_fwd, hipFuncAttributeMaxDynamicSharedMemorySize, LDS_BYTES) != hipSuccess) { fprintf(stderr, "kernel_launch: hipFuncSetAttribute failed\n"); grid = -1; return; }
        if (hipOccupancyMaxActiveBlocksPerMultiprocessor(&per_cu, (const void*)mega_fwd, NWAVES * 64, LDS_BYTES) != hipSuccess || per_cu < 1)
            fprintf(stderr, "kernel_launch: note: occupancy query reports %d workgroups per CU\n", per_cu);
        (void)hipGetLastError();
        grid = cus;
    }
    if (grid < 0) return;
    if (hipMemsetAsync((char*)d_ws + WS_CTL, 0, CTL_ZERO_BYTES, stream) != hipSuccess) return;
    Args a{};
    for (int i = 0; i < N_IN; ++i) a.in[i] = (const float*)d_in[i];
    a.out = (float*)d_out; a.ws = (unsigned char*)d_ws;
    unsigned char* ws = (unsigned char*)d_ws;
    auto launch = [&](int lo, int hi, int li) { a.ph_lo = lo; a.ph_hi = hi; a.li = li; hipLaunchKernelGGL(mega_fwd, dim3(grid), dim3(NWAVES * 64), LDS_BYTES, stream, a); };
#if SIMPLE_HGRN || SIMPLE_LRU
    launch(0, 4, 0);
#if SIMPLE_HGRN
    {   float* OH = (float*)(ws + WS_XB);
        hipLaunchKernelGGL(k_simple_hgrn, dim3(64), dim3(64), 0, stream, (const float*)(ws + WS_LOGF), (const bf16*)(ws + WS_MIXA), (const bf16*)(ws + WS_V), OH);
        hipLaunchKernelGGL(k_simple_hnorm, dim3(M * HEADS / 4), dim3(256), 0, stream, (const float*)OH, (const bf16*)(ws + WS_SG), (const float*)d_in[I_HGN], (bf16*)(ws + WS_MIXA)); }
#endif
#if SIMPLE_LRU
    {   float* LA = (float*)(ws + WS_KVT); float* LU = LA + (size_t)M * 1024;
        hipLaunchKernelGGL(k_simple_lru_a, dim3(M), dim3(256), 0, stream, (const bf16*)(ws + WS_LRX), (const float*)d_in[I_CW], (const float*)d_in[I_CB], (const float*)d_in[I_LWA], (const float*)d_in[I_LBA],
                           (const float*)d_in[I_LWX], (const float*)d_in[I_LBX], (const float*)d_in[I_LAM], LA, LU);
        hipLaunchKernelGGL(k_simple_lru_b, dim3(BATCH * 1024 / 256), dim3(256), 0, stream, (const float*)LA, (const float*)LU, (bf16*)(ws + WS_MIXA)); }
#endif
    launch(4, N_PHASES, 1);
#else
#if N_LAUNCHES == 1
    launch(0, N_PHASES, 0);
#else
    for (int ph = 0; ph < N_PHASES; ++ph) launch(ph, ph + 1, 0);
#endif
#endif
}
```

```cpp
#include <hip/hip_runtime.h>
#include <cstdio>
#include <cstdint>
#ifndef SIMPLE_HGRN
#define SIMPLE_HGRN 0
#endif
#ifndef SIMPLE_LRU
#define SIMPLE_LRU 0
#endif
#ifndef N_LAUNCHES
#define N_LAUNCHES 1
#endif
#if SIMPLE_HGRN
#define MIXER_PHASE_4
#define MIXER_PHASE_6
#define MIXER_SCAN
#else
#define MIXER_PHASE_4 hgrn_local_phase(F);
#ifdef PROBE_H3
#define MIXER_PHASE_6 hgrn_out_phase(F, true); xcd_barrier(bar); hgrn_out_phase(F);
#else
#define MIXER_PHASE_6 hgrn_out_phase(F);
#endif
#ifdef PROBE_SCAN
#define MIXER_SCAN hgrn_scan_phase(F); xcd_barrier(bar); hgrn_scan_phase(F);
#else
#define MIXER_SCAN hgrn_scan_phase(F);
#endif
#endif
#if SIMPLE_LRU
#define MIXER_LRU
#else
#ifdef PROBE_LRU
#define MIXER_LRU lru_phase(F, true); xcd_barrier(bar); lru_phase(F);
#else
#define MIXER_LRU lru_phase(F);
#endif
#endif
#define MIXER_PHASE_5 MIXER_SCAN MIXER_LRU
namespace pg8 {
#define PG8_LAS __attribute__((address_space(3)))
typedef unsigned short bf16_t;
typedef short bf16x8 __attribute__((ext_vector_type(8)));
typedef float f32x4 __attribute__((ext_vector_type(4)));
typedef unsigned u32x4 __attribute__((ext_vector_type(4)));
constexpr int BM = 256, BK = 64, HALF = 128, HTB = HALF * BK * 2  , STAGE_BYTES = 8 * HTB, NXCD = 8, WGM = 8;

__host__ __device__ __forceinline__ int lds_byte(int r, int c) { const int st = (r >> 4) * 2 + (c >> 5), rr = r & 15, cc = c & 31, ob = rr * 64 + cc * 2; return st * 1024 + (ob ^ (((ob >> 9) & 1) << 5)); }
__host__ __device__ __forceinline__ void stage_rc(int b, int& R, int& C) { const int st = b / 1024, sb = b % 1024, swz = sb ^ (((sb >> 9) & 1) << 5); R = (st >> 1) * 16 + swz / 64; C = (st & 1) * 32 + (swz % 64) / 2; }
__host__ __device__ __forceinline__ int perm32(int rho) { const int n = rho >> 4, i = rho & 15; return 8 * (i >> 2) + 4 * n + (i & 3); }

struct Unit { int pm, pn; };
struct Gemm { const bf16_t* A; const bf16_t* Bt; int M, N, K; };

struct StaticOrder {
    int nM, nN, nwg, G, c;
    __host__ __device__ void init(int M, int N, int G_, int c_) { nM = M / BM; nN = N / BM; nwg = nM * nN; G = G_; c = c_; }
    __host__ __device__ bool next(int i, Unit& u) const {
        const long L = (long)i * G + c; if (L >= nwg) return false;
        int wgid = (int)L; { const int q = nwg / NXCD, r = nwg % NXCD, xcd = wgid % NXCD, off = wgid / NXCD; wgid = (xcd < r ? xcd * (q + 1) : r * (q + 1) + (xcd - r) * q) + off; }
        const int nig = WGM * nN, gid = wgid / nig, fm = gid * WGM, gsz = (nM - fm) < WGM ? (nM - fm) : WGM;
        u.pm = fm + ((wgid % nig) % gsz); u.pn = (wgid % nig) / gsz; return true;
    }
    __device__ __forceinline__ void a_ready(const Unit&) const {}
    __device__ __forceinline__ void done(const Unit&) const {}
};
__device__ __forceinline__ int lane_id_asm() { int l; asm volatile("v_mbcnt_lo_u32_b32 %0, -1, 0\n\tv_mbcnt_hi_u32_b32 %0, -1, %0" : "=v"(l)); return l; }
__device__ __forceinline__ unsigned cvt_pk_bf16(float lo, float hi) { unsigned r; asm volatile("v_cvt_pk_bf16_f32 %0, %1, %2" : "=v"(r) : "v"(lo), "v"(hi)); return r; }
typedef unsigned u32x2 __attribute__((ext_vector_type(2)));
constexpr int DM = 2048;
constexpr int NSSQ = 32;
__device__ __forceinline__ float sigmoid_f(float x) { return __builtin_amdgcn_rcpf(1.0f + __expf(-x)); }
__device__ __forceinline__ float silu_f(float x) { return x * sigmoid_f(x); }
__device__ __forceinline__ float gelu_tanh_f(float x) { return x * sigmoid_f(1.5957691216057308f * (x + 0.044715f * x * x * x)); }
__device__ __forceinline__ void rows_rstd(const float* ssq, int row0, int fq, float (&rs)[2][4]) {
    f32x4 pa[2][4], pb[2][4];
#pragma unroll
    for (int ai = 0; ai < 2; ++ai)
#pragma unroll
        for (int m = 0; m < 4; ++m) { const f32x4* p = (const f32x4*)(ssq + (size_t)(row0 + ai * HALF + m * 16) * NSSQ + fq * 8); pa[ai][m] = p[0]; pb[ai][m] = p[1]; }
#pragma unroll
    for (int ai = 0; ai < 2; ++ai)
#pragma unroll
        for (int m = 0; m < 4; ++m) { const f32x4 a = pa[ai][m], b = pb[ai][m];
            float s = ((a[0] + a[1]) + (a[2] + a[3])) + ((b[0] + b[1]) + (b[2] + b[3]));
            s += __shfl_xor(s, 16); s += __shfl_xor(s, 32);
            rs[ai][m] = 1.0f / sqrtf(s * (1.0f / (float)DM) + 1e-6f); }
}

struct EpiSwiGLU {
    static constexpr bool PERM = true, AFTER_DRAIN = false;
    bf16_t* O; int ldo; const float* ssq;
    __device__ __forceinline__ void operator()(const f32x4 (&acc)[2][2][4][2], const Unit& u, int wr, int wc, int fr, int fq) const {
        const int row0 = u.pm * BM + wr * 64 + fr, col0 = u.pn * HALF + wc * 32 + 8 * fq;
        float rs[2][4]; rows_rstd(ssq, row0, fq, rs);
#pragma unroll
        for (int ai = 0; ai < 2; ++ai)
#pragma unroll
            for (int m = 0; m < 4; ++m) {
                const int row = row0 + ai * HALF + m * 16; const float r = rs[ai][m];
                float h[8];
#pragma unroll
                for (int n = 0; n < 2; ++n)
#pragma unroll
                    for (int j = 0; j < 4; ++j) { const float g = acc[ai][0][m][n][j] * r, up = acc[ai][1][m][n][j] * r; h[n * 4 + j] = silu_f(g) * up; }
                u32x4 w; w.x = cvt_pk_bf16(h[0], h[1]); w.y = cvt_pk_bf16(h[2], h[3]); w.z = cvt_pk_bf16(h[4], h[5]); w.w = cvt_pk_bf16(h[6], h[7]);
                *(u32x4*)(O + (size_t)row * ldo + col0) = w;
            }
    }
};
struct EpiResid {
    static constexpr bool PERM = false, AFTER_DRAIN = false;
    const float* src; float* dst; bf16_t* xb; float* ssq_out; float scale;
    __device__ __forceinline__ void operator()(const f32x4 (&acc)[2][2][4][2], const Unit& u, int wr, int wc, int fr, int fq) const {
        const int row0 = u.pm * BM + wr * 64 + fr, col0 = u.pn * BM + wc * 32 + 4 * fq;
#pragma unroll
        for (int ai = 0; ai < 2; ++ai) {
            f32x4 sv[4][2][2];
#pragma unroll
            for (int m = 0; m < 4; ++m)
#pragma unroll
                for (int bj = 0; bj < 2; ++bj)
#pragma unroll
                    for (int n = 0; n < 2; ++n) sv[m][bj][n] = *(const f32x4*)(src + (size_t)(row0 + ai * HALF + m * 16) * DM + col0 + bj * HALF + n * 16);
#pragma unroll
            for (int m = 0; m < 4; ++m) {
                const int row = row0 + ai * HALF + m * 16; float ss = 0.f;
#pragma unroll
                for (int bj = 0; bj < 2; ++bj)
#pragma unroll
                    for (int n = 0; n < 2; ++n) { const size_t off = (size_t)row * DM + col0 + bj * HALF + n * 16;
                        const f32x4 o = sv[m][bj][n] + acc[ai][bj][m][n] * scale;
                        *(f32x4*)(dst + off) = o; u32x2 w; w.x = cvt_pk_bf16(o[0], o[1]); w.y = cvt_pk_bf16(o[2], o[3]); *(u32x2*)(xb + off) = w;
                        ss += (o[0] * o[0] + o[1] * o[1]) + (o[2] * o[2] + o[3] * o[3]); }
                ss += __shfl_xor(ss, 16); ss += __shfl_xor(ss, 32);
                if (fq == 0) ssq_out[(size_t)row * NSSQ + u.pn * 4 + wc] = ss;
            }
        }
    }
};
struct EpiZ {
    static constexpr bool PERM = true, AFTER_DRAIN = false;
    const float* ssq; const float* hlb;
    bf16_t* mixa;
    float* logf; bf16_t* vv; bf16_t* sg; bf16_t* lrx;
    __device__ __forceinline__ void operator()(const f32x4 (&acc)[2][2][4][2], const Unit& u, int wr, int wc, int fr, int fq) const {
        const int seg = u.pn >> 2;
        const int row0 = u.pm * BM + wr * 64 + fr, cs0 = (u.pn & 3) * BM + wc * 32 + 8 * fq;
        float rs[2][4]; rows_rstd(ssq, row0, fq, rs);
        float lbv[2][8];
        if (seg == 1) {
#pragma unroll
            for (int bj = 0; bj < 2; ++bj)
#pragma unroll
                for (int e = 0; e < 8; ++e) { const int c = cs0 + bj * HALF + e; lbv[bj][e] = sigmoid_f(hlb[c] - hlb[1024 + c]); }
        }
#pragma unroll
        for (int ai = 0; ai < 2; ++ai)
#pragma unroll
            for (int m = 0; m < 4; ++m) {
                const int row = row0 + ai * HALF + m * 16; const float r = rs[ai][m];
#pragma unroll
                for (int bj = 0; bj < 2; ++bj) {
                    const int cs = cs0 + bj * HALF;
                    float z[8];
#pragma unroll
                    for (int n = 0; n < 2; ++n)
#pragma unroll
                        for (int j = 0; j < 4; ++j) z[n * 4 + j] = acc[ai][bj][m][n][j] * r;
                    if (seg == 1) {
                        float lf[8];
#pragma unroll
                        for (int e = 0; e < 8; ++e) { const float lb = lbv[bj][e]; lf[e] = __logf(lb + (1.0f - lb) * sigmoid_f(z[e])); }
                        float* p = logf + (size_t)row * 1024 + cs;
                        *(f32x4*)p = (f32x4){lf[0], lf[1], lf[2], lf[3]}; *(f32x4*)(p + 4) = (f32x4){lf[4], lf[5], lf[6], lf[7]};
                    } else {
                        if (seg == 3) {
#pragma unroll
                            for (int e = 0; e < 8; ++e) z[e] = silu_f(z[e]);
                        } else if (seg == 5) {
#pragma unroll
                            for (int e = 0; e < 8; ++e) z[e] = gelu_tanh_f(z[e]);
                        }
                        u32x4 w; w.x = cvt_pk_bf16(z[0], z[1]); w.y = cvt_pk_bf16(z[2], z[3]); w.z = cvt_pk_bf16(z[4], z[5]); w.w = cvt_pk_bf16(z[6], z[7]);
                        bf16_t* p;
                        if (seg == 0) p = mixa + (size_t)row * 2048 + cs;
                        else if (seg == 5) p = mixa + (size_t)row * 2048 + 1024 + cs;
                        else if (seg == 2) p = vv + (size_t)row * 1024 + cs;
                        else if (seg == 3) p = sg + (size_t)row * 1024 + cs;
                        else p = lrx + (size_t)row * 1024 + cs;
                        *(u32x4*)p = w;
                    }
                }
            }
    }
};
struct EpiPP {
    static constexpr bool PERM = false, AFTER_DRAIN = false;
    float* PP;
    __device__ __forceinline__ void operator()(const f32x4 (&acc)[2][2][4][2], const Unit& u, int wr, int wc, int fr, int fq) const {
        const int row0 = u.pm * BM + wr * 64 + fr, col0 = u.pn * BM + wc * 32 + 4 * fq;
#pragma unroll
        for (int ai = 0; ai < 2; ++ai)
#pragma unroll
            for (int m = 0; m < 4; ++m) { float* rowp = PP + (size_t)(row0 + ai * HALF + m * 16) * DM + col0;
#pragma unroll
                for (int bj = 0; bj < 2; ++bj)
#pragma unroll
                    for (int n = 0; n < 2; ++n) *(f32x4*)(rowp + bj * HALF + n * 16) = acc[ai][bj][m][n]; }
    }
};
struct EpiPLE {
    static constexpr bool PERM = false, AFTER_DRAIN = false;
    const float* ssq_in; const float* bg; const float* PP; float* X; float* ssq_out;
    __device__ __forceinline__ void operator()(const f32x4 (&acc)[2][2][4][2], const Unit& u, int wr, int wc, int fr, int fq) const {
        const int row0 = u.pm * BM + wr * 64 + fr, col0 = u.pn * BM + wc * 32 + 4 * fq;
        float rs[2][4]; rows_rstd(ssq_in, row0, fq, rs);
#pragma unroll
        for (int ai = 0; ai < 2; ++ai)
#pragma unroll
            for (int m = 0; m < 4; ++m) {
                const int row = row0 + ai * HALF + m * 16; const float r = rs[ai][m]; float ss = 0.f;
                f32x4 pv[2][2], ov[2][2];
#pragma unroll
                for (int bj = 0; bj < 2; ++bj)
#pragma unroll
                    for (int n = 0; n < 2; ++n) { const size_t off = (size_t)row * DM + col0 + bj * HALF + n * 16; pv[bj][n] = *(const f32x4*)(PP + off); ov[bj][n] = *(const f32x4*)(X + off); }
#pragma unroll
                for (int bj = 0; bj < 2; ++bj)
#pragma unroll
                    for (int n = 0; n < 2; ++n) { const int c = col0 + bj * HALF + n * 16; const size_t off = (size_t)row * DM + c;
                        const f32x4 b4 = *(const f32x4*)(bg + c), a = acc[ai][bj][m][n]; f32x4 o;
#pragma unroll
                        for (int j = 0; j < 4; ++j) o[j] = ov[bj][n][j] + sigmoid_f(a[j] * r + b4[j]) * pv[bj][n][j];
                        *(f32x4*)(X + off) = o; ss += (o[0] * o[0] + o[1] * o[1]) + (o[2] * o[2] + o[3] * o[3]); }
                ss += __shfl_xor(ss, 16); ss += __shfl_xor(ss, 32);
                if (fq == 0) ssq_out[(size_t)row * NSSQ + u.pn * 4 + wc] = ss;
            }
    }
};

template <class Epi, class Sched, bool ALIGN_EPI = false, bool SP2 = false>
__device__ __forceinline__ void gemm_phase(PG8_LAS unsigned char* lds, const Gemm g, const Sched& S, const Epi& E, const int wave_s) {
    int tid_ = wave_s * 64 + lane_id_asm();
    const int tid = tid_, wid = wave_s, lane = tid & 63, wr = wid >> 2, wc = wid & 3, fr = lane & 15, fq = lane >> 4;
    const int K = g.K, nt = K / BK;
    unsigned voffA[2], voffB[2];
#pragma unroll
    for (int i = 0; i < 2; ++i) { int R, C; stage_rc(tid * 16 + i * 8192, R, C); const int Rb = Epi::PERM ? ((R & ~31) + perm32(R & 31)) : R;
        voffA[i] = (unsigned)(R * K + C) * 2u; voffB[i] = (unsigned)(Rb * K + C) * 2u; }
    const size_t kstep = (size_t)(BK * 2);
    const size_t hstep = (size_t)HALF * K * 2;
    const size_t tstep = 2 * hstep;
    const unsigned ldsw = (unsigned)wid * 1024u;
    const int aoff = lds_byte(wr * 64 + fr, fq * 8), boff = lds_byte(wc * 32 + fr, fq * 8);
#define PG8_SA(b, h) (((b) * 2 + (h)) * HTB)
#define PG8_SB(b, h) ((4 + (b) * 2 + (h)) * HTB)
#define PG8_STAGE(bufoff, gbase, voff) do { _Pragma("unroll") for (int _i = 0; _i < 2; ++_i) \
        __builtin_amdgcn_global_load_lds((const unsigned*)((const char*)(gbase) + (voff)[_i]), (PG8_LAS unsigned*)(lds + (bufoff) + ldsw + _i * 8192), 16, 0, 0); } while (0)
#define PG8_LDA(dst, b, h) do { _Pragma("unroll") for (int m = 0; m < 4; ++m) _Pragma("unroll") for (int k = 0; k < 2; ++k) dst[m][k] = *(const PG8_LAS bf16x8*)(lds + PG8_SA(b, h) + aoff + m * 2048 + k * 1024); } while (0)
#define PG8_LDB(dst, b, h) do { _Pragma("unroll") for (int n = 0; n < 2; ++n) _Pragma("unroll") for (int k = 0; k < 2; ++k) dst[n][k] = *(const PG8_LAS bf16x8*)(lds + PG8_SB(b, h) + boff + n * 2048 + k * 1024); } while (0)
#define PG8_MMA(ai, bj, At, Bt) do { __builtin_amdgcn_s_setprio(1); _Pragma("unroll") for (int m = 0; m < 4; ++m) _Pragma("unroll") for (int n = 0; n < 2; ++n) _Pragma("unroll") for (int k = 0; k < 2; ++k) \
        acc[ai][bj][m][n] = __builtin_amdgcn_mfma_f32_16x16x32_bf16(Bt[n][k], At[m][k], acc[ai][bj][m][n], 0, 0, 0); __builtin_amdgcn_s_setprio(0); } while (0)
#define PG8_WAIT_V(n) asm volatile("s_waitcnt vmcnt(" #n ")" ::: "memory")
#define PG8_WAIT_L(n) asm volatile("s_waitcnt lgkmcnt(" #n ")" ::: "memory")
#define PG8_BAR __builtin_amdgcn_s_barrier()
#define PG8_SCHED __builtin_amdgcn_sched_barrier(0)
    Unit cur, nxt; int ui = 0;
    if (!S.next(0, cur)) return;
    f32x4 acc[2][2][4][2];
#pragma unroll
    for (int a = 0; a < 2; ++a)
#pragma unroll
        for (int b = 0; b < 2; ++b)
#pragma unroll
            for (int m = 0; m < 4; ++m)
#pragma unroll
                for (int n = 0; n < 2; ++n) acc[a][b][m][n] = (f32x4){0.f, 0.f, 0.f, 0.f};
    bf16x8 At[4][2], B0[2][2], B1[2][2];
    const char* cA = (const char*)g.A + (size_t)cur.pm * tstep; const char* cB = (const char*)g.Bt + (size_t)cur.pn * tstep;
    S.a_ready(cur);
    if constexpr (SP2) {
        PG8_STAGE(PG8_SB(0, 0), cB, voffB); PG8_STAGE(PG8_SB(0, 1), cB + hstep, voffB); PG8_STAGE(PG8_SA(0, 0), cA, voffA); PG8_STAGE(PG8_SA(0, 1), cA + hstep, voffA);
        if (wr == 1) PG8_BAR;
        PG8_WAIT_V(2); PG8_BAR;
        PG8_STAGE(PG8_SB(1, 0), cB + kstep, voffB); PG8_STAGE(PG8_SA(1, 0), cA + kstep, voffA); PG8_STAGE(PG8_SB(1, 1), cB + hstep + kstep, voffB);
        PG8_WAIT_V(6); PG8_BAR;
    } else {
        PG8_STAGE(PG8_SB(0, 0), cB, voffB); PG8_STAGE(PG8_SA(0, 0), cA, voffA); PG8_STAGE(PG8_SB(0, 1), cB + hstep, voffB); PG8_STAGE(PG8_SA(0, 1), cA + hstep, voffA);
        if (wr == 1) PG8_BAR;
        PG8_WAIT_V(4); PG8_BAR;
        PG8_STAGE(PG8_SB(1, 0), cB + kstep, voffB); PG8_STAGE(PG8_SA(1, 0), cA + kstep, voffA); PG8_STAGE(PG8_SB(1, 1), cB + hstep + kstep, voffB);
        PG8_WAIT_V(6); PG8_BAR;
    }
    for (;;) {
        const bool has_next = S.next(ui + 1, nxt);
        const char* nA = has_next ? (const char*)g.A + (size_t)nxt.pm * tstep : cA; const char* nB = has_next ? (const char*)g.Bt + (size_t)nxt.pn * tstep : cB;
        for (int t = 0; t < nt; t += 2) {
            const bool last = (t == nt - 2);
            const char* a1 = cA + (size_t)(t + 1) * kstep;
            const char* a2 = last ? nA : cA + (size_t)(t + 2) * kstep; const char* b2 = last ? nB : cB + (size_t)(t + 2) * kstep;
            const char* a3 = a2 + kstep; const char* b3 = b2 + kstep;
            if (last && has_next) S.a_ready(nxt);
            if constexpr (SP2) {
            PG8_LDB(B0, 0, 0); PG8_LDB(B1, 0, 1); PG8_SCHED; PG8_LDA(At, 0, 0); PG8_STAGE(PG8_SA(1, 1), a1 + hstep, voffA);
            PG8_WAIT_V(8); PG8_WAIT_L(0); PG8_BAR; PG8_MMA(0, 0, At, B0); PG8_MMA(0, 1, At, B1); PG8_BAR; PG8_SCHED;
            PG8_LDA(At, 0, 1); PG8_STAGE(PG8_SB(0, 0), b2, voffB); PG8_STAGE(PG8_SB(0, 1), b2 + hstep, voffB); PG8_STAGE(PG8_SA(0, 0), a2, voffA);
            PG8_WAIT_V(8); PG8_WAIT_L(0); PG8_BAR; PG8_MMA(1, 0, At, B0); PG8_MMA(1, 1, At, B1); PG8_BAR; PG8_SCHED;
            PG8_LDB(B0, 1, 0); PG8_LDB(B1, 1, 1); PG8_SCHED; PG8_LDA(At, 1, 0); PG8_STAGE(PG8_SA(0, 1), a2 + hstep, voffA);
            PG8_WAIT_V(8); PG8_WAIT_L(0); PG8_BAR; PG8_MMA(0, 0, At, B0); PG8_MMA(0, 1, At, B1); PG8_BAR; PG8_SCHED;
            PG8_LDA(At, 1, 1); PG8_STAGE(PG8_SB(1, 0), b3, voffB); PG8_STAGE(PG8_SB(1, 1), b3 + hstep, voffB); PG8_STAGE(PG8_SA(1, 0), a3, voffA);
            PG8_WAIT_V(8); PG8_WAIT_L(0); PG8_BAR; PG8_MMA(1, 0, At, B0); PG8_MMA(1, 1, At, B1); PG8_BAR; PG8_SCHED;
            } else {
            PG8_LDB(B0, 0, 0); PG8_SCHED; PG8_LDA(At, 0, 0); PG8_STAGE(PG8_SA(1, 1), a1 + hstep, voffA);
            PG8_WAIT_L(8); PG8_BAR; PG8_WAIT_L(0); PG8_MMA(0, 0, At, B0); PG8_BAR; PG8_SCHED;
            PG8_LDB(B1, 0, 1); PG8_STAGE(PG8_SB(0, 0), b2, voffB);
            PG8_BAR; PG8_WAIT_L(0); PG8_MMA(0, 1, At, B1); PG8_BAR;
            PG8_LDA(At, 0, 1); PG8_STAGE(PG8_SA(0, 0), a2, voffA);
            PG8_BAR; PG8_WAIT_L(0); PG8_MMA(1, 0, At, B0); PG8_BAR; PG8_SCHED;
            PG8_STAGE(PG8_SB(0, 1), b2 + hstep, voffB);
            PG8_WAIT_V(6); PG8_BAR; PG8_MMA(1, 1, At, B1); PG8_BAR;
            PG8_LDB(B0, 1, 0); PG8_SCHED; PG8_LDA(At, 1, 0); PG8_STAGE(PG8_SA(0, 1), a2 + hstep, voffA);
            PG8_WAIT_L(8); PG8_BAR; PG8_WAIT_L(0); PG8_MMA(0, 0, At, B0); PG8_BAR; PG8_SCHED;
            PG8_LDB(B1, 1, 1); PG8_STAGE(PG8_SB(1, 0), b3, voffB);
            PG8_BAR; PG8_WAIT_L(0); PG8_MMA(0, 1, At, B1); PG8_BAR;
            PG8_LDA(At, 1, 1); PG8_STAGE(PG8_SA(1, 0), a3, voffA);
            PG8_BAR; PG8_WAIT_L(0); PG8_MMA(1, 0, At, B0); PG8_BAR; PG8_SCHED;
            PG8_STAGE(PG8_SB(1, 1), b3 + hstep, voffB);
            PG8_WAIT_V(6); PG8_BAR; PG8_MMA(1, 1, At, B1); PG8_BAR;
            }
        }
        if constexpr (ALIGN_EPI) { if (wr == 0) PG8_BAR; }
        if constexpr (!Epi::AFTER_DRAIN) { E(acc, cur, wr, wc, fr, fq); S.done(cur); }
        if (!has_next) break;
#pragma unroll
        for (int a = 0; a < 2; ++a)
#pragma unroll
            for (int b = 0; b < 2; ++b)
#pragma unroll
                for (int m = 0; m < 4; ++m)
#pragma unroll
                    for (int n = 0; n < 2; ++n) acc[a][b][m][n] = (f32x4){0.f, 0.f, 0.f, 0.f};
        cur = nxt; cA = nA; cB = nB; ++ui;
        if constexpr (ALIGN_EPI) { if (wr == 1) PG8_BAR; }
    }
    PG8_WAIT_V(0);
    if constexpr (!ALIGN_EPI) { if (wr == 0) PG8_BAR; }
    PG8_BAR;
    if constexpr (Epi::AFTER_DRAIN) { E.fused(acc, cur, wr, wc, fr, fq, lds, wid, lane); S.done(cur); }
#undef PG8_SA
#undef PG8_SB
#undef PG8_STAGE
#undef PG8_LDA
#undef PG8_LDB
#undef PG8_MMA
#undef PG8_WAIT_V
#undef PG8_WAIT_L
#undef PG8_BAR
#undef PG8_SCHED
}
}
#define GAS __attribute__((address_space(1)))
#define LAS __attribute__((address_space(3)))
typedef unsigned short bf16;
typedef unsigned v4u __attribute__((ext_vector_type(4)));
typedef float f32x4 __attribute__((ext_vector_type(4)));
typedef short bf16x8 __attribute__((ext_vector_type(8)));
typedef GAS unsigned gu32;
typedef GAS unsigned long long gu64;
#define RLX_AGENT __ATOMIC_RELAXED, __HIP_MEMORY_SCOPE_AGENT
#define LDS_WAIT() asm volatile("s_waitcnt lgkmcnt(0)" ::: "memory")
#define VM_WAIT() asm volatile("s_waitcnt vmcnt(0)" ::: "memory")
__device__ __forceinline__ unsigned long long rt() { return __builtin_amdgcn_s_memrealtime(); }
__device__ __forceinline__ unsigned f2bf(float f) { unsigned u = __builtin_bit_cast(unsigned, f); return (u + 0x7fffu + ((u >> 16) & 1u)) >> 16; }
__device__ __forceinline__ unsigned pk2(float lo, float hi) { return f2bf(lo) | (f2bf(hi) << 16); }

#define XB_TMO      128
#define XB_XCNT(j)  (256  + 64 * (j))
#define XB_XSUB(j)  (1280 + 64 * (j))
#define XB_XGEN(j)  (2304 + 64 * (j))
#define XB_TOP      3328
#define XB_TOPGEN   3392
#define XCD_BAR_WORDS 3456
#define XB_SPIN_CAP (1u << 18)

__device__ __forceinline__ unsigned xb_ld(unsigned* p)              { return __hip_atomic_load(p, __ATOMIC_RELAXED, __HIP_MEMORY_SCOPE_AGENT); }
__device__ __forceinline__ unsigned xb_add(unsigned* p, unsigned v) { return __hip_atomic_fetch_add(p, v, __ATOMIC_RELAXED, __HIP_MEMORY_SCOPE_AGENT); }
__device__ __forceinline__ unsigned xb_xcc_id() { return (unsigned)__builtin_amdgcn_s_getreg((3 << 11) | 20) & 0xFu; }
#define XB_SPIN(cond, bar) do { unsigned _sp = 0; while (cond) { __builtin_amdgcn_s_sleep(1); \
    if ((++_sp & 255u) == 0u) { if (xb_ld(&(bar)[XB_TMO])) break; if (_sp > XB_SPIN_CAP) { atomicAdd(&(bar)[XB_TMO], 1u); break; } } } } while (0)

struct XcdBarrier {
    unsigned* bar; unsigned x; int wave;
    volatile LAS unsigned* st;
};

__device__ __forceinline__ XcdBarrier xcd_barrier_post(unsigned* bar, volatile LAS unsigned* st, int wave) {
    XcdBarrier b; b.bar = bar; b.x = xb_xcc_id(); b.st = st; b.wave = wave;
    if (wave == 0 && pg8::lane_id_asm() == 0) (void)xb_add(&bar[XB_XCNT(b.x)], 1u);
    return b;
}
__device__ __forceinline__ void xcd_barrier_complete(unsigned* bar, unsigned x, unsigned& nloc, unsigned& nx) {
    const unsigned G = gridDim.x * gridDim.y * gridDim.z;
    unsigned sum, cnt, mine, sp = 0u;
    for (;;) {
        sum = 0u; cnt = 0u; mine = 0u;
#pragma unroll
        for (unsigned j = 0; j < 16; ++j) { const unsigned c = xb_ld(&bar[XB_XCNT(j)]); sum += c; cnt += (c > 0u) ? 1u : 0u; mine = (j == x) ? c : mine; }
        if (sum == G) break;
        __builtin_amdgcn_s_sleep(1);
        if ((++sp & 255u) == 0u) { if (xb_ld(&bar[XB_TMO])) break; if (sp > XB_SPIN_CAP) { atomicAdd(&bar[XB_TMO], 1u); break; } }
    }
    nloc = mine > 0u ? mine : 1u; nx = cnt > 0u ? cnt : 1u;
}

__device__ __forceinline__ void xcd_barrier(const XcdBarrier& b) {
    asm volatile("s_waitcnt vmcnt(0)" ::: "memory");
    __syncthreads();
    if (b.wave == 0 && pg8::lane_id_asm() == 0) {
        unsigned* bar = b.bar;
        __builtin_amdgcn_s_waitcnt(0);
        unsigned nloc = b.st[0], nx = b.st[1];
        if (nloc == 0u) { xcd_barrier_complete(bar, b.x, nloc, nx); b.st[0] = nloc; b.st[1] = nx; }
        const unsigned old = xb_add(&bar[XB_XSUB(b.x)], 1u);
        const unsigned gen = old / nloc;
        if (old + 1u == (gen + 1u) * nloc) {
            __builtin_amdgcn_fence(__ATOMIC_RELEASE, "agent");
            asm volatile("s_waitcnt vmcnt(0)" ::: "memory");
            const unsigned og = xb_add(&bar[XB_TOP], 1u);
            const unsigned tg = og / nx;
            if (og + 1u == (tg + 1u) * nx) xb_add(&bar[XB_TOPGEN], 1u);
            else XB_SPIN(xb_ld(&bar[XB_TOPGEN]) == tg, bar);
            __builtin_amdgcn_fence(__ATOMIC_ACQUIRE, "agent");
            xb_add(&bar[XB_XGEN(b.x)], 1u);
            asm volatile("s_waitcnt vmcnt(0)" ::: "memory");
        } else {
            XB_SPIN(xb_ld(&bar[XB_XGEN(b.x)]) == gen, bar);
            __builtin_amdgcn_fence(__ATOMIC_ACQUIRE, "agent");
            asm volatile("s_waitcnt vmcnt(0)" ::: "memory");
        }
    }
    __syncthreads();
}

constexpr int NWAVES = 8;
constexpr int BATCH = 4, SEQ = 2048, D = 2048, DFF = 5632, NGU = 2 * DFF, NIN = 6144, PLE = 256;
constexpr int HW = 1024, LW = 1024, HEADS = 8, HD = 128, CHUNK = 64, NCH = SEQ / CHUNK;
constexpr int M = BATCH * SEQ;
constexpr float EPS = 1e-6f;
constexpr int N_IN = 27;
enum In { I_X = 0, I_P, I_F1N, I_F1G, I_F1U, I_F1D, I_MIXN, I_WIN, I_HLB, I_HGN, I_CW, I_CB, I_LWA, I_LBA, I_LWX, I_LBX, I_LAM, I_WOUT,
          I_F2N, I_F2G, I_F2U, I_F2D, I_PLN, I_PWG, I_PBG, I_PWP, I_FN };

constexpr size_t MiB = 1u << 20;
constexpr size_t WS_CTL = 0, CTL_ZERO_BYTES = 1 * MiB;
constexpr size_t WS_SSQA = 1 * MiB, WS_SSQB = 2 * MiB, WS_DEC = 3 * MiB;
constexpr size_t WS_WAT = 3 * MiB + 512 * 1024, WS_WXT = 3 * MiB + 768 * 1024;
constexpr size_t WS_WPROJ = 4 * MiB, WS_PB = 5 * MiB;
constexpr size_t WS_WGU1 = 9 * MiB, WS_WD1 = 53 * MiB, WS_WINT = 75 * MiB, WS_WOUT = 99 * MiB, WS_WGU2 = 107 * MiB, WS_WD2 = 151 * MiB, WS_WPG = 173 * MiB;
constexpr size_t WS_XB = 181 * MiB;
constexpr size_t WS_ACT = 213 * MiB;
constexpr size_t WS_LOGF = WS_ACT, WS_V = WS_ACT + 32 * MiB, WS_SG = WS_ACT + 48 * MiB, WS_LRX = WS_ACT + 64 * MiB, WS_PP = WS_ACT;
constexpr size_t WS_MIXA = 301 * MiB;
constexpr size_t WS_KVT = 333 * MiB;
constexpr size_t WS_END = 397 * MiB;
static_assert(WS_WGU1 + (size_t)NGU * D * 2 <= WS_WD1 && WS_WD1 + (size_t)D * DFF * 2 <= WS_WINT && WS_WINT + (size_t)NIN * D * 2 <= WS_WOUT && WS_WOUT + (size_t)D * D * 2 <= WS_WGU2 &&
              WS_WGU2 + (size_t)NGU * D * 2 <= WS_WD2 && WS_WD2 + (size_t)D * DFF * 2 <= WS_WPG && WS_WPG + (size_t)D * D * 2 <= WS_XB && WS_XB + (size_t)M * D * 2 <= WS_ACT &&
              WS_ACT + (size_t)M * DFF * 2 <= WS_MIXA && WS_MIXA + (size_t)M * 2048 * 2 <= WS_KVT && WS_KVT + (size_t)BATCH * HEADS * NCH * HD * HD * 4 <= WS_END &&
              WS_LRX + (size_t)M * 1024 * 2 <= WS_MIXA && WS_PP + (size_t)M * D * 4 <= WS_MIXA && WS_PB + (size_t)M * PLE * 2 <= WS_WGU1 && WS_WPROJ + (size_t)D * PLE * 2 <= WS_PB, "d_ws map");
constexpr int CW_BAR = 4096;

constexpr int RING_OFF = 0, RING_BYTES = 131072;
constexpr int LDSCTL_OFF = 147456 - 512, MISC_OFF = LDSCTL_OFF + 320;
constexpr int LDS_BYTES = 147456;
static_assert(MISC_OFF + 128 <= LDS_BYTES, "LDS map");


struct Frame {
    LAS unsigned char* lds;
    volatile LAS unsigned* MISC;
    gu32* ctl;
    int wave;
    int vcu, G;
    const float* in[N_IN]; float* out; unsigned char* ws;
};
__device__ __forceinline__ float bf2f(bf16 b) { return __builtin_bit_cast(float, (unsigned)b << 16); }
__device__ __forceinline__ float wave_sum(float v) {
#pragma unroll
    for (int o = 1; o < 64; o <<= 1) v += __shfl_xor(v, o);
    return v;
}
__device__ __forceinline__ void p0_transpose_item(const float* W, int ldw, int K, int src_col0, bf16* WT, int dst_row0, const float* gain, LAS float* scr, int kb, int lane) {
    const int k0 = 64 * kb, kq = lane >> 4, nq = lane & 15;
    f32x4 v[16];
#pragma unroll
    for (int i = 0; i < 16; ++i) v[i] = *(const GAS f32x4*)(W + (size_t)(k0 + 4 * i + kq) * ldw + src_col0 + 4 * nq);
    if (gain) {
#pragma unroll
        for (int i = 0; i < 16; ++i) v[i] = v[i] * gain[k0 + 4 * i + kq];
    }
#pragma unroll
    for (int i = 0; i < 16; ++i) { LAS float* s = scr + (4 * i + kq) * 65 + 4 * nq; s[0] = v[i].x; s[1] = v[i].y; s[2] = v[i].z; s[3] = v[i].w; }
    LDS_WAIT(); asm volatile("" ::: "memory");
    const int c = lane & 7;
#pragma unroll
    for (int j = 0; j < 8; ++j) { const int n = (lane >> 3) + 8 * j; const LAS float* s = scr + (8 * c) * 65 + n;
        v4u o; o.x = pk2(s[0 * 65], s[1 * 65]); o.y = pk2(s[2 * 65], s[3 * 65]); o.z = pk2(s[4 * 65], s[5 * 65]); o.w = pk2(s[6 * 65], s[7 * 65]);
        *(GAS v4u*)(WT + (size_t)(dst_row0 + n) * K + k0 + 8 * c) = o; }
    LDS_WAIT(); asm volatile("" ::: "memory");
}
__device__ __forceinline__ bool p0_plain(int& r, const float* W, int K, int N, bf16* WT, const float* gain, LAS float* scr, int lane) {
    const int items = (N / 64) * (K / 64);
    if (r < items) { const int nb = r / (K / 64), kb = r % (K / 64); p0_transpose_item(W, N, K, 64 * nb, WT, 64 * nb, gain, scr, kb, lane); return true; }
    r -= items; return false;
}
__device__ __forceinline__ bool p0_gateup(int& r, const float* Wg, const float* Wu, bf16* WT, const float* gain, LAS float* scr, int lane) {
    const int items = (NGU / 64) * (D / 64);
    if (r < items) { const int rb = r / (D / 64), kb = r % (D / 64), t = rb >> 2, j = rb & 3;
        p0_transpose_item(j < 2 ? Wg : Wu, DFF, D, 128 * t + 64 * (j & 1), WT, 64 * rb, gain, scr, kb, lane); return true; }
    r -= items; return false;
}
__device__ __forceinline__ void p0_prologue(Frame& F) {
    const int lane_ = pg8::lane_id_asm(), wave_ = F.wave;
    LAS float* scr = (LAS float*)(F.lds + RING_OFF + wave_ * 16640);
    const int gw = F.vcu * NWAVES + wave_, NGW = F.G * NWAVES;
    unsigned char* ws = F.ws;
    for (int m = gw; m < M; m += NGW) {
        const GAS f32x4* xr = (const GAS f32x4*)(F.in[I_X] + (size_t)m * D) + lane_;
        GAS unsigned long long* o8 = (GAS unsigned long long*)((bf16*)(ws + WS_XB) + (size_t)m * D) + lane_;
        float s = 0.f;
#pragma unroll
        for (int j = 0; j < 8; ++j) { const f32x4 v = xr[64 * j]; s += (v.x * v.x + v.y * v.y) + (v.z * v.z + v.w * v.w);
            o8[64 * j] = (unsigned long long)pk2(v.x, v.y) | ((unsigned long long)pk2(v.z, v.w) << 32); }
        s = wave_sum(s);
        if (lane_ < 32) ((float*)(ws + WS_SSQA))[(size_t)m * 32 + lane_] = (lane_ == 0) ? s : 0.f;
    }
    for (int m = gw; m < M; m += NGW) {
        const f32x4 v = ((const GAS f32x4*)(F.in[I_P] + (size_t)m * PLE))[lane_];
        ((GAS unsigned long long*)((bf16*)(ws + WS_PB) + (size_t)m * PLE))[lane_] = (unsigned long long)pk2(v.x, v.y) | ((unsigned long long)pk2(v.z, v.w) << 32);
    }
    constexpr int NITEMS = 2 * (NGU / 64) * (D / 64) + 2 * (D / 64) * (DFF / 64) + (NIN / 64) * (D / 64) + 2 * (D / 64) * (D / 64) + (D / 64) * (PLE / 64) + 16 * (128 / 64) * (128 / 64);
    for (int it = gw; it < NITEMS; it += NGW) {
        int r = it;
        if (p0_gateup(r, F.in[I_F1G], F.in[I_F1U], (bf16*)(ws + WS_WGU1), F.in[I_F1N], scr, lane_)) continue;
        if (p0_plain(r, F.in[I_F1D], DFF, D, (bf16*)(ws + WS_WD1), nullptr, scr, lane_)) continue;
        if (p0_plain(r, F.in[I_WIN], D, NIN, (bf16*)(ws + WS_WINT), F.in[I_MIXN], scr, lane_)) continue;
        if (p0_plain(r, F.in[I_WOUT], D, D, (bf16*)(ws + WS_WOUT), nullptr, scr, lane_)) continue;
        if (p0_gateup(r, F.in[I_F2G], F.in[I_F2U], (bf16*)(ws + WS_WGU2), F.in[I_F2N], scr, lane_)) continue;
        if (p0_plain(r, F.in[I_F2D], DFF, D, (bf16*)(ws + WS_WD2), nullptr, scr, lane_)) continue;
        if (p0_plain(r, F.in[I_PWG], D, D, (bf16*)(ws + WS_WPG), F.in[I_PLN], scr, lane_)) continue;
        if (p0_plain(r, F.in[I_PWP], PLE, D, (bf16*)(ws + WS_WPROJ), nullptr, scr, lane_)) continue;
        { const int blk = r >> 2, q = r & 3;
          const float* W = (blk < 8 ? F.in[I_LWA] : F.in[I_LWX]) + (size_t)(blk & 7) * 128 * 128;
          bf16* WT = (bf16*)(ws + (blk < 8 ? WS_WAT : WS_WXT)) + (size_t)(blk & 7) * 128 * 128;
          p0_transpose_item(W, 128, 128, 64 * (q >> 1), WT, 64 * (q >> 1), nullptr, scr, q & 1, lane_); }
    }
}
__device__ __forceinline__ void final_norm(Frame& F, const float* ssq) {
    const int lane_ = pg8::lane_id_asm(), wave_ = F.wave;
    const int gw = F.vcu * NWAVES + wave_, NGW = F.G * NWAVES;
    const GAS f32x4* gf = (const GAS f32x4*)F.in[I_FN] + lane_;
    for (int m = gw; m < M; m += NGW) {
        float s = (lane_ < 32) ? ssq[(size_t)m * 32 + lane_] : 0.f;
        s = wave_sum(s);
        const float rstd = 1.0f / sqrtf(s * (1.0f / D) + EPS);
        GAS f32x4* xr = (GAS f32x4*)(F.out + (size_t)m * D) + lane_;
#pragma unroll
        for (int j = 0; j < 8; ++j) { f32x4 v = xr[64 * j]; const f32x4 g = gf[64 * j]; v = v * rstd * g; xr[64 * j] = v; }
    }
}


typedef float mf32x4 __attribute__((ext_vector_type(4)));
typedef short mbf16x8 __attribute__((ext_vector_type(8)));
typedef unsigned mu32x2 __attribute__((ext_vector_type(2)));
constexpr int TS = 72;
constexpr int QS = 136;
constexpr int NITEM = BATCH * HEADS * NCH;
__device__ __forceinline__ mbf16x8 lds_frag(const LAS bf16* p) { return *(const LAS mbf16x8*)p; }
__device__ __forceinline__ unsigned bf1(float x) { return pg8::cvt_pk_bf16(x, 0.f) & 0xffffu; }
#define MFMA16(a, b, c) __builtin_amdgcn_mfma_f32_16x16x32_bf16((a), (b), (c), 0, 0, 0)

__device__ __forceinline__ void hgrn_local_phase(Frame& F) {
    LAS bf16* kstT = (LAS bf16*)(F.lds);
    LAS bf16* vT = (LAS bf16*)(F.lds + 18432);
    LAS float* qtot = (LAS float*)(F.lds + 36864);
    const int tid_ = F.wave * 64 + pg8::lane_id_asm();
    const int tid = tid_, k = tid & 127, sq = tid >> 7, lane = tid & 63, w = F.wave, fr = lane & 15, fq = lane >> 4;
    const float* LOGF = (const float*)(F.ws + WS_LOGF); const bf16* V = (const bf16*)(F.ws + WS_V);
    float* KVT = (float*)(F.ws + WS_KVT); float* DEC = (float*)(F.ws + WS_DEC);
    for (int item = blockIdx.x; item < NITEM; item += F.G) {
        const int c = item & 31, bh = item >> 5, h = bh & 7, b = bh >> 3;
        const size_t g0 = ((size_t)b * SEQ + c * 64 + sq * 16) * 1024 + h * 128 + k;
        float lf[16]; unsigned vr[16];
#pragma unroll
        for (int i = 0; i < 16; ++i) { lf[i] = LOGF[g0 + (size_t)i * 1024]; vr[i] = V[g0 + (size_t)i * 1024]; }
        float bb[16]; float run = 0.f;
#pragma unroll
        for (int i = 0; i < 16; ++i) { run += lf[i]; bb[i] = run; }
        qtot[sq * 128 + k] = run;
        __syncthreads();
        float pre = 0.f, tot = 0.f;
#pragma unroll
        for (int j = 0; j < 4; ++j) { const float tq = qtot[j * 128 + k]; pre += (j < sq) ? tq : 0.f; tot += tq; }
        unsigned pk[8], pv[8];
#pragma unroll
        for (int i = 0; i < 8; ++i) {
            const float e0 = (1.0f - __expf(lf[2 * i])) * __expf(tot - (pre + bb[2 * i])), e1 = (1.0f - __expf(lf[2 * i + 1])) * __expf(tot - (pre + bb[2 * i + 1]));
            pk[i] = pg8::cvt_pk_bf16(e0, e1); pv[i] = vr[2 * i] | (vr[2 * i + 1] << 16); }
        *(LAS v4u*)(kstT + k * TS + sq * 16) = (v4u){pk[0], pk[1], pk[2], pk[3]}; *(LAS v4u*)(kstT + k * TS + sq * 16 + 8) = (v4u){pk[4], pk[5], pk[6], pk[7]};
        *(LAS v4u*)(vT + k * TS + sq * 16) = (v4u){pv[0], pv[1], pv[2], pv[3]}; *(LAS v4u*)(vT + k * TS + sq * 16 + 8) = (v4u){pv[4], pv[5], pv[6], pv[7]};
        if (sq == 0) DEC[(size_t)item * 128 + k] = __expf(tot);
        __syncthreads();
        const mbf16x8 b0 = lds_frag(vT + (16 * w + fr) * TS + 8 * fq), b1 = lds_frag(vT + (16 * w + fr) * TS + 32 + 8 * fq);
        float* outp = KVT + (size_t)item * 16384 + (size_t)(16 * w + fr) * 128 + 4 * fq;
#pragma unroll
        for (int kt = 0; kt < 8; ++kt) {
            mf32x4 acc = {0.f, 0.f, 0.f, 0.f};
            acc = MFMA16(lds_frag(kstT + (16 * kt + fr) * TS + 8 * fq), b0, acc);
            acc = MFMA16(lds_frag(kstT + (16 * kt + fr) * TS + 32 + 8 * fq), b1, acc);
            *(mf32x4*)(outp + 16 * kt) = acc;
        }
        __syncthreads();
    }
}

__device__ __forceinline__ void hgrn_scan_phase(Frame& F) {
    const float* KVT = (const float*)(F.ws + WS_KVT); const float* DEC = (const float*)(F.ws + WS_DEC); bf16* ST = (bf16*)(F.ws + WS_XB);
    const int tid_ = F.wave * 64 + pg8::lane_id_asm();
    for (int idx = blockIdx.x * (NWAVES * 64) + tid_; idx < BATCH * HEADS * 128 * 32; idx += F.G * NWAVES * 64) {
        const int k4 = idx & 31, v = (idx >> 5) & 127, bh = idx >> 12;
        mf32x4 S = {0.f, 0.f, 0.f, 0.f};
#pragma unroll 1
        for (int half = 0; half < 2; ++half) {
            const size_t off0 = (size_t)(bh * NCH + half * 16) * 16384 + v * 128 + 4 * k4; const size_t d0 = (size_t)(bh * NCH + half * 16) * 128 + 4 * k4;
            mf32x4 kv[16], dd[16];
#pragma unroll
            for (int c = 0; c < 16; ++c) { kv[c] = *(const mf32x4*)(KVT + off0 + (size_t)c * 16384); dd[c] = *(const mf32x4*)(DEC + d0 + (size_t)c * 128); }
#pragma unroll
            for (int c = 0; c < 16; ++c) {
                mu32x2 o; o.x = pg8::cvt_pk_bf16(S[0], S[1]); o.y = pg8::cvt_pk_bf16(S[2], S[3]); *(mu32x2*)(ST + off0 + (size_t)c * 16384) = o;
                S = dd[c] * S + kv[c];
            }
        }
    }
}

__device__ __forceinline__ void hgrn_out_phase(Frame& F, bool dummy = false) {
    LAS bf16* QT = (LAS bf16*)(F.lds);
    LAS bf16* KT = (LAS bf16*)(F.lds + 17408);
    LAS bf16* QI = (LAS bf16*)(F.lds + 34816);
    LAS bf16* vT = (LAS bf16*)(F.lds + 52224);
    LAS bf16* P = (LAS bf16*)(F.lds + 70656);
    LAS float* qtot = (LAS float*)(F.lds + 79872);
    LAS float* ssq = (LAS float*)(F.lds + 81920);
    const int tid_ = F.wave * 64 + pg8::lane_id_asm();
    const int tid = tid_, k = tid & 127, sq = tid >> 7, lane = tid & 63, w = F.wave, fr = lane & 15, fq = lane >> 4, rb = w & 3, ch = w >> 2;
    const float* LOGF = (const float*)(F.ws + WS_LOGF); const bf16* V = (const bf16*)(F.ws + WS_V); const bf16* SG = (const bf16*)(F.ws + WS_SG);
    const bf16* ST = (const bf16*)(F.ws + WS_XB); bf16* MIXA = (bf16*)(F.ws + WS_MIXA);
    for (int item = blockIdx.x; item < NITEM; item += F.G) {
        const int c = item & 31, bh = item >> 5, h = bh & 7, b = bh >> 3;
        const size_t r0 = (size_t)b * SEQ + c * 64;
        {
            const size_t g0 = (r0 + sq * 16) * 1024 + h * 128 + k, gq = (r0 + sq * 16) * 2048 + h * 128 + k;
            float lf[16]; unsigned vr[16], qr[16];
#pragma unroll
            for (int i = 0; i < 16; ++i) { lf[i] = LOGF[g0 + (size_t)i * 1024]; vr[i] = V[g0 + (size_t)i * 1024]; qr[i] = MIXA[gq + (size_t)i * 2048]; }
            float bb[16]; float run = 0.f;
#pragma unroll
            for (int i = 0; i < 16; ++i) { run += lf[i]; bb[i] = run; }
            qtot[sq * 128 + k] = run;
            __syncthreads();
            float pre = 0.f;
#pragma unroll
            for (int j = 0; j < 4; ++j) { const float tq = qtot[j * 128 + k]; pre += (j < sq) ? tq : 0.f; }
            const float bm = qtot[k] + qtot[128 + k], ebm = __expf(bm);
            unsigned pv[8];
#pragma unroll
            for (int i = 0; i < 16; ++i) {
                const float d = fminf(fmaxf(pre + bb[i] - bm, -60.f), 60.f), e1 = __expf(d), e2 = __builtin_amdgcn_rcpf(e1);
                const float qf = bf2f((bf16)qr[i]), qt = qf * e1, kk = (1.0f - __expf(lf[i])) * e2;
                const int s = sq * 16 + i;
                QT[s * QS + k] = (bf16)bf1(qt); QI[s * QS + k] = (bf16)bf1(qt * ebm); KT[s * QS + k] = (bf16)bf1(kk);
            }
#pragma unroll
            for (int i = 0; i < 8; ++i) pv[i] = vr[2 * i] | (vr[2 * i + 1] << 16);
            *(LAS v4u*)(vT + k * TS + sq * 16) = (v4u){pv[0], pv[1], pv[2], pv[3]}; *(LAS v4u*)(vT + k * TS + sq * 16 + 8) = (v4u){pv[4], pv[5], pv[6], pv[7]};
        }
        __syncthreads();
        const int t0 = 16 * rb;
        {
            mbf16x8 bq[4];
#pragma unroll
            for (int ks = 0; ks < 4; ++ks) bq[ks] = lds_frag(QT + (t0 + fr) * QS + 32 * ks + 8 * fq);
#pragma unroll
            for (int j = 0; j < 2; ++j) {
                const int s0 = 32 * ch + 16 * j; mf32x4 acc = {0.f, 0.f, 0.f, 0.f};
#pragma unroll
                for (int ks = 0; ks < 4; ++ks) acc = MFMA16(lds_frag(KT + (s0 + fr) * QS + 32 * ks + 8 * fq), bq[ks], acc);
                const int t = t0 + fr, sb = s0 + 4 * fq;
#pragma unroll
                for (int r = 0; r < 4; ++r) acc[r] = (sb + r <= t) ? acc[r] : 0.f;
                mu32x2 o; o.x = pg8::cvt_pk_bf16(acc[0], acc[1]); o.y = pg8::cvt_pk_bf16(acc[2], acc[3]);
                *(LAS mu32x2*)(P + t * TS + sb) = o;
            }
        }
        __syncthreads();
        mf32x4 o4[4];
        {
            mbf16x8 bqi[4], bp[2];
#pragma unroll
            for (int ks = 0; ks < 4; ++ks) bqi[ks] = lds_frag(QI + (t0 + fr) * QS + 32 * ks + 8 * fq);
#pragma unroll
            for (int ss = 0; ss < 2; ++ss) bp[ss] = lds_frag(P + (t0 + fr) * TS + 32 * ss + 8 * fq);
            float sum = 0.f;
#pragma unroll
            for (int j = 0; j < 4; ++j) {
                const int v0 = 64 * ch + 16 * j; mf32x4 acc = {0.f, 0.f, 0.f, 0.f};
                const bf16* sp = ST + (size_t)item * 16384 + (size_t)(v0 + fr) * 128 + 8 * fq;
#pragma unroll
                for (int ks = 0; ks < 4; ++ks) acc = MFMA16(*(const mbf16x8*)(sp + 32 * ks), bqi[ks], acc);
#pragma unroll
                for (int ss = 0; ss < 2; ++ss) acc = MFMA16(lds_frag(vT + (v0 + fr) * TS + 32 * ss + 8 * fq), bp[ss], acc);
                o4[j] = acc; sum += (acc[0] * acc[0] + acc[1] * acc[1]) + (acc[2] * acc[2] + acc[3] * acc[3]);
            }
            sum += __shfl_xor(sum, 16); sum += __shfl_xor(sum, 32);
            if (fq == 0) ssq[ch * 64 + t0 + fr] = sum;
        }
        __syncthreads();
        {
            const float rn = 1.0f / sqrtf((ssq[t0 + fr] + ssq[64 + t0 + fr]) * (1.0f / 128.0f) + EPS);
            const size_t row = r0 + t0 + fr;
#pragma unroll
            for (int j = 0; j < 4; ++j) {
                const int v = 64 * ch + 16 * j + 4 * fq;
                const mf32x4 gn = *(const mf32x4*)(F.in[I_HGN] + v);
                const mu32x2 sgp = *(const mu32x2*)(SG + row * 1024 + h * 128 + v);
                const float s0 = bf2f((bf16)(sgp.x & 0xffffu)), s1 = bf2f((bf16)(sgp.x >> 16)), s2 = bf2f((bf16)(sgp.y & 0xffffu)), s3 = bf2f((bf16)(sgp.y >> 16));
                mu32x2 o; o.x = pg8::cvt_pk_bf16(o4[j][0] * rn * gn[0] * s0, o4[j][1] * rn * gn[1] * s1); o.y = pg8::cvt_pk_bf16(o4[j][2] * rn * gn[2] * s2, o4[j][3] * rn * gn[3] * s3);
                *(mu32x2*)((dummy ? (bf16*)(F.ws + WS_KVT) : MIXA) + row * 2048 + h * 128 + v) = o;
            }
        }
        __syncthreads();
    }
}

__device__ __forceinline__ void lru_phase(Frame& F, bool dummy = false) {
    LAS bf16* A = (LAS bf16*)(F.lds);
    LAS float* XS = (LAS float*)(F.lds + 69632);
    LAS float* LAt = (LAS float*)(F.lds + 86016);
    LAS float* LUt = (LAS float*)(F.lds + 86016 + 18560);
    const int tid_ = F.wave * 64 + pg8::lane_id_asm();
    const int tid = tid_, lane = tid & 63, w = F.wave, fr = lane & 15, fq = lane >> 4;
    const int cg = tid & 15, rr0 = tid >> 4;
    const int seg = lane & 31, d = 2 * w + (lane >> 5);
    const bf16* LRX = (const bf16*)(F.ws + WS_LRX); bf16* MIXA = (bf16*)(F.ws + WS_MIXA);
    const bf16* WAT = (const bf16*)(F.ws + WS_WAT); const bf16* WXT = (const bf16*)(F.ws + WS_WXT);
    for (int item = blockIdx.x; item < BATCH * 64; item += F.G) {
        const int b = item >> 6, n = (item >> 3) & 7, sl = item & 7;
        const int cbase = n * 128 + 8 * cg;
        float cwv[4][8], cbv[8];
#pragma unroll
        for (int e = 0; e < 8; ++e) { cbv[e] = F.in[I_CB][cbase + e];
#pragma unroll
            for (int j = 0; j < 4; ++j) cwv[j][e] = F.in[I_CW][j * 1024 + cbase + e]; }
        mbf16x8 waf[4], wxf[4];
#pragma unroll
        for (int ks = 0; ks < 4; ++ks) { const size_t o = ((size_t)n * 128 + sl * 16 + fr) * 128 + 32 * ks + 8 * fq; waf[ks] = *(const mbf16x8*)(WAT + o); wxf[ks] = *(const mbf16x8*)(WXT + o); }
        const int cgl = n * 128 + sl * 16 + fr;
        const float ba = F.in[I_LBA][cgl], bx = F.in[I_LBX][cgl], spl = log1pf(__expf(-F.in[I_LAM][cgl]));
        float carry = 0.f;
        v4u xr[11];
#pragma unroll
        for (int j = 0; j < 11; ++j) { const int tl = 8 * rr0 - 3 + j; if (tl >= 0) xr[j] = *(const v4u*)(LRX + ((size_t)b * SEQ + tl) * 1024 + cbase); else xr[j] = (v4u){0u, 0u, 0u, 0u}; }
        for (int mc = 0; mc < 8; ++mc) {
            const size_t rowbase = (size_t)b * SEQ + mc * 256;
            bf16* yp = MIXA + (rowbase + 8 * seg) * 2048 + 1024 + n * 128 + sl * 16 + d;
            bf16* yo = dummy ? (bf16*)(F.ws + WS_END) + (size_t)item * 16384 + (size_t)(mc * 256 + 8 * seg) * 8 + d : yp;
            unsigned gg[8];
#pragma unroll
            for (int i = 0; i < 8; ++i) gg[i] = yp[(size_t)i * 2048];
            {
#pragma unroll
                for (int i = 0; i < 8; ++i) {
                    float xc[8];
#pragma unroll
                    for (int e = 0; e < 8; ++e) xc[e] = cbv[e];
#pragma unroll
                    for (int j = 0; j < 4; ++j) { const v4u x = xr[i + j];
                        const unsigned wd[4] = {x.x, x.y, x.z, x.w};
#pragma unroll
                        for (int e = 0; e < 8; ++e) { const float xv = __builtin_bit_cast(float, (e & 1) ? (wd[e >> 1] & 0xffff0000u) : (wd[e >> 1] << 16)); xc[e] += cwv[j][e] * xv; } }
                    const int lr = 8 * rr0 + i;
                    *(LAS v4u*)(A + lr * QS + 8 * cg) = (v4u){pg8::cvt_pk_bf16(xc[0], xc[1]), pg8::cvt_pk_bf16(xc[2], xc[3]), pg8::cvt_pk_bf16(xc[4], xc[5]), pg8::cvt_pk_bf16(xc[6], xc[7])};
                    if ((cg >> 1) == sl) { LAS float* xp = XS + lr * 16 + (cg & 1) * 8; *(LAS mf32x4*)xp = (mf32x4){xc[0], xc[1], xc[2], xc[3]}; *(LAS mf32x4*)(xp + 4) = (mf32x4){xc[4], xc[5], xc[6], xc[7]}; }
                }
                if (mc < 7) {
#pragma unroll
                    for (int j = 0; j < 11; ++j) xr[j] = *(const v4u*)(LRX + ((size_t)b * SEQ + (mc + 1) * 256 + 8 * rr0 - 3 + j) * 1024 + cbase);
                }
            }
            __syncthreads();
#pragma unroll
            for (int rt = 0; rt < 2; ++rt) {
                const int rowt = 32 * w + 16 * rt; mf32x4 ar = {0.f, 0.f, 0.f, 0.f}, ai = {0.f, 0.f, 0.f, 0.f};
#pragma unroll
                for (int ks = 0; ks < 4; ++ks) { const mbf16x8 a = lds_frag(A + (rowt + fr) * QS + 32 * ks + 8 * fq); ar = MFMA16(a, waf[ks], ar); ai = MFMA16(a, wxf[ks], ai); }
#pragma unroll
                for (int r = 0; r < 4; ++r) { const int row = rowt + 4 * fq + r;
                    const float rg = pg8::sigmoid_f(ar[r] + ba), ig = pg8::sigmoid_f(ai[r] + bx), la = -8.0f * rg * spl, t = 2.0f * la;
                    const float ser = -t * (1.0f + t * (0.5f + t * (0.16666667f + t * (0.041666668f + t * (0.0083333338f + t * 0.0013888889f)))));
                    const float om = (t > -0.25f) ? ser : 1.0f - __expf(t);
                    const int o = fr * 289 + (row >> 3) * 9 + (row & 7);
                    LAt[o] = __expf(la); LUt[o] = sqrtf(om) * ig * XS[row * 16 + fr]; }
            }
            __syncthreads();
            float aa[8], uu[8]; float Ap = 1.f, Hp = 0.f;
#pragma unroll
            for (int i = 0; i < 8; ++i) { aa[i] = LAt[d * 289 + seg * 9 + i]; uu[i] = LUt[d * 289 + seg * 9 + i]; Hp = aa[i] * Hp + uu[i]; Ap *= aa[i]; }
#pragma unroll
            for (int off = 1; off < 32; off <<= 1) { const float Aq = __shfl_up(Ap, off, 32), Hq = __shfl_up(Hp, off, 32); if (seg >= off) { Hp = Ap * Hq + Hp; Ap = Ap * Aq; } }
            float Ae = __shfl_up(Ap, 1, 32), He = __shfl_up(Hp, 1, 32); if (seg == 0) { Ae = 1.f; He = 0.f; }
            float hin = Ae * carry + He;
            carry = __shfl(Ap, 31, 32) * carry + __shfl(Hp, 31, 32);
#pragma unroll
            for (int i = 0; i < 8; ++i) { hin = aa[i] * hin + uu[i]; yo[(size_t)i * 2048] = (bf16)bf1(hin * bf2f((bf16)gg[i])); }
        }
        __syncthreads();
    }
}
constexpr int N_PHASES = 12;
struct Args { const float* in[N_IN]; float* out; unsigned char* ws; int ph_lo, ph_hi, li, pad; };
__global__ void __launch_bounds__(NWAVES * 64, 2) mega_fwd(Args args) {
    extern __shared__ __attribute__((aligned(16))) unsigned char lds[];
    Frame F;
    F.lds = (LAS unsigned char*)lds;
    F.MISC = (volatile LAS unsigned*)(F.lds + MISC_OFF);
    F.wave = __builtin_amdgcn_readfirstlane((int)threadIdx.x >> 6);
    F.G = gridDim.x; { const int bx = blockIdx.x; F.vcu = (F.G % 8 == 0) ? (bx % 8) * (F.G / 8) + bx / 8 : bx; }
#pragma unroll
    for (int i = 0; i < N_IN; ++i) F.in[i] = args.in[i];
    F.out = args.out; F.ws = args.ws;
    unsigned char* ws = args.ws;
    F.ctl = (gu32*)(ws + WS_CTL);
    for (int u = F.wave * 64 + pg8::lane_id_asm(); u < (LDS_BYTES - LDSCTL_OFF) / 4; u += NWAVES * 64) ((LAS unsigned*)(F.lds + LDSCTL_OFF))[u] = 0u;
    __syncthreads();
    const int lo = args.ph_lo, hi = args.ph_hi;
    const bool multi = (hi - lo) > 1;
    XcdBarrier bar; bar.bar = (unsigned*)(F.ctl + CW_BAR) + args.li * XCD_BAR_WORDS; bar.x = 0; bar.st = nullptr; bar.wave = F.wave;
    if (multi) bar = xcd_barrier_post((unsigned*)(F.ctl + CW_BAR) + args.li * XCD_BAR_WORDS, F.MISC + 8, F.wave);

    bf16* const XB = (bf16*)(ws + WS_XB); bf16* const ACT = (bf16*)(ws + WS_ACT); bf16* const MIXA = (bf16*)(ws + WS_MIXA);
    float* const SSQA = (float*)(ws + WS_SSQA); float* const SSQB = (float*)(ws + WS_SSQB);


#define IN(k) (lo <= (k) && (k) < hi)
#define SEAM(k) do { if (IN(k) && IN((k) + 1)) xcd_barrier(bar); } while (0)
#define GEMM_SWIGLU(WOFF) do { pg8::Gemm g{XB, (const bf16*)(ws + (WOFF)), M, NGU, D}; pg8::StaticOrder S; S.init(M, NGU, F.G, (int)blockIdx.x); \
        pg8::EpiSwiGLU E{ACT, DFF, SSQA}; pg8::gemm_phase<pg8::EpiSwiGLU, pg8::StaticOrder, true, true>(F.lds + RING_OFF, g, S, E, F.wave); } while (0)
#define GEMM_RESID(AP, WOFF, KK, SRC, SSQO, SC) do { pg8::Gemm g{(AP), (const bf16*)(ws + (WOFF)), M, D, (KK)}; pg8::StaticOrder S; S.init(M, D, F.G, (int)blockIdx.x); \
        pg8::EpiResid E{(SRC), F.out, XB, (SSQO), (SC)}; pg8::gemm_phase<pg8::EpiResid, pg8::StaticOrder, true, true>(F.lds + RING_OFF, g, S, E, F.wave); } while (0)

    if (IN(0)) { p0_prologue(F); SEAM(0); }
    if (IN(1)) { GEMM_SWIGLU(WS_WGU1); SEAM(1); }
    if (IN(2)) { GEMM_RESID(ACT, WS_WD1, DFF, F.in[I_X], SSQB, 0.5f); SEAM(2); }
    if (IN(3)) {
        pg8::Gemm g{XB, (const bf16*)(ws + WS_WINT), M, NIN, D}; pg8::StaticOrder S; S.init(M, NIN, F.G, (int)blockIdx.x);
        pg8::EpiZ E{SSQB, F.in[I_HLB], MIXA, (float*)(ws + WS_LOGF), (bf16*)(ws + WS_V), (bf16*)(ws + WS_SG), (bf16*)(ws + WS_LRX)};
        pg8::gemm_phase<pg8::EpiZ, pg8::StaticOrder, true, true>(F.lds + RING_OFF, g, S, E, F.wave);
        SEAM(3); }
    if (IN(4)) { MIXER_PHASE_4 SEAM(4); }
    if (IN(5)) { MIXER_PHASE_5 SEAM(5); }
    if (IN(6)) { MIXER_PHASE_6 SEAM(6); }
    if (IN(7)) { GEMM_RESID(MIXA, WS_WOUT, D, F.out, SSQA, 1.0f); SEAM(7); }
    if (IN(8)) { GEMM_SWIGLU(WS_WGU2); SEAM(8); }
    if (IN(9)) { GEMM_RESID(ACT, WS_WD2, DFF, F.out, SSQB, 0.5f); SEAM(9); }
    if (IN(10)) {
        { pg8::Gemm g{(const bf16*)(ws + WS_PB), (const bf16*)(ws + WS_WPROJ), M, D, PLE}; pg8::StaticOrder S; S.init(M, D, F.G, (int)blockIdx.x);
          pg8::EpiPP E{(float*)(ws + WS_PP)};
          pg8::gemm_phase<pg8::EpiPP, pg8::StaticOrder, true, true>(F.lds + RING_OFF, g, S, E, F.wave); }
        { pg8::Gemm g{XB, (const bf16*)(ws + WS_WPG), M, D, D}; pg8::StaticOrder S; S.init(M, D, F.G, (int)blockIdx.x);
          pg8::EpiPLE E{SSQB, F.in[I_PBG], (const float*)(ws + WS_PP), F.out, SSQA};
          pg8::gemm_phase<pg8::EpiPLE, pg8::StaticOrder, true, true>(F.lds + RING_OFF, g, S, E, F.wave); }
        SEAM(10); }
    if (IN(11)) { final_norm(F, SSQA); }
#undef IN
#undef SEAM
}

#if SIMPLE_HGRN
__global__ void __launch_bounds__(64) k_simple_hgrn(const float* logf, const bf16* mixa, const bf16* vv, float* oh) {
    __shared__ float sf[128], sk[128], sq[128];
    const int bh = blockIdx.x >> 1, vh = blockIdx.x & 1, b = bh >> 3, h = bh & 7, lane = threadIdx.x, v = vh * 64 + lane;
    float S[128];
#pragma unroll
    for (int k = 0; k < 128; ++k) S[k] = 0.f;
    for (int t = 0; t < SEQ; ++t) {
        const size_t row = (size_t)b * SEQ + t;
        for (int kk = lane; kk < 128; kk += 64) { const float f = __expf(logf[row * 1024 + h * 128 + kk]); sf[kk] = f; sk[kk] = 1.f - f; sq[kk] = bf2f(mixa[row * 2048 + h * 128 + kk]); }
        __syncthreads();
        const float vt = bf2f(vv[row * 1024 + h * 128 + v]); float o = 0.f;
#pragma unroll
        for (int k = 0; k < 128; ++k) { S[k] = sf[k] * S[k] + sk[k] * vt; o += S[k] * sq[k]; }
        oh[row * 1024 + h * 128 + v] = o;
        __syncthreads();
    }
}
__global__ void __launch_bounds__(256) k_simple_hnorm(const float* oh, const bf16* sg, const float* gn, bf16* mixa) {
    const int gw = (blockIdx.x * 256 + threadIdx.x) >> 6, lane = threadIdx.x & 63;
    if (gw >= M * HEADS) return;
    const int row = gw >> 3, h = gw & 7;
    const float o0 = oh[(size_t)row * 1024 + h * 128 + lane], o1 = oh[(size_t)row * 1024 + h * 128 + 64 + lane];
    const float ss = wave_sum(o0 * o0 + o1 * o1);
    const float r = 1.0f / sqrtf(ss * (1.0f / 128.0f) + EPS);
    mixa[(size_t)row * 2048 + h * 128 + lane] = (bf16)f2bf(o0 * r * gn[lane] * bf2f(sg[(size_t)row * 1024 + h * 128 + lane]));
    mixa[(size_t)row * 2048 + h * 128 + 64 + lane] = (bf16)f2bf(o1 * r * gn[64 + lane] * bf2f(sg[(size_t)row * 1024 + h * 128 + 64 + lane]));
}
#endif
#if SIMPLE_LRU
__global__ void __launch_bounds__(256) k_simple_lru_a(const bf16* lrx, const float* cw, const float* cb, const float* wa, const float* ba, const float* wx, const float* bx, const float* lam, float* LA, float* LU) {
    __shared__ float xc[1024];
    const int row = blockIdx.x, tt = row % SEQ, tid = threadIdx.x;
    for (int c = tid; c < 1024; c += 256) { float s = cb[c];
        for (int j = 0; j < 4; ++j) { const int ts = tt - 3 + j; if (ts >= 0) s += cw[j * 1024 + c] * bf2f(lrx[(size_t)(row - 3 + j) * 1024 + c]); }
        xc[c] = s; }
    __syncthreads();
    for (int d = tid; d < 1024; d += 256) { const int n = d >> 7, dd = d & 127; float r = ba[d], g = bx[d];
        for (int c = 0; c < 128; ++c) { const float x = xc[n * 128 + c]; r += x * wa[((size_t)n * 128 + c) * 128 + dd]; g += x * wx[((size_t)n * 128 + c) * 128 + dd]; }
        r = 1.0f / (1.0f + __expf(-r)); g = 1.0f / (1.0f + __expf(-g));
        const float log_a = -8.0f * r * log1pf(__expf(-lam[d]));
        LA[(size_t)row * 1024 + d] = __expf(log_a); LU[(size_t)row * 1024 + d] = sqrtf(-expm1f(2.0f * log_a)) * g * xc[d]; }
}
__global__ void __launch_bounds__(256) k_simple_lru_b(const float* LA, const float* LU, bf16* mixa) {
    const int gi = blockIdx.x * 256 + threadIdx.x, b = gi >> 10, c = gi & 1023; float h = 0.f;
#pragma unroll 8
    for (int t = 0; t < SEQ; ++t) { const size_t row = (size_t)b * SEQ + t; h = LA[row * 1024 + c] * h + LU[row * 1024 + c];
        bf16* p = mixa + row * 2048 + 1024 + c; *p = (bf16)f2bf(h * bf2f(*p)); }
}
#endif

extern "C" void kernel_launch(void* const* d_in, const int* in_sizes, int n_in, void* d_out, int out_size, void* d_ws, size_t ws_size, hipStream_t stream) {
    static int grid = 0;
    if (grid == 0) {
        if (n_in != N_IN || in_sizes[0] != M * D || out_size != M * D || ws_size < WS_END) { fprintf(stderr, "kernel_launch: unexpected problem (n_in %d, in0 %d, out %d, ws %zu); nothing launched\n", n_in, n_in > 0 ? in_sizes[0] : -1, out_size, ws_size); grid = -1; return; }
        int dev = 0, cus = 0, per_cu = 0;
        if (hipGetDevice(&dev) != hipSuccess || hipDeviceGetAttribute(&cus, hipDeviceAttributeMultiprocessorCount, dev) != hipSuccess) { grid = -1; return; }
        if (hipFuncSetAttribute((const void*)mega_fwd, hipFuncAttributeMaxDynamicSharedMemorySize, LDS_BYTES) != hipSuccess) { fprintf(stderr, "kernel_launch: hipFuncSetAttribute failed\n"); grid = -1; return; }
        if (hipOccupancyMaxActiveBlocksPerMultiprocessor(&per_cu, (const void*)mega_fwd, NWAVES * 64, LDS_BYTES) != hipSuccess || per_cu < 1)
            fprintf(stderr, "kernel_launch: note: occupancy query reports %d workgroups per CU\n", per_cu);
        (void)hipGetLastError();
        grid = cus;
    }
    if (grid < 0) return;
    if (hipMemsetAsync((char*)d_ws + WS_CTL, 0, CTL_ZERO_BYTES, stream) != hipSuccess) return;
    Args a{};
    for (int i = 0; i < N_IN; ++i) a.in[i] = (const float*)d_in[i];
    a.out = (float*)d_out; a.ws = (unsigned char*)d_ws;
    unsigned char* ws = (unsigned char*)d_ws;
    auto launch = [&](int lo, int hi, int li) { a.ph_lo = lo; a.ph_hi = hi; a.li = li; hipLaunchKernelGGL(mega_fwd, dim3(grid), dim3(NWAVES * 64), LDS_BYTES, stream, a); };
#if SIMPLE_HGRN || SIMPLE_LRU
    launch(0, 4, 0);
#if SIMPLE_HGRN
    {   float* OH = (float*)(ws + WS_XB);
        hipLaunchKernelGGL(k_simple_hgrn, dim3(64), dim3(64), 0, stream, (const float*)(ws + WS_LOGF), (const bf16*)(ws + WS_MIXA), (const bf16*)(ws + WS_V), OH);
        hipLaunchKernelGGL(k_simple_hnorm, dim3(M * HEADS / 4), dim3(256), 0, stream, (const float*)OH, (const bf16*)(ws + WS_SG), (const float*)d_in[I_HGN], (bf16*)(ws + WS_MIXA)); }
#endif
#if SIMPLE_LRU
    {   float* LA = (float*)(ws + WS_KVT); float* LU = LA + (size_t)M * 1024;
        hipLaunchKernelGGL(k_simple_lru_a, dim3(M), dim3(256), 0, stream, (const bf16*)(ws + WS_LRX), (const float*)d_in[I_CW], (const float*)d_in[I_CB], (const float*)d_in[I_LWA], (const float*)d_in[I_LBA],
                           (const float*)d_in[I_LWX], (const float*)d_in[I_LBX], (const float*)d_in[I_LAM], LA, LU);
        hipLaunchKernelGGL(k_simple_lru_b, dim3(BATCH * 1024 / 256), dim3(256), 0, stream, (const float*)LA, (const float*)LU, (bf16*)(ws + WS_MIXA)); }
#endif
    launch(4, N_PHASES, 1);
#else
#if N_LAUNCHES == 1
    launch(0, N_PHASES, 0);
#else
    for (int ph = 0; ph < N_PHASES; ++ph) launch(ph, ph + 1, 0);
#endif
#endif
}
```

```cpp
#include <hip/hip_runtime.h>
#include <cstdio>
#include <cstdint>
#ifndef SIMPLE_HGRN
#define SIMPLE_HGRN 0
#endif
#ifndef SIMPLE_LRU
#define SIMPLE_LRU 0
#endif
#ifndef N_LAUNCHES
#define N_LAUNCHES 1
#endif
#if SIMPLE_HGRN
#define MIXER_PHASE_4
#define MIXER_PHASE_6
#define MIXER_SCAN
#else
#define MIXER_PHASE_4 hgrn_local_phase(F);
#ifdef PROBE_H3
#define MIXER_PHASE_6 hgrn_out_phase(F, true); xcd_barrier(bar); hgrn_out_phase(F);
#else
#define MIXER_PHASE_6 hgrn_out_phase(F);
#endif
#ifdef PROBE_SCAN
#define MIXER_SCAN hgrn_scan_phase(F); xcd_barrier(bar); hgrn_scan_phase(F);
#else
#define MIXER_SCAN hgrn_scan_phase(F);
#endif
#endif
#if SIMPLE_LRU
#define MIXER_LRU
#else
#ifdef PROBE_LRU
#define MIXER_LRU lru_phase<PROBE_LRU>(F, true); xcd_barrier(bar); lru_phase<0>(F);
#else
#define MIXER_LRU lru_phase<0>(F);
#endif
#endif
#define MIXER_PHASE_5 MIXER_SCAN MIXER_LRU
namespace pg8 {
#define PG8_LAS __attribute__((address_space(3)))
typedef unsigned short bf16_t;
typedef short bf16x8 __attribute__((ext_vector_type(8)));
typedef float f32x4 __attribute__((ext_vector_type(4)));
typedef unsigned u32x4 __attribute__((ext_vector_type(4)));
constexpr int BM = 256, BK = 64, HALF = 128, HTB = HALF * BK * 2  , STAGE_BYTES = 8 * HTB, NXCD = 8, WGM = 8;

__host__ __device__ __forceinline__ int lds_byte(int r, int c) { const int st = (r >> 4) * 2 + (c >> 5), rr = r & 15, cc = c & 31, ob = rr * 64 + cc * 2; return st * 1024 + (ob ^ (((ob >> 9) & 1) << 5)); }
__host__ __device__ __forceinline__ void stage_rc(int b, int& R, int& C) { const int st = b / 1024, sb = b % 1024, swz = sb ^ (((sb >> 9) & 1) << 5); R = (st >> 1) * 16 + swz / 64; C = (st & 1) * 32 + (swz % 64) / 2; }
__host__ __device__ __forceinline__ int perm32(int rho) { const int n = rho >> 4, i = rho & 15; return 8 * (i >> 2) + 4 * n + (i & 3); }

struct Unit { int pm, pn; };
struct Gemm { const bf16_t* A; const bf16_t* Bt; int M, N, K; };

struct StaticOrder {
    int nM, nN, nwg, G, c;
    __host__ __device__ void init(int M, int N, int G_, int c_) { nM = M / BM; nN = N / BM; nwg = nM * nN; G = G_; c = c_; }
    __host__ __device__ bool next(int i, Unit& u) const {
        const long L = (long)i * G + c; if (L >= nwg) return false;
        int wgid = (int)L; { const int q = nwg / NXCD, r = nwg % NXCD, xcd = wgid % NXCD, off = wgid / NXCD; wgid = (xcd < r ? xcd * (q + 1) : r * (q + 1) + (xcd - r) * q) + off; }
        const int nig = WGM * nN, gid = wgid / nig, fm = gid * WGM, gsz = (nM - fm) < WGM ? (nM - fm) : WGM;
        u.pm = fm + ((wgid % nig) % gsz); u.pn = (wgid % nig) / gsz; return true;
    }
    __device__ __forceinline__ void a_ready(const Unit&) const {}
    __device__ __forceinline__ void done(const Unit&) const {}
};
__device__ __forceinline__ int lane_id_asm() { int l; asm volatile("v_mbcnt_lo_u32_b32 %0, -1, 0\n\tv_mbcnt_hi_u32_b32 %0, -1, %0" : "=v"(l)); return l; }
__device__ __forceinline__ unsigned cvt_pk_bf16(float lo, float hi) { unsigned r; asm volatile("v_cvt_pk_bf16_f32 %0, %1, %2" : "=v"(r) : "v"(lo), "v"(hi)); return r; }
typedef unsigned u32x2 __attribute__((ext_vector_type(2)));
constexpr int DM = 2048;
constexpr int NSSQ = 32;
__device__ __forceinline__ float sigmoid_f(float x) { return __builtin_amdgcn_rcpf(1.0f + __expf(-x)); }
__device__ __forceinline__ float silu_f(float x) { return x * sigmoid_f(x); }
__device__ __forceinline__ float gelu_tanh_f(float x) { return x * sigmoid_f(1.5957691216057308f * (x + 0.044715f * x * x * x)); }
__device__ __forceinline__ void rows_rstd(const float* ssq, int row0, int fq, float (&rs)[2][4]) {
    f32x4 pa[2][4], pb[2][4];
#pragma unroll
    for (int ai = 0; ai < 2; ++ai)
#pragma unroll
        for (int m = 0; m < 4; ++m) { const f32x4* p = (const f32x4*)(ssq + (size_t)(row0 + ai * HALF + m * 16) * NSSQ + fq * 8); pa[ai][m] = p[0]; pb[ai][m] = p[1]; }
#pragma unroll
    for (int ai = 0; ai < 2; ++ai)
#pragma unroll
        for (int m = 0; m < 4; ++m) { const f32x4 a = pa[ai][m], b = pb[ai][m];
            float s = ((a[0] + a[1]) + (a[2] + a[3])) + ((b[0] + b[1]) + (b[2] + b[3]));
            s += __shfl_xor(s, 16); s += __shfl_xor(s, 32);
            rs[ai][m] = 1.0f / sqrtf(s * (1.0f / (float)DM) + 1e-6f); }
}

struct EpiSwiGLU {
    static constexpr bool PERM = true, AFTER_DRAIN = false;
    bf16_t* O; int ldo; const float* ssq;
    __device__ __forceinline__ void operator()(const f32x4 (&acc)[2][2][4][2], const Unit& u, int wr, int wc, int fr, int fq) const {
        const int row0 = u.pm * BM + wr * 64 + fr, col0 = u.pn * HALF + wc * 32 + 8 * fq;
        float rs[2][4]; rows_rstd(ssq, row0, fq, rs);
#pragma unroll
        for (int ai = 0; ai < 2; ++ai)
#pragma unroll
            for (int m = 0; m < 4; ++m) {
                const int row = row0 + ai * HALF + m * 16; const float r = rs[ai][m];
                float h[8];
#pragma unroll
                for (int n = 0; n < 2; ++n)
#pragma unroll
                    for (int j = 0; j < 4; ++j) { const float g = acc[ai][0][m][n][j] * r, up = acc[ai][1][m][n][j] * r; h[n * 4 + j] = silu_f(g) * up; }
                u32x4 w; w.x = cvt_pk_bf16(h[0], h[1]); w.y = cvt_pk_bf16(h[2], h[3]); w.z = cvt_pk_bf16(h[4], h[5]); w.w = cvt_pk_bf16(h[6], h[7]);
                *(u32x4*)(O + (size_t)row * ldo + col0) = w;
            }
    }
};
struct EpiResid {
    static constexpr bool PERM = false, AFTER_DRAIN = false;
    const float* src; float* dst; bf16_t* xb; float* ssq_out; float scale;
    __device__ __forceinline__ void operator()(const f32x4 (&acc)[2][2][4][2], const Unit& u, int wr, int wc, int fr, int fq) const {
        const int row0 = u.pm * BM + wr * 64 + fr, col0 = u.pn * BM + wc * 32 + 4 * fq;
#pragma unroll
        for (int ai = 0; ai < 2; ++ai) {
            f32x4 sv[4][2][2];
#pragma unroll
            for (int m = 0; m < 4; ++m)
#pragma unroll
                for (int bj = 0; bj < 2; ++bj)
#pragma unroll
                    for (int n = 0; n < 2; ++n) sv[m][bj][n] = *(const f32x4*)(src + (size_t)(row0 + ai * HALF + m * 16) * DM + col0 + bj * HALF + n * 16);
#pragma unroll
            for (int m = 0; m < 4; ++m) {
                const int row = row0 + ai * HALF + m * 16; float ss = 0.f;
#pragma unroll
                for (int bj = 0; bj < 2; ++bj)
#pragma unroll
                    for (int n = 0; n < 2; ++n) { const size_t off = (size_t)row * DM + col0 + bj * HALF + n * 16;
                        const f32x4 o = sv[m][bj][n] + acc[ai][bj][m][n] * scale;
                        *(f32x4*)(dst + off) = o; u32x2 w; w.x = cvt_pk_bf16(o[0], o[1]); w.y = cvt_pk_bf16(o[2], o[3]); *(u32x2*)(xb + off) = w;
                        ss += (o[0] * o[0] + o[1] * o[1]) + (o[2] * o[2] + o[3] * o[3]); }
                ss += __shfl_xor(ss, 16); ss += __shfl_xor(ss, 32);
                if (fq == 0) ssq_out[(size_t)row * NSSQ + u.pn * 4 + wc] = ss;
            }
        }
    }
};
struct EpiZ {
    static constexpr bool PERM = true, AFTER_DRAIN = false;
    const float* ssq; const float* hlb;
    bf16_t* mixa;
    float* logf; bf16_t* vv; bf16_t* sg; bf16_t* lrx;
    __device__ __forceinline__ void operator()(const f32x4 (&acc)[2][2][4][2], const Unit& u, int wr, int wc, int fr, int fq) const {
        const int seg = u.pn >> 2;
        const int row0 = u.pm * BM + wr * 64 + fr, cs0 = (u.pn & 3) * BM + wc * 32 + 8 * fq;
        float rs[2][4]; rows_rstd(ssq, row0, fq, rs);
        float lbv[2][8];
        if (seg == 1) {
#pragma unroll
            for (int bj = 0; bj < 2; ++bj)
#pragma unroll
                for (int e = 0; e < 8; ++e) { const int c = cs0 + bj * HALF + e; lbv[bj][e] = sigmoid_f(hlb[c] - hlb[1024 + c]); }
        }
#pragma unroll
        for (int ai = 0; ai < 2; ++ai)
#pragma unroll
            for (int m = 0; m < 4; ++m) {
                const int row = row0 + ai * HALF + m * 16; const float r = rs[ai][m];
#pragma unroll
                for (int bj = 0; bj < 2; ++bj) {
                    const int cs = cs0 + bj * HALF;
                    float z[8];
#pragma unroll
                    for (int n = 0; n < 2; ++n)
#pragma unroll
                        for (int j = 0; j < 4; ++j) z[n * 4 + j] = acc[ai][bj][m][n][j] * r;
                    if (seg == 1) {
                        float lf[8];
#pragma unroll
                        for (int e = 0; e < 8; ++e) { const float lb = lbv[bj][e]; lf[e] = __logf(lb + (1.0f - lb) * sigmoid_f(z[e])); }
                        float* p = logf + (size_t)row * 1024 + cs;
                        *(f32x4*)p = (f32x4){lf[0], lf[1], lf[2], lf[3]}; *(f32x4*)(p + 4) = (f32x4){lf[4], lf[5], lf[6], lf[7]};
                    } else {
                        if (seg == 3) {
#pragma unroll
                            for (int e = 0; e < 8; ++e) z[e] = silu_f(z[e]);
                        } else if (seg == 5) {
#pragma unroll
                            for (int e = 0; e < 8; ++e) z[e] = gelu_tanh_f(z[e]);
                        }
                        u32x4 w; w.x = cvt_pk_bf16(z[0], z[1]); w.y = cvt_pk_bf16(z[2], z[3]); w.z = cvt_pk_bf16(z[4], z[5]); w.w = cvt_pk_bf16(z[6], z[7]);
                        bf16_t* p;
                        if (seg == 0) p = mixa + (size_t)row * 2048 + cs;
                        else if (seg == 5) p = mixa + (size_t)row * 2048 + 1024 + cs;
                        else if (seg == 2) p = vv + (size_t)row * 1024 + cs;
                        else if (seg == 3) p = sg + (size_t)row * 1024 + cs;
                        else p = lrx + (size_t)row * 1024 + cs;
                        *(u32x4*)p = w;
                    }
                }
            }
    }
};
struct EpiPP {
    static constexpr bool PERM = false, AFTER_DRAIN = false;
    bf16_t* PP;
    __device__ __forceinline__ void operator()(const f32x4 (&acc)[2][2][4][2], const Unit& u, int wr, int wc, int fr, int fq) const {
        const int row0 = u.pm * BM + wr * 64 + fr, col0 = u.pn * BM + wc * 32 + 4 * fq;
#pragma unroll
        for (int ai = 0; ai < 2; ++ai)
#pragma unroll
            for (int m = 0; m < 4; ++m) { bf16_t* rowp = PP + (size_t)(row0 + ai * HALF + m * 16) * DM + col0;
#pragma unroll
                for (int bj = 0; bj < 2; ++bj)
#pragma unroll
                    for (int n = 0; n < 2; ++n) { const f32x4 a = acc[ai][bj][m][n]; u32x2 w; w.x = cvt_pk_bf16(a[0], a[1]); w.y = cvt_pk_bf16(a[2], a[3]); *(u32x2*)(rowp + bj * HALF + n * 16) = w; } }
    }
};
__device__ __forceinline__ f32x4 bf16x4_to_f32(u32x2 w) { f32x4 r; r[0] = __builtin_bit_cast(float, w.x << 16); r[1] = __builtin_bit_cast(float, w.x & 0xffff0000u); r[2] = __builtin_bit_cast(float, w.y << 16); r[3] = __builtin_bit_cast(float, w.y & 0xffff0000u); return r; }
struct EpiPLE {
    static constexpr bool PERM = false, AFTER_DRAIN = false;
    const float* ssq_in; const float* bg; const bf16_t* PP; float* X; float* ssq_out;
    __device__ __forceinline__ void operator()(const f32x4 (&acc)[2][2][4][2], const Unit& u, int wr, int wc, int fr, int fq) const {
        const int row0 = u.pm * BM + wr * 64 + fr, col0 = u.pn * BM + wc * 32 + 4 * fq;
        float rs[2][4]; rows_rstd(ssq_in, row0, fq, rs);
#pragma unroll
        for (int ai = 0; ai < 2; ++ai)
#pragma unroll
            for (int m = 0; m < 4; ++m) {
                const int row = row0 + ai * HALF + m * 16; const float r = rs[ai][m]; float ss = 0.f;
                f32x4 pv[2][2], ov[2][2];
#pragma unroll
                for (int bj = 0; bj < 2; ++bj)
#pragma unroll
                    for (int n = 0; n < 2; ++n) { const size_t off = (size_t)row * DM + col0 + bj * HALF + n * 16; pv[bj][n] = bf16x4_to_f32(*(const u32x2*)(PP + off)); ov[bj][n] = *(const f32x4*)(X + off); }
#pragma unroll
                for (int bj = 0; bj < 2; ++bj)
#pragma unroll
                    for (int n = 0; n < 2; ++n) { const int c = col0 + bj * HALF + n * 16; const size_t off = (size_t)row * DM + c;
                        const f32x4 b4 = *(const f32x4*)(bg + c), a = acc[ai][bj][m][n]; f32x4 o;
#pragma unroll
                        for (int j = 0; j < 4; ++j) o[j] = ov[bj][n][j] + sigmoid_f(a[j] * r + b4[j]) * pv[bj][n][j];
                        *(f32x4*)(X + off) = o; ss += (o[0] * o[0] + o[1] * o[1]) + (o[2] * o[2] + o[3] * o[3]); }
                ss += __shfl_xor(ss, 16); ss += __shfl_xor(ss, 32);
                if (fq == 0) ssq_out[(size_t)row * NSSQ + u.pn * 4 + wc] = ss;
            }
    }
};

struct EpiPLEFinal {
    static constexpr bool PERM = false, AFTER_DRAIN = true;
    const float* ssq_in; const float* bg; const bf16_t* PP; float* X; float* xch; unsigned* cnt; const float* gf;
    __device__ __forceinline__ void operator()(const f32x4 (&)[2][2][4][2], const Unit&, int, int, int, int) const {}
    __device__ __forceinline__ void fused(f32x4 (&acc)[2][2][4][2], const Unit& u, int wr, int wc, int fr, int fq, PG8_LAS unsigned char* lds, int wid, int lane) const {
        const int row0 = u.pm * BM + wr * 64 + fr, col0 = u.pn * BM + wc * 32 + 4 * fq;
        float rs[2][4]; rows_rstd(ssq_in, row0, fq, rs);
#pragma unroll
        for (int ai = 0; ai < 2; ++ai)
#pragma unroll
            for (int m = 0; m < 4; ++m) {
                const int row = row0 + ai * HALF + m * 16; const float r = rs[ai][m]; float ss = 0.f;
                f32x4 pv[2][2], ov[2][2];
#pragma unroll
                for (int bj = 0; bj < 2; ++bj)
#pragma unroll
                    for (int n = 0; n < 2; ++n) { const size_t off = (size_t)row * DM + col0 + bj * HALF + n * 16; pv[bj][n] = bf16x4_to_f32(*(const u32x2*)(PP + off)); ov[bj][n] = *(const f32x4*)(X + off); }
#pragma unroll
                for (int bj = 0; bj < 2; ++bj)
#pragma unroll
                    for (int n = 0; n < 2; ++n) { const int c = col0 + bj * HALF + n * 16;
                        const f32x4 b4 = *(const f32x4*)(bg + c), a = acc[ai][bj][m][n]; f32x4 o;
#pragma unroll
                        for (int j = 0; j < 4; ++j) o[j] = ov[bj][n][j] + sigmoid_f(a[j] * r + b4[j]) * pv[bj][n][j];
                        acc[ai][bj][m][n] = o; ss += (o[0] * o[0] + o[1] * o[1]) + (o[2] * o[2] + o[3] * o[3]); }
                ss += __shfl_xor(ss, 16); ss += __shfl_xor(ss, 32);
                if (fq == 0) __hip_atomic_store(xch + (size_t)row * NSSQ + u.pn * 4 + wc, ss, __ATOMIC_RELAXED, __HIP_MEMORY_SCOPE_AGENT);
            }
        asm volatile("s_waitcnt vmcnt(0)" ::: "memory");
        unsigned* pc = cnt + 64 * u.pm;
        if (lane == 0) __hip_atomic_fetch_add(pc, 1u, __ATOMIC_RELAXED, __HIP_MEMORY_SCOPE_AGENT);
        if (wid == 0) {
            unsigned sp = 0;
            while ((unsigned)__builtin_amdgcn_readfirstlane(__hip_atomic_load(pc, __ATOMIC_RELAXED, __HIP_MEMORY_SCOPE_AGENT)) < 64u) { __builtin_amdgcn_s_sleep(2); if (++sp > (1u << 22)) break; }
            __builtin_amdgcn_fence(__ATOMIC_ACQUIRE, "agent");
        }
        asm volatile("s_waitcnt vmcnt(0) lgkmcnt(0)" ::: "memory"); __builtin_amdgcn_s_barrier(); asm volatile("" ::: "memory");
        float r4[2][4]; rows_rstd(xch, row0, fq, r4);
        f32x4 g4[2][2];
#pragma unroll
        for (int bj = 0; bj < 2; ++bj)
#pragma unroll
            for (int n = 0; n < 2; ++n) g4[bj][n] = *(const f32x4*)(gf + col0 + bj * HALF + n * 16);
#pragma unroll
        for (int ai = 0; ai < 2; ++ai)
#pragma unroll
            for (int m = 0; m < 4; ++m) { float* rowp = X + (size_t)(row0 + ai * HALF + m * 16) * DM + col0; const float r = r4[ai][m];
#pragma unroll
                for (int bj = 0; bj < 2; ++bj)
#pragma unroll
                    for (int n = 0; n < 2; ++n) *(f32x4*)(rowp + bj * HALF + n * 16) = acc[ai][bj][m][n] * r * g4[bj][n]; }
    }
};

template <class Epi, class Sched, bool ALIGN_EPI = false, bool SP2 = false>
__device__ __forceinline__ void gemm_phase(PG8_LAS unsigned char* lds, const Gemm g, const Sched& S, const Epi& E, const int wave_s) {
    int tid_ = wave_s * 64 + lane_id_asm();
    const int tid = tid_, wid = wave_s, lane = tid & 63, wr = wid >> 2, wc = wid & 3, fr = lane & 15, fq = lane >> 4;
    const int K = g.K, nt = K / BK;
    unsigned voffA[2], voffB[2];
#pragma unroll
    for (int i = 0; i < 2; ++i) { int R, C; stage_rc(tid * 16 + i * 8192, R, C); const int Rb = Epi::PERM ? ((R & ~31) + perm32(R & 31)) : R;
        voffA[i] = (unsigned)(R * K + C) * 2u; voffB[i] = (unsigned)(Rb * K + C) * 2u; }
    const size_t kstep = (size_t)(BK * 2);
    const size_t hstep = (size_t)HALF * K * 2;
    const size_t tstep = 2 * hstep;
    const unsigned ldsw = (unsigned)wid * 1024u;
    const int aoff = lds_byte(wr * 64 + fr, fq * 8), boff = lds_byte(wc * 32 + fr, fq * 8);
#define PG8_SA(b, h) (((b) * 2 + (h)) * HTB)
#define PG8_SB(b, h) ((4 + (b) * 2 + (h)) * HTB)
#define PG8_STAGE(bufoff, gbase, voff) do { _Pragma("unroll") for (int _i = 0; _i < 2; ++_i) \
        __builtin_amdgcn_global_load_lds((const unsigned*)((const char*)(gbase) + (voff)[_i]), (PG8_LAS unsigned*)(lds + (bufoff) + ldsw + _i * 8192), 16, 0, 0); } while (0)
#define PG8_LDA(dst, b, h) do { _Pragma("unroll") for (int m = 0; m < 4; ++m) _Pragma("unroll") for (int k = 0; k < 2; ++k) dst[m][k] = *(const PG8_LAS bf16x8*)(lds + PG8_SA(b, h) + aoff + m * 2048 + k * 1024); } while (0)
#define PG8_LDB(dst, b, h) do { _Pragma("unroll") for (int n = 0; n < 2; ++n) _Pragma("unroll") for (int k = 0; k < 2; ++k) dst[n][k] = *(const PG8_LAS bf16x8*)(lds + PG8_SB(b, h) + boff + n * 2048 + k * 1024); } while (0)
#define PG8_MMA(ai, bj, At, Bt) do { __builtin_amdgcn_s_setprio(1); _Pragma("unroll") for (int m = 0; m < 4; ++m) _Pragma("unroll") for (int n = 0; n < 2; ++n) _Pragma("unroll") for (int k = 0; k < 2; ++k) \
        acc[ai][bj][m][n] = __builtin_amdgcn_mfma_f32_16x16x32_bf16(Bt[n][k], At[m][k], acc[ai][bj][m][n], 0, 0, 0); __builtin_amdgcn_s_setprio(0); } while (0)
#define PG8_WAIT_V(n) asm volatile("s_waitcnt vmcnt(" #n ")" ::: "memory")
#define PG8_WAIT_L(n) asm volatile("s_waitcnt lgkmcnt(" #n ")" ::: "memory")
#define PG8_BAR __builtin_amdgcn_s_barrier()
#define PG8_SCHED __builtin_amdgcn_sched_barrier(0)
    Unit cur, nxt; int ui = 0;
    if (!S.next(0, cur)) return;
    f32x4 acc[2][2][4][2];
#pragma unroll
    for (int a = 0; a < 2; ++a)
#pragma unroll
        for (int b = 0; b < 2; ++b)
#pragma unroll
            for (int m = 0; m < 4; ++m)
#pragma unroll
                for (int n = 0; n < 2; ++n) acc[a][b][m][n] = (f32x4){0.f, 0.f, 0.f, 0.f};
    bf16x8 At[4][2], B0[2][2], B1[2][2];
    const char* cA = (const char*)g.A + (size_t)cur.pm * tstep; const char* cB = (const char*)g.Bt + (size_t)cur.pn * tstep;
    S.a_ready(cur);
    if constexpr (SP2) {
        PG8_STAGE(PG8_SB(0, 0), cB, voffB); PG8_STAGE(PG8_SB(0, 1), cB + hstep, voffB); PG8_STAGE(PG8_SA(0, 0), cA, voffA); PG8_STAGE(PG8_SA(0, 1), cA + hstep, voffA);
        if (wr == 1) PG8_BAR;
        PG8_WAIT_V(2); PG8_BAR;
        PG8_STAGE(PG8_SB(1, 0), cB + kstep, voffB); PG8_STAGE(PG8_SA(1, 0), cA + kstep, voffA); PG8_STAGE(PG8_SB(1, 1), cB + hstep + kstep, voffB);
        PG8_WAIT_V(6); PG8_BAR;
    } else {
        PG8_STAGE(PG8_SB(0, 0), cB, voffB); PG8_STAGE(PG8_SA(0, 0), cA, voffA); PG8_STAGE(PG8_SB(0, 1), cB + hstep, voffB); PG8_STAGE(PG8_SA(0, 1), cA + hstep, voffA);
        if (wr == 1) PG8_BAR;
        PG8_WAIT_V(4); PG8_BAR;
        PG8_STAGE(PG8_SB(1, 0), cB + kstep, voffB); PG8_STAGE(PG8_SA(1, 0), cA + kstep, voffA); PG8_STAGE(PG8_SB(1, 1), cB + hstep + kstep, voffB);
        PG8_WAIT_V(6); PG8_BAR;
    }
    for (;;) {
        const bool has_next = S.next(ui + 1, nxt);
        const char* nA = has_next ? (const char*)g.A + (size_t)nxt.pm * tstep : cA; const char* nB = has_next ? (const char*)g.Bt + (size_t)nxt.pn * tstep : cB;
        for (int t = 0; t < nt; t += 2) {
            const bool last = (t == nt - 2);
            const char* a1 = cA + (size_t)(t + 1) * kstep;
            const char* a2 = last ? nA : cA + (size_t)(t + 2) * kstep; const char* b2 = last ? nB : cB + (size_t)(t + 2) * kstep;
            const char* a3 = a2 + kstep; const char* b3 = b2 + kstep;
            if (last && has_next) S.a_ready(nxt);
            if constexpr (SP2) {
            PG8_LDB(B0, 0, 0); PG8_LDB(B1, 0, 1); PG8_SCHED; PG8_LDA(At, 0, 0); PG8_STAGE(PG8_SA(1, 1), a1 + hstep, voffA);
            PG8_WAIT_V(8); PG8_WAIT_L(0); PG8_BAR; PG8_MMA(0, 0, At, B0); PG8_MMA(0, 1, At, B1); PG8_BAR; PG8_SCHED;
            PG8_LDA(At, 0, 1); PG8_STAGE(PG8_SB(0, 0), b2, voffB); PG8_STAGE(PG8_SB(0, 1), b2 + hstep, voffB); PG8_STAGE(PG8_SA(0, 0), a2, voffA);
            PG8_WAIT_V(8); PG8_WAIT_L(0); PG8_BAR; PG8_MMA(1, 0, At, B0); PG8_MMA(1, 1, At, B1); PG8_BAR; PG8_SCHED;
            PG8_LDB(B0, 1, 0); PG8_LDB(B1, 1, 1); PG8_SCHED; PG8_LDA(At, 1, 0); PG8_STAGE(PG8_SA(0, 1), a2 + hstep, voffA);
            PG8_WAIT_V(8); PG8_WAIT_L(0); PG8_BAR; PG8_MMA(0, 0, At, B0); PG8_MMA(0, 1, At, B1); PG8_BAR; PG8_SCHED;
            PG8_LDA(At, 1, 1); PG8_STAGE(PG8_SB(1, 0), b3, voffB); PG8_STAGE(PG8_SB(1, 1), b3 + hstep, voffB); PG8_STAGE(PG8_SA(1, 0), a3, voffA);
            PG8_WAIT_V(8); PG8_WAIT_L(0); PG8_BAR; PG8_MMA(1, 0, At, B0); PG8_MMA(1, 1, At, B1); PG8_BAR; PG8_SCHED;
            } else {
            PG8_LDB(B0, 0, 0); PG8_SCHED; PG8_LDA(At, 0, 0); PG8_STAGE(PG8_SA(1, 1), a1 + hstep, voffA);
            PG8_WAIT_L(8); PG8_BAR; PG8_WAIT_L(0); PG8_MMA(0, 0, At, B0); PG8_BAR; PG8_SCHED;
            PG8_LDB(B1, 0, 1); PG8_STAGE(PG8_SB(0, 0), b2, voffB);
            PG8_BAR; PG8_WAIT_L(0); PG8_MMA(0, 1, At, B1); PG8_BAR;
            PG8_LDA(At, 0, 1); PG8_STAGE(PG8_SA(0, 0), a2, voffA);
            PG8_BAR; PG8_WAIT_L(0); PG8_MMA(1, 0, At, B0); PG8_BAR; PG8_SCHED;
            PG8_STAGE(PG8_SB(0, 1), b2 + hstep, voffB);
            PG8_WAIT_V(6); PG8_BAR; PG8_MMA(1, 1, At, B1); PG8_BAR;
            PG8_LDB(B0, 1, 0); PG8_SCHED; PG8_LDA(At, 1, 0); PG8_STAGE(PG8_SA(0, 1), a2 + hstep, voffA);
            PG8_WAIT_L(8); PG8_BAR; PG8_WAIT_L(0); PG8_MMA(0, 0, At, B0); PG8_BAR; PG8_SCHED;
            PG8_LDB(B1, 1, 1); PG8_STAGE(PG8_SB(1, 0), b3, voffB);
            PG8_BAR; PG8_WAIT_L(0); PG8_MMA(0, 1, At, B1); PG8_BAR;
            PG8_LDA(At, 1, 1); PG8_STAGE(PG8_SA(1, 0), a3, voffA);
            PG8_BAR; PG8_WAIT_L(0); PG8_MMA(1, 0, At, B0); PG8_BAR; PG8_SCHED;
            PG8_STAGE(PG8_SB(1, 1), b3 + hstep, voffB);
            PG8_WAIT_V(6); PG8_BAR; PG8_MMA(1, 1, At, B1); PG8_BAR;
            }
        }
        if constexpr (ALIGN_EPI) { if (wr == 0) PG8_BAR; }
        if constexpr (!Epi::AFTER_DRAIN) { E(acc, cur, wr, wc, fr, fq); S.done(cur); }
        if (!has_next) break;
#pragma unroll
        for (int a = 0; a < 2; ++a)
#pragma unroll
            for (int b = 0; b < 2; ++b)
#pragma unroll
                for (int m = 0; m < 4; ++m)
#pragma unroll
                    for (int n = 0; n < 2; ++n) acc[a][b][m][n] = (f32x4){0.f, 0.f, 0.f, 0.f};
        cur = nxt; cA = nA; cB = nB; ++ui;
        if constexpr (ALIGN_EPI) { if (wr == 1) PG8_BAR; }
    }
    PG8_WAIT_V(0);
    if constexpr (!ALIGN_EPI) { if (wr == 0) PG8_BAR; }
    PG8_BAR;
    if constexpr (Epi::AFTER_DRAIN) { E.fused(acc, cur, wr, wc, fr, fq, lds, wid, lane); S.done(cur); }
#undef PG8_SA
#undef PG8_SB
#undef PG8_STAGE
#undef PG8_LDA
#undef PG8_LDB
#undef PG8_MMA
#undef PG8_WAIT_V
#undef PG8_WAIT_L
#undef PG8_BAR
#undef PG8_SCHED
}
}
#define GAS __attribute__((address_space(1)))
#define LAS __attribute__((address_space(3)))
typedef unsigned short bf16;
typedef unsigned v4u __attribute__((ext_vector_type(4)));
typedef float f32x4 __attribute__((ext_vector_type(4)));
typedef short bf16x8 __attribute__((ext_vector_type(8)));
typedef GAS unsigned gu32;
typedef GAS unsigned long long gu64;
#define RLX_AGENT __ATOMIC_RELAXED, __HIP_MEMORY_SCOPE_AGENT
#define LDS_WAIT() asm volatile("s_waitcnt lgkmcnt(0)" ::: "memory")
#define VM_WAIT() asm volatile("s_waitcnt vmcnt(0)" ::: "memory")
__device__ __forceinline__ unsigned long long rt() { return __builtin_amdgcn_s_memrealtime(); }
__device__ __forceinline__ unsigned f2bf(float f) { unsigned u = __builtin_bit_cast(unsigned, f); return (u + 0x7fffu + ((u >> 16) & 1u)) >> 16; }
__device__ __forceinline__ unsigned pk2(float lo, float hi) { return f2bf(lo) | (f2bf(hi) << 16); }

#define XB_TMO      128
#define XB_XCNT(j)  (256  + 64 * (j))
#define XB_XSUB(j)  (1280 + 64 * (j))
#define XB_XGEN(j)  (2304 + 64 * (j))
#define XB_TOP      3328
#define XB_TOPGEN   3392
#define XCD_BAR_WORDS 3456
#define XB_SPIN_CAP (1u << 18)

__device__ __forceinline__ unsigned xb_ld(unsigned* p)              { return __hip_atomic_load(p, __ATOMIC_RELAXED, __HIP_MEMORY_SCOPE_AGENT); }
__device__ __forceinline__ unsigned xb_add(unsigned* p, unsigned v) { return __hip_atomic_fetch_add(p, v, __ATOMIC_RELAXED, __HIP_MEMORY_SCOPE_AGENT); }
__device__ __forceinline__ unsigned xb_xcc_id() { return (unsigned)__builtin_amdgcn_s_getreg((3 << 11) | 20) & 0xFu; }
#define XB_SPIN(cond, bar) do { unsigned _sp = 0; while (cond) { __builtin_amdgcn_s_sleep(1); \
    if ((++_sp & 255u) == 0u) { if (xb_ld(&(bar)[XB_TMO])) break; if (_sp > XB_SPIN_CAP) { atomicAdd(&(bar)[XB_TMO], 1u); break; } } } } while (0)

struct XcdBarrier {
    unsigned* bar; unsigned x; int wave;
    volatile LAS unsigned* st;
};

__device__ __forceinline__ XcdBarrier xcd_barrier_post(unsigned* bar, volatile LAS unsigned* st, int wave) {
    XcdBarrier b; b.bar = bar; b.x = xb_xcc_id(); b.st = st; b.wave = wave;
    if (wave == 0 && pg8::lane_id_asm() == 0) (void)xb_add(&bar[XB_XCNT(b.x)], 1u);
    return b;
}
__device__ __forceinline__ void xcd_barrier_complete(unsigned* bar, unsigned x, unsigned& nloc, unsigned& nx) {
    const unsigned G = gridDim.x * gridDim.y * gridDim.z;
    unsigned sum, cnt, mine, sp = 0u;
    for (;;) {
        sum = 0u; cnt = 0u; mine = 0u;
#pragma unroll
        for (unsigned j = 0; j < 16; ++j) { const unsigned c = xb_ld(&bar[XB_XCNT(j)]); sum += c; cnt += (c > 0u) ? 1u : 0u; mine = (j == x) ? c : mine; }
        if (sum == G) break;
        __builtin_amdgcn_s_sleep(1);
        if ((++sp & 255u) == 0u) { if (xb_ld(&bar[XB_TMO])) break; if (sp > XB_SPIN_CAP) { atomicAdd(&bar[XB_TMO], 1u); break; } }
    }
    nloc = mine > 0u ? mine : 1u; nx = cnt > 0u ? cnt : 1u;
}

__device__ __forceinline__ void xcd_barrier(const XcdBarrier& b) {
    asm volatile("s_waitcnt vmcnt(0)" ::: "memory");
    __syncthreads();
    if (b.wave == 0 && pg8::lane_id_asm() == 0) {
        unsigned* bar = b.bar;
        __builtin_amdgcn_s_waitcnt(0);
        unsigned nloc = b.st[0], nx = b.st[1];
        if (nloc == 0u) { xcd_barrier_complete(bar, b.x, nloc, nx); b.st[0] = nloc; b.st[1] = nx; }
        const unsigned old = xb_add(&bar[XB_XSUB(b.x)], 1u);
        const unsigned gen = old / nloc;
        if (old + 1u == (gen + 1u) * nloc) {
            __builtin_amdgcn_fence(__ATOMIC_RELEASE, "agent");
            asm volatile("s_waitcnt vmcnt(0)" ::: "memory");
            const unsigned og = xb_add(&bar[XB_TOP], 1u);
            const unsigned tg = og / nx;
            if (og + 1u == (tg + 1u) * nx) xb_add(&bar[XB_TOPGEN], 1u);
            else XB_SPIN(xb_ld(&bar[XB_TOPGEN]) == tg, bar);
            __builtin_amdgcn_fence(__ATOMIC_ACQUIRE, "agent");
            xb_add(&bar[XB_XGEN(b.x)], 1u);
            asm volatile("s_waitcnt vmcnt(0)" ::: "memory");
        } else {
            XB_SPIN(xb_ld(&bar[XB_XGEN(b.x)]) == gen, bar);
            __builtin_amdgcn_fence(__ATOMIC_ACQUIRE, "agent");
            asm volatile("s_waitcnt vmcnt(0)" ::: "memory");
        }
    }
    __syncthreads();
}

constexpr int NWAVES = 8;
constexpr int BATCH = 4, SEQ = 2048, D = 2048, DFF = 5632, NGU = 2 * DFF, NIN = 6144, PLE = 256;
constexpr int HW = 1024, LW = 1024, HEADS = 8, HD = 128, CHUNK = 64, NCH = SEQ / CHUNK;
constexpr int M = BATCH * SEQ;
constexpr float EPS = 1e-6f;
constexpr int N_IN = 27;
enum In { I_X = 0, I_P, I_F1N, I_F1G, I_F1U, I_F1D, I_MIXN, I_WIN, I_HLB, I_HGN, I_CW, I_CB, I_LWA, I_LBA, I_LWX, I_LBX, I_LAM, I_WOUT,
          I_F2N, I_F2G, I_F2U, I_F2D, I_PLN, I_PWG, I_PBG, I_PWP, I_FN };

constexpr size_t MiB = 1u << 20;
constexpr size_t WS_CTL = 0, CTL_ZERO_BYTES = 1 * MiB;
constexpr size_t WS_SSQA = 1 * MiB, WS_SSQB = 2 * MiB, WS_DEC = 3 * MiB;
constexpr size_t WS_WAT = 3 * MiB + 512 * 1024, WS_WXT = 3 * MiB + 768 * 1024;
constexpr size_t WS_WPROJ = 4 * MiB, WS_PB = 5 * MiB;
constexpr size_t WS_WGU1 = 9 * MiB, WS_WD1 = 53 * MiB, WS_WINT = 75 * MiB, WS_WOUT = 99 * MiB, WS_WGU2 = 107 * MiB, WS_WD2 = 151 * MiB, WS_WPG = 173 * MiB;
constexpr size_t WS_XB = 181 * MiB;
constexpr size_t WS_ACT = 213 * MiB;
constexpr size_t WS_LOGF = WS_ACT, WS_V = WS_ACT + 32 * MiB, WS_SG = WS_ACT + 48 * MiB, WS_LRX = WS_ACT + 64 * MiB, WS_PP = 333 * MiB;
constexpr size_t WS_MIXA = 301 * MiB;
constexpr size_t WS_KVT = 333 * MiB;
constexpr size_t WS_XCH = 397 * MiB;
constexpr size_t WS_WAJ = 398 * MiB, WS_WXJ = 399 * MiB;
constexpr size_t WS_BA2 = 400 * MiB;
constexpr size_t WS_END = 401 * MiB;
static_assert(WS_WGU1 + (size_t)NGU * D * 2 <= WS_WD1 && WS_WD1 + (size_t)D * DFF * 2 <= WS_WINT && WS_WINT + (size_t)NIN * D * 2 <= WS_WOUT && WS_WOUT + (size_t)D * D * 2 <= WS_WGU2 &&
              WS_WGU2 + (size_t)NGU * D * 2 <= WS_WD2 && WS_WD2 + (size_t)D * DFF * 2 <= WS_WPG && WS_WPG + (size_t)D * D * 2 <= WS_XB && WS_XB + (size_t)M * D * 2 <= WS_ACT &&
              WS_ACT + (size_t)M * DFF * 2 <= WS_MIXA && WS_MIXA + (size_t)M * 2048 * 2 <= WS_KVT && WS_KVT + (size_t)BATCH * HEADS * NCH * HD * HD * 4 <= WS_XCH &&
              WS_LRX + (size_t)M * 1024 * 2 <= WS_MIXA && WS_PP + (size_t)M * D * 4 <= 397 * MiB && WS_PB + (size_t)M * PLE * 2 <= WS_WGU1 && WS_WPROJ + (size_t)D * PLE * 2 <= WS_PB, "d_ws map");
constexpr int CW_PANEL = 16384;
constexpr int CW_BAR = 4096;

constexpr int RING_OFF = 0, RING_BYTES = 131072;
constexpr int LDSCTL_OFF = 147456 - 512, MISC_OFF = LDSCTL_OFF + 320;
constexpr int LDS_BYTES = 147456;
static_assert(MISC_OFF + 128 <= LDS_BYTES, "LDS map");


struct Frame {
    LAS unsigned char* lds;
    volatile LAS unsigned* MISC;
    gu32* ctl;
    int wave;
    int vcu, G;
    const float* in[N_IN]; float* out; unsigned char* ws;
};
__device__ __forceinline__ float bf2f(bf16 b) { return __builtin_bit_cast(float, (unsigned)b << 16); }
__device__ __forceinline__ float wave_sum(float v) {
#pragma unroll
    for (int o = 1; o < 64; o <<= 1) v += __shfl_xor(v, o);
    return v;
}
__device__ __forceinline__ void p0_transpose_item(const float* W, int ldw, int K, int src_col0, bf16* WT, int dst_row0, const float* gain, LAS float* scr, int kb, int lane) {
    const int k0 = 64 * kb, kq = lane >> 4, nq = lane & 15;
    f32x4 v[16];
#pragma unroll
    for (int i = 0; i < 16; ++i) v[i] = __builtin_nontemporal_load((const GAS f32x4*)(W + (size_t)(k0 + 4 * i + kq) * ldw + src_col0 + 4 * nq));
    if (gain) {
#pragma unroll
        for (int i = 0; i < 16; ++i) v[i] = v[i] * gain[k0 + 4 * i + kq];
    }
#pragma unroll
    for (int i = 0; i < 16; ++i) { LAS float* s = scr + (4 * i + kq) * 65 + 4 * nq; s[0] = v[i].x; s[1] = v[i].y; s[2] = v[i].z; s[3] = v[i].w; }
    LDS_WAIT(); asm volatile("" ::: "memory");
    const int c = lane & 7;
#pragma unroll
    for (int j = 0; j < 8; ++j) { const int n = (lane >> 3) + 8 * j; const LAS float* s = scr + (8 * c) * 65 + n;
        v4u o; o.x = pk2(s[0 * 65], s[1 * 65]); o.y = pk2(s[2 * 65], s[3 * 65]); o.z = pk2(s[4 * 65], s[5 * 65]); o.w = pk2(s[6 * 65], s[7 * 65]);
        *(GAS v4u*)(WT + (size_t)(dst_row0 + n) * K + k0 + 8 * c) = o; }
    LDS_WAIT(); asm volatile("" ::: "memory");
}
__device__ __forceinline__ bool p0_plain(int& r, const float* W, int K, int N, bf16* WT, const float* gain, LAS float* scr, int lane) {
    const int items = (N / 64) * (K / 64);
    if (r < items) { const int nb = r / (K / 64), kb = r % (K / 64); p0_transpose_item(W, N, K, 64 * nb, WT, 64 * nb, gain, scr, kb, lane); return true; }
    r -= items; return false;
}
__device__ __forceinline__ bool p0_gateup(int& r, const float* Wg, const float* Wu, bf16* WT, const float* gain, LAS float* scr, int lane) {
    const int items = (NGU / 64) * (D / 64);
    if (r < items) { const int rb = r / (D / 64), kb = r % (D / 64), t = rb >> 2, j = rb & 3;
        p0_transpose_item(j < 2 ? Wg : Wu, DFF, D, 128 * t + 64 * (j & 1), WT, 64 * rb, gain, scr, kb, lane); return true; }
    r -= items; return false;
}
enum { J_X = 1, J_P = 2, J_GU1 = 4, J_D1 = 8, J_WIN = 16, J_WOUT = 32, J_GU2 = 64, J_D2 = 128, J_PG = 256, J_PROJ = 512, J_AX = 1024 };
template <int JOBS>
__device__ __forceinline__ void convert_jobs(Frame& F, int rank, int count) {
    const int lane_ = pg8::lane_id_asm(), wave_ = F.wave;
    LAS float* scr = (LAS float*)(F.lds + RING_OFF + wave_ * 16640);
    const int gw = rank * NWAVES + wave_, NGW = count * NWAVES;
    unsigned char* ws = F.ws;
    if (JOBS & J_X) {
        for (int m = gw; m < M; m += NGW) {
            const GAS f32x4* xr = (const GAS f32x4*)(F.in[I_X] + (size_t)m * D) + lane_;
            GAS unsigned long long* o8 = (GAS unsigned long long*)((bf16*)(ws + WS_XB) + (size_t)m * D) + lane_;
            float s = 0.f;
#pragma unroll
            for (int j = 0; j < 8; ++j) { const f32x4 v = __builtin_nontemporal_load(xr + 64 * j); s += (v.x * v.x + v.y * v.y) + (v.z * v.z + v.w * v.w);
                o8[64 * j] = (unsigned long long)pk2(v.x, v.y) | ((unsigned long long)pk2(v.z, v.w) << 32); }
            s = wave_sum(s);
            if (lane_ < 32) ((float*)(ws + WS_SSQA))[(size_t)m * 32 + lane_] = (lane_ == 0) ? s : 0.f;
        }
    }
    if (JOBS & J_P) {
        for (int m = gw; m < M; m += NGW) {
            const f32x4 v = __builtin_nontemporal_load((const GAS f32x4*)(F.in[I_P] + (size_t)m * PLE) + lane_);
            ((GAS unsigned long long*)((bf16*)(ws + WS_PB) + (size_t)m * PLE))[lane_] = (unsigned long long)pk2(v.x, v.y) | ((unsigned long long)pk2(v.z, v.w) << 32);
        }
    }
    constexpr int I_GU = (NGU / 64) * (D / 64), I_DD = (D / 64) * (DFF / 64), I_IN = (NIN / 64) * (D / 64), I_SQ = (D / 64) * (D / 64), I_PJ = (D / 64) * (PLE / 64), I_AX = 16 * 4 * 4;
    constexpr int NITEMS = ((JOBS & J_GU1) ? I_GU : 0) + ((JOBS & J_D1) ? I_DD : 0) + ((JOBS & J_WIN) ? I_IN : 0) + ((JOBS & J_WOUT) ? I_SQ : 0) + ((JOBS & J_GU2) ? I_GU : 0) +
                           ((JOBS & J_D2) ? I_DD : 0) + ((JOBS & J_PG) ? I_SQ : 0) + ((JOBS & J_PROJ) ? I_PJ : 0) + ((JOBS & J_AX) ? I_AX : 0);
    for (int it = gw; it < NITEMS; it += NGW) {
        int r = it;
        if (JOBS & J_GU1) { if (p0_gateup(r, F.in[I_F1G], F.in[I_F1U], (bf16*)(ws + WS_WGU1), F.in[I_F1N], scr, lane_)) continue; }
        if (JOBS & J_D1) { if (p0_plain(r, F.in[I_F1D], DFF, D, (bf16*)(ws + WS_WD1), nullptr, scr, lane_)) continue; }
        if (JOBS & J_WIN) { if (p0_plain(r, F.in[I_WIN], D, NIN, (bf16*)(ws + WS_WINT), F.in[I_MIXN], scr, lane_)) continue; }
        if (JOBS & J_WOUT) { if (p0_plain(r, F.in[I_WOUT], D, D, (bf16*)(ws + WS_WOUT), nullptr, scr, lane_)) continue; }
        if (JOBS & J_GU2) { if (p0_gateup(r, F.in[I_F2G], F.in[I_F2U], (bf16*)(ws + WS_WGU2), F.in[I_F2N], scr, lane_)) continue; }
        if (JOBS & J_D2) { if (p0_plain(r, F.in[I_F2D], DFF, D, (bf16*)(ws + WS_WD2), nullptr, scr, lane_)) continue; }
        if (JOBS & J_PG) { if (p0_plain(r, F.in[I_PWG], D, D, (bf16*)(ws + WS_WPG), F.in[I_PLN], scr, lane_)) continue; }
        if (JOBS & J_PROJ) { if (p0_plain(r, F.in[I_PWP], PLE, D, (bf16*)(ws + WS_WPROJ), nullptr, scr, lane_)) continue; }
        if (JOBS & J_AX) { const int blk = r >> 4, j = (r >> 2) & 3, q = r & 3;
          const int nb = blk & 7;
          const float* W = (blk < 8 ? F.in[I_LWA] : F.in[I_LWX]) + (size_t)nb * 128 * 128;
          bf16* WT = (bf16*)(ws + (blk < 8 ? WS_WAJ : WS_WXJ)) + (size_t)(nb * 4 + j) * 128 * 128;
          p0_transpose_item(W, 128, 128, 64 * (q >> 1), WT, 64 * (q >> 1), F.in[I_CW] + j * 1024 + nb * 128, scr, q & 1, lane_); }
    }
    if (JOBS & J_AX) {
        for (int o = gw * 64 + lane_; o < 2048; o += NGW * 64) { const int which = o >> 10, dg = o & 1023, nb = dg >> 7, dd = dg & 127;
            const float* W = (which ? F.in[I_LWX] : F.in[I_LWA]) + (size_t)nb * 128 * 128 + dd; float s = (which ? F.in[I_LBX] : F.in[I_LBA])[dg];
            for (int c = 0; c < 128; ++c) s += F.in[I_CB][nb * 128 + c] * W[(size_t)c * 128];
            ((float*)(ws + WS_BA2))[o] = s; }
    }
}
__device__ __forceinline__ void side_workers(int nwg, int G, int c, int& rank, int& count) {
    const int rounds = (nwg + G - 1) / G, last = nwg - (rounds - 1) * G;
    if (last == G) { rank = c; count = G; } else if (c >= last) { rank = c - last; count = G - last; } else { rank = -1; count = 0; }
}
__device__ __forceinline__ void final_norm(Frame& F, const float* ssq) {
    const int lane_ = pg8::lane_id_asm(), wave_ = F.wave;
    const int gw = F.vcu * NWAVES + wave_, NGW = F.G * NWAVES;
    const GAS f32x4* gf = (const GAS f32x4*)F.in[I_FN] + lane_;
    for (int m = gw; m < M; m += NGW) {
        float s = (lane_ < 32) ? ssq[(size_t)m * 32 + lane_] : 0.f;
        s = wave_sum(s);
        const float rstd = 1.0f / sqrtf(s * (1.0f / D) + EPS);
        GAS f32x4* xr = (GAS f32x4*)(F.out + (size_t)m * D) + lane_;
#pragma unroll
        for (int j = 0; j < 8; ++j) { f32x4 v = xr[64 * j]; const f32x4 g = gf[64 * j]; v = v * rstd * g; xr[64 * j] = v; }
    }
}


typedef float mf32x4 __attribute__((ext_vector_type(4)));
typedef short mbf16x8 __attribute__((ext_vector_type(8)));
typedef unsigned mu32x2 __attribute__((ext_vector_type(2)));
constexpr int TS = 72;
constexpr int QS = 136;
constexpr int NITEM = BATCH * HEADS * NCH;
__device__ __forceinline__ mbf16x8 lds_frag(const LAS bf16* p) { return *(const LAS mbf16x8*)p; }
__device__ __forceinline__ unsigned bf1(float x) { return pg8::cvt_pk_bf16(x, 0.f) & 0xffffu; }
#define MFMA16(a, b, c) __builtin_amdgcn_mfma_f32_16x16x32_bf16((a), (b), (c), 0, 0, 0)

__device__ __forceinline__ void hgrn_local_phase(Frame& F) {
    LAS bf16* kstT = (LAS bf16*)(F.lds);
    LAS bf16* vT = (LAS bf16*)(F.lds + 18432);
    LAS float* qtot = (LAS float*)(F.lds + 36864);
    const int tid_ = F.wave * 64 + pg8::lane_id_asm();
    const int tid = tid_, k = tid & 127, sq = tid >> 7, lane = tid & 63, w = F.wave, fr = lane & 15, fq = lane >> 4;
    const float* LOGF = (const float*)(F.ws + WS_LOGF); const bf16* V = (const bf16*)(F.ws + WS_V);
    float* KVT = (float*)(F.ws + WS_KVT); float* DEC = (float*)(F.ws + WS_DEC);
    for (int item = blockIdx.x; item < NITEM; item += F.G) {
        const int c = item & 31, bh = item >> 5, h = bh & 7, b = bh >> 3;
        const size_t g0 = ((size_t)b * SEQ + c * 64 + sq * 16) * 1024 + h * 128 + k;
        float lf[16]; unsigned vr[16];
#pragma unroll
        for (int i = 0; i < 16; ++i) { lf[i] = LOGF[g0 + (size_t)i * 1024]; vr[i] = V[g0 + (size_t)i * 1024]; }
        float bb[16]; float run = 0.f;
#pragma unroll
        for (int i = 0; i < 16; ++i) { run += lf[i]; bb[i] = run; }
        qtot[sq * 128 + k] = run;
        __syncthreads();
        float pre = 0.f, tot = 0.f;
#pragma unroll
        for (int j = 0; j < 4; ++j) { const float tq = qtot[j * 128 + k]; pre += (j < sq) ? tq : 0.f; tot += tq; }
        unsigned pk[8], pv[8];
#pragma unroll
        for (int i = 0; i < 8; ++i) {
            const float e0 = (1.0f - __expf(lf[2 * i])) * __expf(tot - (pre + bb[2 * i])), e1 = (1.0f - __expf(lf[2 * i + 1])) * __expf(tot - (pre + bb[2 * i + 1]));
            pk[i] = pg8::cvt_pk_bf16(e0, e1); pv[i] = vr[2 * i] | (vr[2 * i + 1] << 16); }
        *(LAS v4u*)(kstT + k * TS + sq * 16) = (v4u){pk[0], pk[1], pk[2], pk[3]}; *(LAS v4u*)(kstT + k * TS + sq * 16 + 8) = (v4u){pk[4], pk[5], pk[6], pk[7]};
        *(LAS v4u*)(vT + k * TS + sq * 16) = (v4u){pv[0], pv[1], pv[2], pv[3]}; *(LAS v4u*)(vT + k * TS + sq * 16 + 8) = (v4u){pv[4], pv[5], pv[6], pv[7]};
        if (sq == 0) DEC[(size_t)item * 128 + k] = __expf(tot);
        __syncthreads();
        const mbf16x8 b0 = lds_frag(vT + (16 * w + fr) * TS + 8 * fq), b1 = lds_frag(vT + (16 * w + fr) * TS + 32 + 8 * fq);
        float* outp = KVT + (size_t)item * 16384 + (size_t)(16 * w + fr) * 128 + 4 * fq;
#pragma unroll
        for (int kt = 0; kt < 8; ++kt) {
            mf32x4 acc = {0.f, 0.f, 0.f, 0.f};
            acc = MFMA16(lds_frag(kstT + (16 * kt + fr) * TS + 8 * fq), b0, acc);
            acc = MFMA16(lds_frag(kstT + (16 * kt + fr) * TS + 32 + 8 * fq), b1, acc);
            *(mf32x4*)(outp + 16 * kt) = acc;
        }
        __syncthreads();
    }
}

__device__ __forceinline__ void hgrn_scan_phase(Frame& F) {
    const float* KVT = (const float*)(F.ws + WS_KVT); const float* DEC = (const float*)(F.ws + WS_DEC); bf16* ST = (bf16*)(F.ws + WS_XB);
    const int tid_ = F.wave * 64 + pg8::lane_id_asm();
    for (int idx = blockIdx.x * (NWAVES * 64) + tid_; idx < BATCH * HEADS * 128 * 32; idx += F.G * NWAVES * 64) {
        const int k4 = idx & 31, v = (idx >> 5) & 127, bh = idx >> 12;
        mf32x4 S = {0.f, 0.f, 0.f, 0.f};
#pragma unroll 1
        for (int half = 0; half < 2; ++half) {
            const size_t off0 = (size_t)(bh * NCH + half * 16) * 16384 + v * 128 + 4 * k4; const size_t d0 = (size_t)(bh * NCH + half * 16) * 128 + 4 * k4;
            mf32x4 kv[16], dd[16];
#pragma unroll
            for (int c = 0; c < 16; ++c) { kv[c] = *(const mf32x4*)(KVT + off0 + (size_t)c * 16384); dd[c] = *(const mf32x4*)(DEC + d0 + (size_t)c * 128); }
#pragma unroll
            for (int c = 0; c < 16; ++c) {
                mu32x2 o; o.x = pg8::cvt_pk_bf16(S[0], S[1]); o.y = pg8::cvt_pk_bf16(S[2], S[3]); *(mu32x2*)(ST + off0 + (size_t)c * 16384) = o;
                S = dd[c] * S + kv[c];
            }
        }
    }
}

__device__ __forceinline__ void hgrn_out_phase(Frame& F, bool dummy = false) {
    LAS bf16* QT = (LAS bf16*)(F.lds);
    LAS bf16* KT = (LAS bf16*)(F.lds + 17408);
    LAS bf16* QI = (LAS bf16*)(F.lds + 34816);
    LAS bf16* vT = (LAS bf16*)(F.lds + 52224);
    LAS bf16* P = (LAS bf16*)(F.lds + 70656);
    LAS float* qtot = (LAS float*)(F.lds + 79872);
    LAS float* ssq = (LAS float*)(F.lds + 81920);
    const int tid_ = F.wave * 64 + pg8::lane_id_asm();
    const int tid = tid_, k = tid & 127, sq = tid >> 7, lane = tid & 63, w = F.wave, fr = lane & 15, fq = lane >> 4, rb = w & 3, ch = w >> 2;
    const float* LOGF = (const float*)(F.ws + WS_LOGF); const bf16* V = (const bf16*)(F.ws + WS_V); const bf16* SG = (const bf16*)(F.ws + WS_SG);
    const bf16* ST = (const bf16*)(F.ws + WS_XB); bf16* MIXA = (bf16*)(F.ws + WS_MIXA);
    for (int item = blockIdx.x; item < NITEM; item += F.G) {
        const int c = item & 31, bh = item >> 5, h = bh & 7, b = bh >> 3;
        const size_t r0 = (size_t)b * SEQ + c * 64;
        {
            const size_t g0 = (r0 + sq * 16) * 1024 + h * 128 + k, gq = (r0 + sq * 16) * 2048 + h * 128 + k;
            float lf[16]; unsigned vr[16], qr[16];
#pragma unroll
            for (int i = 0; i < 16; ++i) { lf[i] = LOGF[g0 + (size_t)i * 1024]; vr[i] = V[g0 + (size_t)i * 1024]; qr[i] = MIXA[gq + (size_t)i * 2048]; }
            float bb[16]; float run = 0.f;
#pragma unroll
            for (int i = 0; i < 16; ++i) { run += lf[i]; bb[i] = run; }
            qtot[sq * 128 + k] = run;
            __syncthreads();
            float pre = 0.f;
#pragma unroll
            for (int j = 0; j < 4; ++j) { const float tq = qtot[j * 128 + k]; pre += (j < sq) ? tq : 0.f; }
            const float bm = qtot[k] + qtot[128 + k], ebm = __expf(bm);
            unsigned pv[8];
#pragma unroll
            for (int i = 0; i < 16; ++i) {
                const float d = fminf(fmaxf(pre + bb[i] - bm, -60.f), 60.f), e1 = __expf(d), e2 = __builtin_amdgcn_rcpf(e1);
                const float qf = bf2f((bf16)qr[i]), qt = qf * e1, kk = (1.0f - __expf(lf[i])) * e2;
                const int s = sq * 16 + i;
                QT[s * QS + k] = (bf16)bf1(qt); QI[s * QS + k] = (bf16)bf1(qt * ebm); KT[s * QS + k] = (bf16)bf1(kk);
            }
#pragma unroll
            for (int i = 0; i < 8; ++i) pv[i] = vr[2 * i] | (vr[2 * i + 1] << 16);
            *(LAS v4u*)(vT + k * TS + sq * 16) = (v4u){pv[0], pv[1], pv[2], pv[3]}; *(LAS v4u*)(vT + k * TS + sq * 16 + 8) = (v4u){pv[4], pv[5], pv[6], pv[7]};
        }
        __syncthreads();
        const int t0 = 16 * rb;
        {
            mbf16x8 bq[4];
#pragma unroll
            for (int ks = 0; ks < 4; ++ks) bq[ks] = lds_frag(QT + (t0 + fr) * QS + 32 * ks + 8 * fq);
#pragma unroll
            for (int j = 0; j < 2; ++j) {
                const int s0 = 32 * ch + 16 * j; mf32x4 acc = {0.f, 0.f, 0.f, 0.f};
#pragma unroll
                for (int ks = 0; ks < 4; ++ks) acc = MFMA16(lds_frag(KT + (s0 + fr) * QS + 32 * ks + 8 * fq), bq[ks], acc);
                const int t = t0 + fr, sb = s0 + 4 * fq;
#pragma unroll
                for (int r = 0; r < 4; ++r) acc[r] = (sb + r <= t) ? acc[r] : 0.f;
                mu32x2 o; o.x = pg8::cvt_pk_bf16(acc[0], acc[1]); o.y = pg8::cvt_pk_bf16(acc[2], acc[3]);
                *(LAS mu32x2*)(P + t * TS + sb) = o;
            }
        }
        __syncthreads();
        mf32x4 o4[4];
        {
            mbf16x8 bqi[4], bp[2];
#pragma unroll
            for (int ks = 0; ks < 4; ++ks) bqi[ks] = lds_frag(QI + (t0 + fr) * QS + 32 * ks + 8 * fq);
#pragma unroll
            for (int ss = 0; ss < 2; ++ss) bp[ss] = lds_frag(P + (t0 + fr) * TS + 32 * ss + 8 * fq);
            float sum = 0.f;
#pragma unroll
            for (int j = 0; j < 4; ++j) {
                const int v0 = 64 * ch + 16 * j; mf32x4 acc = {0.f, 0.f, 0.f, 0.f};
                const bf16* sp = ST + (size_t)item * 16384 + (size_t)(v0 + fr) * 128 + 8 * fq;
#pragma unroll
                for (int ks = 0; ks < 4; ++ks) acc = MFMA16(*(const mbf16x8*)(sp + 32 * ks), bqi[ks], acc);
#pragma unroll
                for (int ss = 0; ss < 2; ++ss) acc = MFMA16(lds_frag(vT + (v0 + fr) * TS + 32 * ss + 8 * fq), bp[ss], acc);
                o4[j] = acc; sum += (acc[0] * acc[0] + acc[1] * acc[1]) + (acc[2] * acc[2] + acc[3] * acc[3]);
            }
            sum += __shfl_xor(sum, 16); sum += __shfl_xor(sum, 32);
            if (fq == 0) ssq[ch * 64 + t0 + fr] = sum;
        }
        __syncthreads();
        {
            const float rn = 1.0f / sqrtf((ssq[t0 + fr] + ssq[64 + t0 + fr]) * (1.0f / 128.0f) + EPS);
            const size_t row = r0 + t0 + fr;
#pragma unroll
            for (int j = 0; j < 4; ++j) {
                const int v = 64 * ch + 16 * j + 4 * fq;
                const mf32x4 gn = *(const mf32x4*)(F.in[I_HGN] + v);
                const mu32x2 sgp = *(const mu32x2*)(SG + row * 1024 + h * 128 + v);
                const float s0 = bf2f((bf16)(sgp.x & 0xffffu)), s1 = bf2f((bf16)(sgp.x >> 16)), s2 = bf2f((bf16)(sgp.y & 0xffffu)), s3 = bf2f((bf16)(sgp.y >> 16));
                mu32x2 o; o.x = pg8::cvt_pk_bf16(o4[j][0] * rn * gn[0] * s0, o4[j][1] * rn * gn[1] * s1); o.y = pg8::cvt_pk_bf16(o4[j][2] * rn * gn[2] * s2, o4[j][3] * rn * gn[3] * s3);
                *(mu32x2*)((dummy ? (bf16*)(F.ws + WS_KVT) : MIXA) + row * 2048 + h * 128 + v) = o;
            }
        }
        __syncthreads();
    }
}

#define GLDS16(gp, lp) __builtin_amdgcn_global_load_lds((const unsigned*)(gp), (LAS unsigned*)(lp), 16, 0, 0)
template <int VAR = 0>
__device__ __forceinline__ void lru_phase(Frame& F, bool dummy = false) {
    LAS unsigned char* Ab = F.lds;
    LAS float* LAt = (LAS float*)(F.lds + 66560);
    LAS float* LUt = (LAS float*)(F.lds + 66560 + 18560);
    LAS bf16* GG = (LAS bf16*)(F.lds + 103680);
    LAS bf16* YY = (LAS bf16*)(F.lds + 120064);
    const int tid_ = F.wave * 64 + pg8::lane_id_asm();
    const int tid = tid_, lane = tid & 63, w = F.wave, fr = lane & 15, fq = lane >> 4;
    const int seg = lane & 31, d = 2 * w + (lane >> 5);
    const int grow = tid >> 1, ghalf = tid & 1;
    const bf16* LRX = (const bf16*)(F.ws + WS_LRX); bf16* MIXA = (bf16*)(F.ws + WS_MIXA);
    const bf16* WAJ = (const bf16*)(F.ws + WS_WAJ); const bf16* WXJ = (const bf16*)(F.ws + WS_WXJ);
    for (int item = blockIdx.x; item < BATCH * 64; item += F.G) {
        const int b = item >> 6, n = (item >> 3) & 7, sl = item & 7;
        mbf16x8 waf[4][4], wxf[4][4];
#pragma unroll
        for (int j = 0; j < 4; ++j)
#pragma unroll
            for (int ks = 0; ks < 4; ++ks) { const size_t o = ((size_t)(n * 4 + j) * 128 + sl * 16 + fr) * 128 + 32 * ks + 8 * fq; waf[j][ks] = *(const mbf16x8*)(WAJ + o); wxf[j][ks] = *(const mbf16x8*)(WXJ + o); }
        const int cgl = n * 128 + sl * 16 + fr;
        const float ba2 = ((const float*)(F.ws + WS_BA2))[cgl], bx2 = ((const float*)(F.ws + WS_BA2))[1024 + cgl], spl = log1pf(__expf(-F.in[I_LAM][cgl])), cbv = F.in[I_CB][cgl];
        float cw4[4];
#pragma unroll
        for (int j = 0; j < 4; ++j) cw4[j] = F.in[I_CW][j * 1024 + cgl];
        const bf16* xsrc = LRX + (size_t)b * SEQ * 1024 + n * 128;
        bf16* const gbase = MIXA + (size_t)b * SEQ * 2048 + 1024 + n * 128 + sl * 16 + 8 * ghalf;
        bf16* const obase = dummy ? (bf16*)(F.ws + WS_END) + (size_t)item * 2048 * 16 + 8 * ghalf : gbase;
        const size_t ostr = dummy ? 16 : 2048;
#pragma unroll
        for (int i = 0; i < 9; ++i) { const int p = tid + 512 * i, row = p >> 4, cp = p & 15;
            if (p < 259 * 16 && row >= 3) GLDS16(xsrc + (size_t)(row - 3) * 1024 + 8 * (cp ^ (row & 15)), Ab + (w * 64 + 512 * i) * 16); }
        if (tid < 48) *(LAS v4u*)(Ab + tid * 16) = (v4u){0u, 0u, 0u, 0u};
        GLDS16(gbase + (size_t)grow * 2048, (LAS unsigned char*)GG + w * 1024);
        __syncthreads();
        float carry = 0.f;
        for (int mc = 0; mc < 8; ++mc) {
            int tid = tid_; asm volatile("" : "+v"(tid));
            const int lane = tid & 63, fr = lane & 15, fq = lane >> 4, seg = lane & 31, d = 2 * w + (lane >> 5), grow = tid >> 1, ghalf = tid & 1;
            bf16* const gbase = MIXA + (size_t)b * SEQ * 2048 + 1024 + n * 128 + sl * 16 + 8 * ghalf;
            bf16* const obase = dummy ? (bf16*)(F.ws + WS_END) + (size_t)item * 2048 * 16 + 8 * ghalf : gbase;
            if (mc > 0) *(v4u*)(obase + (size_t)((mc - 1) * 256 + grow) * ostr) = *(const LAS v4u*)(YY + ((mc - 1) & 1) * 4096 + grow * 16 + 8 * ghalf);
#pragma unroll
            for (int rt = 0; rt < (VAR == 2 ? 0 : 2); ++rt) {
                const int rowt = 32 * w + 16 * rt; mf32x4 ar = {0.f, 0.f, 0.f, 0.f}, ai = {0.f, 0.f, 0.f, 0.f};
#pragma unroll
                for (int j = 0; j < 4; ++j) { const int R = rowt + fr + j;
#pragma unroll
                    for (int ks = 0; ks < 4; ++ks) { const mbf16x8 a = *(const LAS mbf16x8*)(Ab + R * 256 + (((4 * ks + fq) ^ (R & 15)) << 4)); ar = MFMA16(a, waf[j][ks], ar); ai = MFMA16(a, wxf[j][ks], ai); } }
#pragma unroll
                for (int r = 0; r < 4; ++r) { const int row = rowt + 4 * fq + r;
                    float xc = cbv;
#pragma unroll
                    for (int j = 0; j < 4; ++j) { const int R = row + j; xc += cw4[j] * bf2f(*(const LAS bf16*)(Ab + R * 256 + (((2 * sl + (fr >> 3)) ^ (R & 15)) << 4) + 2 * (fr & 7))); }
                    const float rg = pg8::sigmoid_f(ar[r] + ba2), ig = pg8::sigmoid_f(ai[r] + bx2), la = -8.0f * rg * spl, t = 2.0f * la;
                    const float ser = -t * (1.0f + t * (0.5f + t * (0.16666667f + t * (0.041666668f + t * (0.0083333338f + t * 0.0013888889f)))));
                    const float om = (t > -0.25f) ? ser : 1.0f - __expf(t);
                    const int o = fr * 289 + (row >> 3) * 9 + (row & 7);
                    LAt[o] = __expf(la); LUt[o] = sqrtf(om) * ig * xc; }
            }
            __syncthreads();
            if (mc < 7) {
#pragma unroll
                for (int i = 0; i < 9; ++i) { const int p = tid + 512 * i, row = p >> 4, cp = p & 15;
                    if (p < 259 * 16) GLDS16(xsrc + (size_t)((mc + 1) * 256 - 3 + row) * 1024 + 8 * (cp ^ (row & 15)), Ab + (w * 64 + 512 * i) * 16); }
                GLDS16(gbase + (size_t)((mc + 1) * 256 + grow) * 2048, (LAS unsigned char*)GG + ((mc + 1) & 1) * 8192 + w * 1024);
            }
            if (VAR != 3) {
                float aa[8], uu[8]; float Ap = 1.f, Hp = 0.f;
#pragma unroll
                for (int i = 0; i < 8; ++i) { aa[i] = LAt[d * 289 + seg * 9 + i]; uu[i] = LUt[d * 289 + seg * 9 + i]; Hp = aa[i] * Hp + uu[i]; Ap *= aa[i]; }
#pragma unroll
                for (int off = 1; off < 32; off <<= 1) { const float Aq = __shfl_up(Ap, off, 32), Hq = __shfl_up(Hp, off, 32); if (seg >= off) { Hp = Ap * Hq + Hp; Ap = Ap * Aq; } }
                float Ae = __shfl_up(Ap, 1, 32), He = __shfl_up(Hp, 1, 32); if (seg == 0) { Ae = 1.f; He = 0.f; }
                float hin = Ae * carry + He;
                carry = __shfl(Ap, 31, 32) * carry + __shfl(Hp, 31, 32);
                const LAS bf16* gp = GG + (mc & 1) * 4096 + (8 * seg) * 16 + d; LAS bf16* yq = YY + (mc & 1) * 4096 + (8 * seg) * 16 + d;
#pragma unroll
                for (int i = 0; i < 8; ++i) { hin = aa[i] * hin + uu[i]; yq[i * 16] = (bf16)bf1(hin * bf2f(gp[i * 16])); }
            }
            __syncthreads();
        }
        *(v4u*)(obase + (size_t)(7 * 256 + grow) * ostr) = *(const LAS v4u*)(YY + 4096 + grow * 16 + 8 * ghalf);
        __syncthreads();
    }
}
constexpr int N_PHASES = 12;
struct Args { const float* in[N_IN]; float* out; unsigned char* ws; int ph_lo, ph_hi, li, pad; };
__global__ void __launch_bounds__(NWAVES * 64, 2) mega_fwd(Args args) {
    extern __shared__ __attribute__((aligned(16))) unsigned char lds[];
    Frame F;
    F.lds = (LAS unsigned char*)lds;
    F.MISC = (volatile LAS unsigned*)(F.lds + MISC_OFF);
    F.wave = __builtin_amdgcn_readfirstlane((int)threadIdx.x >> 6);
    F.G = gridDim.x; { const int bx = blockIdx.x; F.vcu = (F.G % 8 == 0) ? (bx % 8) * (F.G / 8) + bx / 8 : bx; }
#pragma unroll
    for (int i = 0; i < N_IN; ++i) F.in[i] = args.in[i];
    F.out = args.out; F.ws = args.ws;
    unsigned char* ws = args.ws;
    F.ctl = (gu32*)(ws + WS_CTL);
    for (int u = F.wave * 64 + pg8::lane_id_asm(); u < (LDS_BYTES - LDSCTL_OFF) / 4; u += NWAVES * 64) ((LAS unsigned*)(F.lds + LDSCTL_OFF))[u] = 0u;
    __syncthreads();
    const int lo = args.ph_lo, hi = args.ph_hi;
    const bool multi = (hi - lo) > 1;
    XcdBarrier bar; bar.bar = (unsigned*)(F.ctl + CW_BAR) + args.li * XCD_BAR_WORDS; bar.x = 0; bar.st = nullptr; bar.wave = F.wave;
    if (multi) bar = xcd_barrier_post((unsigned*)(F.ctl + CW_BAR) + args.li * XCD_BAR_WORDS, F.MISC + 8, F.wave);

    bf16* const XB = (bf16*)(ws + WS_XB); bf16* const ACT = (bf16*)(ws + WS_ACT); bf16* const MIXA = (bf16*)(ws + WS_MIXA);
    float* const SSQA = (float*)(ws + WS_SSQA); float* const SSQB = (float*)(ws + WS_SSQB);


#define IN(k) (lo <= (k) && (k) < hi)
#ifdef PROBE_PHASE
#define SEAM(k) do { if (IN(k) && ((k) + 1 < N_PHASES ? IN((k) + 1) : true)) { xcd_barrier(bar); \
        if ((k) + 1 == PROBE_PHASE) { if (blockIdx.x == 0 && F.wave == 0 && pg8::lane_id_asm() == 0) __hip_atomic_store((unsigned long long*)(F.ctl + 80000), (unsigned long long)__builtin_amdgcn_s_memrealtime(), RLX_AGENT); } \
        if ((k) == PROBE_PHASE) { if (blockIdx.x == 0 && F.wave == 0 && pg8::lane_id_asm() == 0) { const unsigned long long t1 = __builtin_amdgcn_s_memrealtime(), t0 = __hip_atomic_load((unsigned long long*)(F.ctl + 80000), RLX_AGENT); \
                __hip_atomic_store((unsigned long long*)(F.ctl + 80064), t1 - t0, RLX_AGENT); } \
            xcd_barrier(bar); \
            { const unsigned long long dt = __hip_atomic_load((unsigned long long*)(F.ctl + 80064), RLX_AGENT), s0 = __builtin_amdgcn_s_memrealtime(); while (__builtin_amdgcn_s_memrealtime() - s0 < 4ull * dt) __builtin_amdgcn_s_sleep(32); } } } } while (0)
#else
#define SEAM(k) do { if (IN(k) && IN((k) + 1)) xcd_barrier(bar); } while (0)
#endif
#define GEMM_SWIGLU(WOFF) do { pg8::Gemm g{XB, (const bf16*)(ws + (WOFF)), M, NGU, D}; pg8::StaticOrder S; S.init(M, NGU, F.G, (int)blockIdx.x); \
        pg8::EpiSwiGLU E{ACT, DFF, SSQA}; pg8::gemm_phase<pg8::EpiSwiGLU, pg8::StaticOrder, true, true>(F.lds + RING_OFF, g, S, E, F.wave); } while (0)
#define GEMM_RESID(AP, WOFF, KK, SRC, SSQO, SC) do { pg8::Gemm g{(AP), (const bf16*)(ws + (WOFF)), M, D, (KK)}; pg8::StaticOrder S; S.init(M, D, F.G, (int)blockIdx.x); \
        pg8::EpiResid E{(SRC), F.out, XB, (SSQO), (SC)}; pg8::gemm_phase<pg8::EpiResid, pg8::StaticOrder, true, true>(F.lds + RING_OFF, g, S, E, F.wave); } while (0)

#ifdef PROBE_PHASE
    if (PROBE_PHASE == 0 && blockIdx.x == 0 && F.wave == 0 && pg8::lane_id_asm() == 0) __hip_atomic_store((unsigned long long*)(F.ctl + 80000), (unsigned long long)__builtin_amdgcn_s_memrealtime(), RLX_AGENT);
#endif
    if (IN(0)) { convert_jobs<J_X | J_P | J_GU1 | J_GU2 | J_WOUT | J_PROJ | J_AX>(F, (int)blockIdx.x, F.G); SEAM(0); }
    if (IN(1)) { GEMM_SWIGLU(WS_WGU1);
        { int rank, count; side_workers((M / 256) * (NGU / 256), F.G, (int)blockIdx.x, rank, count); if (rank >= 0) convert_jobs<J_D1 | J_WIN>(F, rank, count); }
        SEAM(1); }
    if (IN(2)) { GEMM_RESID(ACT, WS_WD1, DFF, F.in[I_X], SSQB, 0.5f); SEAM(2); }
    if (IN(3)) {
        pg8::Gemm g{XB, (const bf16*)(ws + WS_WINT), M, NIN, D}; pg8::StaticOrder S; S.init(M, NIN, F.G, (int)blockIdx.x);
        pg8::EpiZ E{SSQB, F.in[I_HLB], MIXA, (float*)(ws + WS_LOGF), (bf16*)(ws + WS_V), (bf16*)(ws + WS_SG), (bf16*)(ws + WS_LRX)};
        pg8::gemm_phase<pg8::EpiZ, pg8::StaticOrder, true, true>(F.lds + RING_OFF, g, S, E, F.wave);
        SEAM(3); }
    if (IN(4)) { MIXER_PHASE_4 SEAM(4); }
    if (IN(5)) { MIXER_PHASE_5 SEAM(5); }
    if (IN(6)) { MIXER_PHASE_6 SEAM(6); }
    if (IN(7)) { GEMM_RESID(MIXA, WS_WOUT, D, F.out, SSQA, 1.0f); SEAM(7); }
    if (IN(8)) { GEMM_SWIGLU(WS_WGU2);
        { int rank, count; side_workers((M / 256) * (NGU / 256), F.G, (int)blockIdx.x, rank, count);
          if (rank >= 0) {
              pg8::Gemm g{(const bf16*)(ws + WS_PB), (const bf16*)(ws + WS_WPROJ), M, D, PLE}; pg8::StaticOrder S; S.init(M, D, count, rank);
              pg8::EpiPP E{(bf16*)(ws + WS_PP)};
              pg8::gemm_phase<pg8::EpiPP, pg8::StaticOrder, true, true>(F.lds + RING_OFF, g, S, E, F.wave);
              convert_jobs<J_D2 | J_PG>(F, rank, count); } }
        SEAM(8); }
    if (IN(9)) { GEMM_RESID(ACT, WS_WD2, DFF, F.out, SSQB, 0.5f); SEAM(9); }
    if (IN(10)) {
        { pg8::Gemm g{XB, (const bf16*)(ws + WS_WPG), M, D, D}; pg8::StaticOrder S; S.init(M, D, F.G, (int)blockIdx.x);
          if (F.G == (M / 256) * (D / 256)) {
              pg8::EpiPLEFinal E{SSQB, F.in[I_PBG], (const bf16*)(ws + WS_PP), F.out, (float*)(ws + WS_XCH), (unsigned*)(F.ctl + CW_PANEL), F.in[I_FN]};
              pg8::gemm_phase<pg8::EpiPLEFinal, pg8::StaticOrder, false, true>(F.lds + RING_OFF, g, S, E, F.wave);
          } else {
              pg8::EpiPLE E{SSQB, F.in[I_PBG], (const bf16*)(ws + WS_PP), F.out, SSQA};
              pg8::gemm_phase<pg8::EpiPLE, pg8::StaticOrder, true, true>(F.lds + RING_OFF, g, S, E, F.wave); } }
        SEAM(10); }
    if (IN(11)) { if (F.G != (M / 256) * (D / 256)) final_norm(F, SSQA); SEAM(11); }
#undef IN
#undef SEAM
}

#if SIMPLE_HGRN
__global__ void __launch_bounds__(64) k_simple_hgrn(const float* logf, const bf16* mixa, const bf16* vv, float* oh) {
    __shared__ float sf[128], sk[128], sq[128];
    const int bh = blockIdx.x >> 1, vh = blockIdx.x & 1, b = bh >> 3, h = bh & 7, lane = threadIdx.x, v = vh * 64 + lane;
    float S[128];
#pragma unroll
    for (int k = 0; k < 128; ++k) S[k] = 0.f;
    for (int t = 0; t < SEQ; ++t) {
        const size_t row = (size_t)b * SEQ + t;
        for (int kk = lane; kk < 128; kk += 64) { const float f = __expf(logf[row * 1024 + h * 128 + kk]); sf[kk] = f; sk[kk] = 1.f - f; sq[kk] = bf2f(mixa[row * 2048 + h * 128 + kk]); }
        __syncthreads();
        const float vt = bf2f(vv[row * 1024 + h * 128 + v]); float o = 0.f;
#pragma unroll
        for (int k = 0; k < 128; ++k) { S[k] = sf[k] * S[k] + sk[k] * vt; o += S[k] * sq[k]; }
        oh[row * 1024 + h * 128 + v] = o;
        __syncthreads();
    }
}
__global__ void __launch_bounds__(256) k_simple_hnorm(const float* oh, const bf16* sg, const float* gn, bf16* mixa) {
    const int gw = (blockIdx.x * 256 + threadIdx.x) >> 6, lane = threadIdx.x & 63;
    if (gw >= M * HEADS) return;
    const int row = gw >> 3, h = gw & 7;
    const float o0 = oh[(size_t)row * 1024 + h * 128 + lane], o1 = oh[(size_t)row * 1024 + h * 128 + 64 + lane];
    const float ss = wave_sum(o0 * o0 + o1 * o1);
    const float r = 1.0f / sqrtf(ss * (1.0f / 128.0f) + EPS);
    mixa[(size_t)row * 2048 + h * 128 + lane] = (bf16)f2bf(o0 * r * gn[lane] * bf2f(sg[(size_t)row * 1024 + h * 128 + lane]));
    mixa[(size_t)row * 2048 + h * 128 + 64 + lane] = (bf16)f2bf(o1 * r * gn[64 + lane] * bf2f(sg[(size_t)row * 1024 + h * 128 + 64 + lane]));
}
#endif
#if SIMPLE_LRU
__global__ void __launch_bounds__(256) k_simple_lru_a(const bf16* lrx, const float* cw, const float* cb, const float* wa, const float* ba, const float* wx, const float* bx, const float* lam, float* LA, float* LU) {
    __shared__ float xc[1024];
    const int row = blockIdx.x, tt = row % SEQ, tid = threadIdx.x;
    for (int c = tid; c < 1024; c += 256) { float s = cb[c];
        for (int j = 0; j < 4; ++j) { const int ts = tt - 3 + j; if (ts >= 0) s += cw[j * 1024 + c] * bf2f(lrx[(size_t)(row - 3 + j) * 1024 + c]); }
        xc[c] = s; }
    __syncthreads();
    for (int d = tid; d < 1024; d += 256) { const int n = d >> 7, dd = d & 127; float r = ba[d], g = bx[d];
        for (int c = 0; c < 128; ++c) { const float x = xc[n * 128 + c]; r += x * wa[((size_t)n * 128 + c) * 128 + dd]; g += x * wx[((size_t)n * 128 + c) * 128 + dd]; }
        r = 1.0f / (1.0f + __expf(-r)); g = 1.0f / (1.0f + __expf(-g));
        const float log_a = -8.0f * r * log1pf(__expf(-lam[d]));
        LA[(size_t)row * 1024 + d] = __expf(log_a); LU[(size_t)row * 1024 + d] = sqrtf(-expm1f(2.0f * log_a)) * g * xc[d]; }
}
__global__ void __launch_bounds__(256) k_simple_lru_b(const float* LA, const float* LU, bf16* mixa) {
    const int gi = blockIdx.x * 256 + threadIdx.x, b = gi >> 10, c = gi & 1023; float h = 0.f;
#pragma unroll 8
    for (int t = 0; t < SEQ; ++t) { const size_t row = (size_t)b * SEQ + t; h = LA[row * 1024 + c] * h + LU[row * 1024 + c];
        bf16* p = mixa + row * 2048 + 1024 + c; *p = (bf16)f2bf(h * bf2f(*p)); }
}
#endif

extern "C" void kernel_launch(void* const* d_in, const int* in_sizes, int n_in, void* d_out, int out_size, void* d_ws, size_t ws_size, hipStream_t stream) {
    static int grid = 0;
    if (grid == 0) {
        if (n_in != N_IN || in_sizes[0] != M * D || out_size != M * D || ws_size < WS_END) { fprintf(stderr, "kernel_launch: unexpected problem (n_in %d, in0 %d, out %d, ws %zu); nothing launched\n", n_in, n_in > 0 ? in_sizes[0] : -1, out_size, ws_size); grid = -1; return; }
        int dev = 0, cus = 0, per_cu = 0;
        if (hipGetDevice(&dev) != hipSuccess || hipDeviceGetAttribute(&cus, hipDeviceAttributeMultiprocessorCount, dev) != hipSuccess) { grid = -1; return; }
        if (hipFuncSetAttribute((const void*)mega_fwd, hipFuncAttributeMaxDynamicSharedMemorySize, LDS_BYTES) != hipSuccess) { fprintf(stderr, "kernel_launch: hipFuncSetAttribute failed\n"); grid = -1; return; }
        if (hipOccupancyMaxActiveBlocksPerMultiprocessor(&per_cu, (const void*)mega_fwd, NWAVES * 64, LDS_BYTES) != hipSuccess || per_cu < 1)
            fprintf(stderr, "kernel_launch: note: occupancy query reports %d workgroups per CU\n", per_cu);
        (void)hipGetLastError();
        grid = cus;
    }
    if (grid < 0) return;
    if (hipMemsetAsync((char*)d_ws + WS_CTL, 0, CTL_ZERO_BYTES, stream) != hipSuccess) return;
    Args a{};
    for (int i = 0; i < N_IN; ++i) a.in[i] = (const float*)d_in[i];
    a.out = (float*)d_out; a.ws = (unsigned char*)d_ws;
    unsigned char* ws = (unsigned char*)d_ws;
    auto launch = [&](int lo, int hi, int li) { a.ph_lo = lo; a.ph_hi = hi; a.li = li; hipLaunchKernelGGL(mega_fwd, dim3(grid), dim3(NWAVES * 64), LDS_BYTES, stream, a); };
#if SIMPLE_HGRN || SIMPLE_LRU
    launch(0, 4, 0);
#if SIMPLE_HGRN
    {   float* OH = (float*)(ws + WS_XB);
        hipLaunchKernelGGL(k_simple_hgrn, dim3(64), dim3(64), 0, stream, (const float*)(ws + WS_LOGF), (const bf16*)(ws + WS_MIXA), (const bf16*)(ws + WS_V), OH);
        hipLaunchKernelGGL(k_simple_hnorm, dim3(M * HEADS / 4), dim3(256), 0, stream, (const float*)OH, (const bf16*)(ws + WS_SG), (const float*)d_in[I_HGN], (bf16*)(ws + WS_MIXA)); }
#endif
#if SIMPLE_LRU
    {   float* LA = (float*)(ws + WS_KVT); float* LU = LA + (size_t)M * 1024;
        hipLaunchKernelGGL(k_simple_lru_a, dim3(M), dim3(256), 0, stream, (const bf16*)(ws + WS_LRX), (const float*)d_in[I_CW], (const float*)d_in[I_CB], (const float*)d_in[I_LWA], (const float*)d_in[I_LBA],
                           (const float*)d_in[I_LWX], (const float*)d_in[I_LBX], (const float*)d_in[I_LAM], LA, LU);
        hipLaunchKernelGGL(k_simple_lru_b, dim3(BATCH * 1024 / 256), dim3(256), 0, stream, (const float*)LA, (const float*)LU, (bf16*)(ws + WS_MIXA)); }
#endif
    launch(4, N_PHASES, 1);
#else
#if N_LAUNCHES == 1
    launch(0, N_PHASES, 0);
#else
    for (int ph = 0; ph < N_PHASES; ++ph) launch(ph, ph + 1, 0);
#endif
#endif
}
```

```cpp
#include <hip/hip_runtime.h>
#include <cstdio>
#include <cstdint>
#ifndef SIMPLE_HGRN
#define SIMPLE_HGRN 0
#endif
#ifndef SIMPLE_LRU
#define SIMPLE_LRU 0
#endif
#ifndef N_LAUNCHES
#define N_LAUNCHES 1
#endif
#if SIMPLE_HGRN
#define MIXER_PHASE_4
#define MIXER_PHASE_6
#define MIXER_SCAN
#else
#define MIXER_PHASE_4 hgrn_local_phase(F);
#ifdef PROBE_H3
#define MIXER_PHASE_6 hgrn_out_phase(F, true); xcd_barrier(bar); hgrn_out_phase(F);
#else
#define MIXER_PHASE_6 hgrn_out_phase(F);
#endif
#ifdef PROBE_SCAN
#define MIXER_SCAN hgrn_scan_phase(F); xcd_barrier(bar); hgrn_scan_phase(F);
#else
#define MIXER_SCAN hgrn_scan_phase(F);
#endif
#endif
#if SIMPLE_LRU
#define MIXER_LRU
#else
#ifdef PROBE_LRU
#define MIXER_LRU lru_phase<PROBE_LRU>(F, true); xcd_barrier(bar); lru_phase<0>(F);
#else
#define MIXER_LRU lru_phase<0>(F);
#endif
#endif
#define MIXER_PHASE_5 MIXER_SCAN MIXER_LRU
namespace pg8 {
#define PG8_LAS __attribute__((address_space(3)))
typedef unsigned short bf16_t;
typedef short bf16x8 __attribute__((ext_vector_type(8)));
typedef float f32x4 __attribute__((ext_vector_type(4)));
typedef unsigned u32x4 __attribute__((ext_vector_type(4)));
constexpr int BM = 256, BK = 64, HALF = 128, HTB = HALF * BK * 2  , STAGE_BYTES = 8 * HTB, NXCD = 8, WGM = 8;

__host__ __device__ __forceinline__ int lds_byte(int r, int c) { const int st = (r >> 4) * 2 + (c >> 5), rr = r & 15, cc = c & 31, ob = rr * 64 + cc * 2; return st * 1024 + (ob ^ (((ob >> 9) & 1) << 5)); }
__host__ __device__ __forceinline__ void stage_rc(int b, int& R, int& C) { const int st = b / 1024, sb = b % 1024, swz = sb ^ (((sb >> 9) & 1) << 5); R = (st >> 1) * 16 + swz / 64; C = (st & 1) * 32 + (swz % 64) / 2; }
__host__ __device__ __forceinline__ int perm32(int rho) { const int n = rho >> 4, i = rho & 15; return 8 * (i >> 2) + 4 * n + (i & 3); }

struct Unit { int pm, pn; };
struct Gemm { const bf16_t* A; const bf16_t* Bt; int M, N, K; };

struct StaticOrder {
    int nM, nN, nwg, G, c;
    __host__ __device__ void init(int M, int N, int G_, int c_) { nM = M / BM; nN = N / BM; nwg = nM * nN; G = G_; c = c_; }
    __host__ __device__ bool next(int i, Unit& u) const {
        const long L = (long)i * G + c; if (L >= nwg) return false;
        int wgid = (int)L; { const int q = nwg / NXCD, r = nwg % NXCD, xcd = wgid % NXCD, off = wgid / NXCD; wgid = (xcd < r ? xcd * (q + 1) : r * (q + 1) + (xcd - r) * q) + off; }
        const int nig = WGM * nN, gid = wgid / nig, fm = gid * WGM, gsz = (nM - fm) < WGM ? (nM - fm) : WGM;
        u.pm = fm + ((wgid % nig) % gsz); u.pn = (wgid % nig) / gsz; return true;
    }
    __device__ __forceinline__ void a_ready(const Unit&) const {}
    __device__ __forceinline__ void done(const Unit&) const {}
};
__device__ __forceinline__ int lane_id_asm() { int l; asm volatile("v_mbcnt_lo_u32_b32 %0, -1, 0\n\tv_mbcnt_hi_u32_b32 %0, -1, %0" : "=v"(l)); return l; }
__device__ __forceinline__ unsigned cvt_pk_bf16(float lo, float hi) { unsigned r; asm volatile("v_cvt_pk_bf16_f32 %0, %1, %2" : "=v"(r) : "v"(lo), "v"(hi)); return r; }
typedef unsigned u32x2 __attribute__((ext_vector_type(2)));
constexpr int DM = 2048;
constexpr int NSSQ = 32;
__device__ __forceinline__ float sigmoid_f(float x) { return __builtin_amdgcn_rcpf(1.0f + __expf(-x)); }
__device__ __forceinline__ float silu_f(float x) { return x * sigmoid_f(x); }
__device__ __forceinline__ float gelu_tanh_f(float x) { return x * sigmoid_f(1.5957691216057308f * (x + 0.044715f * x * x * x)); }
__device__ __forceinline__ void rows_rstd(const float* ssq, int row0, int fq, float (&rs)[2][4]) {
    f32x4 pa[2][4], pb[2][4];
#pragma unroll
    for (int ai = 0; ai < 2; ++ai)
#pragma unroll
        for (int m = 0; m < 4; ++m) { const f32x4* p = (const f32x4*)(ssq + (size_t)(row0 + ai * HALF + m * 16) * NSSQ + fq * 8); pa[ai][m] = p[0]; pb[ai][m] = p[1]; }
#pragma unroll
    for (int ai = 0; ai < 2; ++ai)
#pragma unroll
        for (int m = 0; m < 4; ++m) { const f32x4 a = pa[ai][m], b = pb[ai][m];
            float s = ((a[0] + a[1]) + (a[2] + a[3])) + ((b[0] + b[1]) + (b[2] + b[3]));
            s += __shfl_xor(s, 16); s += __shfl_xor(s, 32);
            rs[ai][m] = 1.0f / sqrtf(s * (1.0f / (float)DM) + 1e-6f); }
}

struct EpiSwiGLU {
    static constexpr bool PERM = true, AFTER_DRAIN = false, INIT_ACC = false;
    bf16_t* O; int ldo; const float* ssq;
    __device__ __forceinline__ void operator()(const f32x4 (&acc)[2][2][4][2], const Unit& u, int wr, int wc, int fr, int fq) const {
        const int row0 = u.pm * BM + wr * 64 + fr, col0 = u.pn * HALF + wc * 32 + 8 * fq;
        float rs[2][4]; rows_rstd(ssq, row0, fq, rs);
#pragma unroll
        for (int ai = 0; ai < 2; ++ai)
#pragma unroll
            for (int m = 0; m < 4; ++m) {
                const int row = row0 + ai * HALF + m * 16; const float r = rs[ai][m];
                float h[8];
#pragma unroll
                for (int n = 0; n < 2; ++n)
#pragma unroll
                    for (int j = 0; j < 4; ++j) { const float g = acc[ai][0][m][n][j] * r, up = acc[ai][1][m][n][j] * r; h[n * 4 + j] = silu_f(g) * up; }
                u32x4 w; w.x = cvt_pk_bf16(h[0], h[1]); w.y = cvt_pk_bf16(h[2], h[3]); w.z = cvt_pk_bf16(h[4], h[5]); w.w = cvt_pk_bf16(h[6], h[7]);
                *(u32x4*)(O + (size_t)row * ldo + col0) = w;
            }
    }
};
struct EpiResid {
    static constexpr bool PERM = false, AFTER_DRAIN = false, INIT_ACC = false;
    const float* src; float* dst; bf16_t* xb; float* ssq_out; float scale;
    __device__ __forceinline__ void operator()(const f32x4 (&acc)[2][2][4][2], const Unit& u, int wr, int wc, int fr, int fq) const {
        const int row0 = u.pm * BM + wr * 64 + fr, col0 = u.pn * BM + wc * 32 + 4 * fq;
#pragma unroll
        for (int ai = 0; ai < 2; ++ai) {
            f32x4 sv[4][2][2];
#pragma unroll
            for (int m = 0; m < 4; ++m)
#pragma unroll
                for (int bj = 0; bj < 2; ++bj)
#pragma unroll
                    for (int n = 0; n < 2; ++n) sv[m][bj][n] = *(const f32x4*)(src + (size_t)(row0 + ai * HALF + m * 16) * DM + col0 + bj * HALF + n * 16);
#pragma unroll
            for (int m = 0; m < 4; ++m) {
                const int row = row0 + ai * HALF + m * 16; float ss = 0.f;
#pragma unroll
                for (int bj = 0; bj < 2; ++bj)
#pragma unroll
                    for (int n = 0; n < 2; ++n) { const size_t off = (size_t)row * DM + col0 + bj * HALF + n * 16;
                        const f32x4 o = sv[m][bj][n] + acc[ai][bj][m][n] * scale;
                        *(f32x4*)(dst + off) = o; u32x2 w; w.x = cvt_pk_bf16(o[0], o[1]); w.y = cvt_pk_bf16(o[2], o[3]); *(u32x2*)(xb + off) = w;
                        ss += (o[0] * o[0] + o[1] * o[1]) + (o[2] * o[2] + o[3] * o[3]); }
                ss += __shfl_xor(ss, 16); ss += __shfl_xor(ss, 32);
                if (fq == 0) ssq_out[(size_t)row * NSSQ + u.pn * 4 + wc] = ss;
            }
        }
    }
};
struct EpiResidInit {
    static constexpr bool PERM = false, AFTER_DRAIN = false, INIT_ACC = true;
    const float* src; float* dst; bf16_t* xb; float* ssq_out;
    __device__ __forceinline__ void init_acc(f32x4 (&acc)[2][2][4][2], const Unit& u, int wr, int wc, int fr, int fq) const {
        const int row0 = u.pm * BM + wr * 64 + fr, col0 = u.pn * BM + wc * 32 + 4 * fq;
#pragma unroll
        for (int ai = 0; ai < 2; ++ai)
#pragma unroll
            for (int m = 0; m < 4; ++m)
#pragma unroll
                for (int bj = 0; bj < 2; ++bj)
#pragma unroll
                    for (int n = 0; n < 2; ++n) acc[ai][bj][m][n] = *(const f32x4*)(src + (size_t)(row0 + ai * HALF + m * 16) * DM + col0 + bj * HALF + n * 16);
    }
    __device__ __forceinline__ void operator()(const f32x4 (&acc)[2][2][4][2], const Unit& u, int wr, int wc, int fr, int fq) const {
        const int row0 = u.pm * BM + wr * 64 + fr, col0 = u.pn * BM + wc * 32 + 4 * fq;
#pragma unroll
        for (int ai = 0; ai < 2; ++ai)
#pragma unroll
            for (int m = 0; m < 4; ++m) {
                const int row = row0 + ai * HALF + m * 16; float ss = 0.f;
#pragma unroll
                for (int bj = 0; bj < 2; ++bj)
#pragma unroll
                    for (int n = 0; n < 2; ++n) { const size_t off = (size_t)row * DM + col0 + bj * HALF + n * 16;
                        const f32x4 o = acc[ai][bj][m][n];
                        *(f32x4*)(dst + off) = o; u32x2 w; w.x = cvt_pk_bf16(o[0], o[1]); w.y = cvt_pk_bf16(o[2], o[3]); *(u32x2*)(xb + off) = w;
                        ss += (o[0] * o[0] + o[1] * o[1]) + (o[2] * o[2] + o[3] * o[3]); }
                ss += __shfl_xor(ss, 16); ss += __shfl_xor(ss, 32);
                if (fq == 0) ssq_out[(size_t)row * NSSQ + u.pn * 4 + wc] = ss;
            }
    }
};
struct EpiZ {
    static constexpr bool PERM = true, AFTER_DRAIN = false, INIT_ACC = false;
    const float* ssq; const float* hlb;
    bf16_t* mixa;
    float* logf; bf16_t* vv; bf16_t* sg; bf16_t* lrx;
    __device__ __forceinline__ void operator()(const f32x4 (&acc)[2][2][4][2], const Unit& u, int wr, int wc, int fr, int fq) const {
        const int seg = u.pn >> 2;
        const int row0 = u.pm * BM + wr * 64 + fr, cs0 = (u.pn & 3) * BM + wc * 32 + 8 * fq;
        float rs[2][4]; rows_rstd(ssq, row0, fq, rs);
        float lbv[2][8];
        if (seg == 1) {
#pragma unroll
            for (int bj = 0; bj < 2; ++bj)
#pragma unroll
                for (int e = 0; e < 8; ++e) { const int c = cs0 + bj * HALF + e; lbv[bj][e] = sigmoid_f(hlb[c] - hlb[1024 + c]); }
        }
#pragma unroll
        for (int ai = 0; ai < 2; ++ai)
#pragma unroll
            for (int m = 0; m < 4; ++m) {
                const int row = row0 + ai * HALF + m * 16; const float r = rs[ai][m];
#pragma unroll
                for (int bj = 0; bj < 2; ++bj) {
                    const int cs = cs0 + bj * HALF;
                    float z[8];
#pragma unroll
                    for (int n = 0; n < 2; ++n)
#pragma unroll
                        for (int j = 0; j < 4; ++j) z[n * 4 + j] = acc[ai][bj][m][n][j] * r;
                    if (seg == 1) {
                        float lf[8];
#pragma unroll
                        for (int e = 0; e < 8; ++e) { const float lb = lbv[bj][e]; lf[e] = __logf(lb + (1.0f - lb) * sigmoid_f(z[e])); }
                        float* p = logf + (size_t)row * 1024 + cs;
                        *(f32x4*)p = (f32x4){lf[0], lf[1], lf[2], lf[3]}; *(f32x4*)(p + 4) = (f32x4){lf[4], lf[5], lf[6], lf[7]};
                    } else {
                        if (seg == 3) {
#pragma unroll
                            for (int e = 0; e < 8; ++e) z[e] = silu_f(z[e]);
                        } else if (seg == 5) {
#pragma unroll
                            for (int e = 0; e < 8; ++e) z[e] = gelu_tanh_f(z[e]);
                        }
                        u32x4 w; w.x = cvt_pk_bf16(z[0], z[1]); w.y = cvt_pk_bf16(z[2], z[3]); w.z = cvt_pk_bf16(z[4], z[5]); w.w = cvt_pk_bf16(z[6], z[7]);
                        bf16_t* p;
                        if (seg == 0) p = mixa + (size_t)row * 2048 + cs;
                        else if (seg == 5) p = mixa + (size_t)row * 2048 + 1024 + cs;
                        else if (seg == 2) p = vv + (size_t)row * 1024 + cs;
                        else if (seg == 3) p = sg + (size_t)row * 1024 + cs;
                        else p = lrx + (size_t)row * 1024 + cs;
                        *(u32x4*)p = w;
                    }
                }
            }
    }
};
struct EpiPP {
    static constexpr bool PERM = false, AFTER_DRAIN = false, INIT_ACC = false;
    bf16_t* PP;
    __device__ __forceinline__ void operator()(const f32x4 (&acc)[2][2][4][2], const Unit& u, int wr, int wc, int fr, int fq) const {
        const int row0 = u.pm * BM + wr * 64 + fr, col0 = u.pn * BM + wc * 32 + 4 * fq;
#pragma unroll
        for (int ai = 0; ai < 2; ++ai)
#pragma unroll
            for (int m = 0; m < 4; ++m) { bf16_t* rowp = PP + (size_t)(row0 + ai * HALF + m * 16) * DM + col0;
#pragma unroll
                for (int bj = 0; bj < 2; ++bj)
#pragma unroll
                    for (int n = 0; n < 2; ++n) { const f32x4 a = acc[ai][bj][m][n]; u32x2 w; w.x = cvt_pk_bf16(a[0], a[1]); w.y = cvt_pk_bf16(a[2], a[3]); *(u32x2*)(rowp + bj * HALF + n * 16) = w; } }
    }
};
__device__ __forceinline__ f32x4 bf16x4_to_f32(u32x2 w) { f32x4 r; r[0] = __builtin_bit_cast(float, w.x << 16); r[1] = __builtin_bit_cast(float, w.x & 0xffff0000u); r[2] = __builtin_bit_cast(float, w.y << 16); r[3] = __builtin_bit_cast(float, w.y & 0xffff0000u); return r; }
struct EpiPLE {
    static constexpr bool PERM = false, AFTER_DRAIN = false, INIT_ACC = false;
    const float* ssq_in; const float* bg; const bf16_t* PP; float* X; float* ssq_out;
    __device__ __forceinline__ void operator()(const f32x4 (&acc)[2][2][4][2], const Unit& u, int wr, int wc, int fr, int fq) const {
        const int row0 = u.pm * BM + wr * 64 + fr, col0 = u.pn * BM + wc * 32 + 4 * fq;
        float rs[2][4]; rows_rstd(ssq_in, row0, fq, rs);
#pragma unroll
        for (int ai = 0; ai < 2; ++ai)
#pragma unroll
            for (int m = 0; m < 4; ++m) {
                const int row = row0 + ai * HALF + m * 16; const float r = rs[ai][m]; float ss = 0.f;
                f32x4 pv[2][2], ov[2][2];
#pragma unroll
                for (int bj = 0; bj < 2; ++bj)
#pragma unroll
                    for (int n = 0; n < 2; ++n) { const size_t off = (size_t)row * DM + col0 + bj * HALF + n * 16; pv[bj][n] = bf16x4_to_f32(*(const u32x2*)(PP + off)); ov[bj][n] = *(const f32x4*)(X + off); }
#pragma unroll
                for (int bj = 0; bj < 2; ++bj)
#pragma unroll
                    for (int n = 0; n < 2; ++n) { const int c = col0 + bj * HALF + n * 16; const size_t off = (size_t)row * DM + c;
                        const f32x4 b4 = *(const f32x4*)(bg + c), a = acc[ai][bj][m][n]; f32x4 o;
#pragma unroll
                        for (int j = 0; j < 4; ++j) o[j] = ov[bj][n][j] + sigmoid_f(a[j] * r + b4[j]) * pv[bj][n][j];
                        *(f32x4*)(X + off) = o; ss += (o[0] * o[0] + o[1] * o[1]) + (o[2] * o[2] + o[3] * o[3]); }
                ss += __shfl_xor(ss, 16); ss += __shfl_xor(ss, 32);
                if (fq == 0) ssq_out[(size_t)row * NSSQ + u.pn * 4 + wc] = ss;
            }
    }
};

struct EpiPLEFinal {
    static constexpr bool PERM = false, AFTER_DRAIN = true, INIT_ACC = false;
    const float* ssq_in; const float* bg; const bf16_t* PP; float* X; float* xch; unsigned* cnt; const float* gf;
    __device__ __forceinline__ void operator()(const f32x4 (&)[2][2][4][2], const Unit&, int, int, int, int) const {}
    __device__ __forceinline__ void fused(f32x4 (&acc)[2][2][4][2], const Unit& u, int wr, int wc, int fr, int fq, PG8_LAS unsigned char* lds, int wid, int lane) const {
        const int row0 = u.pm * BM + wr * 64 + fr, col0 = u.pn * BM + wc * 32 + 4 * fq;
        float rs[2][4]; rows_rstd(ssq_in, row0, fq, rs);
        f32x4 b4[2][2];
#pragma unroll
        for (int bj = 0; bj < 2; ++bj)
#pragma unroll
            for (int n = 0; n < 2; ++n) b4[bj][n] = *(const f32x4*)(bg + col0 + bj * HALF + n * 16);
#pragma unroll
        for (int ai = 0; ai < 2; ++ai)
#pragma unroll
          for (int mp = 0; mp < 2; ++mp) {
            u32x2 pv[2][2][2]; f32x4 ov[2][2][2];
#pragma unroll
            for (int mm = 0; mm < 2; ++mm)
#pragma unroll
                for (int bj = 0; bj < 2; ++bj)
#pragma unroll
                    for (int n = 0; n < 2; ++n) { const size_t off = (size_t)(row0 + ai * HALF + (2 * mp + mm) * 16) * DM + col0 + bj * HALF + n * 16; pv[mm][bj][n] = *(const u32x2*)(PP + off); ov[mm][bj][n] = *(const f32x4*)(X + off); }
#pragma unroll
            for (int mm = 0; mm < 2; ++mm) {
                const int m = 2 * mp + mm, row = row0 + ai * HALF + m * 16; const float r = rs[ai][m]; float ss = 0.f;
#pragma unroll
                for (int bj = 0; bj < 2; ++bj)
#pragma unroll
                    for (int n = 0; n < 2; ++n) { const f32x4 a = acc[ai][bj][m][n], pp = bf16x4_to_f32(pv[mm][bj][n]); f32x4 o;
#pragma unroll
                        for (int j = 0; j < 4; ++j) o[j] = ov[mm][bj][n][j] + sigmoid_f(a[j] * r + b4[bj][n][j]) * pp[j];
                        acc[ai][bj][m][n] = o; ss += (o[0] * o[0] + o[1] * o[1]) + (o[2] * o[2] + o[3] * o[3]); }
                ss += __shfl_xor(ss, 16); ss += __shfl_xor(ss, 32);
                if (fq == 0) __hip_atomic_store(xch + (size_t)row * NSSQ + u.pn * 4 + wc, ss, __ATOMIC_RELAXED, __HIP_MEMORY_SCOPE_AGENT);
            }
          }
        asm volatile("s_waitcnt vmcnt(0)" ::: "memory");
        unsigned* pc = cnt + 64 * u.pm;
        if (lane == 0) __hip_atomic_fetch_add(pc, 1u, __ATOMIC_RELAXED, __HIP_MEMORY_SCOPE_AGENT);
        if (wid == 0) {
            unsigned sp = 0;
            while ((unsigned)__builtin_amdgcn_readfirstlane(__hip_atomic_load(pc, __ATOMIC_RELAXED, __HIP_MEMORY_SCOPE_AGENT)) < 64u) { __builtin_amdgcn_s_sleep(2); if (++sp > (1u << 22)) break; }
            __builtin_amdgcn_fence(__ATOMIC_ACQUIRE, "agent");
        }
        asm volatile("s_waitcnt vmcnt(0) lgkmcnt(0)" ::: "memory"); __builtin_amdgcn_s_barrier(); asm volatile("" ::: "memory");
        float r4[2][4]; rows_rstd(xch, row0, fq, r4);
        f32x4 g4[2][2];
#pragma unroll
        for (int bj = 0; bj < 2; ++bj)
#pragma unroll
            for (int n = 0; n < 2; ++n) g4[bj][n] = *(const f32x4*)(gf + col0 + bj * HALF + n * 16);
#pragma unroll
        for (int ai = 0; ai < 2; ++ai)
#pragma unroll
            for (int m = 0; m < 4; ++m) { float* rowp = X + (size_t)(row0 + ai * HALF + m * 16) * DM + col0; const float r = r4[ai][m];
#pragma unroll
                for (int bj = 0; bj < 2; ++bj)
#pragma unroll
                    for (int n = 0; n < 2; ++n) *(f32x4*)(rowp + bj * HALF + n * 16) = acc[ai][bj][m][n] * r * g4[bj][n]; }
    }
};

template <class Epi, class Sched, bool ALIGN_EPI = false, bool SP2 = false, bool BAL = false>
__device__ __forceinline__ void gemm_phase(PG8_LAS unsigned char* lds, const Gemm g, const Sched& S, const Epi& E, const int wave_s) {
    int tid_ = wave_s * 64 + lane_id_asm();
    const int tid = tid_, wid = wave_s, lane = tid & 63, wr = wid >> 2, wc = wid & 3, fr = lane & 15, fq = lane >> 4;
    const int K = g.K, nt = K / BK;
    unsigned voffA[2], voffB[2];
#pragma unroll
    for (int i = 0; i < 2; ++i) { int R, C; stage_rc(tid * 16 + i * 8192, R, C); const int Rb = Epi::PERM ? ((R & ~31) + perm32(R & 31)) : R;
        voffA[i] = (unsigned)(R * K + C) * 2u; voffB[i] = (unsigned)(Rb * K + C) * 2u; }
    const size_t kstep = (size_t)(BK * 2);
    const size_t hstep = (size_t)HALF * K * 2;
    const size_t tstep = 2 * hstep;
    const unsigned ldsw = (unsigned)wid * 1024u;
    const int aoff = lds_byte(wr * 64 + fr, fq * 8), boff = lds_byte(wc * 32 + fr, fq * 8);
#define PG8_SA(b, h) (((b) * 2 + (h)) * HTB)
#define PG8_SB(b, h) ((4 + (b) * 2 + (h)) * HTB)
#define PG8_STAGE(bufoff, gbase, voff) do { _Pragma("unroll") for (int _i = 0; _i < 2; ++_i) \
        __builtin_amdgcn_global_load_lds((const unsigned*)((const char*)(gbase) + (voff)[_i]), (PG8_LAS unsigned*)(lds + (bufoff) + ldsw + _i * 8192), 16, 0, 0); } while (0)
#define PG8_LDA(dst, b, h) do { _Pragma("unroll") for (int m = 0; m < 4; ++m) _Pragma("unroll") for (int k = 0; k < 2; ++k) dst[m][k] = *(const PG8_LAS bf16x8*)(lds + PG8_SA(b, h) + aoff + m * 2048 + k * 1024); } while (0)
#define PG8_LDB(dst, b, h) do { _Pragma("unroll") for (int n = 0; n < 2; ++n) _Pragma("unroll") for (int k = 0; k < 2; ++k) dst[n][k] = *(const PG8_LAS bf16x8*)(lds + PG8_SB(b, h) + boff + n * 2048 + k * 1024); } while (0)
#define PG8_MMA(ai, bj, At, Bt) do { __builtin_amdgcn_s_setprio(1); _Pragma("unroll") for (int m = 0; m < 4; ++m) _Pragma("unroll") for (int n = 0; n < 2; ++n) _Pragma("unroll") for (int k = 0; k < 2; ++k) \
        acc[ai][bj][m][n] = __builtin_amdgcn_mfma_f32_16x16x32_bf16(Bt[n][k], At[m][k], acc[ai][bj][m][n], 0, 0, 0); __builtin_amdgcn_s_setprio(0); } while (0)
#define PG8_WAIT_V(n) asm volatile("s_waitcnt vmcnt(" #n ")" ::: "memory")
#define PG8_WAIT_L(n) asm volatile("s_waitcnt lgkmcnt(" #n ")" ::: "memory")
#define PG8_BAR __builtin_amdgcn_s_barrier()
#define PG8_SCHED __builtin_amdgcn_sched_barrier(0)
    Unit cur, nxt; int ui = 0;
    if (!S.next(0, cur)) return;
    f32x4 acc[2][2][4][2];
    if constexpr (Epi::INIT_ACC) { E.init_acc(acc, cur, wr, wc, fr, fq); }
    else {
#pragma unroll
    for (int a = 0; a < 2; ++a)
#pragma unroll
        for (int b = 0; b < 2; ++b)
#pragma unroll
            for (int m = 0; m < 4; ++m)
#pragma unroll
                for (int n = 0; n < 2; ++n) acc[a][b][m][n] = (f32x4){0.f, 0.f, 0.f, 0.f};
    }
    bf16x8 At[4][2], B0[2][2], B1[2][2];
    const char* cA = (const char*)g.A + (size_t)cur.pm * tstep; const char* cB = (const char*)g.Bt + (size_t)cur.pn * tstep;
    S.a_ready(cur);
    if constexpr (SP2) {
        PG8_STAGE(PG8_SB(0, 0), cB, voffB); PG8_STAGE(PG8_SB(0, 1), cB + hstep, voffB); PG8_STAGE(PG8_SA(0, 0), cA, voffA); PG8_STAGE(PG8_SA(0, 1), cA + hstep, voffA);
        if (wr == 1) PG8_BAR;
        PG8_WAIT_V(2); PG8_BAR;
        if constexpr (BAL) {
            PG8_STAGE(PG8_SB(1, 0), cB + kstep, voffB); PG8_STAGE(PG8_SB(1, 1), cB + hstep + kstep, voffB);
            PG8_WAIT_V(4); PG8_BAR;
        } else {
        PG8_STAGE(PG8_SB(1, 0), cB + kstep, voffB); PG8_STAGE(PG8_SA(1, 0), cA + kstep, voffA); PG8_STAGE(PG8_SB(1, 1), cB + hstep + kstep, voffB);
        PG8_WAIT_V(6); PG8_BAR;
        }
    } else {
        PG8_STAGE(PG8_SB(0, 0), cB, voffB); PG8_STAGE(PG8_SA(0, 0), cA, voffA); PG8_STAGE(PG8_SB(0, 1), cB + hstep, voffB); PG8_STAGE(PG8_SA(0, 1), cA + hstep, voffA);
        if (wr == 1) PG8_BAR;
        PG8_WAIT_V(4); PG8_BAR;
        PG8_STAGE(PG8_SB(1, 0), cB + kstep, voffB); PG8_STAGE(PG8_SA(1, 0), cA + kstep, voffA); PG8_STAGE(PG8_SB(1, 1), cB + hstep + kstep, voffB);
        PG8_WAIT_V(6); PG8_BAR;
    }
    for (;;) {
        const bool has_next = S.next(ui + 1, nxt);
        const char* nA = has_next ? (const char*)g.A + (size_t)nxt.pm * tstep : cA; const char* nB = has_next ? (const char*)g.Bt + (size_t)nxt.pn * tstep : cB;
        for (int t = 0; t < nt; t += 2) {
            const bool last = (t == nt - 2);
            const char* a1 = cA + (size_t)(t + 1) * kstep;
            const char* a2 = last ? nA : cA + (size_t)(t + 2) * kstep; const char* b2 = last ? nB : cB + (size_t)(t + 2) * kstep;
            const char* a3 = a2 + kstep; const char* b3 = b2 + kstep;
            if (last && has_next) S.a_ready(nxt);
            if constexpr (SP2 && BAL) {
            PG8_LDB(B0, 0, 0); PG8_LDB(B1, 0, 1); PG8_SCHED; PG8_LDA(At, 0, 0); PG8_STAGE(PG8_SA(1, 0), a1, voffA); PG8_STAGE(PG8_SA(1, 1), a1 + hstep, voffA);
            PG8_WAIT_V(4); PG8_WAIT_L(0); PG8_BAR; PG8_MMA(0, 0, At, B0); PG8_MMA(0, 1, At, B1); PG8_BAR; PG8_SCHED;
            PG8_LDA(At, 0, 1); PG8_STAGE(PG8_SB(0, 0), b2, voffB); PG8_STAGE(PG8_SB(0, 1), b2 + hstep, voffB);
            PG8_WAIT_V(4); PG8_WAIT_L(0); PG8_BAR; PG8_MMA(1, 0, At, B0); PG8_MMA(1, 1, At, B1); PG8_BAR; PG8_SCHED;
            PG8_LDB(B0, 1, 0); PG8_LDB(B1, 1, 1); PG8_SCHED; PG8_LDA(At, 1, 0); PG8_STAGE(PG8_SA(0, 0), a2, voffA); PG8_STAGE(PG8_SA(0, 1), a2 + hstep, voffA);
            PG8_WAIT_V(4); PG8_WAIT_L(0); PG8_BAR; PG8_MMA(0, 0, At, B0); PG8_MMA(0, 1, At, B1); PG8_BAR; PG8_SCHED;
            PG8_LDA(At, 1, 1); PG8_STAGE(PG8_SB(1, 0), b3, voffB); PG8_STAGE(PG8_SB(1, 1), b3 + hstep, voffB);
            PG8_WAIT_V(4); PG8_WAIT_L(0); PG8_BAR; PG8_MMA(1, 0, At, B0); PG8_MMA(1, 1, At, B1); PG8_BAR; PG8_SCHED;
            } else if constexpr (SP2) {
            PG8_LDB(B0, 0, 0); PG8_LDB(B1, 0, 1); PG8_SCHED; PG8_LDA(At, 0, 0); PG8_STAGE(PG8_SA(1, 1), a1 + hstep, voffA);
            PG8_WAIT_V(8); PG8_WAIT_L(0); PG8_BAR; PG8_MMA(0, 0, At, B0); PG8_MMA(0, 1, At, B1); PG8_BAR; PG8_SCHED;
            PG8_LDA(At, 0, 1); PG8_STAGE(PG8_SB(0, 0), b2, voffB); PG8_STAGE(PG8_SB(0, 1), b2 + hstep, voffB); PG8_STAGE(PG8_SA(0, 0), a2, voffA);
            PG8_WAIT_V(8); PG8_WAIT_L(0); PG8_BAR; PG8_MMA(1, 0, At, B0); PG8_MMA(1, 1, At, B1); PG8_BAR; PG8_SCHED;
            PG8_LDB(B0, 1, 0); PG8_LDB(B1, 1, 1); PG8_SCHED; PG8_LDA(At, 1, 0); PG8_STAGE(PG8_SA(0, 1), a2 + hstep, voffA);
            PG8_WAIT_V(8); PG8_WAIT_L(0); PG8_BAR; PG8_MMA(0, 0, At, B0); PG8_MMA(0, 1, At, B1); PG8_BAR; PG8_SCHED;
            PG8_LDA(At, 1, 1); PG8_STAGE(PG8_SB(1, 0), b3, voffB); PG8_STAGE(PG8_SB(1, 1), b3 + hstep, voffB); PG8_STAGE(PG8_SA(1, 0), a3, voffA);
            PG8_WAIT_V(8); PG8_WAIT_L(0); PG8_BAR; PG8_MMA(1, 0, At, B0); PG8_MMA(1, 1, At, B1); PG8_BAR; PG8_SCHED;
            } else {
            PG8_LDB(B0, 0, 0); PG8_SCHED; PG8_LDA(At, 0, 0); PG8_STAGE(PG8_SA(1, 1), a1 + hstep, voffA);
            PG8_WAIT_L(8); PG8_BAR; PG8_WAIT_L(0); PG8_MMA(0, 0, At, B0); PG8_BAR; PG8_SCHED;
            PG8_LDB(B1, 0, 1); PG8_STAGE(PG8_SB(0, 0), b2, voffB);
            PG8_BAR; PG8_WAIT_L(0); PG8_MMA(0, 1, At, B1); PG8_BAR;
            PG8_LDA(At, 0, 1); PG8_STAGE(PG8_SA(0, 0), a2, voffA);
            PG8_BAR; PG8_WAIT_L(0); PG8_MMA(1, 0, At, B0); PG8_BAR; PG8_SCHED;
            PG8_STAGE(PG8_SB(0, 1), b2 + hstep, voffB);
            PG8_WAIT_V(6); PG8_BAR; PG8_MMA(1, 1, At, B1); PG8_BAR;
            PG8_LDB(B0, 1, 0); PG8_SCHED; PG8_LDA(At, 1, 0); PG8_STAGE(PG8_SA(0, 1), a2 + hstep, voffA);
            PG8_WAIT_L(8); PG8_BAR; PG8_WAIT_L(0); PG8_MMA(0, 0, At, B0); PG8_BAR; PG8_SCHED;
            PG8_LDB(B1, 1, 1); PG8_STAGE(PG8_SB(1, 0), b3, voffB);
            PG8_BAR; PG8_WAIT_L(0); PG8_MMA(0, 1, At, B1); PG8_BAR;
            PG8_LDA(At, 1, 1); PG8_STAGE(PG8_SA(1, 0), a3, voffA);
            PG8_BAR; PG8_WAIT_L(0); PG8_MMA(1, 0, At, B0); PG8_BAR; PG8_SCHED;
            PG8_STAGE(PG8_SB(1, 1), b3 + hstep, voffB);
            PG8_WAIT_V(6); PG8_BAR; PG8_MMA(1, 1, At, B1); PG8_BAR;
            }
        }
        if constexpr (ALIGN_EPI) { if (wr == 0) PG8_BAR; }
        if constexpr (!Epi::AFTER_DRAIN) { E(acc, cur, wr, wc, fr, fq); S.done(cur); }
        if (!has_next) break;
#pragma unroll
        for (int a = 0; a < 2; ++a)
#pragma unroll
            for (int b = 0; b < 2; ++b)
#pragma unroll
                for (int m = 0; m < 4; ++m)
#pragma unroll
                    for (int n = 0; n < 2; ++n) acc[a][b][m][n] = (f32x4){0.f, 0.f, 0.f, 0.f};
        cur = nxt; cA = nA; cB = nB; ++ui;
        if constexpr (ALIGN_EPI) { if (wr == 1) PG8_BAR; }
    }
    PG8_WAIT_V(0);
    if constexpr (!ALIGN_EPI) { if (wr == 0) PG8_BAR; }
    PG8_BAR;
    if constexpr (Epi::AFTER_DRAIN) { E.fused(acc, cur, wr, wc, fr, fq, lds, wid, lane); S.done(cur); }
#undef PG8_SA
#undef PG8_SB
#undef PG8_STAGE
#undef PG8_LDA
#undef PG8_LDB
#undef PG8_MMA
#undef PG8_WAIT_V
#undef PG8_WAIT_L
#undef PG8_BAR
#undef PG8_SCHED
}
}
#define GAS __attribute__((address_space(1)))
#define LAS __attribute__((address_space(3)))
typedef unsigned short bf16;
typedef unsigned v4u __attribute__((ext_vector_type(4)));
typedef float f32x4 __attribute__((ext_vector_type(4)));
typedef short bf16x8 __attribute__((ext_vector_type(8)));
typedef GAS unsigned gu32;
typedef GAS unsigned long long gu64;
#define RLX_AGENT __ATOMIC_RELAXED, __HIP_MEMORY_SCOPE_AGENT
#define LDS_WAIT() asm volatile("s_waitcnt lgkmcnt(0)" ::: "memory")
#define VM_WAIT() asm volatile("s_waitcnt vmcnt(0)" ::: "memory")
__device__ __forceinline__ unsigned long long rt() { return __builtin_amdgcn_s_memrealtime(); }
__device__ __forceinline__ unsigned f2bf(float f) { unsigned u = __builtin_bit_cast(unsigned, f); return (u + 0x7fffu + ((u >> 16) & 1u)) >> 16; }
__device__ __forceinline__ unsigned pk2(float lo, float hi) { return f2bf(lo) | (f2bf(hi) << 16); }

#define XB_TMO      128
#define XB_XCNT(j)  (256  + 64 * (j))
#define XB_XSUB(j)  (1280 + 64 * (j))
#define XB_XGEN(j)  (2304 + 64 * (j))
#define XB_TOP      3328
#define XB_TOPGEN   3392
#define XCD_BAR_WORDS 3456
#define XB_SPIN_CAP (1u << 18)

__device__ __forceinline__ unsigned xb_ld(unsigned* p)              { return __hip_atomic_load(p, __ATOMIC_RELAXED, __HIP_MEMORY_SCOPE_AGENT); }
__device__ __forceinline__ unsigned xb_add(unsigned* p, unsigned v) { return __hip_atomic_fetch_add(p, v, __ATOMIC_RELAXED, __HIP_MEMORY_SCOPE_AGENT); }
__device__ __forceinline__ unsigned xb_xcc_id() { return (unsigned)__builtin_amdgcn_s_getreg((3 << 11) | 20) & 0xFu; }
#define XB_SPIN(cond, bar) do { unsigned _sp = 0; while (cond) { __builtin_amdgcn_s_sleep(1); \
    if ((++_sp & 255u) == 0u) { if (xb_ld(&(bar)[XB_TMO])) break; if (_sp > XB_SPIN_CAP) { atomicAdd(&(bar)[XB_TMO], 1u); break; } } } } while (0)

struct XcdBarrier {
    unsigned* bar; unsigned x; int wave;
    volatile LAS unsigned* st;
};

__device__ __forceinline__ XcdBarrier xcd_barrier_post(unsigned* bar, volatile LAS unsigned* st, int wave) {
    XcdBarrier b; b.bar = bar; b.x = xb_xcc_id(); b.st = st; b.wave = wave;
    if (wave == 0 && pg8::lane_id_asm() == 0) (void)xb_add(&bar[XB_XCNT(b.x)], 1u);
    return b;
}
__device__ __forceinline__ void xcd_barrier_complete(unsigned* bar, unsigned x, unsigned& nloc, unsigned& nx) {
    const unsigned G = gridDim.x * gridDim.y * gridDim.z;
    unsigned sum, cnt, mine, sp = 0u;
    for (;;) {
        sum = 0u; cnt = 0u; mine = 0u;
#pragma unroll
        for (unsigned j = 0; j < 16; ++j) { const unsigned c = xb_ld(&bar[XB_XCNT(j)]); sum += c; cnt += (c > 0u) ? 1u : 0u; mine = (j == x) ? c : mine; }
        if (sum == G) break;
        __builtin_amdgcn_s_sleep(1);
        if ((++sp & 255u) == 0u) { if (xb_ld(&bar[XB_TMO])) break; if (sp > XB_SPIN_CAP) { atomicAdd(&bar[XB_TMO], 1u); break; } }
    }
    nloc = mine > 0u ? mine : 1u; nx = cnt > 0u ? cnt : 1u;
}

__device__ __forceinline__ void xcd_barrier(const XcdBarrier& b) {
    asm volatile("s_waitcnt vmcnt(0)" ::: "memory");
    __syncthreads();
    if (b.wave == 0 && pg8::lane_id_asm() == 0) {
        unsigned* bar = b.bar;
        __builtin_amdgcn_s_waitcnt(0);
        unsigned nloc = b.st[0], nx = b.st[1];
        if (nloc == 0u) { xcd_barrier_complete(bar, b.x, nloc, nx); b.st[0] = nloc; b.st[1] = nx; }
        const unsigned old = xb_add(&bar[XB_XSUB(b.x)], 1u);
        const unsigned gen = old / nloc;
        if (old + 1u == (gen + 1u) * nloc) {
            __builtin_amdgcn_fence(__ATOMIC_RELEASE, "agent");
            asm volatile("s_waitcnt vmcnt(0)" ::: "memory");
            const unsigned og = xb_add(&bar[XB_TOP], 1u);
            const unsigned tg = og / nx;
            if (og + 1u == (tg + 1u) * nx) xb_add(&bar[XB_TOPGEN], 1u);
            else XB_SPIN(xb_ld(&bar[XB_TOPGEN]) == tg, bar);
            __builtin_amdgcn_fence(__ATOMIC_ACQUIRE, "agent");
            xb_add(&bar[XB_XGEN(b.x)], 1u);
            asm volatile("s_waitcnt vmcnt(0)" ::: "memory");
        } else {
            XB_SPIN(xb_ld(&bar[XB_XGEN(b.x)]) == gen, bar);
            __builtin_amdgcn_fence(__ATOMIC_ACQUIRE, "agent");
            asm volatile("s_waitcnt vmcnt(0)" ::: "memory");
        }
    }
    __syncthreads();
}

constexpr int NWAVES = 8;
constexpr int BATCH = 4, SEQ = 2048, D = 2048, DFF = 5632, NGU = 2 * DFF, NIN = 6144, PLE = 256;
constexpr int HW = 1024, LW = 1024, HEADS = 8, HD = 128, CHUNK = 64, NCH = SEQ / CHUNK;
constexpr int M = BATCH * SEQ;
constexpr float EPS = 1e-6f;
constexpr int N_IN = 27;
enum In { I_X = 0, I_P, I_F1N, I_F1G, I_F1U, I_F1D, I_MIXN, I_WIN, I_HLB, I_HGN, I_CW, I_CB, I_LWA, I_LBA, I_LWX, I_LBX, I_LAM, I_WOUT,
          I_F2N, I_F2G, I_F2U, I_F2D, I_PLN, I_PWG, I_PBG, I_PWP, I_FN };

constexpr size_t MiB = 1u << 20;
constexpr size_t WS_CTL = 0, CTL_ZERO_BYTES = 1 * MiB;
constexpr size_t WS_SSQA = 1 * MiB, WS_SSQB = 2 * MiB, WS_DEC = 3 * MiB;
constexpr size_t WS_WAT = 3 * MiB + 512 * 1024, WS_WXT = 3 * MiB + 768 * 1024;
constexpr size_t WS_WPROJ = 4 * MiB, WS_PB = 5 * MiB;
constexpr size_t WS_WGU1 = 9 * MiB, WS_WD1 = 53 * MiB, WS_WINT = 75 * MiB, WS_WOUT = 99 * MiB, WS_WGU2 = 107 * MiB, WS_WD2 = 151 * MiB, WS_WPG = 173 * MiB;
constexpr size_t WS_XB = 181 * MiB;
constexpr size_t WS_ACT = 213 * MiB;
constexpr size_t WS_LOGF = WS_ACT, WS_V = WS_ACT + 32 * MiB, WS_SG = WS_ACT + 48 * MiB, WS_LRX = WS_ACT + 64 * MiB, WS_PP = 333 * MiB;
constexpr size_t WS_MIXA = 301 * MiB;
constexpr size_t WS_KVT = 333 * MiB;
constexpr size_t WS_XCH = 397 * MiB;
constexpr size_t WS_WAJ = 398 * MiB, WS_WXJ = 399 * MiB;
constexpr size_t WS_BA2 = 400 * MiB;
constexpr size_t WS_END = 401 * MiB;
static_assert(WS_WGU1 + (size_t)NGU * D * 2 <= WS_WD1 && WS_WD1 + (size_t)D * DFF * 2 <= WS_WINT && WS_WINT + (size_t)NIN * D * 2 <= WS_WOUT && WS_WOUT + (size_t)D * D * 2 <= WS_WGU2 &&
              WS_WGU2 + (size_t)NGU * D * 2 <= WS_WD2 && WS_WD2 + (size_t)D * DFF * 2 <= WS_WPG && WS_WPG + (size_t)D * D * 2 <= WS_XB && WS_XB + (size_t)M * D * 2 <= WS_ACT &&
              WS_ACT + (size_t)M * DFF * 2 <= WS_MIXA && WS_MIXA + (size_t)M * 2048 * 2 <= WS_KVT && WS_KVT + (size_t)BATCH * HEADS * NCH * HD * HD * 4 <= WS_XCH &&
              WS_LRX + (size_t)M * 1024 * 2 <= WS_MIXA && WS_PP + (size_t)M * D * 4 <= 397 * MiB && WS_PB + (size_t)M * PLE * 2 <= WS_WGU1 && WS_WPROJ + (size_t)D * PLE * 2 <= WS_PB, "d_ws map");
constexpr int CW_PANEL = 16384;
constexpr int CW_BAR = 4096;

constexpr int RING_OFF = 0, RING_BYTES = 131072;
constexpr int LDSCTL_OFF = 147456 - 512, MISC_OFF = LDSCTL_OFF + 320;
constexpr int LDS_BYTES = 147456;
static_assert(MISC_OFF + 128 <= LDS_BYTES, "LDS map");


struct Frame {
    LAS unsigned char* lds;
    volatile LAS unsigned* MISC;
    gu32* ctl;
    int wave;
    int vcu, G;
    const float* in[N_IN]; float* out; unsigned char* ws;
};
__device__ __forceinline__ float bf2f(bf16 b) { return __builtin_bit_cast(float, (unsigned)b << 16); }
__device__ __forceinline__ float wave_sum(float v) {
#pragma unroll
    for (int o = 1; o < 64; o <<= 1) v += __shfl_xor(v, o);
    return v;
}
__device__ __forceinline__ void p0_transpose_item(const float* W, int ldw, int K, int src_col0, bf16* WT, int dst_row0, const float* gain, LAS float* scr, int kb, int lane, float wscale = 1.0f) {
    const int k0 = 64 * kb, kq = lane >> 4, nq = lane & 15;
    f32x4 v[16];
#pragma unroll
    for (int i = 0; i < 16; ++i) v[i] = __builtin_nontemporal_load((const GAS f32x4*)(W + (size_t)(k0 + 4 * i + kq) * ldw + src_col0 + 4 * nq));
    if (gain) {
#pragma unroll
        for (int i = 0; i < 16; ++i) v[i] = v[i] * gain[k0 + 4 * i + kq];
    }
    if (wscale != 1.0f) {
#pragma unroll
        for (int i = 0; i < 16; ++i) v[i] = v[i] * wscale;
    }
#pragma unroll
    for (int i = 0; i < 16; ++i) { LAS float* s = scr + (4 * i + kq) * 65 + 4 * nq; s[0] = v[i].x; s[1] = v[i].y; s[2] = v[i].z; s[3] = v[i].w; }
    LDS_WAIT(); asm volatile("" ::: "memory");
    const int c = lane & 7;
#pragma unroll
    for (int j = 0; j < 8; ++j) { const int n = (lane >> 3) + 8 * j; const LAS float* s = scr + (8 * c) * 65 + n;
        v4u o; o.x = pk2(s[0 * 65], s[1 * 65]); o.y = pk2(s[2 * 65], s[3 * 65]); o.z = pk2(s[4 * 65], s[5 * 65]); o.w = pk2(s[6 * 65], s[7 * 65]);
        *(GAS v4u*)(WT + (size_t)(dst_row0 + n) * K + k0 + 8 * c) = o; }
    LDS_WAIT(); asm volatile("" ::: "memory");
}
__device__ __forceinline__ bool p0_plain(int& r, const float* W, int K, int N, bf16* WT, const float* gain, LAS float* scr, int lane, float wscale = 1.0f) {
    const int items = (N / 64) * (K / 64);
    if (r < items) { const int nb = r / (K / 64), kb = r % (K / 64); p0_transpose_item(W, N, K, 64 * nb, WT, 64 * nb, gain, scr, kb, lane, wscale); return true; }
    r -= items; return false;
}
__device__ __forceinline__ bool p0_gateup(int& r, const float* Wg, const float* Wu, bf16* WT, const float* gain, LAS float* scr, int lane) {
    const int items = (NGU / 64) * (D / 64);
    if (r < items) { const int rb = r / (D / 64), kb = r % (D / 64), t = rb >> 2, j = rb & 3;
        p0_transpose_item(j < 2 ? Wg : Wu, DFF, D, 128 * t + 64 * (j & 1), WT, 64 * rb, gain, scr, kb, lane); return true; }
    r -= items; return false;
}
enum { J_X = 1, J_P = 2, J_GU1 = 4, J_D1 = 8, J_WIN = 16, J_WOUT = 32, J_GU2 = 64, J_D2 = 128, J_PG = 256, J_PROJ = 512, J_AX = 1024 };
template <int JOBS>
__device__ __forceinline__ void convert_jobs(Frame& F, int rank, int count) {
    const int lane_ = pg8::lane_id_asm(), wave_ = F.wave;
    LAS float* scr = (LAS float*)(F.lds + RING_OFF + wave_ * 16640);
    const int gw = rank * NWAVES + wave_, NGW = count * NWAVES;
    unsigned char* ws = F.ws;
    if (JOBS & J_X) {
        for (int m = gw; m < M; m += NGW) {
            const GAS f32x4* xr = (const GAS f32x4*)(F.in[I_X] + (size_t)m * D) + lane_;
            GAS unsigned long long* o8 = (GAS unsigned long long*)((bf16*)(ws + WS_XB) + (size_t)m * D) + lane_;
            float s = 0.f;
#pragma unroll
            for (int j = 0; j < 8; ++j) { const f32x4 v = __builtin_nontemporal_load(xr + 64 * j); s += (v.x * v.x + v.y * v.y) + (v.z * v.z + v.w * v.w);
                o8[64 * j] = (unsigned long long)pk2(v.x, v.y) | ((unsigned long long)pk2(v.z, v.w) << 32); }
            s = wave_sum(s);
            if (lane_ < 32) ((float*)(ws + WS_SSQA))[(size_t)m * 32 + lane_] = (lane_ == 0) ? s : 0.f;
        }
    }
    if (JOBS & J_P) {
        for (int m = gw; m < M; m += NGW) {
            const f32x4 v = __builtin_nontemporal_load((const GAS f32x4*)(F.in[I_P] + (size_t)m * PLE) + lane_);
            ((GAS unsigned long long*)((bf16*)(ws + WS_PB) + (size_t)m * PLE))[lane_] = (unsigned long long)pk2(v.x, v.y) | ((unsigned long long)pk2(v.z, v.w) << 32);
        }
    }
    constexpr int I_GU = (NGU / 64) * (D / 64), I_DD = (D / 64) * (DFF / 64), I_IN = (NIN / 64) * (D / 64), I_SQ = (D / 64) * (D / 64), I_PJ = (D / 64) * (PLE / 64), I_AX = 16 * 4 * 4;
    constexpr int NITEMS = ((JOBS & J_GU1) ? I_GU : 0) + ((JOBS & J_D1) ? I_DD : 0) + ((JOBS & J_WIN) ? I_IN : 0) + ((JOBS & J_WOUT) ? I_SQ : 0) + ((JOBS & J_GU2) ? I_GU : 0) +
                           ((JOBS & J_D2) ? I_DD : 0) + ((JOBS & J_PG) ? I_SQ : 0) + ((JOBS & J_PROJ) ? I_PJ : 0) + ((JOBS & J_AX) ? I_AX : 0);
    for (int it = gw; it < NITEMS; it += NGW) {
        int r = it;
        if (JOBS & J_GU1) { if (p0_gateup(r, F.in[I_F1G], F.in[I_F1U], (bf16*)(ws + WS_WGU1), F.in[I_F1N], scr, lane_)) continue; }
        if (JOBS & J_D1) { if (p0_plain(r, F.in[I_F1D], DFF, D, (bf16*)(ws + WS_WD1), nullptr, scr, lane_, 0.5f)) continue; }
        if (JOBS & J_WIN) { if (p0_plain(r, F.in[I_WIN], D, NIN, (bf16*)(ws + WS_WINT), F.in[I_MIXN], scr, lane_)) continue; }
        if (JOBS & J_WOUT) { if (p0_plain(r, F.in[I_WOUT], D, D, (bf16*)(ws + WS_WOUT), nullptr, scr, lane_)) continue; }
        if (JOBS & J_GU2) { if (p0_gateup(r, F.in[I_F2G], F.in[I_F2U], (bf16*)(ws + WS_WGU2), F.in[I_F2N], scr, lane_)) continue; }
        if (JOBS & J_D2) { if (p0_plain(r, F.in[I_F2D], DFF, D, (bf16*)(ws + WS_WD2), nullptr, scr, lane_, 0.5f)) continue; }
        if (JOBS & J_PG) { if (p0_plain(r, F.in[I_PWG], D, D, (bf16*)(ws + WS_WPG), F.in[I_PLN], scr, lane_)) continue; }
        if (JOBS & J_PROJ) { if (p0_plain(r, F.in[I_PWP], PLE, D, (bf16*)(ws + WS_WPROJ), nullptr, scr, lane_)) continue; }
        if (JOBS & J_AX) { const int blk = r >> 4, j = (r >> 2) & 3, q = r & 3;
          const int nb = blk & 7;
          const float* W = (blk < 8 ? F.in[I_LWA] : F.in[I_LWX]) + (size_t)nb * 128 * 128;
          bf16* WT = (bf16*)(ws + (blk < 8 ? WS_WAJ : WS_WXJ)) + (size_t)(nb * 4 + j) * 128 * 128;
          p0_transpose_item(W, 128, 128, 64 * (q >> 1), WT, 64 * (q >> 1), F.in[I_CW] + j * 1024 + nb * 128, scr, q & 1, lane_); }
    }
    if (JOBS & J_AX) {
        for (int o = gw * 64 + lane_; o < 2048; o += NGW * 64) { const int which = o >> 10, dg = o & 1023, nb = dg >> 7, dd = dg & 127;
            const float* W = (which ? F.in[I_LWX] : F.in[I_LWA]) + (size_t)nb * 128 * 128 + dd; float s = (which ? F.in[I_LBX] : F.in[I_LBA])[dg];
            for (int c = 0; c < 128; ++c) s += F.in[I_CB][nb * 128 + c] * W[(size_t)c * 128];
            ((float*)(ws + WS_BA2))[o] = s; }
    }
}
__device__ __forceinline__ void side_workers(int nwg, int G, int c, int& rank, int& count) {
    const int rounds = (nwg + G - 1) / G, last = nwg - (rounds - 1) * G;
    if (last == G) { rank = c; count = G; } else if (c >= last) { rank = c - last; count = G - last; } else { rank = -1; count = 0; }
}
__device__ __forceinline__ void final_norm(Frame& F, const float* ssq) {
    const int lane_ = pg8::lane_id_asm(), wave_ = F.wave;
    const int gw = F.vcu * NWAVES + wave_, NGW = F.G * NWAVES;
    const GAS f32x4* gf = (const GAS f32x4*)F.in[I_FN] + lane_;
    for (int m = gw; m < M; m += NGW) {
        float s = (lane_ < 32) ? ssq[(size_t)m * 32 + lane_] : 0.f;
        s = wave_sum(s);
        const float rstd = 1.0f / sqrtf(s * (1.0f / D) + EPS);
        GAS f32x4* xr = (GAS f32x4*)(F.out + (size_t)m * D) + lane_;
#pragma unroll
        for (int j = 0; j < 8; ++j) { f32x4 v = xr[64 * j]; const f32x4 g = gf[64 * j]; v = v * rstd * g; xr[64 * j] = v; }
    }
}


typedef float mf32x4 __attribute__((ext_vector_type(4)));
typedef short mbf16x8 __attribute__((ext_vector_type(8)));
typedef unsigned mu32x2 __attribute__((ext_vector_type(2)));
constexpr int TS = 72;
constexpr int QS = 136;
constexpr int NITEM = BATCH * HEADS * NCH;
__device__ __forceinline__ mbf16x8 lds_frag(const LAS bf16* p) { return *(const LAS mbf16x8*)p; }
__device__ __forceinline__ unsigned bf1(float x) { return pg8::cvt_pk_bf16(x, 0.f) & 0xffffu; }
#define MFMA16(a, b, c) __builtin_amdgcn_mfma_f32_16x16x32_bf16((a), (b), (c), 0, 0, 0)

#define LBAR() do { asm volatile("s_waitcnt lgkmcnt(0)" ::: "memory"); __builtin_amdgcn_s_barrier(); asm volatile("" ::: "memory"); } while (0)

__device__ __forceinline__ void hgrn_local_phase(Frame& F) {
    LAS bf16* kstT = (LAS bf16*)(F.lds);
    LAS bf16* vT = (LAS bf16*)(F.lds + 18432);
    LAS float* qtot = (LAS float*)(F.lds + 36864);
    const int tid_ = F.wave * 64 + pg8::lane_id_asm();
    const int tid = tid_, k = tid & 127, sq = tid >> 7, lane = tid & 63, w = F.wave, fr = lane & 15, fq = lane >> 4;
    const float* LOGF = (const float*)(F.ws + WS_LOGF); const bf16* V = (const bf16*)(F.ws + WS_V);
    bf16* KVT = (bf16*)(F.ws + WS_KVT); float* DEC = (float*)(F.ws + WS_DEC);
    float lf[16]; unsigned vr[16];
    if ((int)blockIdx.x < NITEM) { const int item = blockIdx.x, c = item & 31, bh = item >> 5, h = bh & 7, b = bh >> 3;
        const size_t g0 = ((size_t)b * SEQ + c * 64 + sq * 16) * 1024 + h * 128 + k;
#pragma unroll
        for (int i = 0; i < 16; ++i) { lf[i] = LOGF[g0 + (size_t)i * 1024]; vr[i] = V[g0 + (size_t)i * 1024]; } }
    for (int item = blockIdx.x; item < NITEM; item += F.G) {
        float bb[16]; float run = 0.f;
#pragma unroll
        for (int i = 0; i < 16; ++i) { run += lf[i]; bb[i] = run; }
        qtot[sq * 128 + k] = run;
        LBAR();
        float pre = 0.f, tot = 0.f;
#pragma unroll
        for (int j = 0; j < 4; ++j) { const float tq = qtot[j * 128 + k]; pre += (j < sq) ? tq : 0.f; tot += tq; }
        unsigned pk[8], pv[8];
#pragma unroll
        for (int i = 0; i < 8; ++i) {
            const float e0 = (1.0f - __expf(lf[2 * i])) * __expf(tot - (pre + bb[2 * i])), e1 = (1.0f - __expf(lf[2 * i + 1])) * __expf(tot - (pre + bb[2 * i + 1]));
            pk[i] = pg8::cvt_pk_bf16(e0, e1); pv[i] = vr[2 * i] | (vr[2 * i + 1] << 16); }
        *(LAS v4u*)(kstT + k * TS + sq * 16) = (v4u){pk[0], pk[1], pk[2], pk[3]}; *(LAS v4u*)(kstT + k * TS + sq * 16 + 8) = (v4u){pk[4], pk[5], pk[6], pk[7]};
        *(LAS v4u*)(vT + k * TS + sq * 16) = (v4u){pv[0], pv[1], pv[2], pv[3]}; *(LAS v4u*)(vT + k * TS + sq * 16 + 8) = (v4u){pv[4], pv[5], pv[6], pv[7]};
        if (sq == 0) DEC[(size_t)item * 128 + k] = __expf(tot);
        if (item + F.G < NITEM) { const int it2 = item + F.G, c = it2 & 31, bh = it2 >> 5, h = bh & 7, b = bh >> 3;
            const size_t g0 = ((size_t)b * SEQ + c * 64 + sq * 16) * 1024 + h * 128 + k;
#pragma unroll
            for (int i = 0; i < 16; ++i) { lf[i] = LOGF[g0 + (size_t)i * 1024]; vr[i] = V[g0 + (size_t)i * 1024]; } }
        LBAR();
        const mbf16x8 b0 = lds_frag(vT + (16 * w + fr) * TS + 8 * fq), b1 = lds_frag(vT + (16 * w + fr) * TS + 32 + 8 * fq);
        bf16* outp = KVT + (size_t)item * 16384 + (size_t)(16 * w + fr) * 128 + 4 * fq;
#pragma unroll
        for (int kt = 0; kt < 8; ++kt) {
            mf32x4 acc = {0.f, 0.f, 0.f, 0.f};
            acc = MFMA16(lds_frag(kstT + (16 * kt + fr) * TS + 8 * fq), b0, acc);
            acc = MFMA16(lds_frag(kstT + (16 * kt + fr) * TS + 32 + 8 * fq), b1, acc);
            asm volatile("s_nop 7\n\ts_nop 7" : "+v"(acc));
            mu32x2 o; o.x = pg8::cvt_pk_bf16(acc[0], acc[1]); o.y = pg8::cvt_pk_bf16(acc[2], acc[3]);
            *(mu32x2*)(outp + 16 * kt) = o;
        }
        LBAR();
    }
}

__device__ __forceinline__ void hgrn_scan_phase(Frame& F) {
    const bf16* KVT = (const bf16*)(F.ws + WS_KVT); const float* DEC = (const float*)(F.ws + WS_DEC); bf16* ST = (bf16*)(F.ws + WS_XB);
    const int tid_ = F.wave * 64 + pg8::lane_id_asm();
    for (int idx = blockIdx.x * (NWAVES * 64) + tid_; idx < BATCH * HEADS * 128 * 32; idx += F.G * NWAVES * 64) {
        const int k4 = idx & 31, v = (idx >> 5) & 127, bh = idx >> 12;
        mf32x4 S = {0.f, 0.f, 0.f, 0.f};
#pragma unroll 1
        for (int half = 0; half < 2; ++half) {
            const size_t off0 = (size_t)(bh * NCH + half * 16) * 16384 + v * 128 + 4 * k4; const size_t d0 = (size_t)(bh * NCH + half * 16) * 128 + 4 * k4;
            mu32x2 kv[16]; mf32x4 dd[16];
#pragma unroll
            for (int c = 0; c < 16; ++c) { kv[c] = *(const mu32x2*)(KVT + off0 + (size_t)c * 16384); dd[c] = *(const mf32x4*)(DEC + d0 + (size_t)c * 128); }
#pragma unroll
            for (int c = 0; c < 16; ++c) {
                mu32x2 o; o.x = pg8::cvt_pk_bf16(S[0], S[1]); o.y = pg8::cvt_pk_bf16(S[2], S[3]); *(mu32x2*)(ST + off0 + (size_t)c * 16384) = o;
                S = dd[c] * S + pg8::bf16x4_to_f32(kv[c]);
            }
        }
    }
}

__device__ __forceinline__ void hgrn_out_phase(Frame& F, bool dummy = false) {
    LAS bf16* QT = (LAS bf16*)(F.lds);
    LAS bf16* KT = (LAS bf16*)(F.lds + 17408);
    LAS bf16* QI = (LAS bf16*)(F.lds + 34816);
    LAS bf16* vT = (LAS bf16*)(F.lds + 52224);
    LAS bf16* P = (LAS bf16*)(F.lds + 70656);
    LAS float* qtot = (LAS float*)(F.lds + 79872);
    LAS float* ssq = (LAS float*)(F.lds + 81920);
    const int tid_ = F.wave * 64 + pg8::lane_id_asm();
    const int tid = tid_, k = tid & 127, sq = tid >> 7, lane = tid & 63, w = F.wave, fr = lane & 15, fq = lane >> 4, rb = w & 3, ch = w >> 2;
    const float* LOGF = (const float*)(F.ws + WS_LOGF); const bf16* V = (const bf16*)(F.ws + WS_V); const bf16* SG = (const bf16*)(F.ws + WS_SG);
    const bf16* ST = (const bf16*)(F.ws + WS_XB); bf16* MIXA = (bf16*)(F.ws + WS_MIXA);
    const int t0 = 16 * rb;
    float lf[16]; unsigned vr[16], qr[16];
    if ((int)blockIdx.x < NITEM) { const int item = blockIdx.x, c = item & 31, bh = item >> 5, h = bh & 7, b = bh >> 3;
        const size_t r0 = (size_t)b * SEQ + c * 64, g0 = (r0 + sq * 16) * 1024 + h * 128 + k, gq = (r0 + sq * 16) * 2048 + h * 128 + k;
#pragma unroll
        for (int i = 0; i < 16; ++i) { lf[i] = LOGF[g0 + (size_t)i * 1024]; vr[i] = V[g0 + (size_t)i * 1024]; qr[i] = MIXA[gq + (size_t)i * 2048]; } }
    for (int item = blockIdx.x; item < NITEM; item += F.G) {
        const int c = item & 31, bh = item >> 5, h = bh & 7, b = bh >> 3;
        const size_t r0 = (size_t)b * SEQ + c * 64;
        float bb[16]; float run = 0.f;
#pragma unroll
        for (int i = 0; i < 16; ++i) { run += lf[i]; bb[i] = run; }
        qtot[sq * 128 + k] = run;
        LBAR();
        {
            float pre = 0.f;
#pragma unroll
            for (int j = 0; j < 4; ++j) { const float tq = qtot[j * 128 + k]; pre += (j < sq) ? tq : 0.f; }
            const float bm = qtot[k] + qtot[128 + k], ebm = __expf(bm);
            unsigned pv[8];
#pragma unroll
            for (int i = 0; i < 16; ++i) {
                const float d = fminf(fmaxf(pre + bb[i] - bm, -60.f), 60.f), e1 = __expf(d), e2 = __builtin_amdgcn_rcpf(e1);
                const float qf = bf2f((bf16)qr[i]), qt = qf * e1, kk = (1.0f - __expf(lf[i])) * e2;
                const int s = sq * 16 + i;
                QT[s * QS + k] = (bf16)bf1(qt); QI[s * QS + k] = (bf16)bf1(qt * ebm); KT[s * QS + k] = (bf16)bf1(kk);
            }
#pragma unroll
            for (int i = 0; i < 8; ++i) pv[i] = vr[2 * i] | (vr[2 * i + 1] << 16);
            *(LAS v4u*)(vT + k * TS + sq * 16) = (v4u){pv[0], pv[1], pv[2], pv[3]}; *(LAS v4u*)(vT + k * TS + sq * 16 + 8) = (v4u){pv[4], pv[5], pv[6], pv[7]};
        }
        if (item + F.G < NITEM) { const int it2 = item + F.G, c2 = it2 & 31, bh2 = it2 >> 5, h2 = bh2 & 7, b2 = bh2 >> 3;
            const size_t r2 = (size_t)b2 * SEQ + c2 * 64, g0 = (r2 + sq * 16) * 1024 + h2 * 128 + k, gq = (r2 + sq * 16) * 2048 + h2 * 128 + k;
#pragma unroll
            for (int i = 0; i < 16; ++i) { lf[i] = LOGF[g0 + (size_t)i * 1024]; vr[i] = V[g0 + (size_t)i * 1024]; qr[i] = MIXA[gq + (size_t)i * 2048]; } }
        mbf16x8 stf[4][4]; mu32x2 sgp[4];
#pragma unroll
        for (int j = 0; j < 4; ++j) { const bf16* sp = ST + (size_t)item * 16384 + (size_t)(64 * ch + 16 * j + fr) * 128 + 8 * fq;
#pragma unroll
            for (int ks = 0; ks < 4; ++ks) stf[j][ks] = *(const mbf16x8*)(sp + 32 * ks);
            sgp[j] = *(const mu32x2*)(SG + (r0 + t0 + fr) * 1024 + h * 128 + 64 * ch + 16 * j + 4 * fq); }
        LBAR();
        {
            mbf16x8 bq[4];
#pragma unroll
            for (int ks = 0; ks < 4; ++ks) bq[ks] = lds_frag(QT + (t0 + fr) * QS + 32 * ks + 8 * fq);
#pragma unroll
            for (int j = 0; j < 2; ++j) {
                const int s0 = 32 * ch + 16 * j; mf32x4 acc = {0.f, 0.f, 0.f, 0.f};
#pragma unroll
                for (int ks = 0; ks < 4; ++ks) acc = MFMA16(lds_frag(KT + (s0 + fr) * QS + 32 * ks + 8 * fq), bq[ks], acc);
                const int t = t0 + fr, sb = s0 + 4 * fq;
#pragma unroll
                for (int r = 0; r < 4; ++r) acc[r] = (sb + r <= t) ? acc[r] : 0.f;
                mu32x2 o; o.x = pg8::cvt_pk_bf16(acc[0], acc[1]); o.y = pg8::cvt_pk_bf16(acc[2], acc[3]);
                *(LAS mu32x2*)(P + t * TS + sb) = o;
            }
        }
        LBAR();
        mf32x4 o4[4];
        {
            mbf16x8 bqi[4], bp[2];
#pragma unroll
            for (int ks = 0; ks < 4; ++ks) bqi[ks] = lds_frag(QI + (t0 + fr) * QS + 32 * ks + 8 * fq);
#pragma unroll
            for (int ss = 0; ss < 2; ++ss) bp[ss] = lds_frag(P + (t0 + fr) * TS + 32 * ss + 8 * fq);
            float sum = 0.f;
#pragma unroll
            for (int j = 0; j < 4; ++j) {
                const int v0 = 64 * ch + 16 * j; mf32x4 acc = {0.f, 0.f, 0.f, 0.f};
#pragma unroll
                for (int ks = 0; ks < 4; ++ks) acc = MFMA16(stf[j][ks], bqi[ks], acc);
#pragma unroll
                for (int ss = 0; ss < 2; ++ss) acc = MFMA16(lds_frag(vT + (v0 + fr) * TS + 32 * ss + 8 * fq), bp[ss], acc);
                o4[j] = acc; sum += (acc[0] * acc[0] + acc[1] * acc[1]) + (acc[2] * acc[2] + acc[3] * acc[3]);
            }
            sum += __shfl_xor(sum, 16); sum += __shfl_xor(sum, 32);
            if (fq == 0) ssq[ch * 64 + t0 + fr] = sum;
        }
        LBAR();
        {
            const float rn = 1.0f / sqrtf((ssq[t0 + fr] + ssq[64 + t0 + fr]) * (1.0f / 128.0f) + EPS);
            const size_t row = r0 + t0 + fr;
#pragma unroll
            for (int j = 0; j < 4; ++j) {
                const int v = 64 * ch + 16 * j + 4 * fq;
                const mf32x4 gn = *(const mf32x4*)(F.in[I_HGN] + v);
                const float s0 = bf2f((bf16)(sgp[j].x & 0xffffu)), s1 = bf2f((bf16)(sgp[j].x >> 16)), s2 = bf2f((bf16)(sgp[j].y & 0xffffu)), s3 = bf2f((bf16)(sgp[j].y >> 16));
                mu32x2 o; o.x = pg8::cvt_pk_bf16(o4[j][0] * rn * gn[0] * s0, o4[j][1] * rn * gn[1] * s1); o.y = pg8::cvt_pk_bf16(o4[j][2] * rn * gn[2] * s2, o4[j][3] * rn * gn[3] * s3);
                *(mu32x2*)((dummy ? (bf16*)(F.ws + WS_KVT) : MIXA) + row * 2048 + h * 128 + v) = o;
            }
        }
        LBAR();
    }
}

#define GLDS16(gp, lp) __builtin_amdgcn_global_load_lds((const unsigned*)(gp), (LAS unsigned*)(lp), 16, 0, 0)
template <int VAR = 0>
__device__ __forceinline__ void lru_phase(Frame& F, bool dummy = false) {
    LAS unsigned char* Ab = F.lds;
    LAS float* LAt = (LAS float*)(F.lds + 66560);
    LAS float* LUt = (LAS float*)(F.lds + 66560 + 18560);
    LAS bf16* GG = (LAS bf16*)(F.lds + 103680);
    LAS bf16* YY = (LAS bf16*)(F.lds + 120064);
    const int tid_ = F.wave * 64 + pg8::lane_id_asm();
    const int tid = tid_, lane = tid & 63, w = F.wave, fr = lane & 15, fq = lane >> 4;
    const int seg = lane & 31, d = 2 * w + (lane >> 5);
    const int grow = tid >> 1, ghalf = tid & 1;
    const bf16* LRX = (const bf16*)(F.ws + WS_LRX); bf16* MIXA = (bf16*)(F.ws + WS_MIXA);
    const bf16* WAJ = (const bf16*)(F.ws + WS_WAJ); const bf16* WXJ = (const bf16*)(F.ws + WS_WXJ);
    for (int item = blockIdx.x; item < BATCH * 64; item += F.G) {
        const int b = item >> 6, n = (item >> 3) & 7, sl = item & 7;
        mbf16x8 waf[4][4], wxf[4][4];
#pragma unroll
        for (int j = 0; j < 4; ++j)
#pragma unroll
            for (int ks = 0; ks < 4; ++ks) { const size_t o = ((size_t)(n * 4 + j) * 128 + sl * 16 + fr) * 128 + 32 * ks + 8 * fq; waf[j][ks] = *(const mbf16x8*)(WAJ + o); wxf[j][ks] = *(const mbf16x8*)(WXJ + o); }
        const int cgl = n * 128 + sl * 16 + fr;
        const float ba2 = ((const float*)(F.ws + WS_BA2))[cgl], bx2 = ((const float*)(F.ws + WS_BA2))[1024 + cgl], spl = log1pf(__expf(-F.in[I_LAM][cgl])), cbv = F.in[I_CB][cgl];
        float cw4[4];
#pragma unroll
        for (int j = 0; j < 4; ++j) cw4[j] = F.in[I_CW][j * 1024 + cgl];
        const bf16* xsrc = LRX + (size_t)b * SEQ * 1024 + n * 128;
        bf16* const gbase = MIXA + (size_t)b * SEQ * 2048 + 1024 + n * 128 + sl * 16 + 8 * ghalf;
        bf16* const obase = dummy ? (bf16*)(F.ws + WS_END) + (size_t)item * 2048 * 16 + 8 * ghalf : gbase;
        const size_t ostr = dummy ? 16 : 2048;
#pragma unroll
        for (int i = 0; i < 9; ++i) { const int p = tid + 512 * i, row = p >> 4, cp = p & 15;
            if (p < 259 * 16 && row >= 3) GLDS16(xsrc + (size_t)(row - 3) * 1024 + 8 * (cp ^ (row & 15)), Ab + (w * 64 + 512 * i) * 16); }
        if (tid < 48) *(LAS v4u*)(Ab + tid * 16) = (v4u){0u, 0u, 0u, 0u};
        GLDS16(gbase + (size_t)grow * 2048, (LAS unsigned char*)GG + w * 1024);
        __syncthreads();
        float carry = 0.f;
        for (int mc = 0; mc < 8; ++mc) {
            int tid = tid_; asm volatile("" : "+v"(tid));
            const int lane = tid & 63, fr = lane & 15, fq = lane >> 4, seg = lane & 31, d = 2 * w + (lane >> 5), grow = tid >> 1, ghalf = tid & 1;
            bf16* const gbase = MIXA + (size_t)b * SEQ * 2048 + 1024 + n * 128 + sl * 16 + 8 * ghalf;
            bf16* const obase = dummy ? (bf16*)(F.ws + WS_END) + (size_t)item * 2048 * 16 + 8 * ghalf : gbase;
            if (mc > 0) *(v4u*)(obase + (size_t)((mc - 1) * 256 + grow) * ostr) = *(const LAS v4u*)(YY + ((mc - 1) & 1) * 4096 + grow * 16 + 8 * ghalf);
#pragma unroll
            for (int rt = 0; rt < (VAR == 2 ? 0 : 2); ++rt) {
                const int rowt = 32 * w + 16 * rt; mf32x4 ar = {0.f, 0.f, 0.f, 0.f}, ai = {0.f, 0.f, 0.f, 0.f};
#pragma unroll
                for (int j = 0; j < 4; ++j) { const int R = rowt + fr + j;
#pragma unroll
                    for (int ks = 0; ks < 4; ++ks) { const mbf16x8 a = *(const LAS mbf16x8*)(Ab + R * 256 + (((4 * ks + fq) ^ (R & 15)) << 4)); ar = MFMA16(a, waf[j][ks], ar); ai = MFMA16(a, wxf[j][ks], ai); } }
#pragma unroll
                for (int r = 0; r < 4; ++r) { const int row = rowt + 4 * fq + r;
                    float xc = cbv;
#pragma unroll
                    for (int j = 0; j < 4; ++j) { const int R = row + j; xc += cw4[j] * bf2f(*(const LAS bf16*)(Ab + R * 256 + (((2 * sl + (fr >> 3)) ^ (R & 15)) << 4) + 2 * (fr & 7))); }
                    const float rg = pg8::sigmoid_f(ar[r] + ba2), ig = pg8::sigmoid_f(ai[r] + bx2), la = -8.0f * rg * spl, t = 2.0f * la;
                    const float ser = -t * (1.0f + t * (0.5f + t * (0.16666667f + t * (0.041666668f + t * (0.0083333338f + t * 0.0013888889f)))));
                    const float om = (t > -0.25f) ? ser : 1.0f - __expf(t);
                    const int o = fr * 289 + (row >> 3) * 9 + (row & 7);
                    LAt[o] = __expf(la); LUt[o] = sqrtf(om) * ig * xc; }
            }
            __syncthreads();
            if (mc < 7) {
#pragma unroll
                for (int i = 0; i < 9; ++i) { const int p = tid + 512 * i, row = p >> 4, cp = p & 15;
                    if (p < 259 * 16) GLDS16(xsrc + (size_t)((mc + 1) * 256 - 3 + row) * 1024 + 8 * (cp ^ (row & 15)), Ab + (w * 64 + 512 * i) * 16); }
                GLDS16(gbase + (size_t)((mc + 1) * 256 + grow) * 2048, (LAS unsigned char*)GG + ((mc + 1) & 1) * 8192 + w * 1024);
            }
            if (VAR != 3) {
                float aa[8], uu[8]; float Ap = 1.f, Hp = 0.f;
#pragma unroll
                for (int i = 0; i < 8; ++i) { aa[i] = LAt[d * 289 + seg * 9 + i]; uu[i] = LUt[d * 289 + seg * 9 + i]; Hp = aa[i] * Hp + uu[i]; Ap *= aa[i]; }
#pragma unroll
                for (int off = 1; off < 32; off <<= 1) { const float Aq = __shfl_up(Ap, off, 32), Hq = __shfl_up(Hp, off, 32); if (seg >= off) { Hp = Ap * Hq + Hp; Ap = Ap * Aq; } }
                float Ae = __shfl_up(Ap, 1, 32), He = __shfl_up(Hp, 1, 32); if (seg == 0) { Ae = 1.f; He = 0.f; }
                float hin = Ae * carry + He;
                carry = __shfl(Ap, 31, 32) * carry + __shfl(Hp, 31, 32);
                const LAS bf16* gp = GG + (mc & 1) * 4096 + (8 * seg) * 16 + d; LAS bf16* yq = YY + (mc & 1) * 4096 + (8 * seg) * 16 + d;
#pragma unroll
                for (int i = 0; i < 8; ++i) { hin = aa[i] * hin + uu[i]; yq[i * 16] = (bf16)bf1(hin * bf2f(gp[i * 16])); }
            }
            __syncthreads();
        }
        *(v4u*)(obase + (size_t)(7 * 256 + grow) * ostr) = *(const LAS v4u*)(YY + 4096 + grow * 16 + 8 * ghalf);
        __syncthreads();
    }
}
constexpr int N_PHASES = 12;
struct Args { const float* in[N_IN]; float* out; unsigned char* ws; int ph_lo, ph_hi, li, pad; };
__global__ void __launch_bounds__(NWAVES * 64, 2) mega_fwd(Args args) {
    extern __shared__ __attribute__((aligned(16))) unsigned char lds[];
    Frame F;
    F.lds = (LAS unsigned char*)lds;
    F.MISC = (volatile LAS unsigned*)(F.lds + MISC_OFF);
    F.wave = __builtin_amdgcn_readfirstlane((int)threadIdx.x >> 6);
    F.G = gridDim.x; { const int bx = blockIdx.x; F.vcu = (F.G % 8 == 0) ? (bx % 8) * (F.G / 8) + bx / 8 : bx; }
#pragma unroll
    for (int i = 0; i < N_IN; ++i) F.in[i] = args.in[i];
    F.out = args.out; F.ws = args.ws;
    unsigned char* ws = args.ws;
    F.ctl = (gu32*)(ws + WS_CTL);
    for (int u = F.wave * 64 + pg8::lane_id_asm(); u < (LDS_BYTES - LDSCTL_OFF) / 4; u += NWAVES * 64) ((LAS unsigned*)(F.lds + LDSCTL_OFF))[u] = 0u;
    __syncthreads();
    const int lo = args.ph_lo, hi = args.ph_hi;
    const bool multi = (hi - lo) > 1;
    XcdBarrier bar; bar.bar = (unsigned*)(F.ctl + CW_BAR) + args.li * XCD_BAR_WORDS; bar.x = 0; bar.st = nullptr; bar.wave = F.wave;
    if (multi) bar = xcd_barrier_post((unsigned*)(F.ctl + CW_BAR) + args.li * XCD_BAR_WORDS, F.MISC + 8, F.wave);

    bf16* const XB = (bf16*)(ws + WS_XB); bf16* const ACT = (bf16*)(ws + WS_ACT); bf16* const MIXA = (bf16*)(ws + WS_MIXA);
    float* const SSQA = (float*)(ws + WS_SSQA); float* const SSQB = (float*)(ws + WS_SSQB);


#define IN(k) (lo <= (k) && (k) < hi)
#ifdef PROBE_PHASE
#define SEAM(k) do { if (IN(k) && ((k) + 1 < N_PHASES ? IN((k) + 1) : true)) { xcd_barrier(bar); \
        if ((k) + 1 == PROBE_PHASE) { if (blockIdx.x == 0 && F.wave == 0 && pg8::lane_id_asm() == 0) __hip_atomic_store((unsigned long long*)(F.ctl + 80000), (unsigned long long)__builtin_amdgcn_s_memrealtime(), RLX_AGENT); } \
        if ((k) == PROBE_PHASE) { if (blockIdx.x == 0 && F.wave == 0 && pg8::lane_id_asm() == 0) { const unsigned long long t1 = __builtin_amdgcn_s_memrealtime(), t0 = __hip_atomic_load((unsigned long long*)(F.ctl + 80000), RLX_AGENT); \
                __hip_atomic_store((unsigned long long*)(F.ctl + 80064), t1 - t0, RLX_AGENT); } \
            xcd_barrier(bar); \
            { const unsigned long long dt = __hip_atomic_load((unsigned long long*)(F.ctl + 80064), RLX_AGENT), s0 = __builtin_amdgcn_s_memrealtime(); while (__builtin_amdgcn_s_memrealtime() - s0 < 4ull * dt) __builtin_amdgcn_s_sleep(32); } } } } while (0)
#else
#define SEAM(k) do { if (IN(k) && IN((k) + 1)) xcd_barrier(bar); } while (0)
#endif
#define GEMM_SWIGLU(WOFF) do { pg8::Gemm g{XB, (const bf16*)(ws + (WOFF)), M, NGU, D}; pg8::StaticOrder S; S.init(M, NGU, F.G, (int)blockIdx.x); \
        pg8::EpiSwiGLU E{ACT, DFF, SSQA}; pg8::gemm_phase<pg8::EpiSwiGLU, pg8::StaticOrder, true, true>(F.lds + RING_OFF, g, S, E, F.wave); } while (0)
#define GEMM_RESID(AP, WOFF, KK, SRC, SSQO) do { pg8::Gemm g{(AP), (const bf16*)(ws + (WOFF)), M, D, (KK)}; pg8::StaticOrder S; S.init(M, D, F.G, (int)blockIdx.x); \
        if ((M / 256) * (D / 256) <= F.G) { pg8::EpiResidInit E{(SRC), F.out, XB, (SSQO)}; pg8::gemm_phase<pg8::EpiResidInit, pg8::StaticOrder, true, true>(F.lds + RING_OFF, g, S, E, F.wave); } \
        else { pg8::EpiResid E{(SRC), F.out, XB, (SSQO), 1.0f}; pg8::gemm_phase<pg8::EpiResid, pg8::StaticOrder, true, true>(F.lds + RING_OFF, g, S, E, F.wave); } } while (0)

    if (IN(0)) { convert_jobs<J_X | J_P | J_GU1 | J_GU2 | J_WOUT | J_PROJ | J_AX>(F, (int)blockIdx.x, F.G); SEAM(0); }
    if (IN(1)) { GEMM_SWIGLU(WS_WGU1);
        { int rank, count; side_workers((M / 256) * (NGU / 256), F.G, (int)blockIdx.x, rank, count); if (rank >= 0) convert_jobs<J_D1 | J_WIN>(F, rank, count); }
        SEAM(1); }
    if (IN(2)) { GEMM_RESID(ACT, WS_WD1, DFF, F.in[I_X], SSQB); SEAM(2); }
    if (IN(3)) {
        pg8::Gemm g{XB, (const bf16*)(ws + WS_WINT), M, NIN, D}; pg8::StaticOrder S; S.init(M, NIN, F.G, (int)blockIdx.x);
        pg8::EpiZ E{SSQB, F.in[I_HLB], MIXA, (float*)(ws + WS_LOGF), (bf16*)(ws + WS_V), (bf16*)(ws + WS_SG), (bf16*)(ws + WS_LRX)};
        pg8::gemm_phase<pg8::EpiZ, pg8::StaticOrder, true, true>(F.lds + RING_OFF, g, S, E, F.wave);
        SEAM(3); }
    if (IN(4)) { MIXER_PHASE_4 SEAM(4); }
    if (IN(5)) { MIXER_PHASE_5 SEAM(5); }
    if (IN(6)) { MIXER_PHASE_6 SEAM(6); }
    if (IN(7)) { GEMM_RESID(MIXA, WS_WOUT, D, F.out, SSQA); SEAM(7); }
    if (IN(8)) { GEMM_SWIGLU(WS_WGU2);
        { int rank, count; side_workers((M / 256) * (NGU / 256), F.G, (int)blockIdx.x, rank, count);
          if (rank >= 0) {
              pg8::Gemm g{(const bf16*)(ws + WS_PB), (const bf16*)(ws + WS_WPROJ), M, D, PLE}; pg8::StaticOrder S; S.init(M, D, count, rank);
              pg8::EpiPP E{(bf16*)(ws + WS_PP)};
              pg8::gemm_phase<pg8::EpiPP, pg8::StaticOrder, true, true>(F.lds + RING_OFF, g, S, E, F.wave);
              convert_jobs<J_D2 | J_PG>(F, rank, count); } }
        SEAM(8); }
    if (IN(9)) { GEMM_RESID(ACT, WS_WD2, DFF, F.out, SSQB); SEAM(9); }
    if (IN(10)) {
        { pg8::Gemm g{XB, (const bf16*)(ws + WS_WPG), M, D, D}; pg8::StaticOrder S; S.init(M, D, F.G, (int)blockIdx.x);
          if (F.G == (M / 256) * (D / 256)) {
              pg8::EpiPLEFinal E{SSQB, F.in[I_PBG], (const bf16*)(ws + WS_PP), F.out, (float*)(ws + WS_XCH), (unsigned*)(F.ctl + CW_PANEL), F.in[I_FN]};
              pg8::gemm_phase<pg8::EpiPLEFinal, pg8::StaticOrder, false, true>(F.lds + RING_OFF, g, S, E, F.wave);
          } else {
              pg8::EpiPLE E{SSQB, F.in[I_PBG], (const bf16*)(ws + WS_PP), F.out, SSQA};
              pg8::gemm_phase<pg8::EpiPLE, pg8::StaticOrder, true, true>(F.lds + RING_OFF, g, S, E, F.wave); } }
        SEAM(10); }
    if (IN(11)) { if (F.G != (M / 256) * (D / 256)) final_norm(F, SSQA); SEAM(11); }
#undef IN
#undef SEAM
}

#if SIMPLE_HGRN
__global__ void __launch_bounds__(64) k_simple_hgrn(const float* logf, const bf16* mixa, const bf16* vv, float* oh) {
    __shared__ float sf[128], sk[128], sq[128];
    const int bh = blockIdx.x >> 1, vh = blockIdx.x & 1, b = bh >> 3, h = bh & 7, lane = threadIdx.x, v = vh * 64 + lane;
    float S[128];
#pragma unroll
    for (int k = 0; k < 128; ++k) S[k] = 0.f;
    for (int t = 0; t < SEQ; ++t) {
        const size_t row = (size_t)b * SEQ + t;
        for (int kk = lane; kk < 128; kk += 64) { const float f = __expf(logf[row * 1024 + h * 128 + kk]); sf[kk] = f; sk[kk] = 1.f - f; sq[kk] = bf2f(mixa[row * 2048 + h * 128 + kk]); }
        __syncthreads();
        const float vt = bf2f(vv[row * 1024 + h * 128 + v]); float o = 0.f;
#pragma unroll
        for (int k = 0; k < 128; ++k) { S[k] = sf[k] * S[k] + sk[k] * vt; o += S[k] * sq[k]; }
        oh[row * 1024 + h * 128 + v] = o;
        __syncthreads();
    }
}
__global__ void __launch_bounds__(256) k_simple_hnorm(const float* oh, const bf16* sg, const float* gn, bf16* mixa) {
    const int gw = (blockIdx.x * 256 + threadIdx.x) >> 6, lane = threadIdx.x & 63;
    if (gw >= M * HEADS) return;
    const int row = gw >> 3, h = gw & 7;
    const float o0 = oh[(size_t)row * 1024 + h * 128 + lane], o1 = oh[(size_t)row * 1024 + h * 128 + 64 + lane];
    const float ss = wave_sum(o0 * o0 + o1 * o1);
    const float r = 1.0f / sqrtf(ss * (1.0f / 128.0f) + EPS);
    mixa[(size_t)row * 2048 + h * 128 + lane] = (bf16)f2bf(o0 * r * gn[lane] * bf2f(sg[(size_t)row * 1024 + h * 128 + lane]));
    mixa[(size_t)row * 2048 + h * 128 + 64 + lane] = (bf16)f2bf(o1 * r * gn[64 + lane] * bf2f(sg[(size_t)row * 1024 + h * 128 + 64 + lane]));
}
#endif
#if SIMPLE_LRU
__global__ void __launch_bounds__(256) k_simple_lru_a(const bf16* lrx, const float* cw, const float* cb, const float* wa, const float* ba, const float* wx, const float* bx, const float* lam, float* LA, float* LU) {
    __shared__ float xc[1024];
    const int row = blockIdx.x, tt = row % SEQ, tid = threadIdx.x;
    for (int c = tid; c < 1024; c += 256) { float s = cb[c];
        for (int j = 0; j < 4; ++j) { const int ts = tt - 3 + j; if (ts >= 0) s += cw[j * 1024 + c] * bf2f(lrx[(size_t)(row - 3 + j) * 1024 + c]); }
        xc[c] = s; }
    __syncthreads();
    for (int d = tid; d < 1024; d += 256) { const int n = d >> 7, dd = d & 127; float r = ba[d], g = bx[d];
        for (int c = 0; c < 128; ++c) { const float x = xc[n * 128 + c]; r += x * wa[((size_t)n * 128 + c) * 128 + dd]; g += x * wx[((size_t)n * 128 + c) * 128 + dd]; }
        r = 1.0f / (1.0f + __expf(-r)); g = 1.0f / (1.0f + __expf(-g));
        const float log_a = -8.0f * r * log1pf(__expf(-lam[d]));
        LA[(size_t)row * 1024 + d] = __expf(log_a); LU[(size_t)row * 1024 + d] = sqrtf(-expm1f(2.0f * log_a)) * g * xc[d]; }
}
__global__ void __launch_bounds__(256) k_simple_lru_b(const float* LA, const float* LU, bf16* mixa) {
    const int gi = blockIdx.x * 256 + threadIdx.x, b = gi >> 10, c = gi & 1023; float h = 0.f;
#pragma unroll 8
    for (int t = 0; t < SEQ; ++t) { const size_t row = (size_t)b * SEQ + t; h = LA[row * 1024 + c] * h + LU[row * 1024 + c];
        bf16* p = mixa + row * 2048 + 1024 + c; *p = (bf16)f2bf(h * bf2f(*p)); }
}
#endif

extern "C" void kernel_launch(void* const* d_in, const int* in_sizes, int n_in, void* d_out, int out_size, void* d_ws, size_t ws_size, hipStream_t stream) {
    static int grid = 0;
    if (grid == 0) {
        if (n_in != N_IN || in_sizes[0] != M * D || out_size != M * D || ws_size < WS_END) { fprintf(stderr, "kernel_launch: unexpected problem (n_in %d, in0 %d, out %d, ws %zu); nothing launched\n", n_in, n_in > 0 ? in_sizes[0] : -1, out_size, ws_size); grid = -1; return; }
        int dev = 0, cus = 0, per_cu = 0;
        if (hipGetDevice(&dev) != hipSuccess || hipDeviceGetAttribute(&cus, hipDeviceAttributeMultiprocessorCount, dev) != hipSuccess) { grid = -1; return; }
        if (hipFuncSetAttribute((const void*)mega_fwd, hipFuncAttributeMaxDynamicSharedMemorySize, LDS_BYTES) != hipSuccess) { fprintf(stderr, "kernel_launch: hipFuncSetAttribute failed\n"); grid = -1; return; }
        if (hipOccupancyMaxActiveBlocksPerMultiprocessor(&per_cu, (const void*)mega_fwd, NWAVES * 64, LDS_BYTES) != hipSuccess || per_cu < 1)
            fprintf(stderr, "kernel_launch: note: occupancy query reports %d workgroups per CU\n", per_cu);
        (void)hipGetLastError();
        grid = cus;
    }
    if (grid < 0) return;
    if (hipMemsetAsync((char*)d_ws + WS_CTL, 0, CTL_ZERO_BYTES, stream) != hipSuccess) return;
    Args a{};
    for (int i = 0; i < N_IN; ++i) a.in[i] = (const float*)d_in[i];
    a.out = (float*)d_out; a.ws = (unsigned char*)d_ws;
    unsigned char* ws = (unsigned char*)d_ws;
    auto launch = [&](int lo, int hi, int li) { a.ph_lo = lo; a.ph_hi = hi; a.li = li; hipLaunchKernelGGL(mega_fwd, dim3(grid), dim3(NWAVES * 64), LDS_BYTES, stream, a); };
#if SIMPLE_HGRN || SIMPLE_LRU
    launch(0, 4, 0);
#if SIMPLE_HGRN
    {   float* OH = (float*)(ws + WS_XB);
        hipLaunchKernelGGL(k_simple_hgrn, dim3(64), dim3(64), 0, stream, (const float*)(ws + WS_LOGF), (const bf16*)(ws + WS_MIXA), (const bf16*)(ws + WS_V), OH);
        hipLaunchKernelGGL(k_simple_hnorm, dim3(M * HEADS / 4), dim3(256), 0, stream, (const float*)OH, (const bf16*)(ws + WS_SG), (const float*)d_in[I_HGN], (bf16*)(ws + WS_MIXA)); }
#endif
#if SIMPLE_LRU
    {   float* LA = (float*)(ws + WS_KVT); float* LU = LA + (size_t)M * 1024;
        hipLaunchKernelGGL(k_simple_lru_a, dim3(M), dim3(256), 0, stream, (const bf16*)(ws + WS_LRX), (const float*)d_in[I_CW], (const float*)d_in[I_CB], (const float*)d_in[I_LWA], (const float*)d_in[I_LBA],
                           (const float*)d_in[I_LWX], (const float*)d_in[I_LBX], (const float*)d_in[I_LAM], LA, LU);
        hipLaunchKernelGGL(k_simple_lru_b, dim3(BATCH * 1024 / 256), dim3(256), 0, stream, (const float*)LA, (const float*)LU, (bf16*)(ws + WS_MIXA)); }
#endif
    launch(4, N_PHASES, 1);
#else
#if N_LAUNCHES == 1
    launch(0, N_PHASES, 0);
#else
    for (int ph = 0; ph < N_PHASES; ++ph) launch(ph, ph + 1, 0);
#endif
#endif
}
```

```cpp
#include <hip/hip_runtime.h>
#include <cstdio>
#include <cstdint>
#ifndef SIMPLE_HGRN
#define SIMPLE_HGRN 0
#endif
#ifndef SIMPLE_LRU
#define SIMPLE_LRU 0
#endif
#ifndef N_LAUNCHES
#define N_LAUNCHES 1
#endif
#if SIMPLE_HGRN
#define MIXER_PHASE_4
#define MIXER_PHASE_6
#define MIXER_SCAN
#else
#define MIXER_PHASE_4 hgrn_local_phase(F);
#ifdef PROBE_H3
#define MIXER_PHASE_6 hgrn_out_phase(F, true); xcd_barrier(bar); hgrn_out_phase(F);
#else
#define MIXER_PHASE_6 hgrn_out_phase(F);
#endif
#ifdef PROBE_SCAN
#define MIXER_SCAN hgrn_scan_phase(F); xcd_barrier(bar); hgrn_scan_phase(F);
#else
#define MIXER_SCAN hgrn_scan_phase(F);
#endif
#endif
#if SIMPLE_LRU
#define MIXER_LRU
#else
#ifdef PROBE_LRU
#define MIXER_LRU lru_phase<PROBE_LRU, false, true>(F); xcd_barrier(bar); lru_phase<0>(F);
#else
#define MIXER_LRU lru_phase<0>(F);
#endif
#endif
#if !SIMPLE_HGRN && !SIMPLE_LRU && !defined(PROBE_LRU) && !defined(PROBE_SCAN)
#define MIXER_PHASE_5 if (F.G * NWAVES * 64 == BATCH * HEADS * 128 * 32 && F.G == BATCH * 64) { lru_phase<0, true>(F); } else { hgrn_scan_phase(F); lru_phase<0, false>(F); }
#else
#define MIXER_PHASE_5 MIXER_SCAN MIXER_LRU
#endif
namespace pg8 {
#define PG8_LAS __attribute__((address_space(3)))
typedef unsigned short bf16_t;
typedef short bf16x8 __attribute__((ext_vector_type(8)));
typedef float f32x4 __attribute__((ext_vector_type(4)));
typedef unsigned u32x4 __attribute__((ext_vector_type(4)));
constexpr int BM = 256, BK = 64, HALF = 128, HTB = HALF * BK * 2  , STAGE_BYTES = 8 * HTB, NXCD = 8, WGM = 8;

__host__ __device__ __forceinline__ int lds_byte(int r, int c) { const int st = (r >> 4) * 2 + (c >> 5), rr = r & 15, cc = c & 31, ob = rr * 64 + cc * 2; return st * 1024 + (ob ^ (((ob >> 9) & 1) << 5)); }
__host__ __device__ __forceinline__ void stage_rc(int b, int& R, int& C) { const int st = b / 1024, sb = b % 1024, swz = sb ^ (((sb >> 9) & 1) << 5); R = (st >> 1) * 16 + swz / 64; C = (st & 1) * 32 + (swz % 64) / 2; }
__host__ __device__ __forceinline__ int perm32(int rho) { const int n = rho >> 4, i = rho & 15; return 8 * (i >> 2) + 4 * n + (i & 3); }

struct Unit { int pm, pn; };
struct Gemm { const bf16_t* A; const bf16_t* Bt; int M, N, K; };

struct StaticOrder {
    int nM, nN, nwg, G, c;
    __host__ __device__ void init(int M, int N, int G_, int c_) { nM = M / BM; nN = N / BM; nwg = nM * nN; G = G_; c = c_; }
    __host__ __device__ bool next(int i, Unit& u) const {
        const long L = (long)i * G + c; if (L >= nwg) return false;
        int wgid = (int)L; { const int q = nwg / NXCD, r = nwg % NXCD, xcd = wgid % NXCD, off = wgid / NXCD; wgid = (xcd < r ? xcd * (q + 1) : r * (q + 1) + (xcd - r) * q) + off; }
        const int nig = WGM * nN, gid = wgid / nig, fm = gid * WGM, gsz = (nM - fm) < WGM ? (nM - fm) : WGM;
        u.pm = fm + ((wgid % nig) % gsz); u.pn = (wgid % nig) / gsz; return true;
    }
    __device__ __forceinline__ void a_ready(const Unit&) const {}
    __device__ __forceinline__ void done(const Unit&) const {}
};
__device__ __forceinline__ int lane_id_asm() { int l; asm volatile("v_mbcnt_lo_u32_b32 %0, -1, 0\n\tv_mbcnt_hi_u32_b32 %0, -1, %0" : "=v"(l)); return l; }
__device__ __forceinline__ unsigned cvt_pk_bf16(float lo, float hi) { unsigned r; asm volatile("v_cvt_pk_bf16_f32 %0, %1, %2" : "=v"(r) : "v"(lo), "v"(hi)); return r; }
typedef unsigned u32x2 __attribute__((ext_vector_type(2)));
constexpr int DM = 2048;
constexpr int NSSQ = 32;
__device__ __forceinline__ float sigmoid_f(float x) { return __builtin_amdgcn_rcpf(1.0f + __expf(-x)); }
__device__ __forceinline__ float silu_f(float x) { return x * sigmoid_f(x); }
__device__ __forceinline__ float gelu_tanh_f(float x) { return x * sigmoid_f(1.5957691216057308f * (x + 0.044715f * x * x * x)); }
__device__ __forceinline__ void rows_rstd(const float* ssq, int row0, int fq, float (&rs)[2][4]) {
    f32x4 pa[2][4], pb[2][4];
#pragma unroll
    for (int ai = 0; ai < 2; ++ai)
#pragma unroll
        for (int m = 0; m < 4; ++m) { const f32x4* p = (const f32x4*)(ssq + (size_t)(row0 + ai * HALF + m * 16) * NSSQ + fq * 8); pa[ai][m] = p[0]; pb[ai][m] = p[1]; }
#pragma unroll
    for (int ai = 0; ai < 2; ++ai)
#pragma unroll
        for (int m = 0; m < 4; ++m) { const f32x4 a = pa[ai][m], b = pb[ai][m];
            float s = ((a[0] + a[1]) + (a[2] + a[3])) + ((b[0] + b[1]) + (b[2] + b[3]));
            s += __shfl_xor(s, 16); s += __shfl_xor(s, 32);
            rs[ai][m] = 1.0f / sqrtf(s * (1.0f / (float)DM) + 1e-6f); }
}

struct EpiSwiGLU {
    static constexpr bool PERM = true, AFTER_DRAIN = false, INIT_ACC = false;
    bf16_t* O; int ldo; const float* ssq;
    __device__ __forceinline__ void operator()(const f32x4 (&acc)[2][2][4][2], const Unit& u, int wr, int wc, int fr, int fq) const {
        const int row0 = u.pm * BM + wr * 64 + fr, col0 = u.pn * HALF + wc * 32 + 8 * fq;
        float rs[2][4]; rows_rstd(ssq, row0, fq, rs);
#pragma unroll
        for (int ai = 0; ai < 2; ++ai)
#pragma unroll
            for (int m = 0; m < 4; ++m) {
                const int row = row0 + ai * HALF + m * 16; const float r = rs[ai][m];
                float h[8];
#pragma unroll
                for (int n = 0; n < 2; ++n)
#pragma unroll
                    for (int j = 0; j < 4; ++j) { const float g = acc[ai][0][m][n][j] * r, up = acc[ai][1][m][n][j] * r; h[n * 4 + j] = silu_f(g) * up; }
                u32x4 w; w.x = cvt_pk_bf16(h[0], h[1]); w.y = cvt_pk_bf16(h[2], h[3]); w.z = cvt_pk_bf16(h[4], h[5]); w.w = cvt_pk_bf16(h[6], h[7]);
                *(u32x4*)(O + (size_t)row * ldo + col0) = w;
            }
    }
};
struct EpiResid {
    static constexpr bool PERM = false, AFTER_DRAIN = false, INIT_ACC = false;
    const float* src; float* dst; bf16_t* xb; float* ssq_out; float scale;
    __device__ __forceinline__ void operator()(const f32x4 (&acc)[2][2][4][2], const Unit& u, int wr, int wc, int fr, int fq) const {
        const int row0 = u.pm * BM + wr * 64 + fr, col0 = u.pn * BM + wc * 32 + 4 * fq;
#pragma unroll
        for (int ai = 0; ai < 2; ++ai) {
            f32x4 sv[4][2][2];
#pragma unroll
            for (int m = 0; m < 4; ++m)
#pragma unroll
                for (int bj = 0; bj < 2; ++bj)
#pragma unroll
                    for (int n = 0; n < 2; ++n) sv[m][bj][n] = *(const f32x4*)(src + (size_t)(row0 + ai * HALF + m * 16) * DM + col0 + bj * HALF + n * 16);
#pragma unroll
            for (int m = 0; m < 4; ++m) {
                const int row = row0 + ai * HALF + m * 16; float ss = 0.f;
#pragma unroll
                for (int bj = 0; bj < 2; ++bj)
#pragma unroll
                    for (int n = 0; n < 2; ++n) { const size_t off = (size_t)row * DM + col0 + bj * HALF + n * 16;
                        const f32x4 o = sv[m][bj][n] + acc[ai][bj][m][n] * scale;
                        *(f32x4*)(dst + off) = o; u32x2 w; w.x = cvt_pk_bf16(o[0], o[1]); w.y = cvt_pk_bf16(o[2], o[3]); *(u32x2*)(xb + off) = w;
                        ss += (o[0] * o[0] + o[1] * o[1]) + (o[2] * o[2] + o[3] * o[3]); }
                ss += __shfl_xor(ss, 16); ss += __shfl_xor(ss, 32);
                if (fq == 0) ssq_out[(size_t)row * NSSQ + u.pn * 4 + wc] = ss;
            }
        }
    }
};
struct EpiResidInit {
    static constexpr bool PERM = false, AFTER_DRAIN = false, INIT_ACC = true;
    const float* src; float* dst; bf16_t* xb; float* ssq_out;
    __device__ __forceinline__ void init_acc(f32x4 (&acc)[2][2][4][2], const Unit& u, int wr, int wc, int fr, int fq) const {
        const int row0 = u.pm * BM + wr * 64 + fr, col0 = u.pn * BM + wc * 32 + 4 * fq;
#pragma unroll
        for (int ai = 0; ai < 2; ++ai)
#pragma unroll
            for (int m = 0; m < 4; ++m)
#pragma unroll
                for (int bj = 0; bj < 2; ++bj)
#pragma unroll
                    for (int n = 0; n < 2; ++n) acc[ai][bj][m][n] = __builtin_nontemporal_load((const f32x4*)(src + (size_t)(row0 + ai * HALF + m * 16) * DM + col0 + bj * HALF + n * 16));
    }
    __device__ __forceinline__ void operator()(const f32x4 (&acc)[2][2][4][2], const Unit& u, int wr, int wc, int fr, int fq) const {
        const int row0 = u.pm * BM + wr * 64 + fr, col0 = u.pn * BM + wc * 32 + 4 * fq;
#pragma unroll
        for (int ai = 0; ai < 2; ++ai)
#pragma unroll
            for (int m = 0; m < 4; ++m) {
                const int row = row0 + ai * HALF + m * 16; float ss = 0.f;
#pragma unroll
                for (int bj = 0; bj < 2; ++bj)
#pragma unroll
                    for (int n = 0; n < 2; ++n) { const size_t off = (size_t)row * DM + col0 + bj * HALF + n * 16;
                        const f32x4 o = acc[ai][bj][m][n];
                        *(f32x4*)(dst + off) = o; u32x2 w; w.x = cvt_pk_bf16(o[0], o[1]); w.y = cvt_pk_bf16(o[2], o[3]); *(u32x2*)(xb + off) = w;
                        ss += (o[0] * o[0] + o[1] * o[1]) + (o[2] * o[2] + o[3] * o[3]); }
                ss += __shfl_xor(ss, 16); ss += __shfl_xor(ss, 32);
                if (fq == 0) ssq_out[(size_t)row * NSSQ + u.pn * 4 + wc] = ss;
            }
    }
};
struct EpiZ {
    static constexpr bool PERM = true, AFTER_DRAIN = false, INIT_ACC = false;
    const float* ssq; const float* hlb;
    bf16_t* mixa;
    float* logf; bf16_t* vv; bf16_t* sg; bf16_t* lrx;
    __device__ __forceinline__ void operator()(const f32x4 (&acc)[2][2][4][2], const Unit& u, int wr, int wc, int fr, int fq) const {
        const int seg = u.pn >> 2;
        const int row0 = u.pm * BM + wr * 64 + fr, cs0 = (u.pn & 3) * BM + wc * 32 + 8 * fq;
        float rs[2][4]; rows_rstd(ssq, row0, fq, rs);
        float lbv[2][8];
        if (seg == 1) {
#pragma unroll
            for (int bj = 0; bj < 2; ++bj)
#pragma unroll
                for (int e = 0; e < 8; ++e) { const int c = cs0 + bj * HALF + e; lbv[bj][e] = sigmoid_f(hlb[c] - hlb[1024 + c]); }
        }
#pragma unroll
        for (int ai = 0; ai < 2; ++ai)
#pragma unroll
            for (int m = 0; m < 4; ++m) {
                const int row = row0 + ai * HALF + m * 16; const float r = rs[ai][m];
#pragma unroll
                for (int bj = 0; bj < 2; ++bj) {
                    const int cs = cs0 + bj * HALF;
                    float z[8];
#pragma unroll
                    for (int n = 0; n < 2; ++n)
#pragma unroll
                        for (int j = 0; j < 4; ++j) z[n * 4 + j] = acc[ai][bj][m][n][j] * r;
                    if (seg == 1) {
                        float lf[8];
#pragma unroll
                        for (int e = 0; e < 8; ++e) { const float lb = lbv[bj][e]; lf[e] = __logf(lb + (1.0f - lb) * sigmoid_f(z[e])); }
                        float* p = logf + (size_t)row * 1024 + cs;
                        *(f32x4*)p = (f32x4){lf[0], lf[1], lf[2], lf[3]}; *(f32x4*)(p + 4) = (f32x4){lf[4], lf[5], lf[6], lf[7]};
                    } else {
                        if (seg == 3) {
#pragma unroll
                            for (int e = 0; e < 8; ++e) z[e] = silu_f(z[e]);
                        } else if (seg == 5) {
#pragma unroll
                            for (int e = 0; e < 8; ++e) z[e] = gelu_tanh_f(z[e]);
                        }
                        u32x4 w; w.x = cvt_pk_bf16(z[0], z[1]); w.y = cvt_pk_bf16(z[2], z[3]); w.z = cvt_pk_bf16(z[4], z[5]); w.w = cvt_pk_bf16(z[6], z[7]);
                        bf16_t* p;
                        if (seg == 0) p = mixa + (size_t)row * 2048 + cs;
                        else if (seg == 5) p = mixa + (size_t)row * 2048 + 1024 + cs;
                        else if (seg == 2) p = vv + (size_t)row * 1024 + cs;
                        else if (seg == 3) p = sg + (size_t)row * 1024 + cs;
                        else p = lrx + (size_t)row * 1024 + cs;
                        *(u32x4*)p = w;
                    }
                }
            }
    }
};
struct EpiPP {
    static constexpr bool PERM = false, AFTER_DRAIN = false, INIT_ACC = false;
    bf16_t* PP;
    __device__ __forceinline__ void operator()(const f32x4 (&acc)[2][2][4][2], const Unit& u, int wr, int wc, int fr, int fq) const {
        const int row0 = u.pm * BM + wr * 64 + fr, col0 = u.pn * BM + wc * 32 + 4 * fq;
#pragma unroll
        for (int ai = 0; ai < 2; ++ai)
#pragma unroll
            for (int m = 0; m < 4; ++m) { bf16_t* rowp = PP + (size_t)(row0 + ai * HALF + m * 16) * DM + col0;
#pragma unroll
                for (int bj = 0; bj < 2; ++bj)
#pragma unroll
                    for (int n = 0; n < 2; ++n) { const f32x4 a = acc[ai][bj][m][n]; u32x2 w; w.x = cvt_pk_bf16(a[0], a[1]); w.y = cvt_pk_bf16(a[2], a[3]); *(u32x2*)(rowp + bj * HALF + n * 16) = w; } }
    }
};
__device__ __forceinline__ f32x4 bf16x4_to_f32(u32x2 w) { f32x4 r; r[0] = __builtin_bit_cast(float, w.x << 16); r[1] = __builtin_bit_cast(float, w.x & 0xffff0000u); r[2] = __builtin_bit_cast(float, w.y << 16); r[3] = __builtin_bit_cast(float, w.y & 0xffff0000u); return r; }
struct EpiPLE {
    static constexpr bool PERM = false, AFTER_DRAIN = false, INIT_ACC = false;
    const float* ssq_in; const float* bg; const bf16_t* PP; float* X; float* ssq_out;
    __device__ __forceinline__ void operator()(const f32x4 (&acc)[2][2][4][2], const Unit& u, int wr, int wc, int fr, int fq) const {
        const int row0 = u.pm * BM + wr * 64 + fr, col0 = u.pn * BM + wc * 32 + 4 * fq;
        float rs[2][4]; rows_rstd(ssq_in, row0, fq, rs);
#pragma unroll
        for (int ai = 0; ai < 2; ++ai)
#pragma unroll
            for (int m = 0; m < 4; ++m) {
                const int row = row0 + ai * HALF + m * 16; const float r = rs[ai][m]; float ss = 0.f;
                f32x4 pv[2][2], ov[2][2];
#pragma unroll
                for (int bj = 0; bj < 2; ++bj)
#pragma unroll
                    for (int n = 0; n < 2; ++n) { const size_t off = (size_t)row * DM + col0 + bj * HALF + n * 16; pv[bj][n] = bf16x4_to_f32(*(const u32x2*)(PP + off)); ov[bj][n] = *(const f32x4*)(X + off); }
#pragma unroll
                for (int bj = 0; bj < 2; ++bj)
#pragma unroll
                    for (int n = 0; n < 2; ++n) { const int c = col0 + bj * HALF + n * 16; const size_t off = (size_t)row * DM + c;
                        const f32x4 b4 = *(const f32x4*)(bg + c), a = acc[ai][bj][m][n]; f32x4 o;
#pragma unroll
                        for (int j = 0; j < 4; ++j) o[j] = ov[bj][n][j] + sigmoid_f(a[j] * r + b4[j]) * pv[bj][n][j];
                        *(f32x4*)(X + off) = o; ss += (o[0] * o[0] + o[1] * o[1]) + (o[2] * o[2] + o[3] * o[3]); }
                ss += __shfl_xor(ss, 16); ss += __shfl_xor(ss, 32);
                if (fq == 0) ssq_out[(size_t)row * NSSQ + u.pn * 4 + wc] = ss;
            }
    }
};

struct EpiPLEFinal {
    static constexpr bool PERM = false, AFTER_DRAIN = true, INIT_ACC = false;
    const float* ssq_in; const float* bg; const bf16_t* PP; float* X; float* xch; unsigned* cnt; const float* gf;
    __device__ __forceinline__ void operator()(const f32x4 (&)[2][2][4][2], const Unit&, int, int, int, int) const {}
    __device__ __forceinline__ void fused(f32x4 (&acc)[2][2][4][2], const Unit& u, int wr, int wc, int fr, int fq, PG8_LAS unsigned char* lds, int wid, int lane) const {
        const int row0 = u.pm * BM + wr * 64 + fr, col0 = u.pn * BM + wc * 32 + 4 * fq;
        float rs[2][4]; rows_rstd(ssq_in, row0, fq, rs);
        f32x4 b4[2][2];
#pragma unroll
        for (int bj = 0; bj < 2; ++bj)
#pragma unroll
            for (int n = 0; n < 2; ++n) b4[bj][n] = *(const f32x4*)(bg + col0 + bj * HALF + n * 16);
#pragma unroll
        for (int ai = 0; ai < 2; ++ai)
#pragma unroll
          for (int mp = 0; mp < 2; ++mp) {
            u32x2 pv[2][2][2]; f32x4 ov[2][2][2];
#pragma unroll
            for (int mm = 0; mm < 2; ++mm)
#pragma unroll
                for (int bj = 0; bj < 2; ++bj)
#pragma unroll
                    for (int n = 0; n < 2; ++n) { const size_t off = (size_t)(row0 + ai * HALF + (2 * mp + mm) * 16) * DM + col0 + bj * HALF + n * 16; pv[mm][bj][n] = *(const u32x2*)(PP + off); ov[mm][bj][n] = *(const f32x4*)(X + off); }
#pragma unroll
            for (int mm = 0; mm < 2; ++mm) {
                const int m = 2 * mp + mm, row = row0 + ai * HALF + m * 16; const float r = rs[ai][m]; float ss = 0.f;
#pragma unroll
                for (int bj = 0; bj < 2; ++bj)
#pragma unroll
                    for (int n = 0; n < 2; ++n) { const f32x4 a = acc[ai][bj][m][n], pp = bf16x4_to_f32(pv[mm][bj][n]); f32x4 o;
#pragma unroll
                        for (int j = 0; j < 4; ++j) o[j] = ov[mm][bj][n][j] + sigmoid_f(a[j] * r + b4[bj][n][j]) * pp[j];
                        acc[ai][bj][m][n] = o; ss += (o[0] * o[0] + o[1] * o[1]) + (o[2] * o[2] + o[3] * o[3]); }
                ss += __shfl_xor(ss, 16); ss += __shfl_xor(ss, 32);
                if (fq == 0) __hip_atomic_store(xch + (size_t)row * NSSQ + u.pn * 4 + wc, ss, __ATOMIC_RELAXED, __HIP_MEMORY_SCOPE_AGENT);
            }
          }
        asm volatile("s_waitcnt vmcnt(0)" ::: "memory");
        unsigned* pc = cnt + 64 * u.pm;
        if (lane == 0) __hip_atomic_fetch_add(pc, 1u, __ATOMIC_RELAXED, __HIP_MEMORY_SCOPE_AGENT);
        if (wid == 0) {
            unsigned sp = 0;
            while ((unsigned)__builtin_amdgcn_readfirstlane(__hip_atomic_load(pc, __ATOMIC_RELAXED, __HIP_MEMORY_SCOPE_AGENT)) < 64u) { __builtin_amdgcn_s_sleep(2); if (++sp > (1u << 22)) break; }
            __builtin_amdgcn_fence(__ATOMIC_ACQUIRE, "agent");
        }
        asm volatile("s_waitcnt vmcnt(0) lgkmcnt(0)" ::: "memory"); __builtin_amdgcn_s_barrier(); asm volatile("" ::: "memory");
        float r4[2][4]; rows_rstd(xch, row0, fq, r4);
        f32x4 g4[2][2];
#pragma unroll
        for (int bj = 0; bj < 2; ++bj)
#pragma unroll
            for (int n = 0; n < 2; ++n) g4[bj][n] = *(const f32x4*)(gf + col0 + bj * HALF + n * 16);
#pragma unroll
        for (int ai = 0; ai < 2; ++ai)
#pragma unroll
            for (int m = 0; m < 4; ++m) { float* rowp = X + (size_t)(row0 + ai * HALF + m * 16) * DM + col0; const float r = r4[ai][m];
#pragma unroll
                for (int bj = 0; bj < 2; ++bj)
#pragma unroll
                    for (int n = 0; n < 2; ++n) *(f32x4*)(rowp + bj * HALF + n * 16) = acc[ai][bj][m][n] * r * g4[bj][n]; }
    }
};

template <class Epi, class Sched, bool ALIGN_EPI = false, bool SP2 = false, bool BAL = false>
__device__ __forceinline__ void gemm_phase(PG8_LAS unsigned char* lds, const Gemm g, const Sched& S, const Epi& E, const int wave_s) {
    int tid_ = wave_s * 64 + lane_id_asm();
    const int tid = tid_, wid = wave_s, lane = tid & 63, wr = wid >> 2, wc = wid & 3, fr = lane & 15, fq = lane >> 4;
    const int K = g.K, nt = K / BK;
    unsigned voffA[2], voffB[2];
#pragma unroll
    for (int i = 0; i < 2; ++i) { int R, C; stage_rc(tid * 16 + i * 8192, R, C); const int Rb = Epi::PERM ? ((R & ~31) + perm32(R & 31)) : R;
        voffA[i] = (unsigned)(R * K + C) * 2u; voffB[i] = (unsigned)(Rb * K + C) * 2u; }
    const size_t kstep = (size_t)(BK * 2);
    const size_t hstep = (size_t)HALF * K * 2;
    const size_t tstep = 2 * hstep;
    const unsigned ldsw = (unsigned)wid * 1024u;
    const int aoff = lds_byte(wr * 64 + fr, fq * 8), boff = lds_byte(wc * 32 + fr, fq * 8);
#define PG8_SA(b, h) (((b) * 2 + (h)) * HTB)
#define PG8_SB(b, h) ((4 + (b) * 2 + (h)) * HTB)
#define PG8_STAGE(bufoff, gbase, voff) do { _Pragma("unroll") for (int _i = 0; _i < 2; ++_i) \
        __builtin_amdgcn_global_load_lds((const unsigned*)((const char*)(gbase) + (voff)[_i]), (PG8_LAS unsigned*)(lds + (bufoff) + ldsw + _i * 8192), 16, 0, 0); } while (0)
#define PG8_LDA(dst, b, h) do { _Pragma("unroll") for (int m = 0; m < 4; ++m) _Pragma("unroll") for (int k = 0; k < 2; ++k) dst[m][k] = *(const PG8_LAS bf16x8*)(lds + PG8_SA(b, h) + aoff + m * 2048 + k * 1024); } while (0)
#define PG8_LDB(dst, b, h) do { _Pragma("unroll") for (int n = 0; n < 2; ++n) _Pragma("unroll") for (int k = 0; k < 2; ++k) dst[n][k] = *(const PG8_LAS bf16x8*)(lds + PG8_SB(b, h) + boff + n * 2048 + k * 1024); } while (0)
#define PG8_MMA(ai, bj, At, Bt) do { __builtin_amdgcn_s_setprio(1); _Pragma("unroll") for (int m = 0; m < 4; ++m) _Pragma("unroll") for (int n = 0; n < 2; ++n) _Pragma("unroll") for (int k = 0; k < 2; ++k) \
        acc[ai][bj][m][n] = __builtin_amdgcn_mfma_f32_16x16x32_bf16(Bt[n][k], At[m][k], acc[ai][bj][m][n], 0, 0, 0); __builtin_amdgcn_s_setprio(0); } while (0)
#define PG8_WAIT_V(n) asm volatile("s_waitcnt vmcnt(" #n ")" ::: "memory")
#define PG8_WAIT_L(n) asm volatile("s_waitcnt lgkmcnt(" #n ")" ::: "memory")
#define PG8_BAR __builtin_amdgcn_s_barrier()
#define PG8_SCHED __builtin_amdgcn_sched_barrier(0)
    Unit cur, nxt; int ui = 0;
    if (!S.next(0, cur)) return;
    f32x4 acc[2][2][4][2];
    if constexpr (Epi::INIT_ACC) { E.init_acc(acc, cur, wr, wc, fr, fq); }
    else {
#pragma unroll
    for (int a = 0; a < 2; ++a)
#pragma unroll
        for (int b = 0; b < 2; ++b)
#pragma unroll
            for (int m = 0; m < 4; ++m)
#pragma unroll
                for (int n = 0; n < 2; ++n) acc[a][b][m][n] = (f32x4){0.f, 0.f, 0.f, 0.f};
    }
    bf16x8 At[4][2], B0[2][2], B1[2][2];
    const char* cA = (const char*)g.A + (size_t)cur.pm * tstep; const char* cB = (const char*)g.Bt + (size_t)cur.pn * tstep;
    S.a_ready(cur);
    if constexpr (SP2) {
        PG8_STAGE(PG8_SB(0, 0), cB, voffB); PG8_STAGE(PG8_SB(0, 1), cB + hstep, voffB); PG8_STAGE(PG8_SA(0, 0), cA, voffA); PG8_STAGE(PG8_SA(0, 1), cA + hstep, voffA);
        if (wr == 1) PG8_BAR;
        PG8_WAIT_V(2); PG8_BAR;
        if constexpr (BAL) {
            PG8_STAGE(PG8_SB(1, 0), cB + kstep, voffB); PG8_STAGE(PG8_SB(1, 1), cB + hstep + kstep, voffB);
            PG8_WAIT_V(4); PG8_BAR;
        } else {
        PG8_STAGE(PG8_SB(1, 0), cB + kstep, voffB); PG8_STAGE(PG8_SA(1, 0), cA + kstep, voffA); PG8_STAGE(PG8_SB(1, 1), cB + hstep + kstep, voffB);
        PG8_WAIT_V(6); PG8_BAR;
        }
    } else {
        PG8_STAGE(PG8_SB(0, 0), cB, voffB); PG8_STAGE(PG8_SA(0, 0), cA, voffA); PG8_STAGE(PG8_SB(0, 1), cB + hstep, voffB); PG8_STAGE(PG8_SA(0, 1), cA + hstep, voffA);
        if (wr == 1) PG8_BAR;
        PG8_WAIT_V(4); PG8_BAR;
        PG8_STAGE(PG8_SB(1, 0), cB + kstep, voffB); PG8_STAGE(PG8_SA(1, 0), cA + kstep, voffA); PG8_STAGE(PG8_SB(1, 1), cB + hstep + kstep, voffB);
        PG8_WAIT_V(6); PG8_BAR;
    }
    for (;;) {
        const bool has_next = S.next(ui + 1, nxt);
        const char* nA = has_next ? (const char*)g.A + (size_t)nxt.pm * tstep : cA; const char* nB = has_next ? (const char*)g.Bt + (size_t)nxt.pn * tstep : cB;
        for (int t = 0; t < nt; t += 2) {
            const bool last = (t == nt - 2);
            const char* a1 = cA + (size_t)(t + 1) * kstep;
            const char* a2 = last ? nA : cA + (size_t)(t + 2) * kstep; const char* b2 = last ? nB : cB + (size_t)(t + 2) * kstep;
            const char* a3 = a2 + kstep; const char* b3 = b2 + kstep;
            if (last && has_next) S.a_ready(nxt);
            if constexpr (SP2 && BAL) {
            PG8_LDB(B0, 0, 0); PG8_LDB(B1, 0, 1); PG8_SCHED; PG8_LDA(At, 0, 0); PG8_STAGE(PG8_SA(1, 0), a1, voffA); PG8_STAGE(PG8_SA(1, 1), a1 + hstep, voffA);
            PG8_WAIT_V(4); PG8_WAIT_L(0); PG8_BAR; PG8_MMA(0, 0, At, B0); PG8_MMA(0, 1, At, B1); PG8_BAR; PG8_SCHED;
            PG8_LDA(At, 0, 1); PG8_STAGE(PG8_SB(0, 0), b2, voffB); PG8_STAGE(PG8_SB(0, 1), b2 + hstep, voffB);
            PG8_WAIT_V(4); PG8_WAIT_L(0); PG8_BAR; PG8_MMA(1, 0, At, B0); PG8_MMA(1, 1, At, B1); PG8_BAR; PG8_SCHED;
            PG8_LDB(B0, 1, 0); PG8_LDB(B1, 1, 1); PG8_SCHED; PG8_LDA(At, 1, 0); PG8_STAGE(PG8_SA(0, 0), a2, voffA); PG8_STAGE(PG8_SA(0, 1), a2 + hstep, voffA);
            PG8_WAIT_V(4); PG8_WAIT_L(0); PG8_BAR; PG8_MMA(0, 0, At, B0); PG8_MMA(0, 1, At, B1); PG8_BAR; PG8_SCHED;
            PG8_LDA(At, 1, 1); PG8_STAGE(PG8_SB(1, 0), b3, voffB); PG8_STAGE(PG8_SB(1, 1), b3 + hstep, voffB);
            PG8_WAIT_V(4); PG8_WAIT_L(0); PG8_BAR; PG8_MMA(1, 0, At, B0); PG8_MMA(1, 1, At, B1); PG8_BAR; PG8_SCHED;
            } else if constexpr (SP2) {
            PG8_LDB(B0, 0, 0); PG8_LDB(B1, 0, 1); PG8_SCHED; PG8_LDA(At, 0, 0); PG8_STAGE(PG8_SA(1, 1), a1 + hstep, voffA);
            PG8_WAIT_V(8); PG8_WAIT_L(0); PG8_BAR; PG8_MMA(0, 0, At, B0); PG8_MMA(0, 1, At, B1); PG8_BAR; PG8_SCHED;
            PG8_LDA(At, 0, 1); PG8_STAGE(PG8_SB(0, 0), b2, voffB); PG8_STAGE(PG8_SB(0, 1), b2 + hstep, voffB); PG8_STAGE(PG8_SA(0, 0), a2, voffA);
            PG8_WAIT_V(8); PG8_WAIT_L(0); PG8_BAR; PG8_MMA(1, 0, At, B0); PG8_MMA(1, 1, At, B1); PG8_BAR; PG8_SCHED;
            PG8_LDB(B0, 1, 0); PG8_LDB(B1, 1, 1); PG8_SCHED; PG8_LDA(At, 1, 0); PG8_STAGE(PG8_SA(0, 1), a2 + hstep, voffA);
            PG8_WAIT_V(8); PG8_WAIT_L(0); PG8_BAR; PG8_MMA(0, 0, At, B0); PG8_MMA(0, 1, At, B1); PG8_BAR; PG8_SCHED;
            PG8_LDA(At, 1, 1); PG8_STAGE(PG8_SB(1, 0), b3, voffB); PG8_STAGE(PG8_SB(1, 1), b3 + hstep, voffB); PG8_STAGE(PG8_SA(1, 0), a3, voffA);
            PG8_WAIT_V(8); PG8_WAIT_L(0); PG8_BAR; PG8_MMA(1, 0, At, B0); PG8_MMA(1, 1, At, B1); PG8_BAR; PG8_SCHED;
            } else {
            PG8_LDB(B0, 0, 0); PG8_SCHED; PG8_LDA(At, 0, 0); PG8_STAGE(PG8_SA(1, 1), a1 + hstep, voffA);
            PG8_WAIT_L(8); PG8_BAR; PG8_WAIT_L(0); PG8_MMA(0, 0, At, B0); PG8_BAR; PG8_SCHED;
            PG8_LDB(B1, 0, 1); PG8_STAGE(PG8_SB(0, 0), b2, voffB);
            PG8_BAR; PG8_WAIT_L(0); PG8_MMA(0, 1, At, B1); PG8_BAR;
            PG8_LDA(At, 0, 1); PG8_STAGE(PG8_SA(0, 0), a2, voffA);
            PG8_BAR; PG8_WAIT_L(0); PG8_MMA(1, 0, At, B0); PG8_BAR; PG8_SCHED;
            PG8_STAGE(PG8_SB(0, 1), b2 + hstep, voffB);
            PG8_WAIT_V(6); PG8_BAR; PG8_MMA(1, 1, At, B1); PG8_BAR;
            PG8_LDB(B0, 1, 0); PG8_SCHED; PG8_LDA(At, 1, 0); PG8_STAGE(PG8_SA(0, 1), a2 + hstep, voffA);
            PG8_WAIT_L(8); PG8_BAR; PG8_WAIT_L(0); PG8_MMA(0, 0, At, B0); PG8_BAR; PG8_SCHED;
            PG8_LDB(B1, 1, 1); PG8_STAGE(PG8_SB(1, 0), b3, voffB);
            PG8_BAR; PG8_WAIT_L(0); PG8_MMA(0, 1, At, B1); PG8_BAR;
            PG8_LDA(At, 1, 1); PG8_STAGE(PG8_SA(1, 0), a3, voffA);
            PG8_BAR; PG8_WAIT_L(0); PG8_MMA(1, 0, At, B0); PG8_BAR; PG8_SCHED;
            PG8_STAGE(PG8_SB(1, 1), b3 + hstep, voffB);
            PG8_WAIT_V(6); PG8_BAR; PG8_MMA(1, 1, At, B1); PG8_BAR;
            }
        }
        if constexpr (ALIGN_EPI) { if (wr == 0) PG8_BAR; }
        if constexpr (!Epi::AFTER_DRAIN) { E(acc, cur, wr, wc, fr, fq); S.done(cur); }
        if (!has_next) break;
#pragma unroll
        for (int a = 0; a < 2; ++a)
#pragma unroll
            for (int b = 0; b < 2; ++b)
#pragma unroll
                for (int m = 0; m < 4; ++m)
#pragma unroll
                    for (int n = 0; n < 2; ++n) acc[a][b][m][n] = (f32x4){0.f, 0.f, 0.f, 0.f};
        cur = nxt; cA = nA; cB = nB; ++ui;
        if constexpr (ALIGN_EPI) { if (wr == 1) PG8_BAR; }
    }
    PG8_WAIT_V(0);
    if constexpr (!ALIGN_EPI) { if (wr == 0) PG8_BAR; }
    PG8_BAR;
    if constexpr (Epi::AFTER_DRAIN) { E.fused(acc, cur, wr, wc, fr, fq, lds, wid, lane); S.done(cur); }
#undef PG8_SA
#undef PG8_SB
#undef PG8_STAGE
#undef PG8_LDA
#undef PG8_LDB
#undef PG8_MMA
#undef PG8_WAIT_V
#undef PG8_WAIT_L
#undef PG8_BAR
#undef PG8_SCHED
}
}
#define GAS __attribute__((address_space(1)))
#define LAS __attribute__((address_space(3)))
typedef unsigned short bf16;
typedef unsigned v4u __attribute__((ext_vector_type(4)));
typedef float f32x4 __attribute__((ext_vector_type(4)));
typedef short bf16x8 __attribute__((ext_vector_type(8)));
typedef GAS unsigned gu32;
typedef GAS unsigned long long gu64;
#define RLX_AGENT __ATOMIC_RELAXED, __HIP_MEMORY_SCOPE_AGENT
#define LDS_WAIT() asm volatile("s_waitcnt lgkmcnt(0)" ::: "memory")
#define VM_WAIT() asm volatile("s_waitcnt vmcnt(0)" ::: "memory")
__device__ __forceinline__ unsigned long long rt() { return __builtin_amdgcn_s_memrealtime(); }
__device__ __forceinline__ unsigned f2bf(float f) { unsigned u = __builtin_bit_cast(unsigned, f); return (u + 0x7fffu + ((u >> 16) & 1u)) >> 16; }
__device__ __forceinline__ unsigned pk2(float lo, float hi) { return f2bf(lo) | (f2bf(hi) << 16); }

#define XB_TMO      128
#define XB_XCNT(j)  (256  + 64 * (j))
#define XB_XSUB(j)  (1280 + 64 * (j))
#define XB_XGEN(j)  (2304 + 64 * (j))
#define XB_TOP      3328
#define XB_TOPGEN   3392
#define XCD_BAR_WORDS 3456
#define XB_SPIN_CAP (1u << 18)

__device__ __forceinline__ unsigned xb_ld(unsigned* p)              { return __hip_atomic_load(p, __ATOMIC_RELAXED, __HIP_MEMORY_SCOPE_AGENT); }
__device__ __forceinline__ unsigned xb_add(unsigned* p, unsigned v) { return __hip_atomic_fetch_add(p, v, __ATOMIC_RELAXED, __HIP_MEMORY_SCOPE_AGENT); }
__device__ __forceinline__ unsigned xb_xcc_id() { return (unsigned)__builtin_amdgcn_s_getreg((3 << 11) | 20) & 0xFu; }
#define XB_SPIN(cond, bar) do { unsigned _sp = 0; while (cond) { __builtin_amdgcn_s_sleep(1); \
    if ((++_sp & 255u) == 0u) { if (xb_ld(&(bar)[XB_TMO])) break; if (_sp > XB_SPIN_CAP) { atomicAdd(&(bar)[XB_TMO], 1u); break; } } } } while (0)

struct XcdBarrier {
    unsigned* bar; unsigned x; int wave;
    volatile LAS unsigned* st;
};

__device__ __forceinline__ XcdBarrier xcd_barrier_post(unsigned* bar, volatile LAS unsigned* st, int wave) {
    XcdBarrier b; b.bar = bar; b.x = xb_xcc_id(); b.st = st; b.wave = wave;
    if (wave == 0 && pg8::lane_id_asm() == 0) (void)xb_add(&bar[XB_XCNT(b.x)], 1u);
    return b;
}
__device__ __forceinline__ void xcd_barrier_complete(unsigned* bar, unsigned x, unsigned& nloc, unsigned& nx) {
    const unsigned G = gridDim.x * gridDim.y * gridDim.z;
    unsigned sum, cnt, mine, sp = 0u;
    for (;;) {
        sum = 0u; cnt = 0u; mine = 0u;
#pragma unroll
        for (unsigned j = 0; j < 16; ++j) { const unsigned c = xb_ld(&bar[XB_XCNT(j)]); sum += c; cnt += (c > 0u) ? 1u : 0u; mine = (j == x) ? c : mine; }
        if (sum == G) break;
        __builtin_amdgcn_s_sleep(1);
        if ((++sp & 255u) == 0u) { if (xb_ld(&bar[XB_TMO])) break; if (sp > XB_SPIN_CAP) { atomicAdd(&bar[XB_TMO], 1u); break; } }
    }
    nloc = mine > 0u ? mine : 1u; nx = cnt > 0u ? cnt : 1u;
}

__device__ __forceinline__ void xcd_barrier(const XcdBarrier& b) {
    asm volatile("s_waitcnt vmcnt(0)" ::: "memory");
    __syncthreads();
    if (b.wave == 0 && pg8::lane_id_asm() == 0) {
        unsigned* bar = b.bar;
        __builtin_amdgcn_s_waitcnt(0);
        unsigned nloc = b.st[0], nx = b.st[1];
        if (nloc == 0u) { xcd_barrier_complete(bar, b.x, nloc, nx); b.st[0] = nloc; b.st[1] = nx; }
        const unsigned old = xb_add(&bar[XB_XSUB(b.x)], 1u);
        const unsigned gen = old / nloc;
        if (old + 1u == (gen + 1u) * nloc) {
            __builtin_amdgcn_fence(__ATOMIC_RELEASE, "agent");
            asm volatile("s_waitcnt vmcnt(0)" ::: "memory");
            const unsigned og = xb_add(&bar[XB_TOP], 1u);
            const unsigned tg = og / nx;
            if (og + 1u == (tg + 1u) * nx) xb_add(&bar[XB_TOPGEN], 1u);
            else XB_SPIN(xb_ld(&bar[XB_TOPGEN]) == tg, bar);
            __builtin_amdgcn_fence(__ATOMIC_ACQUIRE, "agent");
            xb_add(&bar[XB_XGEN(b.x)], 1u);
            asm volatile("s_waitcnt vmcnt(0)" ::: "memory");
        } else {
            XB_SPIN(xb_ld(&bar[XB_XGEN(b.x)]) == gen, bar);
            __builtin_amdgcn_fence(__ATOMIC_ACQUIRE, "agent");
            asm volatile("s_waitcnt vmcnt(0)" ::: "memory");
        }
    }
    __syncthreads();
}

constexpr int NWAVES = 8;
constexpr int BATCH = 4, SEQ = 2048, D = 2048, DFF = 5632, NGU = 2 * DFF, NIN = 6144, PLE = 256;
constexpr int HW = 1024, LW = 1024, HEADS = 8, HD = 128, CHUNK = 64, NCH = SEQ / CHUNK;
constexpr int M = BATCH * SEQ;
constexpr float EPS = 1e-6f;
constexpr int N_IN = 27;
enum In { I_X = 0, I_P, I_F1N, I_F1G, I_F1U, I_F1D, I_MIXN, I_WIN, I_HLB, I_HGN, I_CW, I_CB, I_LWA, I_LBA, I_LWX, I_LBX, I_LAM, I_WOUT,
          I_F2N, I_F2G, I_F2U, I_F2D, I_PLN, I_PWG, I_PBG, I_PWP, I_FN };

constexpr size_t MiB = 1u << 20;
constexpr size_t WS_CTL = 0, CTL_ZERO_BYTES = 1 * MiB;
constexpr size_t WS_SSQA = 1 * MiB, WS_SSQB = 2 * MiB, WS_DEC = 3 * MiB;
constexpr size_t WS_WAT = 3 * MiB + 512 * 1024, WS_WXT = 3 * MiB + 768 * 1024;
constexpr size_t WS_WPROJ = 4 * MiB, WS_PB = 5 * MiB;
constexpr size_t WS_WGU1 = 9 * MiB, WS_WD1 = 53 * MiB, WS_WINT = 75 * MiB, WS_WOUT = 99 * MiB, WS_WGU2 = 107 * MiB, WS_WD2 = 151 * MiB, WS_WPG = 173 * MiB;
constexpr size_t WS_XB = 181 * MiB;
constexpr size_t WS_ACT = 213 * MiB;
constexpr size_t WS_LOGF = WS_ACT, WS_V = WS_ACT + 32 * MiB, WS_SG = WS_ACT + 48 * MiB, WS_LRX = WS_ACT + 64 * MiB, WS_PP = 333 * MiB;
constexpr size_t WS_MIXA = 301 * MiB;
constexpr size_t WS_KVT = 333 * MiB;
constexpr size_t WS_XCH = 397 * MiB;
constexpr size_t WS_WAJ = 398 * MiB, WS_WXJ = 399 * MiB;
constexpr size_t WS_BA2 = 400 * MiB;
constexpr size_t WS_END = 401 * MiB;
static_assert(WS_WGU1 + (size_t)NGU * D * 2 <= WS_WD1 && WS_WD1 + (size_t)D * DFF * 2 <= WS_WINT && WS_WINT + (size_t)NIN * D * 2 <= WS_WOUT && WS_WOUT + (size_t)D * D * 2 <= WS_WGU2 &&
              WS_WGU2 + (size_t)NGU * D * 2 <= WS_WD2 && WS_WD2 + (size_t)D * DFF * 2 <= WS_WPG && WS_WPG + (size_t)D * D * 2 <= WS_XB && WS_XB + (size_t)M * D * 2 <= WS_ACT &&
              WS_ACT + (size_t)M * DFF * 2 <= WS_MIXA && WS_MIXA + (size_t)M * 2048 * 2 <= WS_KVT && WS_KVT + (size_t)BATCH * HEADS * NCH * HD * HD * 4 <= WS_XCH &&
              WS_LRX + (size_t)M * 1024 * 2 <= WS_MIXA && WS_PP + (size_t)M * D * 4 <= 397 * MiB && WS_PB + (size_t)M * PLE * 2 <= WS_WGU1 && WS_WPROJ + (size_t)D * PLE * 2 <= WS_PB, "d_ws map");
constexpr int CW_PANEL = 16384;
constexpr int CW_BAR = 4096;

constexpr int RING_OFF = 0, RING_BYTES = 131072;
constexpr int LDSCTL_OFF = 147456 - 512, MISC_OFF = LDSCTL_OFF + 320;
constexpr int LDS_BYTES = 147456;
static_assert(MISC_OFF + 128 <= LDS_BYTES, "LDS map");


struct Frame {
    LAS unsigned char* lds;
    volatile LAS unsigned* MISC;
    gu32* ctl;
    int wave;
    int vcu, G;
    const float* in[N_IN]; float* out; unsigned char* ws;
};
__device__ __forceinline__ float bf2f(bf16 b) { return __builtin_bit_cast(float, (unsigned)b << 16); }
__device__ __forceinline__ float wave_sum(float v) {
#pragma unroll
    for (int o = 1; o < 64; o <<= 1) v += __shfl_xor(v, o);
    return v;
}
__device__ __forceinline__ void p0_transpose_item(const float* W, int ldw, int K, int src_col0, bf16* WT, int dst_row0, const float* gain, LAS float* scr, int kb, int lane, float wscale = 1.0f) {
    const int k0 = 64 * kb, kq = lane >> 4, nq = lane & 15;
    f32x4 v[16];
#pragma unroll
    for (int i = 0; i < 16; ++i) v[i] = __builtin_nontemporal_load((const GAS f32x4*)(W + (size_t)(k0 + 4 * i + kq) * ldw + src_col0 + 4 * nq));
    if (gain) {
#pragma unroll
        for (int i = 0; i < 16; ++i) v[i] = v[i] * gain[k0 + 4 * i + kq];
    }
    if (wscale != 1.0f) {
#pragma unroll
        for (int i = 0; i < 16; ++i) v[i] = v[i] * wscale;
    }
#pragma unroll
    for (int i = 0; i < 16; ++i) { LAS float* s = scr + (4 * i + kq) * 65 + 4 * nq; s[0] = v[i].x; s[1] = v[i].y; s[2] = v[i].z; s[3] = v[i].w; }
    LDS_WAIT(); asm volatile("" ::: "memory");
    const int c = lane & 7;
#pragma unroll
    for (int j = 0; j < 8; ++j) { const int n = (lane >> 3) + 8 * j; const LAS float* s = scr + (8 * c) * 65 + n;
        v4u o; o.x = pk2(s[0 * 65], s[1 * 65]); o.y = pk2(s[2 * 65], s[3 * 65]); o.z = pk2(s[4 * 65], s[5 * 65]); o.w = pk2(s[6 * 65], s[7 * 65]);
        *(GAS v4u*)(WT + (size_t)(dst_row0 + n) * K + k0 + 8 * c) = o; }
    LDS_WAIT(); asm volatile("" ::: "memory");
}
__device__ __forceinline__ bool p0_plain(int& r, const float* W, int K, int N, bf16* WT, const float* gain, LAS float* scr, int lane, float wscale = 1.0f) {
    const int items = (N / 64) * (K / 64);
    if (r < items) { const int nb = r / (K / 64), kb = r % (K / 64); p0_transpose_item(W, N, K, 64 * nb, WT, 64 * nb, gain, scr, kb, lane, wscale); return true; }
    r -= items; return false;
}
__device__ __forceinline__ bool p0_gateup(int& r, const float* Wg, const float* Wu, bf16* WT, const float* gain, LAS float* scr, int lane) {
    const int items = (NGU / 64) * (D / 64);
    if (r < items) { const int rb = r / (D / 64), kb = r % (D / 64), t = rb >> 2, j = rb & 3;
        p0_transpose_item(j < 2 ? Wg : Wu, DFF, D, 128 * t + 64 * (j & 1), WT, 64 * rb, gain, scr, kb, lane); return true; }
    r -= items; return false;
}
enum { J_X = 1, J_P = 2, J_GU1 = 4, J_D1 = 8, J_WIN = 16, J_WOUT = 32, J_GU2 = 64, J_D2 = 128, J_PG = 256, J_PROJ = 512, J_AX = 1024 };
template <int JOBS>
__device__ __forceinline__ void convert_jobs(Frame& F, int rank, int count) {
    const int lane_ = pg8::lane_id_asm(), wave_ = F.wave;
    LAS float* scr = (LAS float*)(F.lds + RING_OFF + wave_ * 16640);
    const int gw = rank * NWAVES + wave_, NGW = count * NWAVES;
    unsigned char* ws = F.ws;
    if (JOBS & J_X) {
        for (int m = gw; m < M; m += NGW) {
            const GAS f32x4* xr = (const GAS f32x4*)(F.in[I_X] + (size_t)m * D) + lane_;
            GAS unsigned long long* o8 = (GAS unsigned long long*)((bf16*)(ws + WS_XB) + (size_t)m * D) + lane_;
            float s = 0.f;
#pragma unroll
            for (int j = 0; j < 8; ++j) { const f32x4 v = __builtin_nontemporal_load(xr + 64 * j); s += (v.x * v.x + v.y * v.y) + (v.z * v.z + v.w * v.w);
                o8[64 * j] = (unsigned long long)pk2(v.x, v.y) | ((unsigned long long)pk2(v.z, v.w) << 32); }
            s = wave_sum(s);
            if (lane_ < 32) ((float*)(ws + WS_SSQA))[(size_t)m * 32 + lane_] = (lane_ == 0) ? s : 0.f;
        }
    }
    if (JOBS & J_P) {
        for (int m = gw; m < M; m += NGW) {
            const f32x4 v = __builtin_nontemporal_load((const GAS f32x4*)(F.in[I_P] + (size_t)m * PLE) + lane_);
            ((GAS unsigned long long*)((bf16*)(ws + WS_PB) + (size_t)m * PLE))[lane_] = (unsigned long long)pk2(v.x, v.y) | ((unsigned long long)pk2(v.z, v.w) << 32);
        }
    }
    constexpr int I_GU = (NGU / 64) * (D / 64), I_DD = (D / 64) * (DFF / 64), I_IN = (NIN / 64) * (D / 64), I_SQ = (D / 64) * (D / 64), I_PJ = (D / 64) * (PLE / 64), I_AX = 16 * 4 * 4;
    constexpr int NITEMS = ((JOBS & J_GU1) ? I_GU : 0) + ((JOBS & J_D1) ? I_DD : 0) + ((JOBS & J_WIN) ? I_IN : 0) + ((JOBS & J_WOUT) ? I_SQ : 0) + ((JOBS & J_GU2) ? I_GU : 0) +
                           ((JOBS & J_D2) ? I_DD : 0) + ((JOBS & J_PG) ? I_SQ : 0) + ((JOBS & J_PROJ) ? I_PJ : 0) + ((JOBS & J_AX) ? I_AX : 0);
    for (int it = gw; it < NITEMS; it += NGW) {
        int r = it;
        if (JOBS & J_GU1) { if (p0_gateup(r, F.in[I_F1G], F.in[I_F1U], (bf16*)(ws + WS_WGU1), F.in[I_F1N], scr, lane_)) continue; }
        if (JOBS & J_D1) { if (p0_plain(r, F.in[I_F1D], DFF, D, (bf16*)(ws + WS_WD1), nullptr, scr, lane_, 0.5f)) continue; }
        if (JOBS & J_WIN) { if (p0_plain(r, F.in[I_WIN], D, NIN, (bf16*)(ws + WS_WINT), F.in[I_MIXN], scr, lane_)) continue; }
        if (JOBS & J_WOUT) { if (p0_plain(r, F.in[I_WOUT], D, D, (bf16*)(ws + WS_WOUT), nullptr, scr, lane_)) continue; }
        if (JOBS & J_GU2) { if (p0_gateup(r, F.in[I_F2G], F.in[I_F2U], (bf16*)(ws + WS_WGU2), F.in[I_F2N], scr, lane_)) continue; }
        if (JOBS & J_D2) { if (p0_plain(r, F.in[I_F2D], DFF, D, (bf16*)(ws + WS_WD2), nullptr, scr, lane_, 0.5f)) continue; }
        if (JOBS & J_PG) { if (p0_plain(r, F.in[I_PWG], D, D, (bf16*)(ws + WS_WPG), F.in[I_PLN], scr, lane_)) continue; }
        if (JOBS & J_PROJ) { if (p0_plain(r, F.in[I_PWP], PLE, D, (bf16*)(ws + WS_WPROJ), nullptr, scr, lane_)) continue; }
        if (JOBS & J_AX) { const int blk = r >> 4, j = (r >> 2) & 3, q = r & 3;
          const int nb = blk & 7;
          const float* W = (blk < 8 ? F.in[I_LWA] : F.in[I_LWX]) + (size_t)nb * 128 * 128;
          bf16* WT = (bf16*)(ws + (blk < 8 ? WS_WAJ : WS_WXJ)) + (size_t)(nb * 4 + j) * 128 * 128;
          p0_transpose_item(W, 128, 128, 64 * (q >> 1), WT, 64 * (q >> 1), F.in[I_CW] + j * 1024 + nb * 128, scr, q & 1, lane_); }
    }
    if (JOBS & J_AX) {
        for (int o = gw * 64 + lane_; o < 2048; o += NGW * 64) { const int which = o >> 10, dg = o & 1023, nb = dg >> 7, dd = dg & 127;
            const float* W = (which ? F.in[I_LWX] : F.in[I_LWA]) + (size_t)nb * 128 * 128 + dd; float s = (which ? F.in[I_LBX] : F.in[I_LBA])[dg];
            for (int c = 0; c < 128; ++c) s += F.in[I_CB][nb * 128 + c] * W[(size_t)c * 128];
            ((float*)(ws + WS_BA2))[o] = s; }
    }
}
__device__ __forceinline__ void side_workers(int nwg, int G, int c, int& rank, int& count) {
    const int rounds = (nwg + G - 1) / G, last = nwg - (rounds - 1) * G;
    if (last == G) { rank = c; count = G; } else if (c >= last) { rank = c - last; count = G - last; } else { rank = -1; count = 0; }
}
__device__ __forceinline__ void final_norm(Frame& F, const float* ssq) {
    const int lane_ = pg8::lane_id_asm(), wave_ = F.wave;
    const int gw = F.vcu * NWAVES + wave_, NGW = F.G * NWAVES;
    const GAS f32x4* gf = (const GAS f32x4*)F.in[I_FN] + lane_;
    for (int m = gw; m < M; m += NGW) {
        float s = (lane_ < 32) ? ssq[(size_t)m * 32 + lane_] : 0.f;
        s = wave_sum(s);
        const float rstd = 1.0f / sqrtf(s * (1.0f / D) + EPS);
        GAS f32x4* xr = (GAS f32x4*)(F.out + (size_t)m * D) + lane_;
#pragma unroll
        for (int j = 0; j < 8; ++j) { f32x4 v = xr[64 * j]; const f32x4 g = gf[64 * j]; v = v * rstd * g; xr[64 * j] = v; }
    }
}


typedef float mf32x4 __attribute__((ext_vector_type(4)));
typedef short mbf16x8 __attribute__((ext_vector_type(8)));
typedef unsigned mu32x2 __attribute__((ext_vector_type(2)));
constexpr int TS = 72;
constexpr int QS = 136;
constexpr int NITEM = BATCH * HEADS * NCH;
__device__ __forceinline__ mbf16x8 lds_frag(const LAS bf16* p) { return *(const LAS mbf16x8*)p; }
__device__ __forceinline__ unsigned bf1(float x) { return pg8::cvt_pk_bf16(x, 0.f) & 0xffffu; }
#define MFMA16(a, b, c) __builtin_amdgcn_mfma_f32_16x16x32_bf16((a), (b), (c), 0, 0, 0)

#define LBAR() do { asm volatile("s_waitcnt lgkmcnt(0)" ::: "memory"); __builtin_amdgcn_s_barrier(); asm volatile("" ::: "memory"); } while (0)

__device__ __forceinline__ void hgrn_local_phase(Frame& F) {
    LAS bf16* kstT = (LAS bf16*)(F.lds);
    LAS bf16* vT = (LAS bf16*)(F.lds + 18432);
    LAS float* qtot = (LAS float*)(F.lds + 36864);
    const int tid_ = F.wave * 64 + pg8::lane_id_asm();
    const int tid = tid_, k = tid & 127, sq = tid >> 7, lane = tid & 63, w = F.wave, fr = lane & 15, fq = lane >> 4;
    const float* LOGF = (const float*)(F.ws + WS_LOGF); const bf16* V = (const bf16*)(F.ws + WS_V);
    bf16* KVT = (bf16*)(F.ws + WS_KVT); float* DEC = (float*)(F.ws + WS_DEC);
    float lf[16]; unsigned vr[16];
    if ((int)blockIdx.x < NITEM) { const int item = blockIdx.x, c = item & 31, bh = item >> 5, h = bh & 7, b = bh >> 3;
        const size_t g0 = ((size_t)b * SEQ + c * 64 + sq * 16) * 1024 + h * 128 + k;
#pragma unroll
        for (int i = 0; i < 16; ++i) { lf[i] = LOGF[g0 + (size_t)i * 1024]; vr[i] = V[g0 + (size_t)i * 1024]; } }
    for (int item = blockIdx.x; item < NITEM; item += F.G) {
        float bb[16]; float run = 0.f;
#pragma unroll
        for (int i = 0; i < 16; ++i) { run += lf[i]; bb[i] = run; }
        qtot[sq * 128 + k] = run;
        LBAR();
        float pre = 0.f, tot = 0.f;
#pragma unroll
        for (int j = 0; j < 4; ++j) { const float tq = qtot[j * 128 + k]; pre += (j < sq) ? tq : 0.f; tot += tq; }
        unsigned pk[8], pv[8];
#pragma unroll
        for (int i = 0; i < 8; ++i) {
            const float e0 = (1.0f - __expf(lf[2 * i])) * __expf(tot - (pre + bb[2 * i])), e1 = (1.0f - __expf(lf[2 * i + 1])) * __expf(tot - (pre + bb[2 * i + 1]));
            pk[i] = pg8::cvt_pk_bf16(e0, e1); pv[i] = vr[2 * i] | (vr[2 * i + 1] << 16); }
        *(LAS v4u*)(kstT + k * TS + sq * 16) = (v4u){pk[0], pk[1], pk[2], pk[3]}; *(LAS v4u*)(kstT + k * TS + sq * 16 + 8) = (v4u){pk[4], pk[5], pk[6], pk[7]};
        *(LAS v4u*)(vT + k * TS + sq * 16) = (v4u){pv[0], pv[1], pv[2], pv[3]}; *(LAS v4u*)(vT + k * TS + sq * 16 + 8) = (v4u){pv[4], pv[5], pv[6], pv[7]};
        if (sq == 0) DEC[(size_t)item * 128 + k] = __expf(tot);
        if (item + F.G < NITEM) { const int it2 = item + F.G, c = it2 & 31, bh = it2 >> 5, h = bh & 7, b = bh >> 3;
            const size_t g0 = ((size_t)b * SEQ + c * 64 + sq * 16) * 1024 + h * 128 + k;
#pragma unroll
            for (int i = 0; i < 16; ++i) { lf[i] = LOGF[g0 + (size_t)i * 1024]; vr[i] = V[g0 + (size_t)i * 1024]; } }
        LBAR();
        const mbf16x8 b0 = lds_frag(vT + (16 * w + fr) * TS + 8 * fq), b1 = lds_frag(vT + (16 * w + fr) * TS + 32 + 8 * fq);
        bf16* outp = KVT + (size_t)item * 16384 + (size_t)(16 * w + fr) * 128 + 4 * fq;
#pragma unroll
        for (int kt = 0; kt < 8; ++kt) {
            mf32x4 acc = {0.f, 0.f, 0.f, 0.f};
            acc = MFMA16(lds_frag(kstT + (16 * kt + fr) * TS + 8 * fq), b0, acc);
            acc = MFMA16(lds_frag(kstT + (16 * kt + fr) * TS + 32 + 8 * fq), b1, acc);
            asm volatile("s_nop 7\n\ts_nop 7" : "+v"(acc));
            mu32x2 o; o.x = pg8::cvt_pk_bf16(acc[0], acc[1]); o.y = pg8::cvt_pk_bf16(acc[2], acc[3]);
            *(mu32x2*)(outp + 16 * kt) = o;
        }
        LBAR();
    }
}

__device__ __forceinline__ void hgrn_scan_phase(Frame& F) {
    const bf16* KVT = (const bf16*)(F.ws + WS_KVT); const float* DEC = (const float*)(F.ws + WS_DEC); bf16* ST = (bf16*)(F.ws + WS_XB);
    const int tid_ = F.wave * 64 + pg8::lane_id_asm();
    for (int idx = blockIdx.x * (NWAVES * 64) + tid_; idx < BATCH * HEADS * 128 * 32; idx += F.G * NWAVES * 64) {
        const int k4 = idx & 31, v = (idx >> 5) & 127, bh = idx >> 12;
        mf32x4 S = {0.f, 0.f, 0.f, 0.f};
#pragma unroll 1
        for (int half = 0; half < 2; ++half) {
            const size_t off0 = (size_t)(bh * NCH + half * 16) * 16384 + v * 128 + 4 * k4; const size_t d0 = (size_t)(bh * NCH + half * 16) * 128 + 4 * k4;
            mu32x2 kv[16]; mf32x4 dd[16];
#pragma unroll
            for (int c = 0; c < 16; ++c) { kv[c] = *(const mu32x2*)(KVT + off0 + (size_t)c * 16384); dd[c] = *(const mf32x4*)(DEC + d0 + (size_t)c * 128); }
#pragma unroll
            for (int c = 0; c < 16; ++c) {
                mu32x2 o; o.x = pg8::cvt_pk_bf16(S[0], S[1]); o.y = pg8::cvt_pk_bf16(S[2], S[3]); *(mu32x2*)(ST + off0 + (size_t)c * 16384) = o;
                S = dd[c] * S + pg8::bf16x4_to_f32(kv[c]);
            }
        }
    }
}

__device__ __forceinline__ void hgrn_out_phase(Frame& F, bool dummy = false) {
    LAS bf16* QT = (LAS bf16*)(F.lds);
    LAS bf16* KT = (LAS bf16*)(F.lds + 17408);
    LAS bf16* QI = (LAS bf16*)(F.lds + 34816);
    LAS bf16* vT = (LAS bf16*)(F.lds + 52224);
    LAS bf16* P = (LAS bf16*)(F.lds + 70656);
    LAS float* qtot = (LAS float*)(F.lds + 79872);
    LAS float* ssq = (LAS float*)(F.lds + 81920);
    const int tid_ = F.wave * 64 + pg8::lane_id_asm();
    const int tid = tid_, k = tid & 127, sq = tid >> 7, lane = tid & 63, w = F.wave, fr = lane & 15, fq = lane >> 4, rb = w & 3, ch = w >> 2;
    const float* LOGF = (const float*)(F.ws + WS_LOGF); const bf16* V = (const bf16*)(F.ws + WS_V); const bf16* SG = (const bf16*)(F.ws + WS_SG);
    const bf16* ST = (const bf16*)(F.ws + WS_XB); bf16* MIXA = (bf16*)(F.ws + WS_MIXA);
    const int t0 = 16 * rb;
    float lf[16]; unsigned vr[16], qr[16];
    if ((int)blockIdx.x < NITEM) { const int item = blockIdx.x, c = item & 31, bh = item >> 5, h = bh & 7, b = bh >> 3;
        const size_t r0 = (size_t)b * SEQ + c * 64, g0 = (r0 + sq * 16) * 1024 + h * 128 + k, gq = (r0 + sq * 16) * 2048 + h * 128 + k;
#pragma unroll
        for (int i = 0; i < 16; ++i) { lf[i] = LOGF[g0 + (size_t)i * 1024]; vr[i] = V[g0 + (size_t)i * 1024]; qr[i] = MIXA[gq + (size_t)i * 2048]; } }
    for (int item = blockIdx.x; item < NITEM; item += F.G) {
        const int c = item & 31, bh = item >> 5, h = bh & 7, b = bh >> 3;
        const size_t r0 = (size_t)b * SEQ + c * 64;
        float bb[16]; float run = 0.f;
#pragma unroll
        for (int i = 0; i < 16; ++i) { run += lf[i]; bb[i] = run; }
        qtot[sq * 128 + k] = run;
        LBAR();
        {
            float pre = 0.f;
#pragma unroll
            for (int j = 0; j < 4; ++j) { const float tq = qtot[j * 128 + k]; pre += (j < sq) ? tq : 0.f; }
            const float bm = qtot[k] + qtot[128 + k], ebm = __expf(bm);
            unsigned pv[8];
#pragma unroll
            for (int i = 0; i < 16; ++i) {
                const float d = fminf(fmaxf(pre + bb[i] - bm, -60.f), 60.f), e1 = __expf(d), e2 = __builtin_amdgcn_rcpf(e1);
                const float qf = bf2f((bf16)qr[i]), qt = qf * e1, kk = (1.0f - __expf(lf[i])) * e2;
                const int s = sq * 16 + i;
                QT[s * QS + k] = (bf16)bf1(qt); QI[s * QS + k] = (bf16)bf1(qt * ebm); KT[s * QS + k] = (bf16)bf1(kk);
            }
#pragma unroll
            for (int i = 0; i < 8; ++i) pv[i] = vr[2 * i] | (vr[2 * i + 1] << 16);
            *(LAS v4u*)(vT + k * TS + sq * 16) = (v4u){pv[0], pv[1], pv[2], pv[3]}; *(LAS v4u*)(vT + k * TS + sq * 16 + 8) = (v4u){pv[4], pv[5], pv[6], pv[7]};
        }
        if (item + F.G < NITEM) { const int it2 = item + F.G, c2 = it2 & 31, bh2 = it2 >> 5, h2 = bh2 & 7, b2 = bh2 >> 3;
            const size_t r2 = (size_t)b2 * SEQ + c2 * 64, g0 = (r2 + sq * 16) * 1024 + h2 * 128 + k, gq = (r2 + sq * 16) * 2048 + h2 * 128 + k;
#pragma unroll
            for (int i = 0; i < 16; ++i) { lf[i] = LOGF[g0 + (size_t)i * 1024]; vr[i] = V[g0 + (size_t)i * 1024]; qr[i] = MIXA[gq + (size_t)i * 2048]; } }
        mbf16x8 stf[4][4]; mu32x2 sgp[4];
#pragma unroll
        for (int j = 0; j < 4; ++j) { const bf16* sp = ST + (size_t)item * 16384 + (size_t)(64 * ch + 16 * j + fr) * 128 + 8 * fq;
#pragma unroll
            for (int ks = 0; ks < 4; ++ks) stf[j][ks] = *(const mbf16x8*)(sp + 32 * ks);
            sgp[j] = *(const mu32x2*)(SG + (r0 + t0 + fr) * 1024 + h * 128 + 64 * ch + 16 * j + 4 * fq); }
        LBAR();
        {
            mbf16x8 bq[4];
#pragma unroll
            for (int ks = 0; ks < 4; ++ks) bq[ks] = lds_frag(QT + (t0 + fr) * QS + 32 * ks + 8 * fq);
#pragma unroll
            for (int j = 0; j < 2; ++j) {
                const int s0 = 32 * ch + 16 * j; mf32x4 acc = {0.f, 0.f, 0.f, 0.f};
#pragma unroll
                for (int ks = 0; ks < 4; ++ks) acc = MFMA16(lds_frag(KT + (s0 + fr) * QS + 32 * ks + 8 * fq), bq[ks], acc);
                const int t = t0 + fr, sb = s0 + 4 * fq;
#pragma unroll
                for (int r = 0; r < 4; ++r) acc[r] = (sb + r <= t) ? acc[r] : 0.f;
                mu32x2 o; o.x = pg8::cvt_pk_bf16(acc[0], acc[1]); o.y = pg8::cvt_pk_bf16(acc[2], acc[3]);
                *(LAS mu32x2*)(P + t * TS + sb) = o;
            }
        }
        LBAR();
        mf32x4 o4[4];
        {
            mbf16x8 bqi[4], bp[2];
#pragma unroll
            for (int ks = 0; ks < 4; ++ks) bqi[ks] = lds_frag(QI + (t0 + fr) * QS + 32 * ks + 8 * fq);
#pragma unroll
            for (int ss = 0; ss < 2; ++ss) bp[ss] = lds_frag(P + (t0 + fr) * TS + 32 * ss + 8 * fq);
            float sum = 0.f;
#pragma unroll
            for (int j = 0; j < 4; ++j) {
                const int v0 = 64 * ch + 16 * j; mf32x4 acc = {0.f, 0.f, 0.f, 0.f};
#pragma unroll
                for (int ks = 0; ks < 4; ++ks) acc = MFMA16(stf[j][ks], bqi[ks], acc);
#pragma unroll
                for (int ss = 0; ss < 2; ++ss) acc = MFMA16(lds_frag(vT + (v0 + fr) * TS + 32 * ss + 8 * fq), bp[ss], acc);
                o4[j] = acc; sum += (acc[0] * acc[0] + acc[1] * acc[1]) + (acc[2] * acc[2] + acc[3] * acc[3]);
            }
            sum += __shfl_xor(sum, 16); sum += __shfl_xor(sum, 32);
            if (fq == 0) ssq[ch * 64 + t0 + fr] = sum;
        }
        LBAR();
        {
            const float rn = 1.0f / sqrtf((ssq[t0 + fr] + ssq[64 + t0 + fr]) * (1.0f / 128.0f) + EPS);
            const size_t row = r0 + t0 + fr;
#pragma unroll
            for (int j = 0; j < 4; ++j) {
                const int v = 64 * ch + 16 * j + 4 * fq;
                const mf32x4 gn = *(const mf32x4*)(F.in[I_HGN] + v);
                const float s0 = bf2f((bf16)(sgp[j].x & 0xffffu)), s1 = bf2f((bf16)(sgp[j].x >> 16)), s2 = bf2f((bf16)(sgp[j].y & 0xffffu)), s3 = bf2f((bf16)(sgp[j].y >> 16));
                mu32x2 o; o.x = pg8::cvt_pk_bf16(o4[j][0] * rn * gn[0] * s0, o4[j][1] * rn * gn[1] * s1); o.y = pg8::cvt_pk_bf16(o4[j][2] * rn * gn[2] * s2, o4[j][3] * rn * gn[3] * s3);
                *(mu32x2*)((dummy ? (bf16*)(F.ws + WS_KVT) : MIXA) + row * 2048 + h * 128 + v) = o;
            }
        }
        LBAR();
    }
}

#define GLDS16(gp, lp) __builtin_amdgcn_global_load_lds((const unsigned*)(gp), (LAS unsigned*)(lp), 16, 0, 0)
template <int VAR = 0, bool FUSE_SCAN = false, bool dummy = false>
__device__ __forceinline__ void lru_phase(Frame& F) {
    LAS unsigned char* Ab = F.lds;
    LAS float* LAt = (LAS float*)(F.lds + 66560);
    LAS float* LUt = (LAS float*)(F.lds + 66560 + 18560);
    LAS bf16* GG = (LAS bf16*)(F.lds + 103680);
    LAS bf16* YY = (LAS bf16*)(F.lds + 120064);
    const int tid_ = F.wave * 64 + pg8::lane_id_asm();
    const int tid = tid_, lane = tid & 63, w = F.wave, fr = lane & 15, fq = lane >> 4;
    const int seg = lane & 31, d = 2 * w + (lane >> 5);
    const int grow = tid >> 1, ghalf = tid & 1;
    const bf16* LRX = (const bf16*)(F.ws + WS_LRX); bf16* MIXA = (bf16*)(F.ws + WS_MIXA);
    const bf16* WAJ = (const bf16*)(F.ws + WS_WAJ); const bf16* WXJ = (const bf16*)(F.ws + WS_WXJ);
    for (int item = blockIdx.x; item < BATCH * 64; item += F.G) {
        const int b = item >> 6, n = (item >> 3) & 7, sl = item & 7;
        int tid = tid_; asm volatile("" : "+v"(tid));
        const int lane = tid & 63, fr = lane & 15, fq = lane >> 4, grow = tid >> 1, ghalf = tid & 1;
        mbf16x8 waf[4][4], wxf[4][4];
#pragma unroll
        for (int j = 0; j < 4; ++j)
#pragma unroll
            for (int ks = 0; ks < 4; ++ks) { const size_t o = ((size_t)(n * 4 + j) * 128 + sl * 16 + fr) * 128 + 32 * ks + 8 * fq; waf[j][ks] = *(const mbf16x8*)(WAJ + o); wxf[j][ks] = *(const mbf16x8*)(WXJ + o); }
        const bf16* xsrc0 = LRX + (size_t)b * SEQ * 1024 + n * 128;
        bf16* const gbase = MIXA + (size_t)b * SEQ * 2048 + 1024 + n * 128 + sl * 16 + 8 * ghalf;
        bf16* const obase = dummy ? (bf16*)(F.ws + WS_END) + (size_t)item * 2048 * 16 + 8 * ghalf : gbase;
        const size_t ostr = dummy ? 16 : 2048;
#pragma unroll
        for (int i = 0; i < 9; ++i) { const int p = tid + 512 * i, row = p >> 4, cp = p & 15;
            if (p < 259 * 16 && row >= 3) GLDS16(xsrc0 + (size_t)(row - 3) * 1024 + 8 * (cp ^ (row & 15)), Ab + (w * 64 + 512 * i) * 16); }
        if (tid < 48) *(LAS v4u*)(Ab + tid * 16) = (v4u){0u, 0u, 0u, 0u};
        GLDS16(gbase + (size_t)grow * 2048, (LAS unsigned char*)GG + w * 1024);
        __syncthreads();
        float carry = 0.f;
        mf32x4 S = {0.f, 0.f, 0.f, 0.f};
        for (int mc = 0; mc < 8; ++mc) {
            int tid = tid_; asm volatile("" : "+v"(tid));
            const int lane = tid & 63, fr = lane & 15, fq = lane >> 4, seg = lane & 31, d = 2 * w + (lane >> 5), grow = tid >> 1, ghalf = tid & 1;
            const bf16* xsrc = LRX + (size_t)b * SEQ * 1024 + n * 128;
            bf16* const gbase = MIXA + (size_t)b * SEQ * 2048 + 1024 + n * 128 + sl * 16 + 8 * ghalf;
            bf16* const obase = dummy ? (bf16*)(F.ws + WS_END) + (size_t)item * 2048 * 16 + 8 * ghalf : gbase;
            const int sidx = blockIdx.x * (NWAVES * 64) + tid;
            const unsigned soff = (unsigned)((sidx >> 12) * NCH + 4 * mc) * 16384u + ((sidx >> 5) & 127) * 128 + 4 * (sidx & 31), sdo = (unsigned)((sidx >> 12) * NCH + 4 * mc) * 128u + 4 * (sidx & 31);
            mu32x2 skv[2]; mf32x4 sdd[2];
            if (FUSE_SCAN) {
#pragma unroll
                for (int c = 0; c < 2; ++c) { skv[c] = *(const mu32x2*)((const bf16*)(F.ws + WS_KVT) + soff + c * 16384u); sdd[c] = *(const mf32x4*)((const float*)(F.ws + WS_DEC) + sdo + c * 128u); }
            }
            if (mc > 0) *(v4u*)(obase + (size_t)((mc - 1) * 256 + grow) * ostr) = *(const LAS v4u*)(YY + ((mc - 1) & 1) * 4096 + grow * 16 + 8 * ghalf);
            const int cgl = n * 128 + sl * 16 + fr;
            const float ba2 = ((const float*)(F.ws + WS_BA2))[cgl], bx2 = ((const float*)(F.ws + WS_BA2))[1024 + cgl], spl = log1pf(__expf(-F.in[I_LAM][cgl])), cbv = F.in[I_CB][cgl];
            float cw4[4];
#pragma unroll
            for (int j = 0; j < 4; ++j) cw4[j] = F.in[I_CW][j * 1024 + cgl];
#pragma unroll
            for (int rt = 0; rt < (VAR == 2 ? 0 : 2); ++rt) {
                const int rowt = 32 * w + 16 * rt; mf32x4 ar = {0.f, 0.f, 0.f, 0.f}, ai = {0.f, 0.f, 0.f, 0.f};
#pragma unroll
                for (int j = 0; j < 4; ++j) { const int R = rowt + fr + j;
#pragma unroll
                    for (int ks = 0; ks < 4; ++ks) { const mbf16x8 a = *(const LAS mbf16x8*)(Ab + R * 256 + (((4 * ks + fq) ^ (R & 15)) << 4)); ar = MFMA16(a, waf[j][ks], ar); ai = MFMA16(a, wxf[j][ks], ai); } }
                float xv[7];
#pragma unroll
                for (int q = 0; q < 7; ++q) { const int R = rowt + 4 * fq + q; xv[q] = bf2f(*(const LAS bf16*)(Ab + R * 256 + (((2 * sl + (fr >> 3)) ^ (R & 15)) << 4) + 2 * (fr & 7))); }
#pragma unroll
                for (int r = 0; r < 4; ++r) { const int row = rowt + 4 * fq + r;
                    const float xc = cbv + ((cw4[0] * xv[r] + cw4[1] * xv[r + 1]) + (cw4[2] * xv[r + 2] + cw4[3] * xv[r + 3]));
                    const float rg = pg8::sigmoid_f(ar[r] + ba2), ig = pg8::sigmoid_f(ai[r] + bx2), la = -8.0f * rg * spl;
                    const float a = __expf(la), om = fmaxf(__builtin_fmaf(-a, a, 1.0f), 0.f);
                    const int o = fr * 289 + (row >> 3) * 9 + (row & 7);
                    LAt[o] = a; LUt[o] = __builtin_amdgcn_sqrtf(om) * ig * xc; }
            }
            if (FUSE_SCAN) {
#pragma unroll
                for (int c = 0; c < 2; ++c) { mu32x2 o; o.x = pg8::cvt_pk_bf16(S[0], S[1]); o.y = pg8::cvt_pk_bf16(S[2], S[3]); *(mu32x2*)((bf16*)(F.ws + WS_XB) + soff + c * 16384u) = o;
                    S = sdd[c] * S + pg8::bf16x4_to_f32(skv[c]); }
#pragma unroll
                for (int c = 0; c < 2; ++c) { skv[c] = *(const mu32x2*)((const bf16*)(F.ws + WS_KVT) + soff + (2 + c) * 16384u); sdd[c] = *(const mf32x4*)((const float*)(F.ws + WS_DEC) + sdo + (2 + c) * 128u); }
            }
            __syncthreads();
            if (mc < 7) {
#pragma unroll
                for (int i = 0; i < 9; ++i) { const int p = tid + 512 * i, row = p >> 4, cp = p & 15;
                    if (p < 259 * 16) GLDS16(xsrc + (size_t)((mc + 1) * 256 - 3 + row) * 1024 + 8 * (cp ^ (row & 15)), Ab + (w * 64 + 512 * i) * 16); }
                GLDS16(gbase + (size_t)((mc + 1) * 256 + grow) * 2048, (LAS unsigned char*)GG + ((mc + 1) & 1) * 8192 + w * 1024);
            }
            if (VAR != 3) {
                float aa[8], uu[8]; float Ap = 1.f, Hp = 0.f;
#pragma unroll
                for (int i = 0; i < 8; ++i) { aa[i] = LAt[d * 289 + seg * 9 + i]; uu[i] = LUt[d * 289 + seg * 9 + i]; Hp = aa[i] * Hp + uu[i]; Ap *= aa[i]; }
#pragma unroll
                for (int off = 1; off < 32; off <<= 1) { const float Aq = __shfl_up(Ap, off, 32), Hq = __shfl_up(Hp, off, 32); if (seg >= off) { Hp = Ap * Hq + Hp; Ap = Ap * Aq; } }
                float Ae = __shfl_up(Ap, 1, 32), He = __shfl_up(Hp, 1, 32); if (seg == 0) { Ae = 1.f; He = 0.f; }
                float hin = Ae * carry + He;
                carry = __shfl(Ap, 31, 32) * carry + __shfl(Hp, 31, 32);
                const LAS bf16* gp = GG + (mc & 1) * 4096 + (8 * seg) * 16 + d; LAS bf16* yq = YY + (mc & 1) * 4096 + (8 * seg) * 16 + d;
#pragma unroll
                for (int i = 0; i < 8; ++i) { hin = aa[i] * hin + uu[i]; yq[i * 16] = (bf16)bf1(hin * bf2f(gp[i * 16])); }
            }
            if (FUSE_SCAN) {
#pragma unroll
                for (int c = 0; c < 2; ++c) { mu32x2 o; o.x = pg8::cvt_pk_bf16(S[0], S[1]); o.y = pg8::cvt_pk_bf16(S[2], S[3]); *(mu32x2*)((bf16*)(F.ws + WS_XB) + soff + (2 + c) * 16384u) = o;
                    S = sdd[c] * S + pg8::bf16x4_to_f32(skv[c]); }
            }
            __syncthreads();
        }
        *(v4u*)(obase + (size_t)(7 * 256 + grow) * ostr) = *(const LAS v4u*)(YY + 4096 + grow * 16 + 8 * ghalf);
        __syncthreads();
    }
}
constexpr int N_PHASES = 12;
struct Args { const float* in[N_IN]; float* out; unsigned char* ws; int ph_lo, ph_hi, li, pad; };
__global__ void __launch_bounds__(NWAVES * 64, 2) mega_fwd(Args args) {
    extern __shared__ __attribute__((aligned(16))) unsigned char lds[];
    Frame F;
    F.lds = (LAS unsigned char*)lds;
    F.MISC = (volatile LAS unsigned*)(F.lds + MISC_OFF);
    F.wave = __builtin_amdgcn_readfirstlane((int)threadIdx.x >> 6);
    F.G = gridDim.x; { const int bx = blockIdx.x; F.vcu = (F.G % 8 == 0) ? (bx % 8) * (F.G / 8) + bx / 8 : bx; }
#pragma unroll
    for (int i = 0; i < N_IN; ++i) F.in[i] = args.in[i];
    F.out = args.out; F.ws = args.ws;
    unsigned char* ws = args.ws;
    F.ctl = (gu32*)(ws + WS_CTL);
    for (int u = F.wave * 64 + pg8::lane_id_asm(); u < (LDS_BYTES - LDSCTL_OFF) / 4; u += NWAVES * 64) ((LAS unsigned*)(F.lds + LDSCTL_OFF))[u] = 0u;
    __syncthreads();
    const int lo = args.ph_lo, hi = args.ph_hi;
    const bool multi = (hi - lo) > 1;
    XcdBarrier bar; bar.bar = (unsigned*)(F.ctl + CW_BAR) + args.li * XCD_BAR_WORDS; bar.x = 0; bar.st = nullptr; bar.wave = F.wave;
    if (multi) bar = xcd_barrier_post((unsigned*)(F.ctl + CW_BAR) + args.li * XCD_BAR_WORDS, F.MISC + 8, F.wave);

    bf16* const XB = (bf16*)(ws + WS_XB); bf16* const ACT = (bf16*)(ws + WS_ACT); bf16* const MIXA = (bf16*)(ws + WS_MIXA);
    float* const SSQA = (float*)(ws + WS_SSQA); float* const SSQB = (float*)(ws + WS_SSQB);


#define IN(k) (lo <= (k) && (k) < hi)
#ifdef PROBE_PHASE
#define SEAM(k) do { if (IN(k) && ((k) + 1 < N_PHASES ? IN((k) + 1) : true)) { xcd_barrier(bar); \
        if ((k) + 1 == PROBE_PHASE) { if (blockIdx.x == 0 && F.wave == 0 && pg8::lane_id_asm() == 0) __hip_atomic_store((unsigned long long*)(F.ctl + 80000), (unsigned long long)__builtin_amdgcn_s_memrealtime(), RLX_AGENT); } \
        if ((k) == PROBE_PHASE) { if (blockIdx.x == 0 && F.wave == 0 && pg8::lane_id_asm() == 0) { const unsigned long long t1 = __builtin_amdgcn_s_memrealtime(), t0 = __hip_atomic_load((unsigned long long*)(F.ctl + 80000), RLX_AGENT); \
                __hip_atomic_store((unsigned long long*)(F.ctl + 80064), t1 - t0, RLX_AGENT); } \
            xcd_barrier(bar); \
            { const unsigned long long dt = __hip_atomic_load((unsigned long long*)(F.ctl + 80064), RLX_AGENT), s0 = __builtin_amdgcn_s_memrealtime(); while (__builtin_amdgcn_s_memrealtime() - s0 < 4ull * dt) __builtin_amdgcn_s_sleep(32); } } } } while (0)
#else
#define SEAM(k) do { if (IN(k) && IN((k) + 1)) xcd_barrier(bar); } while (0)
#endif
#define GEMM_SWIGLU(WOFF) do { pg8::Gemm g{XB, (const bf16*)(ws + (WOFF)), M, NGU, D}; pg8::StaticOrder S; S.init(M, NGU, F.G, (int)blockIdx.x); \
        pg8::EpiSwiGLU E{ACT, DFF, SSQA}; pg8::gemm_phase<pg8::EpiSwiGLU, pg8::StaticOrder, true, true>(F.lds + RING_OFF, g, S, E, F.wave); } while (0)
#define GEMM_RESID(AP, WOFF, KK, SRC, SSQO) do { pg8::Gemm g{(AP), (const bf16*)(ws + (WOFF)), M, D, (KK)}; pg8::StaticOrder S; S.init(M, D, F.G, (int)blockIdx.x); \
        if ((M / 256) * (D / 256) <= F.G) { pg8::EpiResidInit E{(SRC), F.out, XB, (SSQO)}; pg8::gemm_phase<pg8::EpiResidInit, pg8::StaticOrder, true, true>(F.lds + RING_OFF, g, S, E, F.wave); } \
        else { pg8::EpiResid E{(SRC), F.out, XB, (SSQO), 1.0f}; pg8::gemm_phase<pg8::EpiResid, pg8::StaticOrder, true, true>(F.lds + RING_OFF, g, S, E, F.wave); } } while (0)

    if (IN(0)) { convert_jobs<J_X | J_P | J_GU1 | J_GU2 | J_WOUT | J_PROJ | J_AX>(F, (int)blockIdx.x, F.G); SEAM(0); }
    if (IN(1)) { GEMM_SWIGLU(WS_WGU1);
        { int rank, count; side_workers((M / 256) * (NGU / 256), F.G, (int)blockIdx.x, rank, count); if (rank >= 0) convert_jobs<J_D1 | J_WIN>(F, rank, count); }
        SEAM(1); }
    if (IN(2)) { GEMM_RESID(ACT, WS_WD1, DFF, F.in[I_X], SSQB); SEAM(2); }
    if (IN(3)) {
        pg8::Gemm g{XB, (const bf16*)(ws + WS_WINT), M, NIN, D}; pg8::StaticOrder S; S.init(M, NIN, F.G, (int)blockIdx.x);
        pg8::EpiZ E{SSQB, F.in[I_HLB], MIXA, (float*)(ws + WS_LOGF), (bf16*)(ws + WS_V), (bf16*)(ws + WS_SG), (bf16*)(ws + WS_LRX)};
        pg8::gemm_phase<pg8::EpiZ, pg8::StaticOrder, true, true>(F.lds + RING_OFF, g, S, E, F.wave);
        SEAM(3); }
    if (IN(4)) { MIXER_PHASE_4 SEAM(4); }
    if (IN(5)) { MIXER_PHASE_5 SEAM(5); }
    if (IN(6)) { MIXER_PHASE_6 SEAM(6); }
    if (IN(7)) { GEMM_RESID(MIXA, WS_WOUT, D, F.out, SSQA); SEAM(7); }
    if (IN(8)) { GEMM_SWIGLU(WS_WGU2);
        { int rank, count; side_workers((M / 256) * (NGU / 256), F.G, (int)blockIdx.x, rank, count);
          if (rank >= 0) {
              pg8::Gemm g{(const bf16*)(ws + WS_PB), (const bf16*)(ws + WS_WPROJ), M, D, PLE}; pg8::StaticOrder S; S.init(M, D, count, rank);
              pg8::EpiPP E{(bf16*)(ws + WS_PP)};
              pg8::gemm_phase<pg8::EpiPP, pg8::StaticOrder, true, true>(F.lds + RING_OFF, g, S, E, F.wave);
              convert_jobs<J_D2 | J_PG>(F, rank, count); } }
        SEAM(8); }
    if (IN(9)) { GEMM_RESID(ACT, WS_WD2, DFF, F.out, SSQB); SEAM(9); }
    if (IN(10)) {
        { pg8::Gemm g{XB, (const bf16*)(ws + WS_WPG), M, D, D}; pg8::StaticOrder S; S.init(M, D, F.G, (int)blockIdx.x);
          if (F.G == (M / 256) * (D / 256)) {
              pg8::EpiPLEFinal E{SSQB, F.in[I_PBG], (const bf16*)(ws + WS_PP), F.out, (float*)(ws + WS_XCH), (unsigned*)(F.ctl + CW_PANEL), F.in[I_FN]};
              pg8::gemm_phase<pg8::EpiPLEFinal, pg8::StaticOrder, false, true>(F.lds + RING_OFF, g, S, E, F.wave);
          } else {
              pg8::EpiPLE E{SSQB, F.in[I_PBG], (const bf16*)(ws + WS_PP), F.out, SSQA};
              pg8::gemm_phase<pg8::EpiPLE, pg8::StaticOrder, true, true>(F.lds + RING_OFF, g, S, E, F.wave); } }
        SEAM(10); }
    if (IN(11)) { if (F.G != (M / 256) * (D / 256)) final_norm(F, SSQA); SEAM(11); }
#undef IN
#undef SEAM
}

#if SIMPLE_HGRN
__global__ void __launch_bounds__(64) k_simple_hgrn(const float* logf, const bf16* mixa, const bf16* vv, float* oh) {
    __shared__ float sf[128], sk[128], sq[128];
    const int bh = blockIdx.x >> 1, vh = blockIdx.x & 1, b = bh >> 3, h = bh & 7, lane = threadIdx.x, v = vh * 64 + lane;
    float S[128];
#pragma unroll
    for (int k = 0; k < 128; ++k) S[k] = 0.f;
    for (int t = 0; t < SEQ; ++t) {
        const size_t row = (size_t)b * SEQ + t;
        for (int kk = lane; kk < 128; kk += 64) { const float f = __expf(logf[row * 1024 + h * 128 + kk]); sf[kk] = f; sk[kk] = 1.f - f; sq[kk] = bf2f(mixa[row * 2048 + h * 128 + kk]); }
        __syncthreads();
        const float vt = bf2f(vv[row * 1024 + h * 128 + v]); float o = 0.f;
#pragma unroll
        for (int k = 0; k < 128; ++k) { S[k] = sf[k] * S[k] + sk[k] * vt; o += S[k] * sq[k]; }
        oh[row * 1024 + h * 128 + v] = o;
        __syncthreads();
    }
}
__global__ void __launch_bounds__(256) k_simple_hnorm(const float* oh, const bf16* sg, const float* gn, bf16* mixa) {
    const int gw = (blockIdx.x * 256 + threadIdx.x) >> 6, lane = threadIdx.x & 63;
    if (gw >= M * HEADS) return;
    const int row = gw >> 3, h = gw & 7;
    const float o0 = oh[(size_t)row * 1024 + h * 128 + lane], o1 = oh[(size_t)row * 1024 + h * 128 + 64 + lane];
    const float ss = wave_sum(o0 * o0 + o1 * o1);
    const float r = 1.0f / sqrtf(ss * (1.0f / 128.0f) + EPS);
    mixa[(size_t)row * 2048 + h * 128 + lane] = (bf16)f2bf(o0 * r * gn[lane] * bf2f(sg[(size_t)row * 1024 + h * 128 + lane]));
    mixa[(size_t)row * 2048 + h * 128 + 64 + lane] = (bf16)f2bf(o1 * r * gn[64 + lane] * bf2f(sg[(size_t)row * 1024 + h * 128 + 64 + lane]));
}
#endif
#if SIMPLE_LRU
__global__ void __launch_bounds__(256) k_simple_lru_a(const bf16* lrx, const float* cw, const float* cb, const float* wa, const float* ba, const float* wx, const float* bx, const float* lam, float* LA, float* LU) {
    __shared__ float xc[1024];
    const int row = blockIdx.x, tt = row % SEQ, tid = threadIdx.x;
    for (int c = tid; c < 1024; c += 256) { float s = cb[c];
        for (int j = 0; j < 4; ++j) { const int ts = tt - 3 + j; if (ts >= 0) s += cw[j * 1024 + c] * bf2f(lrx[(size_t)(row - 3 + j) * 1024 + c]); }
        xc[c] = s; }
    __syncthreads();
    for (int d = tid; d < 1024; d += 256) { const int n = d >> 7, dd = d & 127; float r = ba[d], g = bx[d];
        for (int c = 0; c < 128; ++c) { const float x = xc[n * 128 + c]; r += x * wa[((size_t)n * 128 + c) * 128 + dd]; g += x * wx[((size_t)n * 128 + c) * 128 + dd]; }
        r = 1.0f / (1.0f + __expf(-r)); g = 1.0f / (1.0f + __expf(-g));
        const float log_a = -8.0f * r * log1pf(__expf(-lam[d]));
        LA[(size_t)row * 1024 + d] = __expf(log_a); LU[(size_t)row * 1024 + d] = sqrtf(-expm1f(2.0f * log_a)) * g * xc[d]; }
}
__global__ void __launch_bounds__(256) k_simple_lru_b(const float* LA, const float* LU, bf16* mixa) {
    const int gi = blockIdx.x * 256 + threadIdx.x, b = gi >> 10, c = gi & 1023; float h = 0.f;
#pragma unroll 8
    for (int t = 0; t < SEQ; ++t) { const size_t row = (size_t)b * SEQ + t; h = LA[row * 1024 + c] * h + LU[row * 1024 + c];
        bf16* p = mixa + row * 2048 + 1024 + c; *p = (bf16)f2bf(h * bf2f(*p)); }
}
#endif

extern "C" void kernel_launch(void* const* d_in, const int* in_sizes, int n_in, void* d_out, int out_size, void* d_ws, size_t ws_size, hipStream_t stream) {
    static int grid = 0;
    if (grid == 0) {
        if (n_in != N_IN || in_sizes[0] != M * D || out_size != M * D || ws_size < WS_END) { fprintf(stderr, "kernel_launch: unexpected problem (n_in %d, in0 %d, out %d, ws %zu); nothing launched\n", n_in, n_in > 0 ? in_sizes[0] : -1, out_size, ws_size); grid = -1; return; }
        int dev = 0, cus = 0, per_cu = 0;
        if (hipGetDevice(&dev) != hipSuccess || hipDeviceGetAttribute(&cus, hipDeviceAttributeMultiprocessorCount, dev) != hipSuccess) { grid = -1; return; }
        if (hipFuncSetAttribute((const void*)mega_fwd, hipFuncAttributeMaxDynamicSharedMemorySize, LDS_BYTES) != hipSuccess) { fprintf(stderr, "kernel_launch: hipFuncSetAttribute failed\n"); grid = -1; return; }
        if (hipOccupancyMaxActiveBlocksPerMultiprocessor(&per_cu, (const void*)mega_fwd, NWAVES * 64, LDS_BYTES) != hipSuccess || per_cu < 1)
            fprintf(stderr, "kernel_launch: note: occupancy query reports %d workgroups per CU\n", per_cu);
        (void)hipGetLastError();
        grid = cus;
    }
    if (grid < 0) return;
    if (hipMemsetAsync((char*)d_ws + WS_CTL, 0, CTL_ZERO_BYTES, stream) != hipSuccess) return;
    Args a{};
    for (int i = 0; i < N_IN; ++i) a.in[i] = (const float*)d_in[i];
    a.out = (float*)d_out; a.ws = (unsigned char*)d_ws;
    unsigned char* ws = (unsigned char*)d_ws;
    auto launch = [&](int lo, int hi, int li) { a.ph_lo = lo; a.ph_hi = hi; a.li = li; hipLaunchKernelGGL(mega_fwd, dim3(grid), dim3(NWAVES * 64), LDS_BYTES, stream, a); };
#if SIMPLE_HGRN || SIMPLE_LRU
    launch(0, 4, 0);
#if SIMPLE_HGRN
    {   float* OH = (float*)(ws + WS_XB);
        hipLaunchKernelGGL(k_simple_hgrn, dim3(64), dim3(64), 0, stream, (const float*)(ws + WS_LOGF), (const bf16*)(ws + WS_MIXA), (const bf16*)(ws + WS_V), OH);
        hipLaunchKernelGGL(k_simple_hnorm, dim3(M * HEADS / 4), dim3(256), 0, stream, (const float*)OH, (const bf16*)(ws + WS_SG), (const float*)d_in[I_HGN], (bf16*)(ws + WS_MIXA)); }
#endif
#if SIMPLE_LRU
    {   float* LA = (float*)(ws + WS_KVT); float* LU = LA + (size_t)M * 1024;
        hipLaunchKernelGGL(k_simple_lru_a, dim3(M), dim3(256), 0, stream, (const bf16*)(ws + WS_LRX), (const float*)d_in[I_CW], (const float*)d_in[I_CB], (const float*)d_in[I_LWA], (const float*)d_in[I_LBA],
                           (const float*)d_in[I_LWX], (const float*)d_in[I_LBX], (const float*)d_in[I_LAM], LA, LU);
        hipLaunchKernelGGL(k_simple_lru_b, dim3(BATCH * 1024 / 256), dim3(256), 0, stream, (const float*)LA, (const float*)LU, (bf16*)(ws + WS_MIXA)); }
#endif
    launch(4, N_PHASES, 1);
#else
#if N_LAUNCHES == 1
    launch(0, N_PHASES, 0);
#else
    for (int ph = 0; ph < N_PHASES; ++ph) launch(ph, ph + 1, 0);
#endif
#endif
}
```

```cpp
#include <hip/hip_runtime.h>
#include <cstdio>
#include <cstdint>
#ifndef SIMPLE_HGRN
#define SIMPLE_HGRN 0
#endif
#ifndef SIMPLE_LRU
#define SIMPLE_LRU 0
#endif
#ifndef N_LAUNCHES
#define N_LAUNCHES 1
#endif
#if SIMPLE_HGRN
#define MIXER_PHASE_4
#define MIXER_PHASE_6
#define MIXER_SCAN
#else
#define MIXER_PHASE_4 hgrn_local_phase(F);
#ifdef PROBE_H3
#define MIXER_PHASE_6 hgrn_out_phase(F, true); xcd_barrier(bar); hgrn_out_phase(F);
#else
#define MIXER_PHASE_6 hgrn_out_phase(F);
#endif
#ifdef PROBE_SCAN
#define MIXER_SCAN hgrn_scan_phase(F); xcd_barrier(bar); hgrn_scan_phase(F);
#else
#define MIXER_SCAN hgrn_scan_phase(F);
#endif
#endif
#if SIMPLE_LRU
#define MIXER_LRU
#else
#ifdef PROBE_LRU
#define MIXER_LRU lru_phase<PROBE_LRU, false, true>(F); xcd_barrier(bar); lru_phase<0>(F);
#else
#define MIXER_LRU lru_phase<0>(F);
#endif
#endif
#if !SIMPLE_HGRN && !SIMPLE_LRU && !defined(PROBE_LRU) && !defined(PROBE_SCAN)
#define MIXER_PHASE_5 if (F.G * NWAVES * 64 == BATCH * HEADS * 128 * 32 && F.G == BATCH * 64) { lru_phase<0, true>(F); } else { hgrn_scan_phase(F); lru_phase<0, false>(F); }
#else
#define MIXER_PHASE_5 MIXER_SCAN MIXER_LRU
#endif
namespace pg8 {
#define PG8_LAS __attribute__((address_space(3)))
typedef unsigned short bf16_t;
typedef short bf16x8 __attribute__((ext_vector_type(8)));
typedef float f32x4 __attribute__((ext_vector_type(4)));
typedef unsigned u32x4 __attribute__((ext_vector_type(4)));
constexpr int BM = 256, BK = 64, HALF = 128, HTB = HALF * BK * 2  , STAGE_BYTES = 8 * HTB, NXCD = 8, WGM = 8;

__host__ __device__ __forceinline__ int lds_byte(int r, int c) { const int st = (r >> 4) * 2 + (c >> 5), rr = r & 15, cc = c & 31, ob = rr * 64 + cc * 2; return st * 1024 + (ob ^ (((ob >> 9) & 1) << 5)); }
__host__ __device__ __forceinline__ void stage_rc(int b, int& R, int& C) { const int st = b / 1024, sb = b % 1024, swz = sb ^ (((sb >> 9) & 1) << 5); R = (st >> 1) * 16 + swz / 64; C = (st & 1) * 32 + (swz % 64) / 2; }
__host__ __device__ __forceinline__ int perm32(int rho) { const int n = rho >> 4, i = rho & 15; return 8 * (i >> 2) + 4 * n + (i & 3); }

struct Unit { int pm, pn; };
struct Gemm { const bf16_t* A; const bf16_t* Bt; int M, N, K; };

struct StaticOrder {
    int nM, nN, nwg, G, c;
    __host__ __device__ void init(int M, int N, int G_, int c_) { nM = M / BM; nN = N / BM; nwg = nM * nN; G = G_; c = c_; }
    __host__ __device__ bool next(int i, Unit& u) const {
        const long L = (long)i * G + c; if (L >= nwg) return false;
        int wgid = (int)L; { const int q = nwg / NXCD, r = nwg % NXCD, xcd = wgid % NXCD, off = wgid / NXCD; wgid = (xcd < r ? xcd * (q + 1) : r * (q + 1) + (xcd - r) * q) + off; }
        const int nig = WGM * nN, gid = wgid / nig, fm = gid * WGM, gsz = (nM - fm) < WGM ? (nM - fm) : WGM;
        u.pm = fm + ((wgid % nig) % gsz); u.pn = (wgid % nig) / gsz; return true;
    }
    __device__ __forceinline__ void a_ready(const Unit&) const {}
    __device__ __forceinline__ void done(const Unit&) const {}
};
__device__ __forceinline__ int lane_id_asm() { int l; asm volatile("v_mbcnt_lo_u32_b32 %0, -1, 0\n\tv_mbcnt_hi_u32_b32 %0, -1, %0" : "=v"(l)); return l; }
__device__ __forceinline__ unsigned cvt_pk_bf16(float lo, float hi) { unsigned r; asm volatile("v_cvt_pk_bf16_f32 %0, %1, %2" : "=v"(r) : "v"(lo), "v"(hi)); return r; }
typedef unsigned u32x2 __attribute__((ext_vector_type(2)));
constexpr int DM = 2048;
constexpr int NSSQ = 32;
__device__ __forceinline__ float sigmoid_f(float x) { return __builtin_amdgcn_rcpf(1.0f + __expf(-x)); }
__device__ __forceinline__ float silu_f(float x) { return x * sigmoid_f(x); }
__device__ __forceinline__ float gelu_tanh_f(float x) { return x * sigmoid_f(1.5957691216057308f * (x + 0.044715f * x * x * x)); }
__device__ __forceinline__ void rows_rstd(const float* ssq, int row0, int fq, float (&rs)[2][4]) {
    f32x4 pa[2][4], pb[2][4];
#pragma unroll
    for (int ai = 0; ai < 2; ++ai)
#pragma unroll
        for (int m = 0; m < 4; ++m) { const f32x4* p = (const f32x4*)(ssq + (size_t)(row0 + ai * HALF + m * 16) * NSSQ + fq * 8); pa[ai][m] = p[0]; pb[ai][m] = p[1]; }
#pragma unroll
    for (int ai = 0; ai < 2; ++ai)
#pragma unroll
        for (int m = 0; m < 4; ++m) { const f32x4 a = pa[ai][m], b = pb[ai][m];
            float s = ((a[0] + a[1]) + (a[2] + a[3])) + ((b[0] + b[1]) + (b[2] + b[3]));
            s += __shfl_xor(s, 16); s += __shfl_xor(s, 32);
            rs[ai][m] = 1.0f / sqrtf(s * (1.0f / (float)DM) + 1e-6f); }
}

struct EpiSwiGLU {
    static constexpr bool PERM = true, AFTER_DRAIN = false, INIT_ACC = false;
    bf16_t* O; int ldo; const float* ssq;
    __device__ __forceinline__ void operator()(const f32x4 (&acc)[2][2][4][2], const Unit& u, int wr, int wc, int fr, int fq) const {
        const int row0 = u.pm * BM + wr * 64 + fr, col0 = u.pn * HALF + wc * 32 + 8 * fq;
        float rs[2][4]; rows_rstd(ssq, row0, fq, rs);
#pragma unroll
        for (int ai = 0; ai < 2; ++ai)
#pragma unroll
            for (int m = 0; m < 4; ++m) {
                const int row = row0 + ai * HALF + m * 16; const float r = rs[ai][m];
                float h[8];
#pragma unroll
                for (int n = 0; n < 2; ++n)
#pragma unroll
                    for (int j = 0; j < 4; ++j) { const float g = acc[ai][0][m][n][j] * r, up = acc[ai][1][m][n][j] * r; h[n * 4 + j] = silu_f(g) * up; }
                u32x4 w; w.x = cvt_pk_bf16(h[0], h[1]); w.y = cvt_pk_bf16(h[2], h[3]); w.z = cvt_pk_bf16(h[4], h[5]); w.w = cvt_pk_bf16(h[6], h[7]);
                *(u32x4*)(O + (size_t)row * ldo + col0) = w;
            }
    }
};
struct EpiResid {
    static constexpr bool PERM = false, AFTER_DRAIN = false, INIT_ACC = false;
    const float* src; float* dst; bf16_t* xb; float* ssq_out; float scale;
    __device__ __forceinline__ void operator()(const f32x4 (&acc)[2][2][4][2], const Unit& u, int wr, int wc, int fr, int fq) const {
        const int row0 = u.pm * BM + wr * 64 + fr, col0 = u.pn * BM + wc * 32 + 4 * fq;
#pragma unroll
        for (int ai = 0; ai < 2; ++ai) {
            f32x4 sv[4][2][2];
#pragma unroll
            for (int m = 0; m < 4; ++m)
#pragma unroll
                for (int bj = 0; bj < 2; ++bj)
#pragma unroll
                    for (int n = 0; n < 2; ++n) sv[m][bj][n] = *(const f32x4*)(src + (size_t)(row0 + ai * HALF + m * 16) * DM + col0 + bj * HALF + n * 16);
#pragma unroll
            for (int m = 0; m < 4; ++m) {
                const int row = row0 + ai * HALF + m * 16; float ss = 0.f;
#pragma unroll
                for (int bj = 0; bj < 2; ++bj)
#pragma unroll
                    for (int n = 0; n < 2; ++n) { const size_t off = (size_t)row * DM + col0 + bj * HALF + n * 16;
                        const f32x4 o = sv[m][bj][n] + acc[ai][bj][m][n] * scale;
                        *(f32x4*)(dst + off) = o; u32x2 w; w.x = cvt_pk_bf16(o[0], o[1]); w.y = cvt_pk_bf16(o[2], o[3]); *(u32x2*)(xb + off) = w;
                        ss += (o[0] * o[0] + o[1] * o[1]) + (o[2] * o[2] + o[3] * o[3]); }
                ss += __shfl_xor(ss, 16); ss += __shfl_xor(ss, 32);
                if (fq == 0) ssq_out[(size_t)row * NSSQ + u.pn * 4 + wc] = ss;
            }
        }
    }
};
struct EpiResidInit {
    static constexpr bool PERM = false, AFTER_DRAIN = false, INIT_ACC = true;
    const float* src; float* dst; bf16_t* xb; float* ssq_out;
    __device__ __forceinline__ void init_acc(f32x4 (&acc)[2][2][4][2], const Unit& u, int wr, int wc, int fr, int fq) const {
        const int row0 = u.pm * BM + wr * 64 + fr, col0 = u.pn * BM + wc * 32 + 4 * fq;
#pragma unroll
        for (int ai = 0; ai < 2; ++ai)
#pragma unroll
            for (int m = 0; m < 4; ++m)
#pragma unroll
                for (int bj = 0; bj < 2; ++bj)
#pragma unroll
                    for (int n = 0; n < 2; ++n) acc[ai][bj][m][n] = __builtin_nontemporal_load((const f32x4*)(src + (size_t)(row0 + ai * HALF + m * 16) * DM + col0 + bj * HALF + n * 16));
    }
    __device__ __forceinline__ void operator()(const f32x4 (&acc)[2][2][4][2], const Unit& u, int wr, int wc, int fr, int fq) const {
        const int row0 = u.pm * BM + wr * 64 + fr, col0 = u.pn * BM + wc * 32 + 4 * fq;
#pragma unroll
        for (int ai = 0; ai < 2; ++ai)
#pragma unroll
            for (int m = 0; m < 4; ++m) {
                const int row = row0 + ai * HALF + m * 16; float ss = 0.f;
#pragma unroll
                for (int bj = 0; bj < 2; ++bj)
#pragma unroll
                    for (int n = 0; n < 2; ++n) { const size_t off = (size_t)row * DM + col0 + bj * HALF + n * 16;
                        const f32x4 o = acc[ai][bj][m][n];
                        *(f32x4*)(dst + off) = o; u32x2 w; w.x = cvt_pk_bf16(o[0], o[1]); w.y = cvt_pk_bf16(o[2], o[3]); *(u32x2*)(xb + off) = w;
                        ss += (o[0] * o[0] + o[1] * o[1]) + (o[2] * o[2] + o[3] * o[3]); }
                ss += __shfl_xor(ss, 16); ss += __shfl_xor(ss, 32);
                if (fq == 0) ssq_out[(size_t)row * NSSQ + u.pn * 4 + wc] = ss;
            }
    }
};
struct EpiZ {
    static constexpr bool PERM = true, AFTER_DRAIN = false, INIT_ACC = false;
    const float* ssq; const float* hlb;
    bf16_t* mixa;
    float* logf; bf16_t* vv; bf16_t* sg; bf16_t* lrx;
    __device__ __forceinline__ void operator()(const f32x4 (&acc)[2][2][4][2], const Unit& u, int wr, int wc, int fr, int fq) const {
        const int seg = u.pn >> 2;
        const int row0 = u.pm * BM + wr * 64 + fr, cs0 = (u.pn & 3) * BM + wc * 32 + 8 * fq;
        float rs[2][4]; rows_rstd(ssq, row0, fq, rs);
        float lbv[2][8];
        if (seg == 1) {
#pragma unroll
            for (int bj = 0; bj < 2; ++bj)
#pragma unroll
                for (int e = 0; e < 8; ++e) { const int c = cs0 + bj * HALF + e; lbv[bj][e] = sigmoid_f(hlb[c] - hlb[1024 + c]); }
        }
#pragma unroll
        for (int ai = 0; ai < 2; ++ai)
#pragma unroll
            for (int m = 0; m < 4; ++m) {
                const int row = row0 + ai * HALF + m * 16; const float r = rs[ai][m];
#pragma unroll
                for (int bj = 0; bj < 2; ++bj) {
                    const int cs = cs0 + bj * HALF;
                    float z[8];
#pragma unroll
                    for (int n = 0; n < 2; ++n)
#pragma unroll
                        for (int j = 0; j < 4; ++j) z[n * 4 + j] = acc[ai][bj][m][n][j] * r;
                    if (seg == 1) {
                        float lf[8];
#pragma unroll
                        for (int e = 0; e < 8; ++e) { const float lb = lbv[bj][e]; lf[e] = __logf(lb + (1.0f - lb) * sigmoid_f(z[e])); }
                        float* p = logf + (size_t)row * 1024 + cs;
                        *(f32x4*)p = (f32x4){lf[0], lf[1], lf[2], lf[3]}; *(f32x4*)(p + 4) = (f32x4){lf[4], lf[5], lf[6], lf[7]};
                    } else {
                        if (seg == 3) {
#pragma unroll
                            for (int e = 0; e < 8; ++e) z[e] = silu_f(z[e]);
                        } else if (seg == 5) {
#pragma unroll
                            for (int e = 0; e < 8; ++e) z[e] = gelu_tanh_f(z[e]);
                        }
                        u32x4 w; w.x = cvt_pk_bf16(z[0], z[1]); w.y = cvt_pk_bf16(z[2], z[3]); w.z = cvt_pk_bf16(z[4], z[5]); w.w = cvt_pk_bf16(z[6], z[7]);
                        bf16_t* p;
                        if (seg == 0) p = mixa + (size_t)row * 2048 + cs;
                        else if (seg == 5) p = mixa + (size_t)row * 2048 + 1024 + cs;
                        else if (seg == 2) p = vv + (size_t)row * 1024 + cs;
                        else if (seg == 3) p = sg + (size_t)row * 1024 + cs;
                        else p = lrx + (size_t)row * 1024 + cs;
                        *(u32x4*)p = w;
                    }
                }
            }
    }
};
struct EpiPP {
    static constexpr bool PERM = false, AFTER_DRAIN = false, INIT_ACC = false;
    bf16_t* PP;
    __device__ __forceinline__ void operator()(const f32x4 (&acc)[2][2][4][2], const Unit& u, int wr, int wc, int fr, int fq) const {
        const int row0 = u.pm * BM + wr * 64 + fr, col0 = u.pn * BM + wc * 32 + 4 * fq;
#pragma unroll
        for (int ai = 0; ai < 2; ++ai)
#pragma unroll
            for (int m = 0; m < 4; ++m) { bf16_t* rowp = PP + (size_t)(row0 + ai * HALF + m * 16) * DM + col0;
#pragma unroll
                for (int bj = 0; bj < 2; ++bj)
#pragma unroll
                    for (int n = 0; n < 2; ++n) { const f32x4 a = acc[ai][bj][m][n]; u32x2 w; w.x = cvt_pk_bf16(a[0], a[1]); w.y = cvt_pk_bf16(a[2], a[3]); *(u32x2*)(rowp + bj * HALF + n * 16) = w; } }
    }
};
__device__ __forceinline__ f32x4 bf16x4_to_f32(u32x2 w) { f32x4 r; r[0] = __builtin_bit_cast(float, w.x << 16); r[1] = __builtin_bit_cast(float, w.x & 0xffff0000u); r[2] = __builtin_bit_cast(float, w.y << 16); r[3] = __builtin_bit_cast(float, w.y & 0xffff0000u); return r; }
struct EpiPLE {
    static constexpr bool PERM = false, AFTER_DRAIN = false, INIT_ACC = false;
    const float* ssq_in; const float* bg; const bf16_t* PP; float* X; float* ssq_out;
    __device__ __forceinline__ void operator()(const f32x4 (&acc)[2][2][4][2], const Unit& u, int wr, int wc, int fr, int fq) const {
        const int row0 = u.pm * BM + wr * 64 + fr, col0 = u.pn * BM + wc * 32 + 4 * fq;
        float rs[2][4]; rows_rstd(ssq_in, row0, fq, rs);
#pragma unroll
        for (int ai = 0; ai < 2; ++ai)
#pragma unroll
            for (int m = 0; m < 4; ++m) {
                const int row = row0 + ai * HALF + m * 16; const float r = rs[ai][m]; float ss = 0.f;
                f32x4 pv[2][2], ov[2][2];
#pragma unroll
                for (int bj = 0; bj < 2; ++bj)
#pragma unroll
                    for (int n = 0; n < 2; ++n) { const size_t off = (size_t)row * DM + col0 + bj * HALF + n * 16; pv[bj][n] = bf16x4_to_f32(*(const u32x2*)(PP + off)); ov[bj][n] = *(const f32x4*)(X + off); }
#pragma unroll
                for (int bj = 0; bj < 2; ++bj)
#pragma unroll
                    for (int n = 0; n < 2; ++n) { const int c = col0 + bj * HALF + n * 16; const size_t off = (size_t)row * DM + c;
                        const f32x4 b4 = *(const f32x4*)(bg + c), a = acc[ai][bj][m][n]; f32x4 o;
#pragma unroll
                        for (int j = 0; j < 4; ++j) o[j] = ov[bj][n][j] + sigmoid_f(a[j] * r + b4[j]) * pv[bj][n][j];
                        *(f32x4*)(X + off) = o; ss += (o[0] * o[0] + o[1] * o[1]) + (o[2] * o[2] + o[3] * o[3]); }
                ss += __shfl_xor(ss, 16); ss += __shfl_xor(ss, 32);
                if (fq == 0) ssq_out[(size_t)row * NSSQ + u.pn * 4 + wc] = ss;
            }
    }
};

struct EpiPLEFinal {
    static constexpr bool PERM = false, AFTER_DRAIN = true, INIT_ACC = false;
    const float* ssq_in; const float* bg; const bf16_t* PP; float* X; float* xch; unsigned* cnt; const float* gf;
    __device__ __forceinline__ void operator()(const f32x4 (&)[2][2][4][2], const Unit&, int, int, int, int) const {}
    __device__ __forceinline__ void fused(f32x4 (&acc)[2][2][4][2], const Unit& u, int wr, int wc, int fr, int fq, PG8_LAS unsigned char* lds, int wid, int lane) const {
        const int row0 = u.pm * BM + wr * 64 + fr, col0 = u.pn * BM + wc * 32 + 4 * fq;
        float rs[2][4]; rows_rstd(ssq_in, row0, fq, rs);
        f32x4 b4[2][2];
#pragma unroll
        for (int bj = 0; bj < 2; ++bj)
#pragma unroll
            for (int n = 0; n < 2; ++n) b4[bj][n] = *(const f32x4*)(bg + col0 + bj * HALF + n * 16);
#pragma unroll
        for (int ai = 0; ai < 2; ++ai)
#pragma unroll
          for (int mp = 0; mp < 2; ++mp) {
            u32x2 pv[2][2][2]; f32x4 ov[2][2][2];
#pragma unroll
            for (int mm = 0; mm < 2; ++mm)
#pragma unroll
                for (int bj = 0; bj < 2; ++bj)
#pragma unroll
                    for (int n = 0; n < 2; ++n) { const size_t off = (size_t)(row0 + ai * HALF + (2 * mp + mm) * 16) * DM + col0 + bj * HALF + n * 16; pv[mm][bj][n] = *(const u32x2*)(PP + off); ov[mm][bj][n] = *(const f32x4*)(X + off); }
#pragma unroll
            for (int mm = 0; mm < 2; ++mm) {
                const int m = 2 * mp + mm, row = row0 + ai * HALF + m * 16; const float r = rs[ai][m]; float ss = 0.f;
#pragma unroll
                for (int bj = 0; bj < 2; ++bj)
#pragma unroll
                    for (int n = 0; n < 2; ++n) { const f32x4 a = acc[ai][bj][m][n], pp = bf16x4_to_f32(pv[mm][bj][n]); f32x4 o;
#pragma unroll
                        for (int j = 0; j < 4; ++j) o[j] = ov[mm][bj][n][j] + sigmoid_f(a[j] * r + b4[bj][n][j]) * pp[j];
                        acc[ai][bj][m][n] = o; ss += (o[0] * o[0] + o[1] * o[1]) + (o[2] * o[2] + o[3] * o[3]); }
                ss += __shfl_xor(ss, 16); ss += __shfl_xor(ss, 32);
                if (fq == 0) __hip_atomic_store(xch + (size_t)row * NSSQ + u.pn * 4 + wc, ss, __ATOMIC_RELAXED, __HIP_MEMORY_SCOPE_AGENT);
            }
          }
        asm volatile("s_waitcnt vmcnt(0)" ::: "memory");
        unsigned* pc = cnt + 64 * u.pm;
        if (lane == 0) __hip_atomic_fetch_add(pc, 1u, __ATOMIC_RELAXED, __HIP_MEMORY_SCOPE_AGENT);
        if (wid == 0) {
            unsigned sp = 0;
            while ((unsigned)__builtin_amdgcn_readfirstlane(__hip_atomic_load(pc, __ATOMIC_RELAXED, __HIP_MEMORY_SCOPE_AGENT)) < 64u) { __builtin_amdgcn_s_sleep(2); if (++sp > (1u << 22)) break; }
            __builtin_amdgcn_fence(__ATOMIC_ACQUIRE, "agent");
        }
        asm volatile("s_waitcnt vmcnt(0) lgkmcnt(0)" ::: "memory"); __builtin_amdgcn_s_barrier(); asm volatile("" ::: "memory");
        float r4[2][4]; rows_rstd(xch, row0, fq, r4);
        f32x4 g4[2][2];
#pragma unroll
        for (int bj = 0; bj < 2; ++bj)
#pragma unroll
            for (int n = 0; n < 2; ++n) g4[bj][n] = *(const f32x4*)(gf + col0 + bj * HALF + n * 16);
#pragma unroll
        for (int ai = 0; ai < 2; ++ai)
#pragma unroll
            for (int m = 0; m < 4; ++m) { float* rowp = X + (size_t)(row0 + ai * HALF + m * 16) * DM + col0; const float r = r4[ai][m];
#pragma unroll
                for (int bj = 0; bj < 2; ++bj)
#pragma unroll
                    for (int n = 0; n < 2; ++n) *(f32x4*)(rowp + bj * HALF + n * 16) = acc[ai][bj][m][n] * r * g4[bj][n]; }
    }
};

template <class Epi, class Sched, bool ALIGN_EPI = false, bool SP2 = false, bool BAL = false>
__device__ __forceinline__ void gemm_phase(PG8_LAS unsigned char* lds, const Gemm g, const Sched& S, const Epi& E, const int wave_s) {
    int tid_ = wave_s * 64 + lane_id_asm();
    const int tid = tid_, wid = wave_s, lane = tid & 63, wr = wid >> 2, wc = wid & 3, fr = lane & 15, fq = lane >> 4;
    const int K = g.K, nt = K / BK;
    unsigned voffA[2], voffB[2];
#pragma unroll
    for (int i = 0; i < 2; ++i) { int R, C; stage_rc(tid * 16 + i * 8192, R, C); const int Rb = Epi::PERM ? ((R & ~31) + perm32(R & 31)) : R;
        voffA[i] = (unsigned)(R * K + C) * 2u; voffB[i] = (unsigned)(Rb * K + C) * 2u; }
    const size_t kstep = (size_t)(BK * 2);
    const size_t hstep = (size_t)HALF * K * 2;
    const size_t tstep = 2 * hstep;
    const unsigned ldsw = (unsigned)wid * 1024u;
    const int aoff = lds_byte(wr * 64 + fr, fq * 8), boff = lds_byte(wc * 32 + fr, fq * 8);
#define PG8_SA(b, h) (((b) * 2 + (h)) * HTB)
#define PG8_SB(b, h) ((4 + (b) * 2 + (h)) * HTB)
#define PG8_STAGE(bufoff, gbase, voff) do { _Pragma("unroll") for (int _i = 0; _i < 2; ++_i) \
        __builtin_amdgcn_global_load_lds((const unsigned*)((const char*)(gbase) + (voff)[_i]), (PG8_LAS unsigned*)(lds + (bufoff) + ldsw + _i * 8192), 16, 0, 0); } while (0)
#define PG8_LDA(dst, b, h) do { _Pragma("unroll") for (int m = 0; m < 4; ++m) _Pragma("unroll") for (int k = 0; k < 2; ++k) dst[m][k] = *(const PG8_LAS bf16x8*)(lds + PG8_SA(b, h) + aoff + m * 2048 + k * 1024); } while (0)
#define PG8_LDB(dst, b, h) do { _Pragma("unroll") for (int n = 0; n < 2; ++n) _Pragma("unroll") for (int k = 0; k < 2; ++k) dst[n][k] = *(const PG8_LAS bf16x8*)(lds + PG8_SB(b, h) + boff + n * 2048 + k * 1024); } while (0)
#define PG8_MMA(ai, bj, At, Bt) do { __builtin_amdgcn_s_setprio(1); _Pragma("unroll") for (int m = 0; m < 4; ++m) _Pragma("unroll") for (int n = 0; n < 2; ++n) _Pragma("unroll") for (int k = 0; k < 2; ++k) \
        acc[ai][bj][m][n] = __builtin_amdgcn_mfma_f32_16x16x32_bf16(Bt[n][k], At[m][k], acc[ai][bj][m][n], 0, 0, 0); __builtin_amdgcn_s_setprio(0); } while (0)
#define PG8_WAIT_V(n) asm volatile("s_waitcnt vmcnt(" #n ")" ::: "memory")
#define PG8_WAIT_L(n) asm volatile("s_waitcnt lgkmcnt(" #n ")" ::: "memory")
#define PG8_BAR __builtin_amdgcn_s_barrier()
#define PG8_SCHED __builtin_amdgcn_sched_barrier(0)
    Unit cur, nxt; int ui = 0;
    if (!S.next(0, cur)) return;
    f32x4 acc[2][2][4][2];
    if constexpr (Epi::INIT_ACC) { E.init_acc(acc, cur, wr, wc, fr, fq); }
    else {
#pragma unroll
    for (int a = 0; a < 2; ++a)
#pragma unroll
        for (int b = 0; b < 2; ++b)
#pragma unroll
            for (int m = 0; m < 4; ++m)
#pragma unroll
                for (int n = 0; n < 2; ++n) acc[a][b][m][n] = (f32x4){0.f, 0.f, 0.f, 0.f};
    }
    bf16x8 At[4][2], B0[2][2], B1[2][2];
    const char* cA = (const char*)g.A + (size_t)cur.pm * tstep; const char* cB = (const char*)g.Bt + (size_t)cur.pn * tstep;
    S.a_ready(cur);
    if constexpr (SP2) {
        PG8_STAGE(PG8_SB(0, 0), cB, voffB); PG8_STAGE(PG8_SB(0, 1), cB + hstep, voffB); PG8_STAGE(PG8_SA(0, 0), cA, voffA); PG8_STAGE(PG8_SA(0, 1), cA + hstep, voffA);
        if (wr == 1) PG8_BAR;
        PG8_WAIT_V(2); PG8_BAR;
        if constexpr (BAL) {
            PG8_STAGE(PG8_SB(1, 0), cB + kstep, voffB); PG8_STAGE(PG8_SB(1, 1), cB + hstep + kstep, voffB);
            PG8_WAIT_V(4); PG8_BAR;
        } else {
        PG8_STAGE(PG8_SB(1, 0), cB + kstep, voffB); PG8_STAGE(PG8_SA(1, 0), cA + kstep, voffA); PG8_STAGE(PG8_SB(1, 1), cB + hstep + kstep, voffB);
        PG8_WAIT_V(6); PG8_BAR;
        }
    } else {
        PG8_STAGE(PG8_SB(0, 0), cB, voffB); PG8_STAGE(PG8_SA(0, 0), cA, voffA); PG8_STAGE(PG8_SB(0, 1), cB + hstep, voffB); PG8_STAGE(PG8_SA(0, 1), cA + hstep, voffA);
        if (wr == 1) PG8_BAR;
        PG8_WAIT_V(4); PG8_BAR;
        PG8_STAGE(PG8_SB(1, 0), cB + kstep, voffB); PG8_STAGE(PG8_SA(1, 0), cA + kstep, voffA); PG8_STAGE(PG8_SB(1, 1), cB + hstep + kstep, voffB);
        PG8_WAIT_V(6); PG8_BAR;
    }
    for (;;) {
        const bool has_next = S.next(ui + 1, nxt);
        const char* nA = has_next ? (const char*)g.A + (size_t)nxt.pm * tstep : cA; const char* nB = has_next ? (const char*)g.Bt + (size_t)nxt.pn * tstep : cB;
        for (int t = 0; t < nt; t += 2) {
            const bool last = (t == nt - 2);
            const char* a1 = cA + (size_t)(t + 1) * kstep;
            const char* a2 = last ? nA : cA + (size_t)(t + 2) * kstep; const char* b2 = last ? nB : cB + (size_t)(t + 2) * kstep;
            const char* a3 = a2 + kstep; const char* b3 = b2 + kstep;
            if (last && has_next) S.a_ready(nxt);
            if constexpr (SP2 && BAL) {
            PG8_LDB(B0, 0, 0); PG8_LDB(B1, 0, 1); PG8_SCHED; PG8_LDA(At, 0, 0); PG8_STAGE(PG8_SA(1, 0), a1, voffA); PG8_STAGE(PG8_SA(1, 1), a1 + hstep, voffA);
            PG8_WAIT_V(4); PG8_WAIT_L(0); PG8_BAR; PG8_MMA(0, 0, At, B0); PG8_MMA(0, 1, At, B1); PG8_BAR; PG8_SCHED;
            PG8_LDA(At, 0, 1); PG8_STAGE(PG8_SB(0, 0), b2, voffB); PG8_STAGE(PG8_SB(0, 1), b2 + hstep, voffB);
            PG8_WAIT_V(4); PG8_WAIT_L(0); PG8_BAR; PG8_MMA(1, 0, At, B0); PG8_MMA(1, 1, At, B1); PG8_BAR; PG8_SCHED;
            PG8_LDB(B0, 1, 0); PG8_LDB(B1, 1, 1); PG8_SCHED; PG8_LDA(At, 1, 0); PG8_STAGE(PG8_SA(0, 0), a2, voffA); PG8_STAGE(PG8_SA(0, 1), a2 + hstep, voffA);
            PG8_WAIT_V(4); PG8_WAIT_L(0); PG8_BAR; PG8_MMA(0, 0, At, B0); PG8_MMA(0, 1, At, B1); PG8_BAR; PG8_SCHED;
            PG8_LDA(At, 1, 1); PG8_STAGE(PG8_SB(1, 0), b3, voffB); PG8_STAGE(PG8_SB(1, 1), b3 + hstep, voffB);
            PG8_WAIT_V(4); PG8_WAIT_L(0); PG8_BAR; PG8_MMA(1, 0, At, B0); PG8_MMA(1, 1, At, B1); PG8_BAR; PG8_SCHED;
            } else if constexpr (SP2) {
            PG8_LDB(B0, 0, 0); PG8_LDB(B1, 0, 1); PG8_SCHED; PG8_LDA(At, 0, 0); PG8_STAGE(PG8_SA(1, 1), a1 + hstep, voffA);
            PG8_WAIT_V(8); PG8_WAIT_L(0); PG8_BAR; PG8_MMA(0, 0, At, B0); PG8_MMA(0, 1, At, B1); PG8_BAR; PG8_SCHED;
            PG8_LDA(At, 0, 1); PG8_STAGE(PG8_SB(0, 0), b2, voffB); PG8_STAGE(PG8_SB(0, 1), b2 + hstep, voffB); PG8_STAGE(PG8_SA(0, 0), a2, voffA);
            PG8_WAIT_V(8); PG8_WAIT_L(0); PG8_BAR; PG8_MMA(1, 0, At, B0); PG8_MMA(1, 1, At, B1); PG8_BAR; PG8_SCHED;
            PG8_LDB(B0, 1, 0); PG8_LDB(B1, 1, 1); PG8_SCHED; PG8_LDA(At, 1, 0); PG8_STAGE(PG8_SA(0, 1), a2 + hstep, voffA);
            PG8_WAIT_V(8); PG8_WAIT_L(0); PG8_BAR; PG8_MMA(0, 0, At, B0); PG8_MMA(0, 1, At, B1); PG8_BAR; PG8_SCHED;
            PG8_LDA(At, 1, 1); PG8_STAGE(PG8_SB(1, 0), b3, voffB); PG8_STAGE(PG8_SB(1, 1), b3 + hstep, voffB); PG8_STAGE(PG8_SA(1, 0), a3, voffA);
            PG8_WAIT_V(8); PG8_WAIT_L(0); PG8_BAR; PG8_MMA(1, 0, At, B0); PG8_MMA(1, 1, At, B1); PG8_BAR; PG8_SCHED;
            } else {
            PG8_LDB(B0, 0, 0); PG8_SCHED; PG8_LDA(At, 0, 0); PG8_STAGE(PG8_SA(1, 1), a1 + hstep, voffA);
            PG8_WAIT_L(8); PG8_BAR; PG8_WAIT_L(0); PG8_MMA(0, 0, At, B0); PG8_BAR; PG8_SCHED;
            PG8_LDB(B1, 0, 1); PG8_STAGE(PG8_SB(0, 0), b2, voffB);
            PG8_BAR; PG8_WAIT_L(0); PG8_MMA(0, 1, At, B1); PG8_BAR;
            PG8_LDA(At, 0, 1); PG8_STAGE(PG8_SA(0, 0), a2, voffA);
            PG8_BAR; PG8_WAIT_L(0); PG8_MMA(1, 0, At, B0); PG8_BAR; PG8_SCHED;
            PG8_STAGE(PG8_SB(0, 1), b2 + hstep, voffB);
            PG8_WAIT_V(6); PG8_BAR; PG8_MMA(1, 1, At, B1); PG8_BAR;
            PG8_LDB(B0, 1, 0); PG8_SCHED; PG8_LDA(At, 1, 0); PG8_STAGE(PG8_SA(0, 1), a2 + hstep, voffA);
            PG8_WAIT_L(8); PG8_BAR; PG8_WAIT_L(0); PG8_MMA(0, 0, At, B0); PG8_BAR; PG8_SCHED;
            PG8_LDB(B1, 1, 1); PG8_STAGE(PG8_SB(1, 0), b3, voffB);
            PG8_BAR; PG8_WAIT_L(0); PG8_MMA(0, 1, At, B1); PG8_BAR;
            PG8_LDA(At, 1, 1); PG8_STAGE(PG8_SA(1, 0), a3, voffA);
            PG8_BAR; PG8_WAIT_L(0); PG8_MMA(1, 0, At, B0); PG8_BAR; PG8_SCHED;
            PG8_STAGE(PG8_SB(1, 1), b3 + hstep, voffB);
            PG8_WAIT_V(6); PG8_BAR; PG8_MMA(1, 1, At, B1); PG8_BAR;
            }
        }
        if constexpr (ALIGN_EPI) { if (wr == 0) PG8_BAR; }
        if constexpr (!Epi::AFTER_DRAIN) { E(acc, cur, wr, wc, fr, fq); S.done(cur); }
        if (!has_next) break;
#pragma unroll
        for (int a = 0; a < 2; ++a)
#pragma unroll
            for (int b = 0; b < 2; ++b)
#pragma unroll
                for (int m = 0; m < 4; ++m)
#pragma unroll
                    for (int n = 0; n < 2; ++n) acc[a][b][m][n] = (f32x4){0.f, 0.f, 0.f, 0.f};
        cur = nxt; cA = nA; cB = nB; ++ui;
        if constexpr (ALIGN_EPI) { if (wr == 1) PG8_BAR; }
    }
    PG8_WAIT_V(0);
    if constexpr (!ALIGN_EPI) { if (wr == 0) PG8_BAR; }
    PG8_BAR;
    if constexpr (Epi::AFTER_DRAIN) { E.fused(acc, cur, wr, wc, fr, fq, lds, wid, lane); S.done(cur); }
#undef PG8_SA
#undef PG8_SB
#undef PG8_STAGE
#undef PG8_LDA
#undef PG8_LDB
#undef PG8_MMA
#undef PG8_WAIT_V
#undef PG8_WAIT_L
#undef PG8_BAR
#undef PG8_SCHED
}
}
#define GAS __attribute__((address_space(1)))
#define LAS __attribute__((address_space(3)))
typedef unsigned short bf16;
typedef unsigned v4u __attribute__((ext_vector_type(4)));
typedef float f32x4 __attribute__((ext_vector_type(4)));
typedef short bf16x8 __attribute__((ext_vector_type(8)));
typedef GAS unsigned gu32;
typedef GAS unsigned long long gu64;
#define RLX_AGENT __ATOMIC_RELAXED, __HIP_MEMORY_SCOPE_AGENT
#define LDS_WAIT() asm volatile("s_waitcnt lgkmcnt(0)" ::: "memory")
#define VM_WAIT() asm volatile("s_waitcnt vmcnt(0)" ::: "memory")
__device__ __forceinline__ unsigned long long rt() { return __builtin_amdgcn_s_memrealtime(); }
__device__ __forceinline__ unsigned f2bf(float f) { unsigned u = __builtin_bit_cast(unsigned, f); return (u + 0x7fffu + ((u >> 16) & 1u)) >> 16; }
__device__ __forceinline__ unsigned pk2(float lo, float hi) { return f2bf(lo) | (f2bf(hi) << 16); }

#define XB_TMO      128
#define XB_XCNT(j)  (256  + 64 * (j))
#define XB_XSUB(j)  (1280 + 64 * (j))
#define XB_XGEN(j)  (2304 + 64 * (j))
#define XB_TOP      3328
#define XB_TOPGEN   3392
#define XCD_BAR_WORDS 3456
#define XB_SPIN_CAP (1u << 18)

__device__ __forceinline__ unsigned xb_ld(unsigned* p)              { return __hip_atomic_load(p, __ATOMIC_RELAXED, __HIP_MEMORY_SCOPE_AGENT); }
__device__ __forceinline__ unsigned xb_add(unsigned* p, unsigned v) { return __hip_atomic_fetch_add(p, v, __ATOMIC_RELAXED, __HIP_MEMORY_SCOPE_AGENT); }
__device__ __forceinline__ unsigned xb_xcc_id() { return (unsigned)__builtin_amdgcn_s_getreg((3 << 11) | 20) & 0xFu; }
#define XB_SPIN(cond, bar) do { unsigned _sp = 0; while (cond) { __builtin_amdgcn_s_sleep(1); \
    if ((++_sp & 255u) == 0u) { if (xb_ld(&(bar)[XB_TMO])) break; if (_sp > XB_SPIN_CAP) { atomicAdd(&(bar)[XB_TMO], 1u); break; } } } } while (0)

struct XcdBarrier {
    unsigned* bar; unsigned x; int wave;
    volatile LAS unsigned* st;
};

__device__ __forceinline__ XcdBarrier xcd_barrier_post(unsigned* bar, volatile LAS unsigned* st, int wave) {
    XcdBarrier b; b.bar = bar; b.x = xb_xcc_id(); b.st = st; b.wave = wave;
    if (wave == 0 && pg8::lane_id_asm() == 0) (void)xb_add(&bar[XB_XCNT(b.x)], 1u);
    return b;
}
__device__ __forceinline__ void xcd_barrier_complete(unsigned* bar, unsigned x, unsigned& nloc, unsigned& nx) {
    const unsigned G = gridDim.x * gridDim.y * gridDim.z;
    unsigned sum, cnt, mine, sp = 0u;
    for (;;) {
        sum = 0u; cnt = 0u; mine = 0u;
#pragma unroll
        for (unsigned j = 0; j < 16; ++j) { const unsigned c = xb_ld(&bar[XB_XCNT(j)]); sum += c; cnt += (c > 0u) ? 1u : 0u; mine = (j == x) ? c : mine; }
        if (sum == G) break;
        __builtin_amdgcn_s_sleep(1);
        if ((++sp & 255u) == 0u) { if (xb_ld(&bar[XB_TMO])) break; if (sp > XB_SPIN_CAP) { atomicAdd(&bar[XB_TMO], 1u); break; } }
    }
    nloc = mine > 0u ? mine : 1u; nx = cnt > 0u ? cnt : 1u;
}

__device__ __forceinline__ void xcd_barrier(const XcdBarrier& b) {
    asm volatile("s_waitcnt vmcnt(0)" ::: "memory");
    __syncthreads();
    if (b.wave == 0 && pg8::lane_id_asm() == 0) {
        unsigned* bar = b.bar;
        __builtin_amdgcn_s_waitcnt(0);
        unsigned nloc = b.st[0], nx = b.st[1];
        if (nloc == 0u) { xcd_barrier_complete(bar, b.x, nloc, nx); b.st[0] = nloc; b.st[1] = nx; }
        const unsigned old = xb_add(&bar[XB_XSUB(b.x)], 1u);
        const unsigned gen = old / nloc;
        if (old + 1u == (gen + 1u) * nloc) {
            __builtin_amdgcn_fence(__ATOMIC_RELEASE, "agent");
            asm volatile("s_waitcnt vmcnt(0)" ::: "memory");
            const unsigned og = xb_add(&bar[XB_TOP], 1u);
            const unsigned tg = og / nx;
            if (og + 1u == (tg + 1u) * nx) xb_add(&bar[XB_TOPGEN], 1u);
            else XB_SPIN(xb_ld(&bar[XB_TOPGEN]) == tg, bar);
            __builtin_amdgcn_fence(__ATOMIC_ACQUIRE, "agent");
            xb_add(&bar[XB_XGEN(b.x)], 1u);
            asm volatile("s_waitcnt vmcnt(0)" ::: "memory");
        } else {
            XB_SPIN(xb_ld(&bar[XB_XGEN(b.x)]) == gen, bar);
            __builtin_amdgcn_fence(__ATOMIC_ACQUIRE, "agent");
            asm volatile("s_waitcnt vmcnt(0)" ::: "memory");
        }
    }
    __syncthreads();
}

constexpr int NWAVES = 8;
constexpr int BATCH = 4, SEQ = 2048, D = 2048, DFF = 5632, NGU = 2 * DFF, NIN = 6144, PLE = 256;
constexpr int HW = 1024, LW = 1024, HEADS = 8, HD = 128, CHUNK = 64, NCH = SEQ / CHUNK;
constexpr int M = BATCH * SEQ;
constexpr float EPS = 1e-6f;
constexpr int N_IN = 27;
enum In { I_X = 0, I_P, I_F1N, I_F1G, I_F1U, I_F1D, I_MIXN, I_WIN, I_HLB, I_HGN, I_CW, I_CB, I_LWA, I_LBA, I_LWX, I_LBX, I_LAM, I_WOUT,
          I_F2N, I_F2G, I_F2U, I_F2D, I_PLN, I_PWG, I_PBG, I_PWP, I_FN };

constexpr size_t MiB = 1u << 20;
constexpr size_t WS_CTL = 0, CTL_ZERO_BYTES = 128 * 1024;
constexpr size_t WS_SSQA = 1 * MiB, WS_SSQB = 2 * MiB, WS_DEC = 3 * MiB;
constexpr size_t WS_WAT = 3 * MiB + 512 * 1024, WS_WXT = 3 * MiB + 768 * 1024;
constexpr size_t WS_WPROJ = 4 * MiB, WS_PB = 5 * MiB;
constexpr size_t WS_WGU1 = 9 * MiB, WS_WD1 = 53 * MiB, WS_WINT = 75 * MiB, WS_WOUT = 99 * MiB, WS_WGU2 = 107 * MiB, WS_WD2 = 151 * MiB, WS_WPG = 173 * MiB;
constexpr size_t WS_XB = 181 * MiB;
constexpr size_t WS_ACT = 213 * MiB;
constexpr size_t WS_LOGF = WS_ACT, WS_V = WS_ACT + 32 * MiB, WS_SG = WS_ACT + 48 * MiB, WS_LRX = WS_ACT + 64 * MiB, WS_PP = 333 * MiB;
constexpr size_t WS_MIXA = 301 * MiB;
constexpr size_t WS_KVT = 333 * MiB;
constexpr size_t WS_XCH = 397 * MiB;
constexpr size_t WS_WAJ = 398 * MiB, WS_WXJ = 399 * MiB;
constexpr size_t WS_BA2 = 400 * MiB;
constexpr size_t WS_END = 401 * MiB;
static_assert(WS_WGU1 + (size_t)NGU * D * 2 <= WS_WD1 && WS_WD1 + (size_t)D * DFF * 2 <= WS_WINT && WS_WINT + (size_t)NIN * D * 2 <= WS_WOUT && WS_WOUT + (size_t)D * D * 2 <= WS_WGU2 &&
              WS_WGU2 + (size_t)NGU * D * 2 <= WS_WD2 && WS_WD2 + (size_t)D * DFF * 2 <= WS_WPG && WS_WPG + (size_t)D * D * 2 <= WS_XB && WS_XB + (size_t)M * D * 2 <= WS_ACT &&
              WS_ACT + (size_t)M * DFF * 2 <= WS_MIXA && WS_MIXA + (size_t)M * 2048 * 2 <= WS_KVT && WS_KVT + (size_t)BATCH * HEADS * NCH * HD * HD * 4 <= WS_XCH &&
              WS_LRX + (size_t)M * 1024 * 2 <= WS_MIXA && WS_PP + (size_t)M * D * 4 <= 397 * MiB && WS_PB + (size_t)M * PLE * 2 <= WS_WGU1 && WS_WPROJ + (size_t)D * PLE * 2 <= WS_PB, "d_ws map");
constexpr int CW_PANEL = 16384;
constexpr int CW_BAR = 4096;

constexpr int RING_OFF = 0, RING_BYTES = 131072;
constexpr int LDSCTL_OFF = 147456 - 512, MISC_OFF = LDSCTL_OFF + 320;
constexpr int LDS_BYTES = 147456;
static_assert(MISC_OFF + 128 <= LDS_BYTES, "LDS map");


struct Frame {
    LAS unsigned char* lds;
    volatile LAS unsigned* MISC;
    gu32* ctl;
    int wave;
    int vcu, G;
    const float* in[N_IN]; float* out; unsigned char* ws;
};
__device__ __forceinline__ float bf2f(bf16 b) { return __builtin_bit_cast(float, (unsigned)b << 16); }
__device__ __forceinline__ float wave_sum(float v) {
#pragma unroll
    for (int o = 1; o < 64; o <<= 1) v += __shfl_xor(v, o);
    return v;
}
__device__ __forceinline__ void p0_transpose_item(const float* W, int ldw, int K, int src_col0, bf16* WT, int dst_row0, const float* gain, LAS float* scr, int kb, int lane, float wscale = 1.0f) {
    const int k0 = 64 * kb, kq = lane >> 4, nq = lane & 15;
    f32x4 v[16];
#pragma unroll
    for (int i = 0; i < 16; ++i) v[i] = __builtin_nontemporal_load((const GAS f32x4*)(W + (size_t)(k0 + 4 * i + kq) * ldw + src_col0 + 4 * nq));
    if (gain) {
#pragma unroll
        for (int i = 0; i < 16; ++i) v[i] = v[i] * gain[k0 + 4 * i + kq];
    }
    if (wscale != 1.0f) {
#pragma unroll
        for (int i = 0; i < 16; ++i) v[i] = v[i] * wscale;
    }
#pragma unroll
    for (int i = 0; i < 16; ++i) { LAS float* s = scr + (4 * i + kq) * 65 + 4 * nq; s[0] = v[i].x; s[1] = v[i].y; s[2] = v[i].z; s[3] = v[i].w; }
    LDS_WAIT(); asm volatile("" ::: "memory");
    const int c = lane & 7;
#pragma unroll
    for (int j = 0; j < 8; ++j) { const int n = (lane >> 3) + 8 * j; const LAS float* s = scr + (8 * c) * 65 + n;
        v4u o; o.x = pk2(s[0 * 65], s[1 * 65]); o.y = pk2(s[2 * 65], s[3 * 65]); o.z = pk2(s[4 * 65], s[5 * 65]); o.w = pk2(s[6 * 65], s[7 * 65]);
        *(GAS v4u*)(WT + (size_t)(dst_row0 + n) * K + k0 + 8 * c) = o; }
    LDS_WAIT(); asm volatile("" ::: "memory");
}
__device__ __forceinline__ bool p0_plain(int& r, const float* W, int K, int N, bf16* WT, const float* gain, LAS float* scr, int lane, float wscale = 1.0f) {
    const int items = (N / 64) * (K / 64);
    if (r < items) { const int nb = r / (K / 64), kb = r % (K / 64); p0_transpose_item(W, N, K, 64 * nb, WT, 64 * nb, gain, scr, kb, lane, wscale); return true; }
    r -= items; return false;
}
__device__ __forceinline__ bool p0_gateup(int& r, const float* Wg, const float* Wu, bf16* WT, const float* gain, LAS float* scr, int lane) {
    const int items = (NGU / 64) * (D / 64);
    if (r < items) { const int rb = r / (D / 64), kb = r % (D / 64), t = rb >> 2, j = rb & 3;
        p0_transpose_item(j < 2 ? Wg : Wu, DFF, D, 128 * t + 64 * (j & 1), WT, 64 * rb, gain, scr, kb, lane); return true; }
    r -= items; return false;
}
enum { J_X = 1, J_P = 2, J_GU1 = 4, J_D1 = 8, J_WIN = 16, J_WOUT = 32, J_GU2 = 64, J_D2 = 128, J_PG = 256, J_PROJ = 512, J_AX = 1024 };
template <int JOBS>
__device__ __forceinline__ void convert_jobs(Frame& F, int rank, int count) {
    const int lane_ = pg8::lane_id_asm(), wave_ = F.wave;
    LAS float* scr = (LAS float*)(F.lds + RING_OFF + wave_ * 16640);
    const int gw = rank * NWAVES + wave_, NGW = count * NWAVES;
    unsigned char* ws = F.ws;
    if (JOBS & J_X) {
        for (int m = gw; m < M; m += NGW) {
            const GAS f32x4* xr = (const GAS f32x4*)(F.in[I_X] + (size_t)m * D) + lane_;
            GAS unsigned long long* o8 = (GAS unsigned long long*)((bf16*)(ws + WS_XB) + (size_t)m * D) + lane_;
            float s = 0.f;
#pragma unroll
            for (int j = 0; j < 8; ++j) { const f32x4 v = __builtin_nontemporal_load(xr + 64 * j); s += (v.x * v.x + v.y * v.y) + (v.z * v.z + v.w * v.w);
                o8[64 * j] = (unsigned long long)pk2(v.x, v.y) | ((unsigned long long)pk2(v.z, v.w) << 32); }
            s = wave_sum(s);
            if (lane_ < 32) ((float*)(ws + WS_SSQA))[(size_t)m * 32 + lane_] = (lane_ == 0) ? s : 0.f;
        }
    }
    if (JOBS & J_P) {
        for (int m = gw; m < M; m += NGW) {
            const f32x4 v = __builtin_nontemporal_load((const GAS f32x4*)(F.in[I_P] + (size_t)m * PLE) + lane_);
            ((GAS unsigned long long*)((bf16*)(ws + WS_PB) + (size_t)m * PLE))[lane_] = (unsigned long long)pk2(v.x, v.y) | ((unsigned long long)pk2(v.z, v.w) << 32);
        }
    }
    constexpr int I_GU = (NGU / 64) * (D / 64), I_DD = (D / 64) * (DFF / 64), I_IN = (NIN / 64) * (D / 64), I_SQ = (D / 64) * (D / 64), I_PJ = (D / 64) * (PLE / 64), I_AX = 16 * 4 * 4;
    constexpr int NITEMS = ((JOBS & J_GU1) ? I_GU : 0) + ((JOBS & J_D1) ? I_DD : 0) + ((JOBS & J_WIN) ? I_IN : 0) + ((JOBS & J_WOUT) ? I_SQ : 0) + ((JOBS & J_GU2) ? I_GU : 0) +
                           ((JOBS & J_D2) ? I_DD : 0) + ((JOBS & J_PG) ? I_SQ : 0) + ((JOBS & J_PROJ) ? I_PJ : 0) + ((JOBS & J_AX) ? I_AX : 0);
    for (int it = gw; it < NITEMS; it += NGW) {
        int r = it;
        if (JOBS & J_GU1) { if (p0_gateup(r, F.in[I_F1G], F.in[I_F1U], (bf16*)(ws + WS_WGU1), F.in[I_F1N], scr, lane_)) continue; }
        if (JOBS & J_D1) { if (p0_plain(r, F.in[I_F1D], DFF, D, (bf16*)(ws + WS_WD1), nullptr, scr, lane_, 0.5f)) continue; }
        if (JOBS & J_WIN) { if (p0_plain(r, F.in[I_WIN], D, NIN, (bf16*)(ws + WS_WINT), F.in[I_MIXN], scr, lane_)) continue; }
        if (JOBS & J_WOUT) { if (p0_plain(r, F.in[I_WOUT], D, D, (bf16*)(ws + WS_WOUT), nullptr, scr, lane_)) continue; }
        if (JOBS & J_GU2) { if (p0_gateup(r, F.in[I_F2G], F.in[I_F2U], (bf16*)(ws + WS_WGU2), F.in[I_F2N], scr, lane_)) continue; }
        if (JOBS & J_D2) { if (p0_plain(r, F.in[I_F2D], DFF, D, (bf16*)(ws + WS_WD2), nullptr, scr, lane_, 0.5f)) continue; }
        if (JOBS & J_PG) { if (p0_plain(r, F.in[I_PWG], D, D, (bf16*)(ws + WS_WPG), F.in[I_PLN], scr, lane_)) continue; }
        if (JOBS & J_PROJ) { if (p0_plain(r, F.in[I_PWP], PLE, D, (bf16*)(ws + WS_WPROJ), nullptr, scr, lane_)) continue; }
        if (JOBS & J_AX) { const int blk = r >> 4, j = (r >> 2) & 3, q = r & 3;
          const int nb = blk & 7;
          const float* W = (blk < 8 ? F.in[I_LWA] : F.in[I_LWX]) + (size_t)nb * 128 * 128;
          bf16* WT = (bf16*)(ws + (blk < 8 ? WS_WAJ : WS_WXJ)) + (size_t)(nb * 4 + j) * 128 * 128;
          p0_transpose_item(W, 128, 128, 64 * (q >> 1), WT, 64 * (q >> 1), F.in[I_CW] + j * 1024 + nb * 128, scr, q & 1, lane_); }
    }
    if (JOBS & J_AX) {
        for (int o = gw * 64 + lane_; o < 2048; o += NGW * 64) { const int which = o >> 10, dg = o & 1023, nb = dg >> 7, dd = dg & 127;
            const float* W = (which ? F.in[I_LWX] : F.in[I_LWA]) + (size_t)nb * 128 * 128 + dd; float s = (which ? F.in[I_LBX] : F.in[I_LBA])[dg];
            for (int c = 0; c < 128; ++c) s += F.in[I_CB][nb * 128 + c] * W[(size_t)c * 128];
            ((float*)(ws + WS_BA2))[o] = s; }
    }
}
__device__ __forceinline__ void side_workers(int nwg, int G, int c, int& rank, int& count) {
    const int rounds = (nwg + G - 1) / G, last = nwg - (rounds - 1) * G;
    if (last == G) { rank = c; count = G; } else if (c >= last) { rank = c - last; count = G - last; } else { rank = -1; count = 0; }
}
__device__ __forceinline__ void final_norm(Frame& F, const float* ssq) {
    const int lane_ = pg8::lane_id_asm(), wave_ = F.wave;
    const int gw = F.vcu * NWAVES + wave_, NGW = F.G * NWAVES;
    const GAS f32x4* gf = (const GAS f32x4*)F.in[I_FN] + lane_;
    for (int m = gw; m < M; m += NGW) {
        float s = (lane_ < 32) ? ssq[(size_t)m * 32 + lane_] : 0.f;
        s = wave_sum(s);
        const float rstd = 1.0f / sqrtf(s * (1.0f / D) + EPS);
        GAS f32x4* xr = (GAS f32x4*)(F.out + (size_t)m * D) + lane_;
#pragma unroll
        for (int j = 0; j < 8; ++j) { f32x4 v = xr[64 * j]; const f32x4 g = gf[64 * j]; v = v * rstd * g; xr[64 * j] = v; }
    }
}


typedef float mf32x4 __attribute__((ext_vector_type(4)));
typedef short mbf16x8 __attribute__((ext_vector_type(8)));
typedef unsigned mu32x2 __attribute__((ext_vector_type(2)));
constexpr int TS = 72;
constexpr int QS = 136;
constexpr int NITEM = BATCH * HEADS * NCH;
__device__ __forceinline__ mbf16x8 lds_frag(const LAS bf16* p) { return *(const LAS mbf16x8*)p; }
__device__ __forceinline__ unsigned bf1(float x) { return pg8::cvt_pk_bf16(x, 0.f) & 0xffffu; }
#define MFMA16(a, b, c) __builtin_amdgcn_mfma_f32_16x16x32_bf16((a), (b), (c), 0, 0, 0)

#define LBAR() do { asm volatile("s_waitcnt lgkmcnt(0)" ::: "memory"); __builtin_amdgcn_s_barrier(); asm volatile("" ::: "memory"); } while (0)

__device__ __forceinline__ void hgrn_local_phase(Frame& F) {
    LAS bf16* kstT = (LAS bf16*)(F.lds);
    LAS bf16* vT = (LAS bf16*)(F.lds + 18432);
    LAS float* qtot = (LAS float*)(F.lds + 36864);
    const int tid_ = F.wave * 64 + pg8::lane_id_asm();
    const int tid = tid_, k = tid & 127, sq = tid >> 7, lane = tid & 63, w = F.wave, fr = lane & 15, fq = lane >> 4;
    const float* LOGF = (const float*)(F.ws + WS_LOGF); const bf16* V = (const bf16*)(F.ws + WS_V);
    bf16* KVT = (bf16*)(F.ws + WS_KVT); float* DEC = (float*)(F.ws + WS_DEC);
    float lf[16]; unsigned vr[16];
    if ((int)blockIdx.x < NITEM) { const int item = blockIdx.x, c = item & 31, bh = item >> 5, h = bh & 7, b = bh >> 3;
        const size_t g0 = ((size_t)b * SEQ + c * 64 + sq * 16) * 1024 + h * 128 + k;
#pragma unroll
        for (int i = 0; i < 16; ++i) { lf[i] = LOGF[g0 + (size_t)i * 1024]; vr[i] = V[g0 + (size_t)i * 1024]; } }
    for (int item = blockIdx.x; item < NITEM; item += F.G) {
        float bb[16]; float run = 0.f;
#pragma unroll
        for (int i = 0; i < 16; ++i) { run += lf[i]; bb[i] = run; }
        qtot[sq * 128 + k] = run;
        LBAR();
        float pre = 0.f, tot = 0.f;
#pragma unroll
        for (int j = 0; j < 4; ++j) { const float tq = qtot[j * 128 + k]; pre += (j < sq) ? tq : 0.f; tot += tq; }
        unsigned pk[8], pv[8];
#pragma unroll
        for (int i = 0; i < 8; ++i) {
            const float e0 = (1.0f - __expf(lf[2 * i])) * __expf(tot - (pre + bb[2 * i])), e1 = (1.0f - __expf(lf[2 * i + 1])) * __expf(tot - (pre + bb[2 * i + 1]));
            pk[i] = pg8::cvt_pk_bf16(e0, e1); pv[i] = vr[2 * i] | (vr[2 * i + 1] << 16); }
        *(LAS v4u*)(kstT + k * TS + sq * 16) = (v4u){pk[0], pk[1], pk[2], pk[3]}; *(LAS v4u*)(kstT + k * TS + sq * 16 + 8) = (v4u){pk[4], pk[5], pk[6], pk[7]};
        *(LAS v4u*)(vT + k * TS + sq * 16) = (v4u){pv[0], pv[1], pv[2], pv[3]}; *(LAS v4u*)(vT + k * TS + sq * 16 + 8) = (v4u){pv[4], pv[5], pv[6], pv[7]};
        if (sq == 0) DEC[(size_t)item * 128 + k] = __expf(tot);
        if (item + F.G < NITEM) { const int it2 = item + F.G, c = it2 & 31, bh = it2 >> 5, h = bh & 7, b = bh >> 3;
            const size_t g0 = ((size_t)b * SEQ + c * 64 + sq * 16) * 1024 + h * 128 + k;
#pragma unroll
            for (int i = 0; i < 16; ++i) { lf[i] = LOGF[g0 + (size_t)i * 1024]; vr[i] = V[g0 + (size_t)i * 1024]; } }
        LBAR();
        const mbf16x8 b0 = lds_frag(vT + (16 * w + fr) * TS + 8 * fq), b1 = lds_frag(vT + (16 * w + fr) * TS + 32 + 8 * fq);
        bf16* outp = KVT + (size_t)item * 16384 + (size_t)(16 * w + fr) * 128 + 4 * fq;
#pragma unroll
        for (int kt = 0; kt < 8; ++kt) {
            mf32x4 acc = {0.f, 0.f, 0.f, 0.f};
            acc = MFMA16(lds_frag(kstT + (16 * kt + fr) * TS + 8 * fq), b0, acc);
            acc = MFMA16(lds_frag(kstT + (16 * kt + fr) * TS + 32 + 8 * fq), b1, acc);
            asm volatile("s_nop 7\n\ts_nop 7" : "+v"(acc));
            mu32x2 o; o.x = pg8::cvt_pk_bf16(acc[0], acc[1]); o.y = pg8::cvt_pk_bf16(acc[2], acc[3]);
            *(mu32x2*)(outp + 16 * kt) = o;
        }
        LBAR();
    }
}

__device__ __forceinline__ void hgrn_scan_phase(Frame& F) {
    const bf16* KVT = (const bf16*)(F.ws + WS_KVT); const float* DEC = (const float*)(F.ws + WS_DEC); bf16* ST = (bf16*)(F.ws + WS_XB);
    const int tid_ = F.wave * 64 + pg8::lane_id_asm();
    for (int idx = blockIdx.x * (NWAVES * 64) + tid_; idx < BATCH * HEADS * 128 * 32; idx += F.G * NWAVES * 64) {
        const int k4 = idx & 31, v = (idx >> 5) & 127, bh = idx >> 12;
        mf32x4 S = {0.f, 0.f, 0.f, 0.f};
#pragma unroll 1
        for (int half = 0; half < 2; ++half) {
            const size_t off0 = (size_t)(bh * NCH + half * 16) * 16384 + v * 128 + 4 * k4; const size_t d0 = (size_t)(bh * NCH + half * 16) * 128 + 4 * k4;
            mu32x2 kv[16]; mf32x4 dd[16];
#pragma unroll
            for (int c = 0; c < 16; ++c) { kv[c] = *(const mu32x2*)(KVT + off0 + (size_t)c * 16384); dd[c] = *(const mf32x4*)(DEC + d0 + (size_t)c * 128); }
#pragma unroll
            for (int c = 0; c < 16; ++c) {
                mu32x2 o; o.x = pg8::cvt_pk_bf16(S[0], S[1]); o.y = pg8::cvt_pk_bf16(S[2], S[3]); *(mu32x2*)(ST + off0 + (size_t)c * 16384) = o;
                S = dd[c] * S + pg8::bf16x4_to_f32(kv[c]);
            }
        }
    }
}

__device__ __forceinline__ void hgrn_out_phase(Frame& F, bool dummy = false) {
    LAS bf16* QT = (LAS bf16*)(F.lds);
    LAS bf16* KT = (LAS bf16*)(F.lds + 17408);
    LAS bf16* QI = (LAS bf16*)(F.lds + 34816);
    LAS bf16* vT = (LAS bf16*)(F.lds + 52224);
    LAS bf16* P = (LAS bf16*)(F.lds + 70656);
    LAS float* qtot = (LAS float*)(F.lds + 79872);
    LAS float* ssq = (LAS float*)(F.lds + 81920);
    const int tid_ = F.wave * 64 + pg8::lane_id_asm();
    const int tid = tid_, k = tid & 127, sq = tid >> 7, lane = tid & 63, w = F.wave, fr = lane & 15, fq = lane >> 4, rb = w & 3, ch = w >> 2;
    const float* LOGF = (const float*)(F.ws + WS_LOGF); const bf16* V = (const bf16*)(F.ws + WS_V); const bf16* SG = (const bf16*)(F.ws + WS_SG);
    const bf16* ST = (const bf16*)(F.ws + WS_XB); bf16* MIXA = (bf16*)(F.ws + WS_MIXA);
    const int t0 = 16 * rb;
    float lf[16]; unsigned vr[16], qr[16];
    if ((int)blockIdx.x < NITEM) { const int item = blockIdx.x, c = item & 31, bh = item >> 5, h = bh & 7, b = bh >> 3;
        const size_t r0 = (size_t)b * SEQ + c * 64, g0 = (r0 + sq * 16) * 1024 + h * 128 + k, gq = (r0 + sq * 16) * 2048 + h * 128 + k;
#pragma unroll
        for (int i = 0; i < 16; ++i) { lf[i] = LOGF[g0 + (size_t)i * 1024]; vr[i] = V[g0 + (size_t)i * 1024]; qr[i] = MIXA[gq + (size_t)i * 2048]; } }
    for (int item = blockIdx.x; item < NITEM; item += F.G) {
        const int c = item & 31, bh = item >> 5, h = bh & 7, b = bh >> 3;
        const size_t r0 = (size_t)b * SEQ + c * 64;
        float bb[16]; float run = 0.f;
#pragma unroll
        for (int i = 0; i < 16; ++i) { run += lf[i]; bb[i] = run; }
        qtot[sq * 128 + k] = run;
        LBAR();
        {
            float pre = 0.f;
#pragma unroll
            for (int j = 0; j < 4; ++j) { const float tq = qtot[j * 128 + k]; pre += (j < sq) ? tq : 0.f; }
            const float bm = qtot[k] + qtot[128 + k], ebm = __expf(bm);
            unsigned pv[8];
#pragma unroll
            for (int i = 0; i < 16; ++i) {
                const float d = fminf(fmaxf(pre + bb[i] - bm, -60.f), 60.f), e1 = __expf(d), e2 = __builtin_amdgcn_rcpf(e1);
                const float qf = bf2f((bf16)qr[i]), qt = qf * e1, kk = (1.0f - __expf(lf[i])) * e2;
                const int s = sq * 16 + i;
                QT[s * QS + k] = (bf16)bf1(qt); QI[s * QS + k] = (bf16)bf1(qt * ebm); KT[s * QS + k] = (bf16)bf1(kk);
            }
#pragma unroll
            for (int i = 0; i < 8; ++i) pv[i] = vr[2 * i] | (vr[2 * i + 1] << 16);
            *(LAS v4u*)(vT + k * TS + sq * 16) = (v4u){pv[0], pv[1], pv[2], pv[3]}; *(LAS v4u*)(vT + k * TS + sq * 16 + 8) = (v4u){pv[4], pv[5], pv[6], pv[7]};
        }
        if (item + F.G < NITEM) { const int it2 = item + F.G, c2 = it2 & 31, bh2 = it2 >> 5, h2 = bh2 & 7, b2 = bh2 >> 3;
            const size_t r2 = (size_t)b2 * SEQ + c2 * 64, g0 = (r2 + sq * 16) * 1024 + h2 * 128 + k, gq = (r2 + sq * 16) * 2048 + h2 * 128 + k;
#pragma unroll
            for (int i = 0; i < 16; ++i) { lf[i] = LOGF[g0 + (size_t)i * 1024]; vr[i] = V[g0 + (size_t)i * 1024]; qr[i] = MIXA[gq + (size_t)i * 2048]; } }
        mbf16x8 stf[4][4]; mu32x2 sgp[4];
#pragma unroll
        for (int j = 0; j < 4; ++j) { const bf16* sp = ST + (size_t)item * 16384 + (size_t)(64 * ch + 16 * j + fr) * 128 + 8 * fq;
#pragma unroll
            for (int ks = 0; ks < 4; ++ks) stf[j][ks] = *(const mbf16x8*)(sp + 32 * ks);
            sgp[j] = *(const mu32x2*)(SG + (r0 + t0 + fr) * 1024 + h * 128 + 64 * ch + 16 * j + 4 * fq); }
        LBAR();
        {
            mbf16x8 bq[4];
#pragma unroll
            for (int ks = 0; ks < 4; ++ks) bq[ks] = lds_frag(QT + (t0 + fr) * QS + 32 * ks + 8 * fq);
#pragma unroll
            for (int j = 0; j < 2; ++j) {
                const int s0 = 32 * ch + 16 * j; mf32x4 acc = {0.f, 0.f, 0.f, 0.f};
#pragma unroll
                for (int ks = 0; ks < 4; ++ks) acc = MFMA16(lds_frag(KT + (s0 + fr) * QS + 32 * ks + 8 * fq), bq[ks], acc);
                const int t = t0 + fr, sb = s0 + 4 * fq;
#pragma unroll
                for (int r = 0; r < 4; ++r) acc[r] = (sb + r <= t) ? acc[r] : 0.f;
                mu32x2 o; o.x = pg8::cvt_pk_bf16(acc[0], acc[1]); o.y = pg8::cvt_pk_bf16(acc[2], acc[3]);
                *(LAS mu32x2*)(P + t * TS + sb) = o;
            }
        }
        LBAR();
        mf32x4 o4[4];
        {
            mbf16x8 bqi[4], bp[2];
#pragma unroll
            for (int ks = 0; ks < 4; ++ks) bqi[ks] = lds_frag(QI + (t0 + fr) * QS + 32 * ks + 8 * fq);
#pragma unroll
            for (int ss = 0; ss < 2; ++ss) bp[ss] = lds_frag(P + (t0 + fr) * TS + 32 * ss + 8 * fq);
            float sum = 0.f;
#pragma unroll
            for (int j = 0; j < 4; ++j) {
                const int v0 = 64 * ch + 16 * j; mf32x4 acc = {0.f, 0.f, 0.f, 0.f};
#pragma unroll
                for (int ks = 0; ks < 4; ++ks) acc = MFMA16(stf[j][ks], bqi[ks], acc);
#pragma unroll
                for (int ss = 0; ss < 2; ++ss) acc = MFMA16(lds_frag(vT + (v0 + fr) * TS + 32 * ss + 8 * fq), bp[ss], acc);
                o4[j] = acc; sum += (acc[0] * acc[0] + acc[1] * acc[1]) + (acc[2] * acc[2] + acc[3] * acc[3]);
            }
            sum += __shfl_xor(sum, 16); sum += __shfl_xor(sum, 32);
            if (fq == 0) ssq[ch * 64 + t0 + fr] = sum;
        }
        LBAR();
        {
            const float rn = 1.0f / sqrtf((ssq[t0 + fr] + ssq[64 + t0 + fr]) * (1.0f / 128.0f) + EPS);
            const size_t row = r0 + t0 + fr;
#pragma unroll
            for (int j = 0; j < 4; ++j) {
                const int v = 64 * ch + 16 * j + 4 * fq;
                const mf32x4 gn = *(const mf32x4*)(F.in[I_HGN] + v);
                const float s0 = bf2f((bf16)(sgp[j].x & 0xffffu)), s1 = bf2f((bf16)(sgp[j].x >> 16)), s2 = bf2f((bf16)(sgp[j].y & 0xffffu)), s3 = bf2f((bf16)(sgp[j].y >> 16));
                mu32x2 o; o.x = pg8::cvt_pk_bf16(o4[j][0] * rn * gn[0] * s0, o4[j][1] * rn * gn[1] * s1); o.y = pg8::cvt_pk_bf16(o4[j][2] * rn * gn[2] * s2, o4[j][3] * rn * gn[3] * s3);
                *(mu32x2*)((dummy ? (bf16*)(F.ws + WS_KVT) : MIXA) + row * 2048 + h * 128 + v) = o;
            }
        }
        LBAR();
    }
}

#define GLDS16(gp, lp) __builtin_amdgcn_global_load_lds((const unsigned*)(gp), (LAS unsigned*)(lp), 16, 0, 0)
template <int VAR = 0, bool FUSE_SCAN = false, bool dummy = false>
__device__ __forceinline__ void lru_phase(Frame& F) {
    LAS unsigned char* Ab = F.lds;
    LAS float* LAt = (LAS float*)(F.lds + 66560);
    LAS float* LUt = (LAS float*)(F.lds + 66560 + 18560);
    LAS bf16* GG = (LAS bf16*)(F.lds + 103680);
    LAS bf16* YY = (LAS bf16*)(F.lds + 120064);
    const int tid_ = F.wave * 64 + pg8::lane_id_asm();
    const int tid = tid_, lane = tid & 63, w = F.wave, fr = lane & 15, fq = lane >> 4;
    const int seg = lane & 31, d = 2 * w + (lane >> 5);
    const int grow = tid >> 1, ghalf = tid & 1;
    const bf16* LRX = (const bf16*)(F.ws + WS_LRX); bf16* MIXA = (bf16*)(F.ws + WS_MIXA);
    const bf16* WAJ = (const bf16*)(F.ws + WS_WAJ); const bf16* WXJ = (const bf16*)(F.ws + WS_WXJ);
    for (int item = blockIdx.x; item < BATCH * 64; item += F.G) {
        const int b = item >> 6, n = (item >> 3) & 7, sl = item & 7;
        int tid = tid_; asm volatile("" : "+v"(tid));
        const int lane = tid & 63, fr = lane & 15, fq = lane >> 4, grow = tid >> 1, ghalf = tid & 1;
        mbf16x8 waf[4][4], wxf[4][4];
#pragma unroll
        for (int j = 0; j < 4; ++j)
#pragma unroll
            for (int ks = 0; ks < 4; ++ks) { const size_t o = ((size_t)(n * 4 + j) * 128 + sl * 16 + fr) * 128 + 32 * ks + 8 * fq; waf[j][ks] = *(const mbf16x8*)(WAJ + o); wxf[j][ks] = *(const mbf16x8*)(WXJ + o); }
        const bf16* xsrc0 = LRX + (size_t)b * SEQ * 1024 + n * 128;
        bf16* const gbase = MIXA + (size_t)b * SEQ * 2048 + 1024 + n * 128 + sl * 16 + 8 * ghalf;
        bf16* const obase = dummy ? (bf16*)(F.ws + WS_END) + (size_t)item * 2048 * 16 + 8 * ghalf : gbase;
        const size_t ostr = dummy ? 16 : 2048;
#pragma unroll
        for (int i = 0; i < 9; ++i) { const int p = tid + 512 * i, row = p >> 4, cp = p & 15;
            if (p < 259 * 16 && row >= 3) GLDS16(xsrc0 + (size_t)(row - 3) * 1024 + 8 * (cp ^ (row & 15)), Ab + (w * 64 + 512 * i) * 16); }
        if (tid < 48) *(LAS v4u*)(Ab + tid * 16) = (v4u){0u, 0u, 0u, 0u};
        GLDS16(gbase + (size_t)grow * 2048, (LAS unsigned char*)GG + w * 1024);
        __syncthreads();
        float carry = 0.f;
        mf32x4 S = {0.f, 0.f, 0.f, 0.f};
        for (int mc = 0; mc < 8; ++mc) {
            int tid = tid_; asm volatile("" : "+v"(tid));
            const int lane = tid & 63, fr = lane & 15, fq = lane >> 4, seg = lane & 31, d = 2 * w + (lane >> 5), grow = tid >> 1, ghalf = tid & 1;
            const bf16* xsrc = LRX + (size_t)b * SEQ * 1024 + n * 128;
            bf16* const gbase = MIXA + (size_t)b * SEQ * 2048 + 1024 + n * 128 + sl * 16 + 8 * ghalf;
            bf16* const obase = dummy ? (bf16*)(F.ws + WS_END) + (size_t)item * 2048 * 16 + 8 * ghalf : gbase;
            const int sidx = blockIdx.x * (NWAVES * 64) + tid;
            const unsigned soff = (unsigned)((sidx >> 12) * NCH + 4 * mc) * 16384u + ((sidx >> 5) & 127) * 128 + 4 * (sidx & 31), sdo = (unsigned)((sidx >> 12) * NCH + 4 * mc) * 128u + 4 * (sidx & 31);
            mu32x2 skv[2]; mf32x4 sdd[2];
            if (FUSE_SCAN) {
#pragma unroll
                for (int c = 0; c < 2; ++c) { skv[c] = *(const mu32x2*)((const bf16*)(F.ws + WS_KVT) + soff + c * 16384u); sdd[c] = *(const mf32x4*)((const float*)(F.ws + WS_DEC) + sdo + c * 128u); }
            }
            if (mc > 0) *(v4u*)(obase + (size_t)((mc - 1) * 256 + grow) * ostr) = *(const LAS v4u*)(YY + ((mc - 1) & 1) * 4096 + grow * 16 + 8 * ghalf);
            const int cgl = n * 128 + sl * 16 + fr;
            const float ba2 = ((const float*)(F.ws + WS_BA2))[cgl], bx2 = ((const float*)(F.ws + WS_BA2))[1024 + cgl], spl = log1pf(__expf(-F.in[I_LAM][cgl])), cbv = F.in[I_CB][cgl];
            float cw4[4];
#pragma unroll
            for (int j = 0; j < 4; ++j) cw4[j] = F.in[I_CW][j * 1024 + cgl];
#pragma unroll
            for (int rt = 0; rt < (VAR == 2 ? 0 : 2); ++rt) {
                const int rowt = 32 * w + 16 * rt; mf32x4 ar = {0.f, 0.f, 0.f, 0.f}, ai = {0.f, 0.f, 0.f, 0.f};
#pragma unroll
                for (int j = 0; j < 4; ++j) { const int R = rowt + fr + j;
#pragma unroll
                    for (int ks = 0; ks < 4; ++ks) { const mbf16x8 a = *(const LAS mbf16x8*)(Ab + R * 256 + (((4 * ks + fq) ^ (R & 15)) << 4)); ar = MFMA16(a, waf[j][ks], ar); ai = MFMA16(a, wxf[j][ks], ai); } }
                float xv[7];
#pragma unroll
                for (int q = 0; q < 7; ++q) { const int R = rowt + 4 * fq + q; xv[q] = bf2f(*(const LAS bf16*)(Ab + R * 256 + (((2 * sl + (fr >> 3)) ^ (R & 15)) << 4) + 2 * (fr & 7))); }
#pragma unroll
                for (int r = 0; r < 4; ++r) { const int row = rowt + 4 * fq + r;
                    const float xc = cbv + ((cw4[0] * xv[r] + cw4[1] * xv[r + 1]) + (cw4[2] * xv[r + 2] + cw4[3] * xv[r + 3]));
                    const float rg = pg8::sigmoid_f(ar[r] + ba2), ig = pg8::sigmoid_f(ai[r] + bx2), la = -8.0f * rg * spl;
                    const float a = __expf(la), om = fmaxf(__builtin_fmaf(-a, a, 1.0f), 0.f);
                    const int o = fr * 289 + (row >> 3) * 9 + (row & 7);
                    LAt[o] = a; LUt[o] = __builtin_amdgcn_sqrtf(om) * ig * xc; }
            }
            if (FUSE_SCAN) {
#pragma unroll
                for (int c = 0; c < 2; ++c) { mu32x2 o; o.x = pg8::cvt_pk_bf16(S[0], S[1]); o.y = pg8::cvt_pk_bf16(S[2], S[3]); *(mu32x2*)((bf16*)(F.ws + WS_XB) + soff + c * 16384u) = o;
                    S = sdd[c] * S + pg8::bf16x4_to_f32(skv[c]); }
#pragma unroll
                for (int c = 0; c < 2; ++c) { skv[c] = *(const mu32x2*)((const bf16*)(F.ws + WS_KVT) + soff + (2 + c) * 16384u); sdd[c] = *(const mf32x4*)((const float*)(F.ws + WS_DEC) + sdo + (2 + c) * 128u); }
            }
            __syncthreads();
            if (mc < 7) {
#pragma unroll
                for (int i = 0; i < 9; ++i) { const int p = tid + 512 * i, row = p >> 4, cp = p & 15;
                    if (p < 259 * 16) GLDS16(xsrc + (size_t)((mc + 1) * 256 - 3 + row) * 1024 + 8 * (cp ^ (row & 15)), Ab + (w * 64 + 512 * i) * 16); }
                GLDS16(gbase + (size_t)((mc + 1) * 256 + grow) * 2048, (LAS unsigned char*)GG + ((mc + 1) & 1) * 8192 + w * 1024);
            }
            if (VAR != 3) {
                float aa[8], uu[8]; float Ap = 1.f, Hp = 0.f;
#pragma unroll
                for (int i = 0; i < 8; ++i) { aa[i] = LAt[d * 289 + seg * 9 + i]; uu[i] = LUt[d * 289 + seg * 9 + i]; Hp = aa[i] * Hp + uu[i]; Ap *= aa[i]; }
#pragma unroll
                for (int off = 1; off < 32; off <<= 1) { const float Aq = __shfl_up(Ap, off, 32), Hq = __shfl_up(Hp, off, 32); if (seg >= off) { Hp = Ap * Hq + Hp; Ap = Ap * Aq; } }
                float Ae = __shfl_up(Ap, 1, 32), He = __shfl_up(Hp, 1, 32); if (seg == 0) { Ae = 1.f; He = 0.f; }
                float hin = Ae * carry + He;
                carry = __shfl(Ap, 31, 32) * carry + __shfl(Hp, 31, 32);
                const LAS bf16* gp = GG + (mc & 1) * 4096 + (8 * seg) * 16 + d; LAS bf16* yq = YY + (mc & 1) * 4096 + (8 * seg) * 16 + d;
#pragma unroll
                for (int i = 0; i < 8; ++i) { hin = aa[i] * hin + uu[i]; yq[i * 16] = (bf16)bf1(hin * bf2f(gp[i * 16])); }
            }
            if (FUSE_SCAN) {
#pragma unroll
                for (int c = 0; c < 2; ++c) { mu32x2 o; o.x = pg8::cvt_pk_bf16(S[0], S[1]); o.y = pg8::cvt_pk_bf16(S[2], S[3]); *(mu32x2*)((bf16*)(F.ws + WS_XB) + soff + (2 + c) * 16384u) = o;
                    S = sdd[c] * S + pg8::bf16x4_to_f32(skv[c]); }
            }
            __syncthreads();
        }
        *(v4u*)(obase + (size_t)(7 * 256 + grow) * ostr) = *(const LAS v4u*)(YY + 4096 + grow * 16 + 8 * ghalf);
        __syncthreads();
    }
}
constexpr int N_PHASES = 12;
struct Args { const float* in[N_IN]; float* out; unsigned char* ws; int ph_lo, ph_hi, li, pad; };
__global__ void __launch_bounds__(NWAVES * 64, 2) mega_fwd(Args args) {
    extern __shared__ __attribute__((aligned(16))) unsigned char lds[];
    Frame F;
    F.lds = (LAS unsigned char*)lds;
    F.MISC = (volatile LAS unsigned*)(F.lds + MISC_OFF);
    F.wave = __builtin_amdgcn_readfirstlane((int)threadIdx.x >> 6);
    F.G = gridDim.x; { const int bx = blockIdx.x; F.vcu = (F.G % 8 == 0) ? (bx % 8) * (F.G / 8) + bx / 8 : bx; }
#pragma unroll
    for (int i = 0; i < N_IN; ++i) F.in[i] = args.in[i];
    F.out = args.out; F.ws = args.ws;
    unsigned char* ws = args.ws;
    F.ctl = (gu32*)(ws + WS_CTL);
    for (int u = F.wave * 64 + pg8::lane_id_asm(); u < (LDS_BYTES - LDSCTL_OFF) / 4; u += NWAVES * 64) ((LAS unsigned*)(F.lds + LDSCTL_OFF))[u] = 0u;
    __syncthreads();
    const int lo = args.ph_lo, hi = args.ph_hi;
    const bool multi = (hi - lo) > 1;
    XcdBarrier bar; bar.bar = (unsigned*)(F.ctl + CW_BAR) + args.li * XCD_BAR_WORDS; bar.x = 0; bar.st = nullptr; bar.wave = F.wave;
    if (multi) bar = xcd_barrier_post((unsigned*)(F.ctl + CW_BAR) + args.li * XCD_BAR_WORDS, F.MISC + 8, F.wave);

    bf16* const XB = (bf16*)(ws + WS_XB); bf16* const ACT = (bf16*)(ws + WS_ACT); bf16* const MIXA = (bf16*)(ws + WS_MIXA);
    float* const SSQA = (float*)(ws + WS_SSQA); float* const SSQB = (float*)(ws + WS_SSQB);


#define IN(k) (lo <= (k) && (k) < hi)
#ifdef PROBE_PHASE
#define SEAM(k) do { if (IN(k) && ((k) + 1 < N_PHASES ? IN((k) + 1) : true)) { xcd_barrier(bar); \
        if ((k) + 1 == PROBE_PHASE) { if (blockIdx.x == 0 && F.wave == 0 && pg8::lane_id_asm() == 0) __hip_atomic_store((unsigned long long*)(F.ctl + 30000), (unsigned long long)__builtin_amdgcn_s_memrealtime(), RLX_AGENT); } \
        if ((k) == PROBE_PHASE) { if (blockIdx.x == 0 && F.wave == 0 && pg8::lane_id_asm() == 0) { const unsigned long long t1 = __builtin_amdgcn_s_memrealtime(), t0 = __hip_atomic_load((unsigned long long*)(F.ctl + 30000), RLX_AGENT); \
                __hip_atomic_store((unsigned long long*)(F.ctl + 30064), t1 - t0, RLX_AGENT); } \
            xcd_barrier(bar); \
            { const unsigned long long dt = __hip_atomic_load((unsigned long long*)(F.ctl + 30064), RLX_AGENT), s0 = __builtin_amdgcn_s_memrealtime(); while (__builtin_amdgcn_s_memrealtime() - s0 < 4ull * dt) __builtin_amdgcn_s_sleep(32); } } } } while (0)
#else
#define SEAM(k) do { if (IN(k) && IN((k) + 1)) xcd_barrier(bar); } while (0)
#endif
#define GEMM_SWIGLU(WOFF) do { pg8::Gemm g{XB, (const bf16*)(ws + (WOFF)), M, NGU, D}; pg8::StaticOrder S; S.init(M, NGU, F.G, (int)blockIdx.x); \
        pg8::EpiSwiGLU E{ACT, DFF, SSQA}; pg8::gemm_phase<pg8::EpiSwiGLU, pg8::StaticOrder, true, true>(F.lds + RING_OFF, g, S, E, F.wave); } while (0)
#define GEMM_RESID(AP, WOFF, KK, SRC, SSQO) do { pg8::Gemm g{(AP), (const bf16*)(ws + (WOFF)), M, D, (KK)}; pg8::StaticOrder S; S.init(M, D, F.G, (int)blockIdx.x); \
        if ((M / 256) * (D / 256) <= F.G) { pg8::EpiResidInit E{(SRC), F.out, XB, (SSQO)}; pg8::gemm_phase<pg8::EpiResidInit, pg8::StaticOrder, true, true>(F.lds + RING_OFF, g, S, E, F.wave); } \
        else { pg8::EpiResid E{(SRC), F.out, XB, (SSQO), 1.0f}; pg8::gemm_phase<pg8::EpiResid, pg8::StaticOrder, true, true>(F.lds + RING_OFF, g, S, E, F.wave); } } while (0)

    if (IN(0)) { convert_jobs<J_X | J_P | J_GU1 | J_GU2 | J_PROJ | J_AX | J_PG>(F, (int)blockIdx.x, F.G); SEAM(0); }
    if (IN(1)) { GEMM_SWIGLU(WS_WGU1);
        { int rank, count; side_workers((M / 256) * (NGU / 256), F.G, (int)blockIdx.x, rank, count); if (rank >= 0) convert_jobs<J_D1 | J_WIN | J_WOUT>(F, rank, count); }
        SEAM(1); }
    if (IN(2)) { GEMM_RESID(ACT, WS_WD1, DFF, F.in[I_X], SSQB); SEAM(2); }
    if (IN(3)) {
        pg8::Gemm g{XB, (const bf16*)(ws + WS_WINT), M, NIN, D}; pg8::StaticOrder S; S.init(M, NIN, F.G, (int)blockIdx.x);
        pg8::EpiZ E{SSQB, F.in[I_HLB], MIXA, (float*)(ws + WS_LOGF), (bf16*)(ws + WS_V), (bf16*)(ws + WS_SG), (bf16*)(ws + WS_LRX)};
        pg8::gemm_phase<pg8::EpiZ, pg8::StaticOrder, true, true>(F.lds + RING_OFF, g, S, E, F.wave);
        SEAM(3); }
    if (IN(4)) { MIXER_PHASE_4 SEAM(4); }
    if (IN(5)) { MIXER_PHASE_5 SEAM(5); }
    if (IN(6)) { MIXER_PHASE_6 SEAM(6); }
    if (IN(7)) { GEMM_RESID(MIXA, WS_WOUT, D, F.out, SSQA); SEAM(7); }
    if (IN(8)) { GEMM_SWIGLU(WS_WGU2);
        { int rank, count; side_workers((M / 256) * (NGU / 256), F.G, (int)blockIdx.x, rank, count);
          if (rank >= 0) {
              pg8::Gemm g{(const bf16*)(ws + WS_PB), (const bf16*)(ws + WS_WPROJ), M, D, PLE}; pg8::StaticOrder S; S.init(M, D, count, rank);
              pg8::EpiPP E{(bf16*)(ws + WS_PP)};
              pg8::gemm_phase<pg8::EpiPP, pg8::StaticOrder, true, true>(F.lds + RING_OFF, g, S, E, F.wave);
              convert_jobs<J_D2>(F, rank, count); } }
        SEAM(8); }
    if (IN(9)) { GEMM_RESID(ACT, WS_WD2, DFF, F.out, SSQB); SEAM(9); }
    if (IN(10)) {
        { pg8::Gemm g{XB, (const bf16*)(ws + WS_WPG), M, D, D}; pg8::StaticOrder S; S.init(M, D, F.G, (int)blockIdx.x);
          if (F.G == (M / 256) * (D / 256)) {
              pg8::EpiPLEFinal E{SSQB, F.in[I_PBG], (const bf16*)(ws + WS_PP), F.out, (float*)(ws + WS_XCH), (unsigned*)(F.ctl + CW_PANEL), F.in[I_FN]};
              pg8::gemm_phase<pg8::EpiPLEFinal, pg8::StaticOrder, false, true>(F.lds + RING_OFF, g, S, E, F.wave);
          } else {
              pg8::EpiPLE E{SSQB, F.in[I_PBG], (const bf16*)(ws + WS_PP), F.out, SSQA};
              pg8::gemm_phase<pg8::EpiPLE, pg8::StaticOrder, true, true>(F.lds + RING_OFF, g, S, E, F.wave); } }
        SEAM(10); }
    if (IN(11)) { if (F.G != (M / 256) * (D / 256)) final_norm(F, SSQA); SEAM(11); }
#undef IN
#undef SEAM
}

#if SIMPLE_HGRN
__global__ void __launch_bounds__(64) k_simple_hgrn(const float* logf, const bf16* mixa, const bf16* vv, float* oh) {
    __shared__ float sf[128], sk[128], sq[128];
    const int bh = blockIdx.x >> 1, vh = blockIdx.x & 1, b = bh >> 3, h = bh & 7, lane = threadIdx.x, v = vh * 64 + lane;
    float S[128];
#pragma unroll
    for (int k = 0; k < 128; ++k) S[k] = 0.f;
    for (int t = 0; t < SEQ; ++t) {
        const size_t row = (size_t)b * SEQ + t;
        for (int kk = lane; kk < 128; kk += 64) { const float f = __expf(logf[row * 1024 + h * 128 + kk]); sf[kk] = f; sk[kk] = 1.f - f; sq[kk] = bf2f(mixa[row * 2048 + h * 128 + kk]); }
        __syncthreads();
        const float vt = bf2f(vv[row * 1024 + h * 128 + v]); float o = 0.f;
#pragma unroll
        for (int k = 0; k < 128; ++k) { S[k] = sf[k] * S[k] + sk[k] * vt; o += S[k] * sq[k]; }
        oh[row * 1024 + h * 128 + v] = o;
        __syncthreads();
    }
}
__global__ void __launch_bounds__(256) k_simple_hnorm(const float* oh, const bf16* sg, const float* gn, bf16* mixa) {
    const int gw = (blockIdx.x * 256 + threadIdx.x) >> 6, lane = threadIdx.x & 63;
    if (gw >= M * HEADS) return;
    const int row = gw >> 3, h = gw & 7;
    const float o0 = oh[(size_t)row * 1024 + h * 128 + lane], o1 = oh[(size_t)row * 1024 + h * 128 + 64 + lane];
    const float ss = wave_sum(o0 * o0 + o1 * o1);
    const float r = 1.0f / sqrtf(ss * (1.0f / 128.0f) + EPS);
    mixa[(size_t)row * 2048 + h * 128 + lane] = (bf16)f2bf(o0 * r * gn[lane] * bf2f(sg[(size_t)row * 1024 + h * 128 + lane]));
    mixa[(size_t)row * 2048 + h * 128 + 64 + lane] = (bf16)f2bf(o1 * r * gn[64 + lane] * bf2f(sg[(size_t)row * 1024 + h * 128 + 64 + lane]));
}
#endif
#if SIMPLE_LRU
__global__ void __launch_bounds__(256) k_simple_lru_a(const bf16* lrx, const float* cw, const float* cb, const float* wa, const float* ba, const float* wx, const float* bx, const float* lam, float* LA, float* LU) {
    __shared__ float xc[1024];
    const int row = blockIdx.x, tt = row % SEQ, tid = threadIdx.x;
    for (int c = tid; c < 1024; c += 256) { float s = cb[c];
        for (int j = 0; j < 4; ++j) { const int ts = tt - 3 + j; if (ts >= 0) s += cw[j * 1024 + c] * bf2f(lrx[(size_t)(row - 3 + j) * 1024 + c]); }
        xc[c] = s; }
    __syncthreads();
    for (int d = tid; d < 1024; d += 256) { const int n = d >> 7, dd = d & 127; float r = ba[d], g = bx[d];
        for (int c = 0; c < 128; ++c) { const float x = xc[n * 128 + c]; r += x * wa[((size_t)n * 128 + c) * 128 + dd]; g += x * wx[((size_t)n * 128 + c) * 128 + dd]; }
        r = 1.0f / (1.0f + __expf(-r)); g = 1.0f / (1.0f + __expf(-g));
        const float log_a = -8.0f * r * log1pf(__expf(-lam[d]));
        LA[(size_t)row * 1024 + d] = __expf(log_a); LU[(size_t)row * 1024 + d] = sqrtf(-expm1f(2.0f * log_a)) * g * xc[d]; }
}
__global__ void __launch_bounds__(256) k_simple_lru_b(const float* LA, const float* LU, bf16* mixa) {
    const int gi = blockIdx.x * 256 + threadIdx.x, b = gi >> 10, c = gi & 1023; float h = 0.f;
#pragma unroll 8
    for (int t = 0; t < SEQ; ++t) { const size_t row = (size_t)b * SEQ + t; h = LA[row * 1024 + c] * h + LU[row * 1024 + c];
        bf16* p = mixa + row * 2048 + 1024 + c; *p = (bf16)f2bf(h * bf2f(*p)); }
}
#endif

extern "C" void kernel_launch(void* const* d_in, const int* in_sizes, int n_in, void* d_out, int out_size, void* d_ws, size_t ws_size, hipStream_t stream) {
    static int grid = 0;
    if (grid == 0) {
        if (n_in != N_IN || in_sizes[0] != M * D || out_size != M * D || ws_size < WS_END) { fprintf(stderr, "kernel_launch: unexpected problem (n_in %d, in0 %d, out %d, ws %zu); nothing launched\n", n_in, n_in > 0 ? in_sizes[0] : -1, out_size, ws_size); grid = -1; return; }
        int dev = 0, cus = 0, per_cu = 0;
        if (hipGetDevice(&dev) != hipSuccess || hipDeviceGetAttribute(&cus, hipDeviceAttributeMultiprocessorCount, dev) != hipSuccess) { grid = -1; return; }
        if (hipFuncSetAttribute((const void*)mega_fwd, hipFuncAttributeMaxDynamicSharedMemorySize, LDS_BYTES) != hipSuccess) { fprintf(stderr, "kernel_launch: hipFuncSetAttribute failed\n"); grid = -1; return; }
        if (hipOccupancyMaxActiveBlocksPerMultiprocessor(&per_cu, (const void*)mega_fwd, NWAVES * 64, LDS_BYTES) != hipSuccess || per_cu < 1)
            fprintf(stderr, "kernel_launch: note: occupancy query reports %d workgroups per CU\n", per_cu);
        (void)hipGetLastError();
        grid = cus;
    }
    if (grid < 0) return;
    if (hipMemsetAsync((char*)d_ws + WS_CTL, 0, CTL_ZERO_BYTES, stream) != hipSuccess) return;
    Args a{};
    for (int i = 0; i < N_IN; ++i) a.in[i] = (const float*)d_in[i];
    a.out = (float*)d_out; a.ws = (unsigned char*)d_ws;
    unsigned char* ws = (unsigned char*)d_ws;
    auto launch = [&](int lo, int hi, int li) { a.ph_lo = lo; a.ph_hi = hi; a.li = li; hipLaunchKernelGGL(mega_fwd, dim3(grid), dim3(NWAVES * 64), LDS_BYTES, stream, a); };
#if SIMPLE_HGRN || SIMPLE_LRU
    launch(0, 4, 0);
#if SIMPLE_HGRN
    {   float* OH = (float*)(ws + WS_XB);
        hipLaunchKernelGGL(k_simple_hgrn, dim3(64), dim3(64), 0, stream, (const float*)(ws + WS_LOGF), (const bf16*)(ws + WS_MIXA), (const bf16*)(ws + WS_V), OH);
        hipLaunchKernelGGL(k_simple_hnorm, dim3(M * HEADS / 4), dim3(256), 0, stream, (const float*)OH, (const bf16*)(ws + WS_SG), (const float*)d_in[I_HGN], (bf16*)(ws + WS_MIXA)); }
#endif
#if SIMPLE_LRU
    {   float* LA = (float*)(ws + WS_KVT); float* LU = LA + (size_t)M * 1024;
        hipLaunchKernelGGL(k_simple_lru_a, dim3(M), dim3(256), 0, stream, (const bf16*)(ws + WS_LRX), (const float*)d_in[I_CW], (const float*)d_in[I_CB], (const float*)d_in[I_LWA], (const float*)d_in[I_LBA],
                           (const float*)d_in[I_LWX], (const float*)d_in[I_LBX], (const float*)d_in[I_LAM], LA, LU);
        hipLaunchKernelGGL(k_simple_lru_b, dim3(BATCH * 1024 / 256), dim3(256), 0, stream, (const float*)LA, (const float*)LU, (bf16*)(ws + WS_MIXA)); }
#endif
    launch(4, N_PHASES, 1);
#else
#if N_LAUNCHES == 1
    launch(0, N_PHASES, 0);
#else
    for (int ph = 0; ph < N_PHASES; ++ph) launch(ph, ph + 1, 0);
#endif
#endif
}
```

```cpp
#include <hip/hip_runtime.h>
#include <cstdio>
#include <cstdint>
#ifndef SIMPLE_HGRN
#define SIMPLE_HGRN 0
#endif
#ifndef SIMPLE_LRU
#define SIMPLE_LRU 0
#endif
#ifndef N_LAUNCHES
#define N_LAUNCHES 1
#endif
#if SIMPLE_HGRN
#define MIXER_PHASE_4
#define MIXER_PHASE_6
#define MIXER_SCAN
#else
#define MIXER_PHASE_4 hgrn_local_phase(F);
#ifdef PROBE_H3
#define MIXER_PHASE_6 hgrn_out_phase(F, true); xcd_barrier(bar); hgrn_out_phase(F);
#else
#define MIXER_PHASE_6 hgrn_out_phase(F);
#endif
#ifdef PROBE_SCAN
#define MIXER_SCAN hgrn_scan_phase(F); xcd_barrier(bar); hgrn_scan_phase(F);
#else
#define MIXER_SCAN hgrn_scan_phase(F);
#endif
#endif
#if SIMPLE_LRU
#define MIXER_LRU
#else
#ifdef PROBE_LRU
#define MIXER_LRU lru_phase<PROBE_LRU, false, true>(F); xcd_barrier(bar); lru_phase<0>(F);
#else
#define MIXER_LRU lru_phase<0>(F);
#endif
#endif
#if !SIMPLE_HGRN && !SIMPLE_LRU && !defined(PROBE_LRU) && !defined(PROBE_SCAN)
#define MIXER_PHASE_5 if (F.G * NWAVES * 64 == BATCH * HEADS * 128 * 32 && F.G == BATCH * 64) { lru_phase<0, true>(F); } else { hgrn_scan_phase(F); lru_phase<0, false>(F); }
#else
#define MIXER_PHASE_5 MIXER_SCAN MIXER_LRU
#endif
namespace pg8 {
#define PG8_LAS __attribute__((address_space(3)))
typedef unsigned short bf16_t;
typedef short bf16x8 __attribute__((ext_vector_type(8)));
typedef float f32x4 __attribute__((ext_vector_type(4)));
typedef unsigned u32x4 __attribute__((ext_vector_type(4)));
constexpr int BM = 256, BK = 64, HALF = 128, HTB = HALF * BK * 2  , STAGE_BYTES = 8 * HTB, NXCD = 8, WGM = 8;

__host__ __device__ __forceinline__ int lds_byte(int r, int c) { const int st = (r >> 4) * 2 + (c >> 5), rr = r & 15, cc = c & 31, ob = rr * 64 + cc * 2; return st * 1024 + (ob ^ (((ob >> 9) & 1) << 5)); }
__host__ __device__ __forceinline__ void stage_rc(int b, int& R, int& C) { const int st = b / 1024, sb = b % 1024, swz = sb ^ (((sb >> 9) & 1) << 5); R = (st >> 1) * 16 + swz / 64; C = (st & 1) * 32 + (swz % 64) / 2; }
__host__ __device__ __forceinline__ int perm32(int rho) { const int n = rho >> 4, i = rho & 15; return 8 * (i >> 2) + 4 * n + (i & 3); }

struct Unit { int pm, pn; };
struct Gemm { const bf16_t* A; const bf16_t* Bt; int M, N, K; };

struct StaticOrder {
    int nM, nN, nwg, G, c;
    __host__ __device__ void init(int M, int N, int G_, int c_) { nM = M / BM; nN = N / BM; nwg = nM * nN; G = G_; c = c_; }
    __host__ __device__ bool next(int i, Unit& u) const {
        const long L = (long)i * G + c; if (L >= nwg) return false;
        int wgid = (int)L; { const int q = nwg / NXCD, r = nwg % NXCD, xcd = wgid % NXCD, off = wgid / NXCD; wgid = (xcd < r ? xcd * (q + 1) : r * (q + 1) + (xcd - r) * q) + off; }
        const int nig = WGM * nN, gid = wgid / nig, fm = gid * WGM, gsz = (nM - fm) < WGM ? (nM - fm) : WGM;
        u.pm = fm + ((wgid % nig) % gsz); u.pn = (wgid % nig) / gsz; return true;
    }
    __device__ __forceinline__ void a_ready(const Unit&) const {}
    __device__ __forceinline__ void done(const Unit&) const {}
};
__device__ __forceinline__ int lane_id_asm() { int l; asm volatile("v_mbcnt_lo_u32_b32 %0, -1, 0\n\tv_mbcnt_hi_u32_b32 %0, -1, %0" : "=v"(l)); return l; }
__device__ __forceinline__ unsigned cvt_pk_bf16(float lo, float hi) { unsigned r; asm volatile("v_cvt_pk_bf16_f32 %0, %1, %2" : "=v"(r) : "v"(lo), "v"(hi)); return r; }
typedef unsigned u32x2 __attribute__((ext_vector_type(2)));
constexpr int DM = 2048;
constexpr int NSSQ = 32;
__device__ __forceinline__ float sigmoid_f(float x) { return __builtin_amdgcn_rcpf(1.0f + __expf(-x)); }
__device__ __forceinline__ float silu_f(float x) { return x * sigmoid_f(x); }
__device__ __forceinline__ float gelu_tanh_f(float x) { return x * sigmoid_f(1.5957691216057308f * (x + 0.044715f * x * x * x)); }
__device__ __forceinline__ void rows_rstd(const float* ssq, int row0, int fq, float (&rs)[2][4]) {
    f32x4 pa[2][4], pb[2][4];
#pragma unroll
    for (int ai = 0; ai < 2; ++ai)
#pragma unroll
        for (int m = 0; m < 4; ++m) { const f32x4* p = (const f32x4*)(ssq + (size_t)(row0 + ai * HALF + m * 16) * NSSQ + fq * 8); pa[ai][m] = p[0]; pb[ai][m] = p[1]; }
#pragma unroll
    for (int ai = 0; ai < 2; ++ai)
#pragma unroll
        for (int m = 0; m < 4; ++m) { const f32x4 a = pa[ai][m], b = pb[ai][m];
            float s = ((a[0] + a[1]) + (a[2] + a[3])) + ((b[0] + b[1]) + (b[2] + b[3]));
            s += __shfl_xor(s, 16); s += __shfl_xor(s, 32);
            rs[ai][m] = 1.0f / sqrtf(s * (1.0f / (float)DM) + 1e-6f); }
}

struct EpiSwiGLU {
    static constexpr bool PERM = true, AFTER_DRAIN = false, INIT_ACC = false;
    bf16_t* O; int ldo; const float* ssq;
    __device__ __forceinline__ void operator()(const f32x4 (&acc)[2][2][4][2], const Unit& u, int wr, int wc, int fr, int fq) const {
        const int row0 = u.pm * BM + wr * 64 + fr, col0 = u.pn * HALF + wc * 32 + 8 * fq;
        float rs[2][4]; rows_rstd(ssq, row0, fq, rs);
#pragma unroll
        for (int ai = 0; ai < 2; ++ai)
#pragma unroll
            for (int m = 0; m < 4; ++m) {
                const int row = row0 + ai * HALF + m * 16; const float r = rs[ai][m];
                float h[8];
#pragma unroll
                for (int n = 0; n < 2; ++n)
#pragma unroll
                    for (int j = 0; j < 4; ++j) { const float g = acc[ai][0][m][n][j] * r, up = acc[ai][1][m][n][j] * r; h[n * 4 + j] = silu_f(g) * up; }
                u32x4 w; w.x = cvt_pk_bf16(h[0], h[1]); w.y = cvt_pk_bf16(h[2], h[3]); w.z = cvt_pk_bf16(h[4], h[5]); w.w = cvt_pk_bf16(h[6], h[7]);
                *(u32x4*)(O + (size_t)row * ldo + col0) = w;
            }
    }
};
struct EpiResid {
    static constexpr bool PERM = false, AFTER_DRAIN = false, INIT_ACC = false;
    const float* src; float* dst; bf16_t* xb; float* ssq_out; float scale;
    __device__ __forceinline__ void operator()(const f32x4 (&acc)[2][2][4][2], const Unit& u, int wr, int wc, int fr, int fq) const {
        const int row0 = u.pm * BM + wr * 64 + fr, col0 = u.pn * BM + wc * 32 + 4 * fq;
#pragma unroll
        for (int ai = 0; ai < 2; ++ai) {
            f32x4 sv[4][2][2];
#pragma unroll
            for (int m = 0; m < 4; ++m)
#pragma unroll
                for (int bj = 0; bj < 2; ++bj)
#pragma unroll
                    for (int n = 0; n < 2; ++n) sv[m][bj][n] = *(const f32x4*)(src + (size_t)(row0 + ai * HALF + m * 16) * DM + col0 + bj * HALF + n * 16);
#pragma unroll
            for (int m = 0; m < 4; ++m) {
                const int row = row0 + ai * HALF + m * 16; float ss = 0.f;
#pragma unroll
                for (int bj = 0; bj < 2; ++bj)
#pragma unroll
                    for (int n = 0; n < 2; ++n) { const size_t off = (size_t)row * DM + col0 + bj * HALF + n * 16;
                        const f32x4 o = sv[m][bj][n] + acc[ai][bj][m][n] * scale;
                        *(f32x4*)(dst + off) = o; u32x2 w; w.x = cvt_pk_bf16(o[0], o[1]); w.y = cvt_pk_bf16(o[2], o[3]); *(u32x2*)(xb + off) = w;
                        ss += (o[0] * o[0] + o[1] * o[1]) + (o[2] * o[2] + o[3] * o[3]); }
                ss += __shfl_xor(ss, 16); ss += __shfl_xor(ss, 32);
                if (fq == 0) ssq_out[(size_t)row * NSSQ + u.pn * 4 + wc] = ss;
            }
        }
    }
};
struct EpiResidInit {
    static constexpr bool PERM = false, AFTER_DRAIN = false, INIT_ACC = true;
    const float* src; float* dst; bf16_t* xb; float* ssq_out;
    __device__ __forceinline__ void init_acc(f32x4 (&acc)[2][2][4][2], const Unit& u, int wr, int wc, int fr, int fq) const {
        const int row0 = u.pm * BM + wr * 64 + fr, col0 = u.pn * BM + wc * 32 + 4 * fq;
#pragma unroll
        for (int ai = 0; ai < 2; ++ai)
#pragma unroll
            for (int m = 0; m < 4; ++m)
#pragma unroll
                for (int bj = 0; bj < 2; ++bj)
#pragma unroll
                    for (int n = 0; n < 2; ++n) acc[ai][bj][m][n] = __builtin_nontemporal_load((const f32x4*)(src + (size_t)(row0 + ai * HALF + m * 16) * DM + col0 + bj * HALF + n * 16));
    }
    __device__ __forceinline__ void operator()(const f32x4 (&acc)[2][2][4][2], const Unit& u, int wr, int wc, int fr, int fq) const {
        const int row0 = u.pm * BM + wr * 64 + fr, col0 = u.pn * BM + wc * 32 + 4 * fq;
#pragma unroll
        for (int ai = 0; ai < 2; ++ai)
#pragma unroll
            for (int m = 0; m < 4; ++m) {
                const int row = row0 + ai * HALF + m * 16; float ss = 0.f;
#pragma unroll
                for (int bj = 0; bj < 2; ++bj)
#pragma unroll
                    for (int n = 0; n < 2; ++n) { const size_t off = (size_t)row * DM + col0 + bj * HALF + n * 16;
                        const f32x4 o = acc[ai][bj][m][n];
                        *(f32x4*)(dst + off) = o; u32x2 w; w.x = cvt_pk_bf16(o[0], o[1]); w.y = cvt_pk_bf16(o[2], o[3]); *(u32x2*)(xb + off) = w;
                        ss += (o[0] * o[0] + o[1] * o[1]) + (o[2] * o[2] + o[3] * o[3]); }
                ss += __shfl_xor(ss, 16); ss += __shfl_xor(ss, 32);
                if (fq == 0) ssq_out[(size_t)row * NSSQ + u.pn * 4 + wc] = ss;
            }
    }
};
struct EpiZ {
    static constexpr bool PERM = true, AFTER_DRAIN = false, INIT_ACC = false;
    const float* ssq; const float* hlb;
    bf16_t* mixa;
    float* logf; bf16_t* vv; bf16_t* sg; bf16_t* lrx;
    __device__ __forceinline__ void operator()(const f32x4 (&acc)[2][2][4][2], const Unit& u, int wr, int wc, int fr, int fq) const {
        const int seg = u.pn >> 2;
        const int row0 = u.pm * BM + wr * 64 + fr, cs0 = (u.pn & 3) * BM + wc * 32 + 8 * fq;
        float rs[2][4]; rows_rstd(ssq, row0, fq, rs);
        float lbv[2][8];
        if (seg == 1) {
#pragma unroll
            for (int bj = 0; bj < 2; ++bj)
#pragma unroll
                for (int e = 0; e < 8; ++e) { const int c = cs0 + bj * HALF + e; lbv[bj][e] = sigmoid_f(hlb[c] - hlb[1024 + c]); }
        }
#pragma unroll
        for (int ai = 0; ai < 2; ++ai)
#pragma unroll
            for (int m = 0; m < 4; ++m) {
                const int row = row0 + ai * HALF + m * 16; const float r = rs[ai][m];
#pragma unroll
                for (int bj = 0; bj < 2; ++bj) {
                    const int cs = cs0 + bj * HALF;
                    float z[8];
#pragma unroll
                    for (int n = 0; n < 2; ++n)
#pragma unroll
                        for (int j = 0; j < 4; ++j) z[n * 4 + j] = acc[ai][bj][m][n][j] * r;
                    if (seg == 1) {
                        float lf[8];
#pragma unroll
                        for (int e = 0; e < 8; ++e) { const float lb = lbv[bj][e]; lf[e] = __logf(lb + (1.0f - lb) * sigmoid_f(z[e])); }
                        float* p = logf + (size_t)row * 1024 + cs;
                        *(f32x4*)p = (f32x4){lf[0], lf[1], lf[2], lf[3]}; *(f32x4*)(p + 4) = (f32x4){lf[4], lf[5], lf[6], lf[7]};
                    } else {
                        if (seg == 3) {
#pragma unroll
                            for (int e = 0; e < 8; ++e) z[e] = silu_f(z[e]);
                        } else if (seg == 5) {
#pragma unroll
                            for (int e = 0; e < 8; ++e) z[e] = gelu_tanh_f(z[e]);
                        }
                        u32x4 w; w.x = cvt_pk_bf16(z[0], z[1]); w.y = cvt_pk_bf16(z[2], z[3]); w.z = cvt_pk_bf16(z[4], z[5]); w.w = cvt_pk_bf16(z[6], z[7]);
                        bf16_t* p;
                        if (seg == 0) p = mixa + (size_t)row * 2048 + cs;
                        else if (seg == 5) p = mixa + (size_t)row * 2048 + 1024 + cs;
                        else if (seg == 2) p = vv + (size_t)row * 1024 + cs;
                        else if (seg == 3) p = sg + (size_t)row * 1024 + cs;
                        else p = lrx + (size_t)row * 1024 + cs;
                        *(u32x4*)p = w;
                    }
                }
            }
    }
};
struct EpiPP {
    static constexpr bool PERM = false, AFTER_DRAIN = false, INIT_ACC = false;
    bf16_t* PP;
    __device__ __forceinline__ void operator()(const f32x4 (&acc)[2][2][4][2], const Unit& u, int wr, int wc, int fr, int fq) const {
        const int row0 = u.pm * BM + wr * 64 + fr, col0 = u.pn * BM + wc * 32 + 4 * fq;
#pragma unroll
        for (int ai = 0; ai < 2; ++ai)
#pragma unroll
            for (int m = 0; m < 4; ++m) { bf16_t* rowp = PP + (size_t)(row0 + ai * HALF + m * 16) * DM + col0;
#pragma unroll
                for (int bj = 0; bj < 2; ++bj)
#pragma unroll
                    for (int n = 0; n < 2; ++n) { const f32x4 a = acc[ai][bj][m][n]; u32x2 w; w.x = cvt_pk_bf16(a[0], a[1]); w.y = cvt_pk_bf16(a[2], a[3]); *(u32x2*)(rowp + bj * HALF + n * 16) = w; } }
    }
};
__device__ __forceinline__ f32x4 bf16x4_to_f32(u32x2 w) { f32x4 r; r[0] = __builtin_bit_cast(float, w.x << 16); r[1] = __builtin_bit_cast(float, w.x & 0xffff0000u); r[2] = __builtin_bit_cast(float, w.y << 16); r[3] = __builtin_bit_cast(float, w.y & 0xffff0000u); return r; }
struct EpiPLE {
    static constexpr bool PERM = false, AFTER_DRAIN = false, INIT_ACC = false;
    const float* ssq_in; const float* bg; const bf16_t* PP; float* X; float* ssq_out;
    __device__ __forceinline__ void operator()(const f32x4 (&acc)[2][2][4][2], const Unit& u, int wr, int wc, int fr, int fq) const {
        const int row0 = u.pm * BM + wr * 64 + fr, col0 = u.pn * BM + wc * 32 + 4 * fq;
        float rs[2][4]; rows_rstd(ssq_in, row0, fq, rs);
#pragma unroll
        for (int ai = 0; ai < 2; ++ai)
#pragma unroll
            for (int m = 0; m < 4; ++m) {
                const int row = row0 + ai * HALF + m * 16; const float r = rs[ai][m]; float ss = 0.f;
                f32x4 pv[2][2], ov[2][2];
#pragma unroll
                for (int bj = 0; bj < 2; ++bj)
#pragma unroll
                    for (int n = 0; n < 2; ++n) { const size_t off = (size_t)row * DM + col0 + bj * HALF + n * 16; pv[bj][n] = bf16x4_to_f32(*(const u32x2*)(PP + off)); ov[bj][n] = *(const f32x4*)(X + off); }
#pragma unroll
                for (int bj = 0; bj < 2; ++bj)
#pragma unroll
                    for (int n = 0; n < 2; ++n) { const int c = col0 + bj * HALF + n * 16; const size_t off = (size_t)row * DM + c;
                        const f32x4 b4 = *(const f32x4*)(bg + c), a = acc[ai][bj][m][n]; f32x4 o;
#pragma unroll
                        for (int j = 0; j < 4; ++j) o[j] = ov[bj][n][j] + sigmoid_f(a[j] * r + b4[j]) * pv[bj][n][j];
                        *(f32x4*)(X + off) = o; ss += (o[0] * o[0] + o[1] * o[1]) + (o[2] * o[2] + o[3] * o[3]); }
                ss += __shfl_xor(ss, 16); ss += __shfl_xor(ss, 32);
                if (fq == 0) ssq_out[(size_t)row * NSSQ + u.pn * 4 + wc] = ss;
            }
    }
};

struct EpiPLEFinal {
    static constexpr bool PERM = false, AFTER_DRAIN = true, INIT_ACC = false;
    const float* ssq_in; const float* bg; const bf16_t* PP; float* X; float* xch; unsigned* cnt; const float* gf;
    __device__ __forceinline__ void operator()(const f32x4 (&)[2][2][4][2], const Unit&, int, int, int, int) const {}
    __device__ __forceinline__ void fused(f32x4 (&acc)[2][2][4][2], const Unit& u, int wr, int wc, int fr, int fq, PG8_LAS unsigned char* lds, int wid, int lane) const {
        const int row0 = u.pm * BM + wr * 64 + fr, col0 = u.pn * BM + wc * 32 + 4 * fq;
        float rs[2][4]; rows_rstd(ssq_in, row0, fq, rs);
        f32x4 b4[2][2];
#pragma unroll
        for (int bj = 0; bj < 2; ++bj)
#pragma unroll
            for (int n = 0; n < 2; ++n) b4[bj][n] = *(const f32x4*)(bg + col0 + bj * HALF + n * 16);
#pragma unroll
        for (int ai = 0; ai < 2; ++ai)
#pragma unroll
          for (int mp = 0; mp < 2; ++mp) {
            u32x2 pv[2][2][2]; f32x4 ov[2][2][2];
#pragma unroll
            for (int mm = 0; mm < 2; ++mm)
#pragma unroll
                for (int bj = 0; bj < 2; ++bj)
#pragma unroll
                    for (int n = 0; n < 2; ++n) { const size_t off = (size_t)(row0 + ai * HALF + (2 * mp + mm) * 16) * DM + col0 + bj * HALF + n * 16; pv[mm][bj][n] = *(const u32x2*)(PP + off); ov[mm][bj][n] = *(const f32x4*)(X + off); }
#pragma unroll
            for (int mm = 0; mm < 2; ++mm) {
                const int m = 2 * mp + mm, row = row0 + ai * HALF + m * 16; const float r = rs[ai][m]; float ss = 0.f;
#pragma unroll
                for (int bj = 0; bj < 2; ++bj)
#pragma unroll
                    for (int n = 0; n < 2; ++n) { const f32x4 a = acc[ai][bj][m][n], pp = bf16x4_to_f32(pv[mm][bj][n]); f32x4 o;
#pragma unroll
                        for (int j = 0; j < 4; ++j) o[j] = ov[mm][bj][n][j] + sigmoid_f(a[j] * r + b4[bj][n][j]) * pp[j];
                        acc[ai][bj][m][n] = o; ss += (o[0] * o[0] + o[1] * o[1]) + (o[2] * o[2] + o[3] * o[3]); }
                ss += __shfl_xor(ss, 16); ss += __shfl_xor(ss, 32);
                if (fq == 0) __hip_atomic_store(xch + (size_t)row * NSSQ + u.pn * 4 + wc, ss, __ATOMIC_RELAXED, __HIP_MEMORY_SCOPE_AGENT);
            }
          }
        asm volatile("s_waitcnt vmcnt(0)" ::: "memory");
        unsigned* pc = cnt + 64 * u.pm;
        if (lane == 0) __hip_atomic_fetch_add(pc, 1u, __ATOMIC_RELAXED, __HIP_MEMORY_SCOPE_AGENT);
        if (wid == 0) {
            unsigned sp = 0;
            while ((unsigned)__builtin_amdgcn_readfirstlane(__hip_atomic_load(pc, __ATOMIC_RELAXED, __HIP_MEMORY_SCOPE_AGENT)) < 64u) { __builtin_amdgcn_s_sleep(2); if (++sp > (1u << 22)) break; }
            __builtin_amdgcn_fence(__ATOMIC_ACQUIRE, "agent");
        }
        asm volatile("s_waitcnt vmcnt(0) lgkmcnt(0)" ::: "memory"); __builtin_amdgcn_s_barrier(); asm volatile("" ::: "memory");
        float r4[2][4]; rows_rstd(xch, row0, fq, r4);
        f32x4 g4[2][2];
#pragma unroll
        for (int bj = 0; bj < 2; ++bj)
#pragma unroll
            for (int n = 0; n < 2; ++n) g4[bj][n] = *(const f32x4*)(gf + col0 + bj * HALF + n * 16);
#pragma unroll
        for (int ai = 0; ai < 2; ++ai)
#pragma unroll
            for (int m = 0; m < 4; ++m) { float* rowp = X + (size_t)(row0 + ai * HALF + m * 16) * DM + col0; const float r = r4[ai][m];
#pragma unroll
                for (int bj = 0; bj < 2; ++bj)
#pragma unroll
                    for (int n = 0; n < 2; ++n) *(f32x4*)(rowp + bj * HALF + n * 16) = acc[ai][bj][m][n] * r * g4[bj][n]; }
    }
};

template <class Epi, class Sched, bool ALIGN_EPI = false, bool SP2 = false, bool BAL = false>
__device__ __forceinline__ void gemm_phase(PG8_LAS unsigned char* lds, const Gemm g, const Sched& S, const Epi& E, const int wave_s) {
    int tid_ = wave_s * 64 + lane_id_asm();
    const int tid = tid_, wid = wave_s, lane = tid & 63, wr = wid >> 2, wc = wid & 3, fr = lane & 15, fq = lane >> 4;
    const int K = g.K, nt = K / BK;
    unsigned voffA[2], voffB[2];
#pragma unroll
    for (int i = 0; i < 2; ++i) { int R, C; stage_rc(tid * 16 + i * 8192, R, C); const int Rb = Epi::PERM ? ((R & ~31) + perm32(R & 31)) : R;
        voffA[i] = (unsigned)(R * K + C) * 2u; voffB[i] = (unsigned)(Rb * K + C) * 2u; }
    const size_t kstep = (size_t)(BK * 2);
    const size_t hstep = (size_t)HALF * K * 2;
    const size_t tstep = 2 * hstep;
    const unsigned ldsw = (unsigned)wid * 1024u;
    const int aoff = lds_byte(wr * 64 + fr, fq * 8), boff = lds_byte(wc * 32 + fr, fq * 8);
#define PG8_SA(b, h) (((b) * 2 + (h)) * HTB)
#define PG8_SB(b, h) ((4 + (b) * 2 + (h)) * HTB)
#define PG8_STAGE(bufoff, gbase, voff) do { _Pragma("unroll") for (int _i = 0; _i < 2; ++_i) \
        __builtin_amdgcn_global_load_lds((const unsigned*)((const char*)(gbase) + (voff)[_i]), (PG8_LAS unsigned*)(lds + (bufoff) + ldsw + _i * 8192), 16, 0, 0); } while (0)
#define PG8_LDA(dst, b, h) do { _Pragma("unroll") for (int m = 0; m < 4; ++m) _Pragma("unroll") for (int k = 0; k < 2; ++k) dst[m][k] = *(const PG8_LAS bf16x8*)(lds + PG8_SA(b, h) + aoff + m * 2048 + k * 1024); } while (0)
#define PG8_LDB(dst, b, h) do { _Pragma("unroll") for (int n = 0; n < 2; ++n) _Pragma("unroll") for (int k = 0; k < 2; ++k) dst[n][k] = *(const PG8_LAS bf16x8*)(lds + PG8_SB(b, h) + boff + n * 2048 + k * 1024); } while (0)
#define PG8_MMA(ai, bj, At, Bt) do { __builtin_amdgcn_s_setprio(1); _Pragma("unroll") for (int m = 0; m < 4; ++m) _Pragma("unroll") for (int n = 0; n < 2; ++n) _Pragma("unroll") for (int k = 0; k < 2; ++k) \
        acc[ai][bj][m][n] = __builtin_amdgcn_mfma_f32_16x16x32_bf16(Bt[n][k], At[m][k], acc[ai][bj][m][n], 0, 0, 0); __builtin_amdgcn_s_setprio(0); } while (0)
#define PG8_WAIT_V(n) asm volatile("s_waitcnt vmcnt(" #n ")" ::: "memory")
#define PG8_WAIT_L(n) asm volatile("s_waitcnt lgkmcnt(" #n ")" ::: "memory")
#define PG8_BAR __builtin_amdgcn_s_barrier()
#define PG8_SCHED __builtin_amdgcn_sched_barrier(0)
    Unit cur, nxt; int ui = 0;
    if (!S.next(0, cur)) return;
    f32x4 acc[2][2][4][2];
    if constexpr (Epi::INIT_ACC) { E.init_acc(acc, cur, wr, wc, fr, fq); }
    else {
#pragma unroll
    for (int a = 0; a < 2; ++a)
#pragma unroll
        for (int b = 0; b < 2; ++b)
#pragma unroll
            for (int m = 0; m < 4; ++m)
#pragma unroll
                for (int n = 0; n < 2; ++n) acc[a][b][m][n] = (f32x4){0.f, 0.f, 0.f, 0.f};
    }
    bf16x8 At[4][2], B0[2][2], B1[2][2];
    const char* cA = (const char*)g.A + (size_t)cur.pm * tstep; const char* cB = (const char*)g.Bt + (size_t)cur.pn * tstep;
    S.a_ready(cur);
    if constexpr (SP2) {
        PG8_STAGE(PG8_SB(0, 0), cB, voffB); PG8_STAGE(PG8_SB(0, 1), cB + hstep, voffB); PG8_STAGE(PG8_SA(0, 0), cA, voffA); PG8_STAGE(PG8_SA(0, 1), cA + hstep, voffA);
        if (wr == 1) PG8_BAR;
        PG8_WAIT_V(2); PG8_BAR;
        if constexpr (BAL) {
            PG8_STAGE(PG8_SB(1, 0), cB + kstep, voffB); PG8_STAGE(PG8_SB(1, 1), cB + hstep + kstep, voffB);
            PG8_WAIT_V(4); PG8_BAR;
        } else {
        PG8_STAGE(PG8_SB(1, 0), cB + kstep, voffB); PG8_STAGE(PG8_SA(1, 0), cA + kstep, voffA); PG8_STAGE(PG8_SB(1, 1), cB + hstep + kstep, voffB);
        PG8_WAIT_V(6); PG8_BAR;
        }
    } else {
        PG8_STAGE(PG8_SB(0, 0), cB, voffB); PG8_STAGE(PG8_SA(0, 0), cA, voffA); PG8_STAGE(PG8_SB(0, 1), cB + hstep, voffB); PG8_STAGE(PG8_SA(0, 1), cA + hstep, voffA);
        if (wr == 1) PG8_BAR;
        PG8_WAIT_V(4); PG8_BAR;
        PG8_STAGE(PG8_SB(1, 0), cB + kstep, voffB); PG8_STAGE(PG8_SA(1, 0), cA + kstep, voffA); PG8_STAGE(PG8_SB(1, 1), cB + hstep + kstep, voffB);
        PG8_WAIT_V(6); PG8_BAR;
    }
    for (;;) {
        const bool has_next = S.next(ui + 1, nxt);
        const char* nA = has_next ? (const char*)g.A + (size_t)nxt.pm * tstep : cA; const char* nB = has_next ? (const char*)g.Bt + (size_t)nxt.pn * tstep : cB;
        for (int t = 0; t < nt; t += 2) {
            const bool last = (t == nt - 2);
            const char* a1 = cA + (size_t)(t + 1) * kstep;
            const char* a2 = last ? nA : cA + (size_t)(t + 2) * kstep; const char* b2 = last ? nB : cB + (size_t)(t + 2) * kstep;
            const char* a3 = a2 + kstep; const char* b3 = b2 + kstep;
            if (last && has_next) S.a_ready(nxt);
            if constexpr (SP2 && BAL) {
            PG8_LDB(B0, 0, 0); PG8_LDB(B1, 0, 1); PG8_SCHED; PG8_LDA(At, 0, 0); PG8_STAGE(PG8_SA(1, 0), a1, voffA); PG8_STAGE(PG8_SA(1, 1), a1 + hstep, voffA);
            PG8_WAIT_V(4); PG8_WAIT_L(0); PG8_BAR; PG8_MMA(0, 0, At, B0); PG8_MMA(0, 1, At, B1); PG8_BAR; PG8_SCHED;
            PG8_LDA(At, 0, 1); PG8_STAGE(PG8_SB(0, 0), b2, voffB); PG8_STAGE(PG8_SB(0, 1), b2 + hstep, voffB);
            PG8_WAIT_V(4); PG8_WAIT_L(0); PG8_BAR; PG8_MMA(1, 0, At, B0); PG8_MMA(1, 1, At, B1); PG8_BAR; PG8_SCHED;
            PG8_LDB(B0, 1, 0); PG8_LDB(B1, 1, 1); PG8_SCHED; PG8_LDA(At, 1, 0); PG8_STAGE(PG8_SA(0, 0), a2, voffA); PG8_STAGE(PG8_SA(0, 1), a2 + hstep, voffA);
            PG8_WAIT_V(4); PG8_WAIT_L(0); PG8_BAR; PG8_MMA(0, 0, At, B0); PG8_MMA(0, 1, At, B1); PG8_BAR; PG8_SCHED;
            PG8_LDA(At, 1, 1); PG8_STAGE(PG8_SB(1, 0), b3, voffB); PG8_STAGE(PG8_SB(1, 1), b3 + hstep, voffB);
            PG8_WAIT_V(4); PG8_WAIT_L(0); PG8_BAR; PG8_MMA(1, 0, At, B0); PG8_MMA(1, 1, At, B1); PG8_BAR; PG8_SCHED;
            } else if constexpr (SP2) {
            PG8_LDB(B0, 0, 0); PG8_LDB(B1, 0, 1); PG8_SCHED; PG8_LDA(At, 0, 0); PG8_STAGE(PG8_SA(1, 1), a1 + hstep, voffA);
            PG8_WAIT_V(8); PG8_WAIT_L(0); PG8_BAR; PG8_MMA(0, 0, At, B0); PG8_MMA(0, 1, At, B1); PG8_BAR; PG8_SCHED;
            PG8_LDA(At, 0, 1); PG8_STAGE(PG8_SB(0, 0), b2, voffB); PG8_STAGE(PG8_SB(0, 1), b2 + hstep, voffB); PG8_STAGE(PG8_SA(0, 0), a2, voffA);
            PG8_WAIT_V(8); PG8_WAIT_L(0); PG8_BAR; PG8_MMA(1, 0, At, B0); PG8_MMA(1, 1, At, B1); PG8_BAR; PG8_SCHED;
            PG8_LDB(B0, 1, 0); PG8_LDB(B1, 1, 1); PG8_SCHED; PG8_LDA(At, 1, 0); PG8_STAGE(PG8_SA(0, 1), a2 + hstep, voffA);
            PG8_WAIT_V(8); PG8_WAIT_L(0); PG8_BAR; PG8_MMA(0, 0, At, B0); PG8_MMA(0, 1, At, B1); PG8_BAR; PG8_SCHED;
            PG8_LDA(At, 1, 1); PG8_STAGE(PG8_SB(1, 0), b3, voffB); PG8_STAGE(PG8_SB(1, 1), b3 + hstep, voffB); PG8_STAGE(PG8_SA(1, 0), a3, voffA);
            PG8_WAIT_V(8); PG8_WAIT_L(0); PG8_BAR; PG8_MMA(1, 0, At, B0); PG8_MMA(1, 1, At, B1); PG8_BAR; PG8_SCHED;
            } else {
            PG8_LDB(B0, 0, 0); PG8_SCHED; PG8_LDA(At, 0, 0); PG8_STAGE(PG8_SA(1, 1), a1 + hstep, voffA);
            PG8_WAIT_L(8); PG8_BAR; PG8_WAIT_L(0); PG8_MMA(0, 0, At, B0); PG8_BAR; PG8_SCHED;
            PG8_LDB(B1, 0, 1); PG8_STAGE(PG8_SB(0, 0), b2, voffB);
            PG8_BAR; PG8_WAIT_L(0); PG8_MMA(0, 1, At, B1); PG8_BAR;
            PG8_LDA(At, 0, 1); PG8_STAGE(PG8_SA(0, 0), a2, voffA);
            PG8_BAR; PG8_WAIT_L(0); PG8_MMA(1, 0, At, B0); PG8_BAR; PG8_SCHED;
            PG8_STAGE(PG8_SB(0, 1), b2 + hstep, voffB);
            PG8_WAIT_V(6); PG8_BAR; PG8_MMA(1, 1, At, B1); PG8_BAR;
            PG8_LDB(B0, 1, 0); PG8_SCHED; PG8_LDA(At, 1, 0); PG8_STAGE(PG8_SA(0, 1), a2 + hstep, voffA);
            PG8_WAIT_L(8); PG8_BAR; PG8_WAIT_L(0); PG8_MMA(0, 0, At, B0); PG8_BAR; PG8_SCHED;
            PG8_LDB(B1, 1, 1); PG8_STAGE(PG8_SB(1, 0), b3, voffB);
            PG8_BAR; PG8_WAIT_L(0); PG8_MMA(0, 1, At, B1); PG8_BAR;
            PG8_LDA(At, 1, 1); PG8_STAGE(PG8_SA(1, 0), a3, voffA);
            PG8_BAR; PG8_WAIT_L(0); PG8_MMA(1, 0, At, B0); PG8_BAR; PG8_SCHED;
            PG8_STAGE(PG8_SB(1, 1), b3 + hstep, voffB);
            PG8_WAIT_V(6); PG8_BAR; PG8_MMA(1, 1, At, B1); PG8_BAR;
            }
        }
        if constexpr (ALIGN_EPI) { if (wr == 0) PG8_BAR; }
        if constexpr (!Epi::AFTER_DRAIN) { E(acc, cur, wr, wc, fr, fq); S.done(cur); }
        if (!has_next) break;
#pragma unroll
        for (int a = 0; a < 2; ++a)
#pragma unroll
            for (int b = 0; b < 2; ++b)
#pragma unroll
                for (int m = 0; m < 4; ++m)
#pragma unroll
                    for (int n = 0; n < 2; ++n) acc[a][b][m][n] = (f32x4){0.f, 0.f, 0.f, 0.f};
        cur = nxt; cA = nA; cB = nB; ++ui;
        if constexpr (ALIGN_EPI) { if (wr == 1) PG8_BAR; }
    }
    PG8_WAIT_V(0);
    if constexpr (!ALIGN_EPI) { if (wr == 0) PG8_BAR; }
    PG8_BAR;
    if constexpr (Epi::AFTER_DRAIN) { E.fused(acc, cur, wr, wc, fr, fq, lds, wid, lane); S.done(cur); }
#undef PG8_SA
#undef PG8_SB
#undef PG8_STAGE
#undef PG8_LDA
#undef PG8_LDB
#undef PG8_MMA
#undef PG8_WAIT_V
#undef PG8_WAIT_L
#undef PG8_BAR
#undef PG8_SCHED
}
}
#define GAS __attribute__((address_space(1)))
#define LAS __attribute__((address_space(3)))
typedef unsigned short bf16;
typedef unsigned v4u __attribute__((ext_vector_type(4)));
typedef float f32x4 __attribute__((ext_vector_type(4)));
typedef short bf16x8 __attribute__((ext_vector_type(8)));
typedef GAS unsigned gu32;
typedef GAS unsigned long long gu64;
#define RLX_AGENT __ATOMIC_RELAXED, __HIP_MEMORY_SCOPE_AGENT
#define LDS_WAIT() asm volatile("s_waitcnt lgkmcnt(0)" ::: "memory")
#define VM_WAIT() asm volatile("s_waitcnt vmcnt(0)" ::: "memory")
__device__ __forceinline__ unsigned long long rt() { return __builtin_amdgcn_s_memrealtime(); }
__device__ __forceinline__ unsigned f2bf(float f) { unsigned u = __builtin_bit_cast(unsigned, f); return (u + 0x7fffu + ((u >> 16) & 1u)) >> 16; }
__device__ __forceinline__ unsigned pk2(float lo, float hi) { return f2bf(lo) | (f2bf(hi) << 16); }

#define XB_TMO      128
#define XB_XCNT(j)  (256  + 64 * (j))
#define XB_XSUB(j)  (1280 + 64 * (j))
#define XB_XGEN(j)  (2304 + 64 * (j))
#define XB_TOP      3328
#define XB_TOPGEN   3392
#define XCD_BAR_WORDS 3456
#define XB_SPIN_CAP (1u << 18)

__device__ __forceinline__ unsigned xb_ld(unsigned* p)              { return __hip_atomic_load(p, __ATOMIC_RELAXED, __HIP_MEMORY_SCOPE_AGENT); }
__device__ __forceinline__ unsigned xb_add(unsigned* p, unsigned v) { return __hip_atomic_fetch_add(p, v, __ATOMIC_RELAXED, __HIP_MEMORY_SCOPE_AGENT); }
__device__ __forceinline__ unsigned xb_xcc_id() { return (unsigned)__builtin_amdgcn_s_getreg((3 << 11) | 20) & 0xFu; }
#define XB_SPIN(cond, bar) do { unsigned _sp = 0; while (cond) { __builtin_amdgcn_s_sleep(1); \
    if ((++_sp & 255u) == 0u) { if (xb_ld(&(bar)[XB_TMO])) break; if (_sp > XB_SPIN_CAP) { atomicAdd(&(bar)[XB_TMO], 1u); break; } } } } while (0)

struct XcdBarrier {
    unsigned* bar; unsigned x; int wave;
    volatile LAS unsigned* st;
};

__device__ __forceinline__ XcdBarrier xcd_barrier_post(unsigned* bar, volatile LAS unsigned* st, int wave) {
    XcdBarrier b; b.bar = bar; b.x = xb_xcc_id(); b.st = st; b.wave = wave;
    if (wave == 0 && pg8::lane_id_asm() == 0) (void)xb_add(&bar[XB_XCNT(b.x)], 1u);
    return b;
}
__device__ __forceinline__ void xcd_barrier_complete(unsigned* bar, unsigned x, unsigned& nloc, unsigned& nx) {
    const unsigned G = gridDim.x * gridDim.y * gridDim.z;
    unsigned sum, cnt, mine, sp = 0u;
    for (;;) {
        sum = 0u; cnt = 0u; mine = 0u;
#pragma unroll
        for (unsigned j = 0; j < 16; ++j) { const unsigned c = xb_ld(&bar[XB_XCNT(j)]); sum += c; cnt += (c > 0u) ? 1u : 0u; mine = (j == x) ? c : mine; }
        if (sum == G) break;
        __builtin_amdgcn_s_sleep(1);
        if ((++sp & 255u) == 0u) { if (xb_ld(&bar[XB_TMO])) break; if (sp > XB_SPIN_CAP) { atomicAdd(&bar[XB_TMO], 1u); break; } }
    }
    nloc = mine > 0u ? mine : 1u; nx = cnt > 0u ? cnt : 1u;
}

__device__ __forceinline__ void xcd_barrier(const XcdBarrier& b) {
    asm volatile("s_waitcnt vmcnt(0)" ::: "memory");
    __syncthreads();
    if (b.wave == 0 && pg8::lane_id_asm() == 0) {
        unsigned* bar = b.bar;
        __builtin_amdgcn_s_waitcnt(0);
        unsigned nloc = b.st[0], nx = b.st[1];
        if (nloc == 0u) { xcd_barrier_complete(bar, b.x, nloc, nx); b.st[0] = nloc; b.st[1] = nx; }
        const unsigned old = xb_add(&bar[XB_XSUB(b.x)], 1u);
        const unsigned gen = old / nloc;
        if (old + 1u == (gen + 1u) * nloc) {
            __builtin_amdgcn_fence(__ATOMIC_RELEASE, "agent");
            asm volatile("s_waitcnt vmcnt(0)" ::: "memory");
            const unsigned og = xb_add(&bar[XB_TOP], 1u);
            const unsigned tg = og / nx;
            if (og + 1u == (tg + 1u) * nx) xb_add(&bar[XB_TOPGEN], 1u);
            else XB_SPIN(xb_ld(&bar[XB_TOPGEN]) == tg, bar);
            __builtin_amdgcn_fence(__ATOMIC_ACQUIRE, "agent");
            xb_add(&bar[XB_XGEN(b.x)], 1u);
            asm volatile("s_waitcnt vmcnt(0)" ::: "memory");
        } else {
            XB_SPIN(xb_ld(&bar[XB_XGEN(b.x)]) == gen, bar);
            __builtin_amdgcn_fence(__ATOMIC_ACQUIRE, "agent");
            asm volatile("s_waitcnt vmcnt(0)" ::: "memory");
        }
    }
    __syncthreads();
}

constexpr int NWAVES = 8;
constexpr int BATCH = 4, SEQ = 2048, D = 2048, DFF = 5632, NGU = 2 * DFF, NIN = 6144, PLE = 256;
constexpr int HW = 1024, LW = 1024, HEADS = 8, HD = 128, CHUNK = 64, NCH = SEQ / CHUNK;
constexpr int M = BATCH * SEQ;
constexpr float EPS = 1e-6f;
constexpr int N_IN = 27;
enum In { I_X = 0, I_P, I_F1N, I_F1G, I_F1U, I_F1D, I_MIXN, I_WIN, I_HLB, I_HGN, I_CW, I_CB, I_LWA, I_LBA, I_LWX, I_LBX, I_LAM, I_WOUT,
          I_F2N, I_F2G, I_F2U, I_F2D, I_PLN, I_PWG, I_PBG, I_PWP, I_FN };

constexpr size_t MiB = 1u << 20;
constexpr size_t WS_CTL = 0, CTL_ZERO_BYTES = 128 * 1024;
constexpr size_t WS_SSQA = 1 * MiB, WS_SSQB = 2 * MiB, WS_DEC = 3 * MiB;
constexpr size_t WS_WAT = 3 * MiB + 512 * 1024, WS_WXT = 3 * MiB + 768 * 1024;
constexpr size_t WS_WPROJ = 4 * MiB, WS_PB = 5 * MiB;
constexpr size_t WS_WGU1 = 9 * MiB, WS_WD1 = 53 * MiB, WS_WINT = 75 * MiB, WS_WOUT = 99 * MiB, WS_WGU2 = 107 * MiB, WS_WD2 = 151 * MiB, WS_WPG = 173 * MiB;
constexpr size_t WS_XB = 181 * MiB;
constexpr size_t WS_ACT = 213 * MiB;
constexpr size_t WS_LOGF = WS_ACT, WS_V = WS_ACT + 32 * MiB, WS_SG = WS_ACT + 48 * MiB, WS_LRX = WS_ACT + 64 * MiB, WS_PP = 365 * MiB;
constexpr size_t WS_MIXA = 301 * MiB;
constexpr size_t WS_KVT = 333 * MiB;
constexpr size_t WS_XCH = 397 * MiB;
constexpr size_t WS_WAJ = 398 * MiB, WS_WXJ = 399 * MiB;
constexpr size_t WS_BA2 = 400 * MiB;
constexpr size_t WS_END = 401 * MiB;
static_assert(WS_WGU1 + (size_t)NGU * D * 2 <= WS_WD1 && WS_WD1 + (size_t)D * DFF * 2 <= WS_WINT && WS_WINT + (size_t)NIN * D * 2 <= WS_WOUT && WS_WOUT + (size_t)D * D * 2 <= WS_WGU2 &&
              WS_WGU2 + (size_t)NGU * D * 2 <= WS_WD2 && WS_WD2 + (size_t)D * DFF * 2 <= WS_WPG && WS_WPG + (size_t)D * D * 2 <= WS_XB && WS_XB + (size_t)M * D * 2 <= WS_ACT &&
              WS_ACT + (size_t)M * DFF * 2 <= WS_MIXA && WS_MIXA + (size_t)M * 2048 * 2 <= WS_KVT && WS_KVT + (size_t)BATCH * HEADS * NCH * HD * HD * 4 <= WS_XCH &&
              WS_LRX + (size_t)M * 1024 * 2 <= WS_MIXA && WS_PP + (size_t)M * D * 2 <= 397 * MiB && WS_PB + (size_t)M * PLE * 2 <= WS_WGU1 && WS_WPROJ + (size_t)D * PLE * 2 <= WS_PB, "d_ws map");
constexpr int CW_PANEL = 16384;
constexpr int CW_BAR = 4096;

constexpr int RING_OFF = 0, RING_BYTES = 131072;
constexpr int LDSCTL_OFF = 147456 - 512, MISC_OFF = LDSCTL_OFF + 320;
constexpr int LDS_BYTES = 147456;
static_assert(MISC_OFF + 128 <= LDS_BYTES, "LDS map");


struct Frame {
    LAS unsigned char* lds;
    volatile LAS unsigned* MISC;
    gu32* ctl;
    int wave;
    int vcu, G;
    const float* in[N_IN]; float* out; unsigned char* ws;
};
__device__ __forceinline__ float bf2f(bf16 b) { return __builtin_bit_cast(float, (unsigned)b << 16); }
__device__ __forceinline__ float wave_sum(float v) {
#pragma unroll
    for (int o = 1; o < 64; o <<= 1) v += __shfl_xor(v, o);
    return v;
}
__device__ __forceinline__ void p0_transpose_item(const float* W, int ldw, int K, int src_col0, bf16* WT, int dst_row0, const float* gain, LAS float* scr, int kb, int lane, float wscale = 1.0f) {
    const int k0 = 64 * kb, kq = lane >> 4, nq = lane & 15;
    f32x4 v[16];
#pragma unroll
    for (int i = 0; i < 16; ++i) v[i] = __builtin_nontemporal_load((const GAS f32x4*)(W + (size_t)(k0 + 4 * i + kq) * ldw + src_col0 + 4 * nq));
    if (gain) {
#pragma unroll
        for (int i = 0; i < 16; ++i) v[i] = v[i] * gain[k0 + 4 * i + kq];
    }
    if (wscale != 1.0f) {
#pragma unroll
        for (int i = 0; i < 16; ++i) v[i] = v[i] * wscale;
    }
#pragma unroll
    for (int i = 0; i < 16; ++i) { LAS float* s = scr + (4 * i + kq) * 65 + 4 * nq; s[0] = v[i].x; s[1] = v[i].y; s[2] = v[i].z; s[3] = v[i].w; }
    LDS_WAIT(); asm volatile("" ::: "memory");
    const int c = lane & 7;
#pragma unroll
    for (int j = 0; j < 8; ++j) { const int n = (lane >> 3) + 8 * j; const LAS float* s = scr + (8 * c) * 65 + n;
        v4u o; o.x = pk2(s[0 * 65], s[1 * 65]); o.y = pk2(s[2 * 65], s[3 * 65]); o.z = pk2(s[4 * 65], s[5 * 65]); o.w = pk2(s[6 * 65], s[7 * 65]);
        *(GAS v4u*)(WT + (size_t)(dst_row0 + n) * K + k0 + 8 * c) = o; }
    LDS_WAIT(); asm volatile("" ::: "memory");
}
__device__ __forceinline__ bool p0_plain(int& r, const float* W, int K, int N, bf16* WT, const float* gain, LAS float* scr, int lane, float wscale = 1.0f) {
    const int items = (N / 64) * (K / 64);
    if (r < items) { const int nb = r / (K / 64), kb = r % (K / 64); p0_transpose_item(W, N, K, 64 * nb, WT, 64 * nb, gain, scr, kb, lane, wscale); return true; }
    r -= items; return false;
}
__device__ __forceinline__ bool p0_gateup(int& r, const float* Wg, const float* Wu, bf16* WT, const float* gain, LAS float* scr, int lane) {
    const int items = (NGU / 64) * (D / 64);
    if (r < items) { const int rb = r / (D / 64), kb = r % (D / 64), t = rb >> 2, j = rb & 3;
        p0_transpose_item(j < 2 ? Wg : Wu, DFF, D, 128 * t + 64 * (j & 1), WT, 64 * rb, gain, scr, kb, lane); return true; }
    r -= items; return false;
}
enum { J_X = 1, J_P = 2, J_GU1 = 4, J_D1 = 8, J_WIN = 16, J_WOUT = 32, J_GU2 = 64, J_D2 = 128, J_PG = 256, J_PROJ = 512, J_AX = 1024 };
template <int JOBS>
__device__ __forceinline__ void convert_jobs(Frame& F, int rank, int count) {
    const int lane_ = pg8::lane_id_asm(), wave_ = F.wave;
    LAS float* scr = (LAS float*)(F.lds + RING_OFF + wave_ * 16640);
    const int gw = rank * NWAVES + wave_, NGW = count * NWAVES;
    unsigned char* ws = F.ws;
    if (JOBS & J_X) {
        for (int m = gw; m < M; m += NGW) {
            const GAS f32x4* xr = (const GAS f32x4*)(F.in[I_X] + (size_t)m * D) + lane_;
            GAS unsigned long long* o8 = (GAS unsigned long long*)((bf16*)(ws + WS_XB) + (size_t)m * D) + lane_;
            float s = 0.f;
#pragma unroll
            for (int j = 0; j < 8; ++j) { const f32x4 v = __builtin_nontemporal_load(xr + 64 * j); s += (v.x * v.x + v.y * v.y) + (v.z * v.z + v.w * v.w);
                o8[64 * j] = (unsigned long long)pk2(v.x, v.y) | ((unsigned long long)pk2(v.z, v.w) << 32); }
            s = wave_sum(s);
            if (lane_ < 32) ((float*)(ws + WS_SSQA))[(size_t)m * 32 + lane_] = (lane_ == 0) ? s : 0.f;
        }
    }
    if (JOBS & J_P) {
        for (int m = gw; m < M; m += NGW) {
            const f32x4 v = __builtin_nontemporal_load((const GAS f32x4*)(F.in[I_P] + (size_t)m * PLE) + lane_);
            ((GAS unsigned long long*)((bf16*)(ws + WS_PB) + (size_t)m * PLE))[lane_] = (unsigned long long)pk2(v.x, v.y) | ((unsigned long long)pk2(v.z, v.w) << 32);
        }
    }
    constexpr int I_GU = (NGU / 64) * (D / 64), I_DD = (D / 64) * (DFF / 64), I_IN = (NIN / 64) * (D / 64), I_SQ = (D / 64) * (D / 64), I_PJ = (D / 64) * (PLE / 64), I_AX = 16 * 4 * 4;
    constexpr int NITEMS = ((JOBS & J_GU1) ? I_GU : 0) + ((JOBS & J_D1) ? I_DD : 0) + ((JOBS & J_WIN) ? I_IN : 0) + ((JOBS & J_WOUT) ? I_SQ : 0) + ((JOBS & J_GU2) ? I_GU : 0) +
                           ((JOBS & J_D2) ? I_DD : 0) + ((JOBS & J_PG) ? I_SQ : 0) + ((JOBS & J_PROJ) ? I_PJ : 0) + ((JOBS & J_AX) ? I_AX : 0);
    for (int it = gw; it < NITEMS; it += NGW) {
        int r = it;
        if (JOBS & J_GU1) { if (p0_gateup(r, F.in[I_F1G], F.in[I_F1U], (bf16*)(ws + WS_WGU1), F.in[I_F1N], scr, lane_)) continue; }
        if (JOBS & J_D1) { if (p0_plain(r, F.in[I_F1D], DFF, D, (bf16*)(ws + WS_WD1), nullptr, scr, lane_, 0.5f)) continue; }
        if (JOBS & J_WIN) { if (p0_plain(r, F.in[I_WIN], D, NIN, (bf16*)(ws + WS_WINT), F.in[I_MIXN], scr, lane_)) continue; }
        if (JOBS & J_WOUT) { if (p0_plain(r, F.in[I_WOUT], D, D, (bf16*)(ws + WS_WOUT), nullptr, scr, lane_)) continue; }
        if (JOBS & J_GU2) { if (p0_gateup(r, F.in[I_F2G], F.in[I_F2U], (bf16*)(ws + WS_WGU2), F.in[I_F2N], scr, lane_)) continue; }
        if (JOBS & J_D2) { if (p0_plain(r, F.in[I_F2D], DFF, D, (bf16*)(ws + WS_WD2), nullptr, scr, lane_, 0.5f)) continue; }
        if (JOBS & J_PG) { if (p0_plain(r, F.in[I_PWG], D, D, (bf16*)(ws + WS_WPG), F.in[I_PLN], scr, lane_)) continue; }
        if (JOBS & J_PROJ) { if (p0_plain(r, F.in[I_PWP], PLE, D, (bf16*)(ws + WS_WPROJ), nullptr, scr, lane_)) continue; }
        if (JOBS & J_AX) { const int blk = r >> 4, j = (r >> 2) & 3, q = r & 3;
          const int nb = blk & 7;
          const float* W = (blk < 8 ? F.in[I_LWA] : F.in[I_LWX]) + (size_t)nb * 128 * 128;
          bf16* WT = (bf16*)(ws + (blk < 8 ? WS_WAJ : WS_WXJ)) + (size_t)(nb * 4 + j) * 128 * 128;
          p0_transpose_item(W, 128, 128, 64 * (q >> 1), WT, 64 * (q >> 1), F.in[I_CW] + j * 1024 + nb * 128, scr, q & 1, lane_); }
    }
    if (JOBS & J_AX) {
        for (int o = gw * 64 + lane_; o < 2048; o += NGW * 64) { const int which = o >> 10, dg = o & 1023, nb = dg >> 7, dd = dg & 127;
            const float* W = (which ? F.in[I_LWX] : F.in[I_LWA]) + (size_t)nb * 128 * 128 + dd; float s = (which ? F.in[I_LBX] : F.in[I_LBA])[dg];
            for (int c = 0; c < 128; ++c) s += F.in[I_CB][nb * 128 + c] * W[(size_t)c * 128];
            ((float*)(ws + WS_BA2))[o] = s; }
    }
}
__device__ __forceinline__ void side_workers(int nwg, int G, int c, int& rank, int& count) {
    const int rounds = (nwg + G - 1) / G, last = nwg - (rounds - 1) * G;
    if (last == G) { rank = c; count = G; } else if (c >= last) { rank = c - last; count = G - last; } else { rank = -1; count = 0; }
}
__device__ __forceinline__ void final_norm(Frame& F, const float* ssq) {
    const int lane_ = pg8::lane_id_asm(), wave_ = F.wave;
    const int gw = F.vcu * NWAVES + wave_, NGW = F.G * NWAVES;
    const GAS f32x4* gf = (const GAS f32x4*)F.in[I_FN] + lane_;
    for (int m = gw; m < M; m += NGW) {
        float s = (lane_ < 32) ? ssq[(size_t)m * 32 + lane_] : 0.f;
        s = wave_sum(s);
        const float rstd = 1.0f / sqrtf(s * (1.0f / D) + EPS);
        GAS f32x4* xr = (GAS f32x4*)(F.out + (size_t)m * D) + lane_;
#pragma unroll
        for (int j = 0; j < 8; ++j) { f32x4 v = xr[64 * j]; const f32x4 g = gf[64 * j]; v = v * rstd * g; xr[64 * j] = v; }
    }
}


typedef float mf32x4 __attribute__((ext_vector_type(4)));
typedef short mbf16x8 __attribute__((ext_vector_type(8)));
typedef unsigned mu32x2 __attribute__((ext_vector_type(2)));
constexpr int TS = 72;
constexpr int QS = 136;
constexpr int NITEM = BATCH * HEADS * NCH;
__device__ __forceinline__ mbf16x8 lds_frag(const LAS bf16* p) { return *(const LAS mbf16x8*)p; }
__device__ __forceinline__ unsigned bf1(float x) { return pg8::cvt_pk_bf16(x, 0.f) & 0xffffu; }
#define MFMA16(a, b, c) __builtin_amdgcn_mfma_f32_16x16x32_bf16((a), (b), (c), 0, 0, 0)

#define LBAR() do { asm volatile("s_waitcnt lgkmcnt(0)" ::: "memory"); __builtin_amdgcn_s_barrier(); asm volatile("" ::: "memory"); } while (0)

__device__ __forceinline__ void hgrn_local_phase(Frame& F) {
    LAS bf16* kstT = (LAS bf16*)(F.lds);
    LAS bf16* vT = (LAS bf16*)(F.lds + 18432);
    LAS float* qtot = (LAS float*)(F.lds + 36864);
    const int tid_ = F.wave * 64 + pg8::lane_id_asm();
    const int tid = tid_, k = tid & 127, sq = tid >> 7, lane = tid & 63, w = F.wave, fr = lane & 15, fq = lane >> 4;
    const float* LOGF = (const float*)(F.ws + WS_LOGF); const bf16* V = (const bf16*)(F.ws + WS_V);
    bf16* KVT = (bf16*)(F.ws + WS_KVT); float* DEC = (float*)(F.ws + WS_DEC);
    float lf[16]; unsigned vr[16];
    if ((int)blockIdx.x < NITEM) { const int item = blockIdx.x, c = item & 31, bh = item >> 5, h = bh & 7, b = bh >> 3;
        const size_t g0 = ((size_t)b * SEQ + c * 64 + sq * 16) * 1024 + h * 128 + k;
#pragma unroll
        for (int i = 0; i < 16; ++i) { lf[i] = LOGF[g0 + (size_t)i * 1024]; vr[i] = V[g0 + (size_t)i * 1024]; } }
    for (int item = blockIdx.x; item < NITEM; item += F.G) {
        float bb[16]; float run = 0.f;
#pragma unroll
        for (int i = 0; i < 16; ++i) { run += lf[i]; bb[i] = run; }
        qtot[sq * 128 + k] = run;
        LBAR();
        float pre = 0.f, tot = 0.f;
#pragma unroll
        for (int j = 0; j < 4; ++j) { const float tq = qtot[j * 128 + k]; pre += (j < sq) ? tq : 0.f; tot += tq; }
        unsigned pk[8], pv[8];
#pragma unroll
        for (int i = 0; i < 8; ++i) {
            const float e0 = (1.0f - __expf(lf[2 * i])) * __expf(tot - (pre + bb[2 * i])), e1 = (1.0f - __expf(lf[2 * i + 1])) * __expf(tot - (pre + bb[2 * i + 1]));
            pk[i] = pg8::cvt_pk_bf16(e0, e1); pv[i] = vr[2 * i] | (vr[2 * i + 1] << 16); }
        *(LAS v4u*)(kstT + k * TS + sq * 16) = (v4u){pk[0], pk[1], pk[2], pk[3]}; *(LAS v4u*)(kstT + k * TS + sq * 16 + 8) = (v4u){pk[4], pk[5], pk[6], pk[7]};
        *(LAS v4u*)(vT + k * TS + sq * 16) = (v4u){pv[0], pv[1], pv[2], pv[3]}; *(LAS v4u*)(vT + k * TS + sq * 16 + 8) = (v4u){pv[4], pv[5], pv[6], pv[7]};
        if (sq == 0) DEC[(size_t)item * 128 + k] = __expf(tot);
        if (item + F.G < NITEM) { const int it2 = item + F.G, c = it2 & 31, bh = it2 >> 5, h = bh & 7, b = bh >> 3;
            const size_t g0 = ((size_t)b * SEQ + c * 64 + sq * 16) * 1024 + h * 128 + k;
#pragma unroll
            for (int i = 0; i < 16; ++i) { lf[i] = LOGF[g0 + (size_t)i * 1024]; vr[i] = V[g0 + (size_t)i * 1024]; } }
        LBAR();
        const mbf16x8 b0 = lds_frag(vT + (16 * w + fr) * TS + 8 * fq), b1 = lds_frag(vT + (16 * w + fr) * TS + 32 + 8 * fq);
        bf16* outp = KVT + (size_t)item * 16384 + (size_t)(16 * w + fr) * 128 + 4 * fq;
#pragma unroll
        for (int kt = 0; kt < 8; ++kt) {
            mf32x4 acc = {0.f, 0.f, 0.f, 0.f};
            acc = MFMA16(lds_frag(kstT + (16 * kt + fr) * TS + 8 * fq), b0, acc);
            acc = MFMA16(lds_frag(kstT + (16 * kt + fr) * TS + 32 + 8 * fq), b1, acc);
            asm volatile("s_nop 7\n\ts_nop 7" : "+v"(acc));
            mu32x2 o; o.x = pg8::cvt_pk_bf16(acc[0], acc[1]); o.y = pg8::cvt_pk_bf16(acc[2], acc[3]);
            *(mu32x2*)(outp + 16 * kt) = o;
        }
        LBAR();
    }
}

__device__ __forceinline__ void hgrn_scan_phase(Frame& F) {
    const bf16* KVT = (const bf16*)(F.ws + WS_KVT); const float* DEC = (const float*)(F.ws + WS_DEC); bf16* ST = (bf16*)(F.ws + WS_XB);
    const int tid_ = F.wave * 64 + pg8::lane_id_asm();
    for (int idx = blockIdx.x * (NWAVES * 64) + tid_; idx < BATCH * HEADS * 128 * 32; idx += F.G * NWAVES * 64) {
        const int k4 = idx & 31, v = (idx >> 5) & 127, bh = idx >> 12;
        mf32x4 S = {0.f, 0.f, 0.f, 0.f};
#pragma unroll 1
        for (int half = 0; half < 2; ++half) {
            const size_t off0 = (size_t)(bh * NCH + half * 16) * 16384 + v * 128 + 4 * k4; const size_t d0 = (size_t)(bh * NCH + half * 16) * 128 + 4 * k4;
            mu32x2 kv[16]; mf32x4 dd[16];
#pragma unroll
            for (int c = 0; c < 16; ++c) { kv[c] = *(const mu32x2*)(KVT + off0 + (size_t)c * 16384); dd[c] = *(const mf32x4*)(DEC + d0 + (size_t)c * 128); }
#pragma unroll
            for (int c = 0; c < 16; ++c) {
                mu32x2 o; o.x = pg8::cvt_pk_bf16(S[0], S[1]); o.y = pg8::cvt_pk_bf16(S[2], S[3]); *(mu32x2*)(ST + off0 + (size_t)c * 16384) = o;
                S = dd[c] * S + pg8::bf16x4_to_f32(kv[c]);
            }
        }
    }
}

__device__ __forceinline__ void hgrn_out_phase(Frame& F, bool dummy = false) {
    LAS bf16* QT = (LAS bf16*)(F.lds);
    LAS bf16* KT = (LAS bf16*)(F.lds + 17408);
    LAS bf16* QI = (LAS bf16*)(F.lds + 34816);
    LAS bf16* vT = (LAS bf16*)(F.lds + 52224);
    LAS bf16* P = (LAS bf16*)(F.lds + 70656);
    LAS float* qtot = (LAS float*)(F.lds + 79872);
    LAS float* ssq = (LAS float*)(F.lds + 81920);
    const int tid_ = F.wave * 64 + pg8::lane_id_asm();
    const int tid = tid_, k = tid & 127, sq = tid >> 7, lane = tid & 63, w = F.wave, fr = lane & 15, fq = lane >> 4, rb = w & 3, ch = w >> 2;
    const float* LOGF = (const float*)(F.ws + WS_LOGF); const bf16* V = (const bf16*)(F.ws + WS_V); const bf16* SG = (const bf16*)(F.ws + WS_SG);
    const bf16* ST = (const bf16*)(F.ws + WS_XB); bf16* MIXA = (bf16*)(F.ws + WS_MIXA);
    const int t0 = 16 * rb;
    float lf[16]; unsigned vr[16], qr[16];
    if ((int)blockIdx.x < NITEM) { const int item = blockIdx.x, c = item & 31, bh = item >> 5, h = bh & 7, b = bh >> 3;
        const size_t r0 = (size_t)b * SEQ + c * 64, g0 = (r0 + sq * 16) * 1024 + h * 128 + k, gq = (r0 + sq * 16) * 2048 + h * 128 + k;
#pragma unroll
        for (int i = 0; i < 16; ++i) { lf[i] = LOGF[g0 + (size_t)i * 1024]; vr[i] = V[g0 + (size_t)i * 1024]; qr[i] = MIXA[gq + (size_t)i * 2048]; } }
    for (int item = blockIdx.x; item < NITEM; item += F.G) {
        const int c = item & 31, bh = item >> 5, h = bh & 7, b = bh >> 3;
        const size_t r0 = (size_t)b * SEQ + c * 64;
        float bb[16]; float run = 0.f;
#pragma unroll
        for (int i = 0; i < 16; ++i) { run += lf[i]; bb[i] = run; }
        qtot[sq * 128 + k] = run;
        LBAR();
        {
            float pre = 0.f;
#pragma unroll
            for (int j = 0; j < 4; ++j) { const float tq = qtot[j * 128 + k]; pre += (j < sq) ? tq : 0.f; }
            const float bm = qtot[k] + qtot[128 + k], ebm = __expf(bm);
            unsigned pv[8];
#pragma unroll
            for (int i = 0; i < 16; ++i) {
                const float d = fminf(fmaxf(pre + bb[i] - bm, -60.f), 60.f), e1 = __expf(d), e2 = __builtin_amdgcn_rcpf(e1);
                const float qf = bf2f((bf16)qr[i]), qt = qf * e1, kk = (1.0f - __expf(lf[i])) * e2;
                const int s = sq * 16 + i;
                QT[s * QS + k] = (bf16)bf1(qt); QI[s * QS + k] = (bf16)bf1(qt * ebm); KT[s * QS + k] = (bf16)bf1(kk);
            }
#pragma unroll
            for (int i = 0; i < 8; ++i) pv[i] = vr[2 * i] | (vr[2 * i + 1] << 16);
            *(LAS v4u*)(vT + k * TS + sq * 16) = (v4u){pv[0], pv[1], pv[2], pv[3]}; *(LAS v4u*)(vT + k * TS + sq * 16 + 8) = (v4u){pv[4], pv[5], pv[6], pv[7]};
        }
        if (item + F.G < NITEM) { const int it2 = item + F.G, c2 = it2 & 31, bh2 = it2 >> 5, h2 = bh2 & 7, b2 = bh2 >> 3;
            const size_t r2 = (size_t)b2 * SEQ + c2 * 64, g0 = (r2 + sq * 16) * 1024 + h2 * 128 + k, gq = (r2 + sq * 16) * 2048 + h2 * 128 + k;
#pragma unroll
            for (int i = 0; i < 16; ++i) { lf[i] = LOGF[g0 + (size_t)i * 1024]; vr[i] = V[g0 + (size_t)i * 1024]; qr[i] = MIXA[gq + (size_t)i * 2048]; } }
        mbf16x8 stf[4][4]; mu32x2 sgp[4];
#pragma unroll
        for (int j = 0; j < 4; ++j) { const bf16* sp = ST + (size_t)item * 16384 + (size_t)(64 * ch + 16 * j + fr) * 128 + 8 * fq;
#pragma unroll
            for (int ks = 0; ks < 4; ++ks) stf[j][ks] = *(const mbf16x8*)(sp + 32 * ks);
            sgp[j] = *(const mu32x2*)(SG + (r0 + t0 + fr) * 1024 + h * 128 + 64 * ch + 16 * j + 4 * fq); }
        LBAR();
        {
            mbf16x8 bq[4];
#pragma unroll
            for (int ks = 0; ks < 4; ++ks) bq[ks] = lds_frag(QT + (t0 + fr) * QS + 32 * ks + 8 * fq);
#pragma unroll
            for (int j = 0; j < 2; ++j) {
                const int s0 = 32 * ch + 16 * j; mf32x4 acc = {0.f, 0.f, 0.f, 0.f};
#pragma unroll
                for (int ks = 0; ks < 4; ++ks) acc = MFMA16(lds_frag(KT + (s0 + fr) * QS + 32 * ks + 8 * fq), bq[ks], acc);
                const int t = t0 + fr, sb = s0 + 4 * fq;
#pragma unroll
                for (int r = 0; r < 4; ++r) acc[r] = (sb + r <= t) ? acc[r] : 0.f;
                mu32x2 o; o.x = pg8::cvt_pk_bf16(acc[0], acc[1]); o.y = pg8::cvt_pk_bf16(acc[2], acc[3]);
                *(LAS mu32x2*)(P + t * TS + sb) = o;
            }
        }
        LBAR();
        mf32x4 o4[4];
        {
            mbf16x8 bqi[4], bp[2];
#pragma unroll
            for (int ks = 0; ks < 4; ++ks) bqi[ks] = lds_frag(QI + (t0 + fr) * QS + 32 * ks + 8 * fq);
#pragma unroll
            for (int ss = 0; ss < 2; ++ss) bp[ss] = lds_frag(P + (t0 + fr) * TS + 32 * ss + 8 * fq);
            float sum = 0.f;
#pragma unroll
            for (int j = 0; j < 4; ++j) {
                const int v0 = 64 * ch + 16 * j; mf32x4 acc = {0.f, 0.f, 0.f, 0.f};
#pragma unroll
                for (int ks = 0; ks < 4; ++ks) acc = MFMA16(stf[j][ks], bqi[ks], acc);
#pragma unroll
                for (int ss = 0; ss < 2; ++ss) acc = MFMA16(lds_frag(vT + (v0 + fr) * TS + 32 * ss + 8 * fq), bp[ss], acc);
                o4[j] = acc; sum += (acc[0] * acc[0] + acc[1] * acc[1]) + (acc[2] * acc[2] + acc[3] * acc[3]);
            }
            sum += __shfl_xor(sum, 16); sum += __shfl_xor(sum, 32);
            if (fq == 0) ssq[ch * 64 + t0 + fr] = sum;
        }
        LBAR();
        {
            const float rn = 1.0f / sqrtf((ssq[t0 + fr] + ssq[64 + t0 + fr]) * (1.0f / 128.0f) + EPS);
            const size_t row = r0 + t0 + fr;
#pragma unroll
            for (int j = 0; j < 4; ++j) {
                const int v = 64 * ch + 16 * j + 4 * fq;
                const mf32x4 gn = *(const mf32x4*)(F.in[I_HGN] + v);
                const float s0 = bf2f((bf16)(sgp[j].x & 0xffffu)), s1 = bf2f((bf16)(sgp[j].x >> 16)), s2 = bf2f((bf16)(sgp[j].y & 0xffffu)), s3 = bf2f((bf16)(sgp[j].y >> 16));
                mu32x2 o; o.x = pg8::cvt_pk_bf16(o4[j][0] * rn * gn[0] * s0, o4[j][1] * rn * gn[1] * s1); o.y = pg8::cvt_pk_bf16(o4[j][2] * rn * gn[2] * s2, o4[j][3] * rn * gn[3] * s3);
                *(mu32x2*)((dummy ? (bf16*)(F.ws + WS_KVT) : MIXA) + row * 2048 + h * 128 + v) = o;
            }
        }
        LBAR();
    }
}

#define GLDS16(gp, lp) __builtin_amdgcn_global_load_lds((const unsigned*)(gp), (LAS unsigned*)(lp), 16, 0, 0)
template <int VAR = 0, bool FUSE_SCAN = false, bool dummy = false>
__device__ __forceinline__ void lru_phase(Frame& F) {
    LAS unsigned char* Ab = F.lds;
    LAS float* LAt = (LAS float*)(F.lds + 66560);
    LAS float* LUt = (LAS float*)(F.lds + 66560 + 18560);
    LAS bf16* GG = (LAS bf16*)(F.lds + 103680);
    LAS bf16* GGt = (LAS bf16*)(F.lds + 111872);
    LAS bf16* YYt = (LAS bf16*)(F.lds + 121344);
    const int tid_ = F.wave * 64 + pg8::lane_id_asm();
    const int tid = tid_, lane = tid & 63, w = F.wave, fr = lane & 15, fq = lane >> 4;
    const int seg = lane & 31, d = 2 * w + (lane >> 5);
    const int grow = tid >> 1, ghalf = tid & 1;
    const bf16* LRX = (const bf16*)(F.ws + WS_LRX); bf16* MIXA = (bf16*)(F.ws + WS_MIXA);
    const bf16* WAJ = (const bf16*)(F.ws + WS_WAJ); const bf16* WXJ = (const bf16*)(F.ws + WS_WXJ);
    for (int item = blockIdx.x; item < BATCH * 64; item += F.G) {
        const int b = item >> 6, n = (item >> 3) & 7, sl = item & 7;
        int tid = tid_; asm volatile("" : "+v"(tid));
        const int lane = tid & 63, fr = lane & 15, fq = lane >> 4, grow = tid >> 1, ghalf = tid & 1;
        mbf16x8 waf[4][4], wxf[4][4];
#pragma unroll
        for (int j = 0; j < 4; ++j)
#pragma unroll
            for (int ks = 0; ks < 4; ++ks) { const size_t o = ((size_t)(n * 4 + j) * 128 + sl * 16 + fr) * 128 + 32 * ks + 8 * fq; waf[j][ks] = *(const mbf16x8*)(WAJ + o); wxf[j][ks] = *(const mbf16x8*)(WXJ + o); }
        const bf16* xsrc0 = LRX + (size_t)b * SEQ * 1024 + n * 128;
        bf16* const gbase = MIXA + (size_t)b * SEQ * 2048 + 1024 + n * 128 + sl * 16 + 8 * ghalf;
        bf16* const obase = dummy ? (bf16*)(F.ws + WS_END) + (size_t)item * 2048 * 16 + 8 * ghalf : gbase;
        const size_t ostr = dummy ? 16 : 2048;
#pragma unroll
        for (int i = 0; i < 9; ++i) { const int p = tid + 512 * i, row = p >> 4, cp = p & 15;
            if (p < 259 * 16 && row >= 3) GLDS16(xsrc0 + (size_t)(row - 3) * 1024 + 8 * (cp ^ (row & 15)), Ab + (w * 64 + 512 * i) * 16); }
        if (tid < 48) *(LAS v4u*)(Ab + tid * 16) = (v4u){0u, 0u, 0u, 0u};
        GLDS16(gbase + (size_t)grow * 2048, (LAS unsigned char*)GG + w * 1024);
        __syncthreads();
        float carry = 0.f;
        mf32x4 S = {0.f, 0.f, 0.f, 0.f};
        for (int mc = 0; mc < 8; ++mc) {
            int tid = tid_; asm volatile("" : "+v"(tid));
            const int lane = tid & 63, fr = lane & 15, fq = lane >> 4, seg = lane & 31, d = 2 * w + (lane >> 5), grow = tid >> 1, ghalf = tid & 1;
            const bf16* xsrc = LRX + (size_t)b * SEQ * 1024 + n * 128;
            bf16* const gbase = MIXA + (size_t)b * SEQ * 2048 + 1024 + n * 128 + sl * 16 + 8 * ghalf;
            bf16* const obase = dummy ? (bf16*)(F.ws + WS_END) + (size_t)item * 2048 * 16 + 8 * ghalf : gbase;
            const int sidx = blockIdx.x * (NWAVES * 64) + tid;
            const unsigned soff = (unsigned)((sidx >> 12) * NCH + 4 * mc) * 16384u + ((sidx >> 5) & 127) * 128 + 4 * (sidx & 31), sdo = (unsigned)((sidx >> 12) * NCH + 4 * mc) * 128u + 4 * (sidx & 31);
            mu32x2 skv[2]; mf32x4 sdd[2];
            if (FUSE_SCAN) {
#pragma unroll
                for (int c = 0; c < 2; ++c) { skv[c] = *(const mu32x2*)((const bf16*)(F.ws + WS_KVT) + soff + c * 16384u); sdd[c] = *(const mf32x4*)((const float*)(F.ws + WS_DEC) + sdo + c * 128u); }
            }
            mf32x4 ar[2], ai[2]; float xv[2][7];
#pragma unroll
            for (int rt = 0; rt < 2; ++rt) {
                const int rowt = 32 * w + 16 * rt; ar[rt] = (mf32x4){0.f, 0.f, 0.f, 0.f}; ai[rt] = (mf32x4){0.f, 0.f, 0.f, 0.f};
#pragma unroll
                for (int j = 0; j < 4; ++j) { const int R = rowt + fr + j;
#pragma unroll
                    for (int ks = 0; ks < 4; ++ks) { const mbf16x8 a = *(const LAS mbf16x8*)(Ab + R * 256 + (((4 * ks + fq) ^ (R & 15)) << 4)); ar[rt] = MFMA16(a, waf[j][ks], ar[rt]); ai[rt] = MFMA16(a, wxf[j][ks], ai[rt]); } }
#pragma unroll
                for (int q = 0; q < 7; ++q) { const int R = rowt + 4 * fq + q; xv[rt][q] = bf2f(*(const LAS bf16*)(Ab + R * 256 + (((2 * sl + (fr >> 3)) ^ (R & 15)) << 4) + 2 * (fr & 7))); }
            }
            __syncthreads();
            if (mc < 7) {
#pragma unroll
                for (int i = 0; i < 9; ++i) { const int p = tid + 512 * i, row = p >> 4, cp = p & 15;
                    if (p < 259 * 16) GLDS16(xsrc + (size_t)((mc + 1) * 256 - 3 + row) * 1024 + 8 * (cp ^ (row & 15)), Ab + (w * 64 + 512 * i) * 16); }
            }
            {
                const v4u g = *(const LAS v4u*)(GG + tid * 8); const unsigned gw4[4] = {g.x, g.y, g.z, g.w};
                const int tb = (8 * ghalf) * 296 + (grow >> 3) * 9 + (grow & 7);
#pragma unroll
                for (int e = 0; e < 8; ++e) GGt[tb + e * 296] = (bf16)((e & 1) ? (gw4[e >> 1] >> 16) : (gw4[e >> 1] & 0xffffu));
                if (mc > 0) { unsigned yv[8];
#pragma unroll
                    for (int e = 0; e < 8; ++e) yv[e] = YYt[tb + e * 296];
                    *(v4u*)(obase + (size_t)((mc - 1) * 256 + grow) * ostr) = (v4u){yv[0] | (yv[1] << 16), yv[2] | (yv[3] << 16), yv[4] | (yv[5] << 16), yv[6] | (yv[7] << 16)}; }
                if (mc < 7) { asm volatile("s_waitcnt lgkmcnt(0)" ::: "memory"); GLDS16(gbase + (size_t)((mc + 1) * 256 + grow) * 2048, (LAS unsigned char*)GG + w * 1024); }
            }
            {
                const int cgl = n * 128 + sl * 16 + fr;
                const float ba2 = ((const float*)(F.ws + WS_BA2))[cgl], bx2 = ((const float*)(F.ws + WS_BA2))[1024 + cgl], spl = log1pf(__expf(-F.in[I_LAM][cgl])), cbv = F.in[I_CB][cgl];
                float cw4[4];
#pragma unroll
                for (int j = 0; j < 4; ++j) cw4[j] = F.in[I_CW][j * 1024 + cgl];
#pragma unroll
                for (int rt = 0; rt < (VAR == 2 ? 0 : 2); ++rt)
#pragma unroll
                    for (int r = 0; r < 4; ++r) { const int row = 32 * w + 16 * rt + 4 * fq + r;
                        const float xc = cbv + ((cw4[0] * xv[rt][r] + cw4[1] * xv[rt][r + 1]) + (cw4[2] * xv[rt][r + 2] + cw4[3] * xv[rt][r + 3]));
                        const float rg = pg8::sigmoid_f(ar[rt][r] + ba2), ig = pg8::sigmoid_f(ai[rt][r] + bx2), la = -8.0f * rg * spl;
                        const float a = __expf(la), om = fmaxf(__builtin_fmaf(-a, a, 1.0f), 0.f);
                        const int o = fr * 289 + (row >> 3) * 9 + (row & 7);
                        LAt[o] = a; LUt[o] = __builtin_amdgcn_sqrtf(om) * ig * xc; }
            }
            if (FUSE_SCAN) {
#pragma unroll
                for (int c = 0; c < 2; ++c) { mu32x2 o; o.x = pg8::cvt_pk_bf16(S[0], S[1]); o.y = pg8::cvt_pk_bf16(S[2], S[3]); *(mu32x2*)((bf16*)(F.ws + WS_XB) + soff + c * 16384u) = o;
                    S = sdd[c] * S + pg8::bf16x4_to_f32(skv[c]); }
#pragma unroll
                for (int c = 0; c < 2; ++c) { skv[c] = *(const mu32x2*)((const bf16*)(F.ws + WS_KVT) + soff + (2 + c) * 16384u); sdd[c] = *(const mf32x4*)((const float*)(F.ws + WS_DEC) + sdo + (2 + c) * 128u); }
            }
            __syncthreads();
            if (VAR != 3) {
                float aa[8], uu[8]; float Ap = 1.f, Hp = 0.f;
#pragma unroll
                for (int i = 0; i < 8; ++i) { aa[i] = LAt[d * 289 + seg * 9 + i]; uu[i] = LUt[d * 289 + seg * 9 + i]; Hp = aa[i] * Hp + uu[i]; Ap *= aa[i]; }
#pragma unroll
                for (int off = 1; off < 32; off <<= 1) { const float Aq = __shfl_up(Ap, off, 32), Hq = __shfl_up(Hp, off, 32); if (seg >= off) { Hp = Ap * Hq + Hp; Ap = Ap * Aq; } }
                float Ae = __shfl_up(Ap, 1, 32), He = __shfl_up(Hp, 1, 32); if (seg == 0) { Ae = 1.f; He = 0.f; }
                float hin = Ae * carry + He;
                carry = __shfl(Ap, 31, 32) * carry + __shfl(Hp, 31, 32);
                const LAS bf16* gp = GGt + d * 296 + seg * 9; LAS bf16* yq = YYt + d * 296 + seg * 9;
#pragma unroll
                for (int i = 0; i < 8; ++i) { hin = aa[i] * hin + uu[i]; yq[i] = (bf16)bf1(hin * bf2f(gp[i])); }
            }
            if (FUSE_SCAN) {
#pragma unroll
                for (int c = 0; c < 2; ++c) { mu32x2 o; o.x = pg8::cvt_pk_bf16(S[0], S[1]); o.y = pg8::cvt_pk_bf16(S[2], S[3]); *(mu32x2*)((bf16*)(F.ws + WS_XB) + soff + (2 + c) * 16384u) = o;
                    S = sdd[c] * S + pg8::bf16x4_to_f32(skv[c]); }
            }
        }
        __syncthreads();
        { const int tb = (8 * ghalf) * 296 + (grow >> 3) * 9 + (grow & 7); unsigned yv[8];
#pragma unroll
          for (int e = 0; e < 8; ++e) yv[e] = YYt[tb + e * 296];
          *(v4u*)(obase + (size_t)(7 * 256 + grow) * ostr) = (v4u){yv[0] | (yv[1] << 16), yv[2] | (yv[3] << 16), yv[4] | (yv[5] << 16), yv[6] | (yv[7] << 16)}; }
        __syncthreads();
    }
}
constexpr int N_PHASES = 12;
struct Args { const float* in[N_IN]; float* out; unsigned char* ws; int ph_lo, ph_hi, li, pad; };
__global__ void __launch_bounds__(NWAVES * 64, 2) mega_fwd(Args args) {
    extern __shared__ __attribute__((aligned(16))) unsigned char lds[];
    Frame F;
    F.lds = (LAS unsigned char*)lds;
    F.MISC = (volatile LAS unsigned*)(F.lds + MISC_OFF);
    F.wave = __builtin_amdgcn_readfirstlane((int)threadIdx.x >> 6);
    F.G = gridDim.x; { const int bx = blockIdx.x; F.vcu = (F.G % 8 == 0) ? (bx % 8) * (F.G / 8) + bx / 8 : bx; }
#pragma unroll
    for (int i = 0; i < N_IN; ++i) F.in[i] = args.in[i];
    F.out = args.out; F.ws = args.ws;
    unsigned char* ws = args.ws;
    F.ctl = (gu32*)(ws + WS_CTL);
    for (int u = F.wave * 64 + pg8::lane_id_asm(); u < (LDS_BYTES - LDSCTL_OFF) / 4; u += NWAVES * 64) ((LAS unsigned*)(F.lds + LDSCTL_OFF))[u] = 0u;
    __syncthreads();
    const int lo = args.ph_lo, hi = args.ph_hi;
    const bool multi = (hi - lo) > 1;
    XcdBarrier bar; bar.bar = (unsigned*)(F.ctl + CW_BAR) + args.li * XCD_BAR_WORDS; bar.x = 0; bar.st = nullptr; bar.wave = F.wave;
    if (multi) bar = xcd_barrier_post((unsigned*)(F.ctl + CW_BAR) + args.li * XCD_BAR_WORDS, F.MISC + 8, F.wave);

    bf16* const XB = (bf16*)(ws + WS_XB); bf16* const ACT = (bf16*)(ws + WS_ACT); bf16* const MIXA = (bf16*)(ws + WS_MIXA);
    float* const SSQA = (float*)(ws + WS_SSQA); float* const SSQB = (float*)(ws + WS_SSQB);


#define IN(k) (lo <= (k) && (k) < hi)
#ifdef PROBE_PHASE
#define SEAM(k) do { if (IN(k) && ((k) + 1 < N_PHASES ? IN((k) + 1) : true)) { xcd_barrier(bar); \
        if ((k) + 1 == PROBE_PHASE) { if (blockIdx.x == 0 && F.wave == 0 && pg8::lane_id_asm() == 0) __hip_atomic_store((unsigned long long*)(F.ctl + 30000), (unsigned long long)__builtin_amdgcn_s_memrealtime(), RLX_AGENT); } \
        if ((k) == PROBE_PHASE) { if (blockIdx.x == 0 && F.wave == 0 && pg8::lane_id_asm() == 0) { const unsigned long long t1 = __builtin_amdgcn_s_memrealtime(), t0 = __hip_atomic_load((unsigned long long*)(F.ctl + 30000), RLX_AGENT); \
                __hip_atomic_store((unsigned long long*)(F.ctl + 30064), t1 - t0, RLX_AGENT); } \
            xcd_barrier(bar); \
            { const unsigned long long dt = __hip_atomic_load((unsigned long long*)(F.ctl + 30064), RLX_AGENT), s0 = __builtin_amdgcn_s_memrealtime(); while (__builtin_amdgcn_s_memrealtime() - s0 < 4ull * dt) __builtin_amdgcn_s_sleep(32); } } } } while (0)
#else
#define SEAM(k) do { if (IN(k) && IN((k) + 1)) xcd_barrier(bar); } while (0)
#endif
#define GEMM_SWIGLU(WOFF) do { pg8::Gemm g{XB, (const bf16*)(ws + (WOFF)), M, NGU, D}; pg8::StaticOrder S; S.init(M, NGU, F.G, (int)blockIdx.x); \
        pg8::EpiSwiGLU E{ACT, DFF, SSQA}; pg8::gemm_phase<pg8::EpiSwiGLU, pg8::StaticOrder, true, true>(F.lds + RING_OFF, g, S, E, F.wave); } while (0)
#define GEMM_RESID(AP, WOFF, KK, SRC, SSQO) do { pg8::Gemm g{(AP), (const bf16*)(ws + (WOFF)), M, D, (KK)}; pg8::StaticOrder S; S.init(M, D, F.G, (int)blockIdx.x); \
        if ((M / 256) * (D / 256) <= F.G) { pg8::EpiResidInit E{(SRC), F.out, XB, (SSQO)}; pg8::gemm_phase<pg8::EpiResidInit, pg8::StaticOrder, true, true>(F.lds + RING_OFF, g, S, E, F.wave); } \
        else { pg8::EpiResid E{(SRC), F.out, XB, (SSQO), 1.0f}; pg8::gemm_phase<pg8::EpiResid, pg8::StaticOrder, true, true>(F.lds + RING_OFF, g, S, E, F.wave); } } while (0)

    if (IN(0)) { convert_jobs<J_X | J_P | J_GU1 | J_GU2 | J_PROJ | J_AX | J_PG>(F, (int)blockIdx.x, F.G); SEAM(0); }
    if (IN(1)) { GEMM_SWIGLU(WS_WGU1);
        { int rank, count; side_workers((M / 256) * (NGU / 256), F.G, (int)blockIdx.x, rank, count); if (rank >= 0) convert_jobs<J_D1 | J_WIN | J_WOUT>(F, rank, count); }
        SEAM(1); }
    if (IN(2)) { GEMM_RESID(ACT, WS_WD1, DFF, F.in[I_X], SSQB); SEAM(2); }
    if (IN(3)) {
        pg8::Gemm g{XB, (const bf16*)(ws + WS_WINT), M, NIN, D}; pg8::StaticOrder S; S.init(M, NIN, F.G, (int)blockIdx.x);
        pg8::EpiZ E{SSQB, F.in[I_HLB], MIXA, (float*)(ws + WS_LOGF), (bf16*)(ws + WS_V), (bf16*)(ws + WS_SG), (bf16*)(ws + WS_LRX)};
        pg8::gemm_phase<pg8::EpiZ, pg8::StaticOrder, true, true>(F.lds + RING_OFF, g, S, E, F.wave);
        SEAM(3); }
    if (IN(4)) { MIXER_PHASE_4 SEAM(4); }
    if (IN(5)) { MIXER_PHASE_5 SEAM(5); }
    if (IN(6)) { MIXER_PHASE_6 SEAM(6); }
    if (IN(7)) { GEMM_RESID(MIXA, WS_WOUT, D, F.out, SSQA); SEAM(7); }
    if (IN(8)) { GEMM_SWIGLU(WS_WGU2);
        { int rank, count; side_workers((M / 256) * (NGU / 256), F.G, (int)blockIdx.x, rank, count);
          if (rank >= 0) {
              pg8::Gemm g{(const bf16*)(ws + WS_PB), (const bf16*)(ws + WS_WPROJ), M, D, PLE}; pg8::StaticOrder S; S.init(M, D, count, rank);
              pg8::EpiPP E{(bf16*)(ws + WS_PP)};
              pg8::gemm_phase<pg8::EpiPP, pg8::StaticOrder, true, true>(F.lds + RING_OFF, g, S, E, F.wave);
              convert_jobs<J_D2>(F, rank, count); } }
        SEAM(8); }
    if (IN(9)) { GEMM_RESID(ACT, WS_WD2, DFF, F.out, SSQB); SEAM(9); }
    if (IN(10)) {
        { pg8::Gemm g{XB, (const bf16*)(ws + WS_WPG), M, D, D}; pg8::StaticOrder S; S.init(M, D, F.G, (int)blockIdx.x);
          if (F.G == (M / 256) * (D / 256)) {
              pg8::EpiPLEFinal E{SSQB, F.in[I_PBG], (const bf16*)(ws + WS_PP), F.out, (float*)(ws + WS_XCH), (unsigned*)(F.ctl + CW_PANEL), F.in[I_FN]};
              pg8::gemm_phase<pg8::EpiPLEFinal, pg8::StaticOrder, false, true>(F.lds + RING_OFF, g, S, E, F.wave);
          } else {
              pg8::EpiPLE E{SSQB, F.in[I_PBG], (const bf16*)(ws + WS_PP), F.out, SSQA};
              pg8::gemm_phase<pg8::EpiPLE, pg8::StaticOrder, true, true>(F.lds + RING_OFF, g, S, E, F.wave); } }
        SEAM(10); }
    if (IN(11)) { if (F.G != (M / 256) * (D / 256)) final_norm(F, SSQA); SEAM(11); }
#undef IN
#undef SEAM
}

#if SIMPLE_HGRN
__global__ void __launch_bounds__(64) k_simple_hgrn(const float* logf, const bf16* mixa, const bf16* vv, float* oh) {
    __shared__ float sf[128], sk[128], sq[128];
    const int bh = blockIdx.x >> 1, vh = blockIdx.x & 1, b = bh >> 3, h = bh & 7, lane = threadIdx.x, v = vh * 64 + lane;
    float S[128];
#pragma unroll
    for (int k = 0; k < 128; ++k) S[k] = 0.f;
    for (int t = 0; t < SEQ; ++t) {
        const size_t row = (size_t)b * SEQ + t;
        for (int kk = lane; kk < 128; kk += 64) { const float f = __expf(logf[row * 1024 + h * 128 + kk]); sf[kk] = f; sk[kk] = 1.f - f; sq[kk] = bf2f(mixa[row * 2048 + h * 128 + kk]); }
        __syncthreads();
        const float vt = bf2f(vv[row * 1024 + h * 128 + v]); float o = 0.f;
#pragma unroll
        for (int k = 0; k < 128; ++k) { S[k] = sf[k] * S[k] + sk[k] * vt; o += S[k] * sq[k]; }
        oh[row * 1024 + h * 128 + v] = o;
        __syncthreads();
    }
}
__global__ void __launch_bounds__(256) k_simple_hnorm(const float* oh, const bf16* sg, const float* gn, bf16* mixa) {
    const int gw = (blockIdx.x * 256 + threadIdx.x) >> 6, lane = threadIdx.x & 63;
    if (gw >= M * HEADS) return;
    const int row = gw >> 3, h = gw & 7;
    const float o0 = oh[(size_t)row * 1024 + h * 128 + lane], o1 = oh[(size_t)row * 1024 + h * 128 + 64 + lane];
    const float ss = wave_sum(o0 * o0 + o1 * o1);
    const float r = 1.0f / sqrtf(ss * (1.0f / 128.0f) + EPS);
    mixa[(size_t)row * 2048 + h * 128 + lane] = (bf16)f2bf(o0 * r * gn[lane] * bf2f(sg[(size_t)row * 1024 + h * 128 + lane]));
    mixa[(size_t)row * 2048 + h * 128 + 64 + lane] = (bf16)f2bf(o1 * r * gn[64 + lane] * bf2f(sg[(size_t)row * 1024 + h * 128 + 64 + lane]));
}
#endif
#if SIMPLE_LRU
__global__ void __launch_bounds__(256) k_simple_lru_a(const bf16* lrx, const float* cw, const float* cb, const float* wa, const float* ba, const float* wx, const float* bx, const float* lam, float* LA, float* LU) {
    __shared__ float xc[1024];
    const int row = blockIdx.x, tt = row % SEQ, tid = threadIdx.x;
    for (int c = tid; c < 1024; c += 256) { float s = cb[c];
        for (int j = 0; j < 4; ++j) { const int ts = tt - 3 + j; if (ts >= 0) s += cw[j * 1024 + c] * bf2f(lrx[(size_t)(row - 3 + j) * 1024 + c]); }
        xc[c] = s; }
    __syncthreads();
    for (int d = tid; d < 1024; d += 256) { const int n = d >> 7, dd = d & 127; float r = ba[d], g = bx[d];
        for (int c = 0; c < 128; ++c) { const float x = xc[n * 128 + c]; r += x * wa[((size_t)n * 128 + c) * 128 + dd]; g += x * wx[((size_t)n * 128 + c) * 128 + dd]; }
        r = 1.0f / (1.0f + __expf(-r)); g = 1.0f / (1.0f + __expf(-g));
        const float log_a = -8.0f * r * log1pf(__expf(-lam[d]));
        LA[(size_t)row * 1024 + d] = __expf(log_a); LU[(size_t)row * 1024 + d] = sqrtf(-expm1f(2.0f * log_a)) * g * xc[d]; }
}
__global__ void __launch_bounds__(256) k_simple_lru_b(const float* LA, const float* LU, bf16* mixa) {
    const int gi = blockIdx.x * 256 + threadIdx.x, b = gi >> 10, c = gi & 1023; float h = 0.f;
#pragma unroll 8
    for (int t = 0; t < SEQ; ++t) { const size_t row = (size_t)b * SEQ + t; h = LA[row * 1024 + c] * h + LU[row * 1024 + c];
        bf16* p = mixa + row * 2048 + 1024 + c; *p = (bf16)f2bf(h * bf2f(*p)); }
}
#endif

extern "C" void kernel_launch(void* const* d_in, const int* in_sizes, int n_in, void* d_out, int out_size, void* d_ws, size_t ws_size, hipStream_t stream) {
    static int grid = 0;
    if (grid == 0) {
        if (n_in != N_IN || in_sizes[0] != M * D || out_size != M * D || ws_size < WS_END) { fprintf(stderr, "kernel_launch: unexpected problem (n_in %d, in0 %d, out %d, ws %zu); nothing launched\n", n_in, n_in > 0 ? in_sizes[0] : -1, out_size, ws_size); grid = -1; return; }
        int dev = 0, cus = 0, per_cu = 0;
        if (hipGetDevice(&dev) != hipSuccess || hipDeviceGetAttribute(&cus, hipDeviceAttributeMultiprocessorCount, dev) != hipSuccess) { grid = -1; return; }
        if (hipFuncSetAttribute((const void*)mega_fwd, hipFuncAttributeMaxDynamicSharedMemorySize, LDS_BYTES) != hipSuccess) { fprintf(stderr, "kernel_launch: hipFuncSetAttribute failed\n"); grid = -1; return; }
        if (hipOccupancyMaxActiveBlocksPerMultiprocessor(&per_cu, (const void*)mega_fwd, NWAVES * 64, LDS_BYTES) != hipSuccess || per_cu < 1)
            fprintf(stderr, "kernel_launch: note: occupancy query reports %d workgroups per CU\n", per_cu);
        (void)hipGetLastError();
        grid = cus;
    }
    if (grid < 0) return;
    if (hipMemsetAsync((char*)d_ws + WS_CTL, 0, CTL_ZERO_BYTES, stream) != hipSuccess) return;
    Args a{};
    for (int i = 0; i < N_IN; ++i) a.in[i] = (const float*)d_in[i];
    a.out = (float*)d_out; a.ws = (unsigned char*)d_ws;
    unsigned char* ws = (unsigned char*)d_ws;
    auto launch = [&](int lo, int hi, int li) { a.ph_lo = lo; a.ph_hi = hi; a.li = li; hipLaunchKernelGGL(mega_fwd, dim3(grid), dim3(NWAVES * 64), LDS_BYTES, stream, a); };
#if SIMPLE_HGRN || SIMPLE_LRU
    launch(0, 4, 0);
#if SIMPLE_HGRN
    {   float* OH = (float*)(ws + WS_XB);
        hipLaunchKernelGGL(k_simple_hgrn, dim3(64), dim3(64), 0, stream, (const float*)(ws + WS_LOGF), (const bf16*)(ws + WS_MIXA), (const bf16*)(ws + WS_V), OH);
        hipLaunchKernelGGL(k_simple_hnorm, dim3(M * HEADS / 4), dim3(256), 0, stream, (const float*)OH, (const bf16*)(ws + WS_SG), (const float*)d_in[I_HGN], (bf16*)(ws + WS_MIXA)); }
#endif
#if SIMPLE_LRU
    {   float* LA = (float*)(ws + WS_KVT); float* LU = LA + (size_t)M * 1024;
        hipLaunchKernelGGL(k_simple_lru_a, dim3(M), dim3(256), 0, stream, (const bf16*)(ws + WS_LRX), (const float*)d_in[I_CW], (const float*)d_in[I_CB], (const float*)d_in[I_LWA], (const float*)d_in[I_LBA],
                           (const float*)d_in[I_LWX], (const float*)d_in[I_LBX], (const float*)d_in[I_LAM], LA, LU);
        hipLaunchKernelGGL(k_simple_lru_b, dim3(BATCH * 1024 / 256), dim3(256), 0, stream, (const float*)LA, (const float*)LU, (bf16*)(ws + WS_MIXA)); }
#endif
    launch(4, N_PHASES, 1);
#else
#if N_LAUNCHES == 1
    launch(0, N_PHASES, 0);
#else
    for (int ph = 0; ph < N_PHASES; ++ph) launch(ph, ph + 1, 0);
#endif
#endif
}
```

```cpp
#include <hip/hip_runtime.h>
#include <cstdio>
#include <cstdint>
#ifndef SIMPLE_HGRN
#define SIMPLE_HGRN 0
#endif
#ifndef SIMPLE_LRU
#define SIMPLE_LRU 0
#endif
#ifndef N_LAUNCHES
#define N_LAUNCHES 1
#endif
#if SIMPLE_HGRN
#define MIXER_PHASE_4
#define MIXER_PHASE_6
#define MIXER_SCAN
#else
#define MIXER_PHASE_4 hgrn_local_phase(F);
#ifdef PROBE_H3
#define MIXER_PHASE_6 hgrn_out_phase(F, true); xcd_barrier(bar); hgrn_out_phase(F);
#else
#define MIXER_PHASE_6 hgrn_out_phase(F);
#endif
#ifdef PROBE_SCAN
#define MIXER_SCAN hgrn_scan_phase(F); xcd_barrier(bar); hgrn_scan_phase(F);
#else
#define MIXER_SCAN hgrn_scan_phase(F);
#endif
#endif
#if SIMPLE_LRU
#define MIXER_LRU
#else
#ifdef PROBE_LRU
#define MIXER_LRU lru_phase<PROBE_LRU, false, true>(F); xcd_barrier(bar); lru_phase<0>(F);
#else
#define MIXER_LRU lru_phase<0>(F);
#endif
#endif
#if !SIMPLE_HGRN && !SIMPLE_LRU && !defined(PROBE_LRU) && !defined(PROBE_SCAN)
#define MIXER_PHASE_5 if (F.G * NWAVES * 64 == BATCH * HEADS * 128 * 32 && F.G == BATCH * 64) { lru_phase<0, true>(F); } else { hgrn_scan_phase(F); lru_phase<0, false>(F); }
#else
#define MIXER_PHASE_5 MIXER_SCAN MIXER_LRU
#endif
namespace pg8 {
#define PG8_LAS __attribute__((address_space(3)))
typedef unsigned short bf16_t;
typedef short bf16x8 __attribute__((ext_vector_type(8)));
typedef float f32x4 __attribute__((ext_vector_type(4)));
typedef unsigned u32x4 __attribute__((ext_vector_type(4)));
constexpr int BM = 256, BK = 64, HALF = 128, HTB = HALF * BK * 2  , STAGE_BYTES = 8 * HTB, NXCD = 8, WGM = 8;

__host__ __device__ __forceinline__ int lds_byte(int r, int c) { const int st = (r >> 4) * 2 + (c >> 5), rr = r & 15, cc = c & 31, ob = rr * 64 + cc * 2; return st * 1024 + (ob ^ (((ob >> 9) & 1) << 5)); }
__host__ __device__ __forceinline__ void stage_rc(int b, int& R, int& C) { const int st = b / 1024, sb = b % 1024, swz = sb ^ (((sb >> 9) & 1) << 5); R = (st >> 1) * 16 + swz / 64; C = (st & 1) * 32 + (swz % 64) / 2; }
__host__ __device__ __forceinline__ int perm32(int rho) { const int n = rho >> 4, i = rho & 15; return 8 * (i >> 2) + 4 * n + (i & 3); }

struct Unit { int pm, pn; };
struct Gemm { const bf16_t* A; const bf16_t* Bt; int M, N, K; };

struct StaticOrder {
    int nM, nN, nwg, G, c;
    __host__ __device__ void init(int M, int N, int G_, int c_) { nM = M / BM; nN = N / BM; nwg = nM * nN; G = G_; c = c_; }
    __host__ __device__ bool next(int i, Unit& u) const {
        const long L = (long)i * G + c; if (L >= nwg) return false;
        int wgid = (int)L; { const int q = nwg / NXCD, r = nwg % NXCD, xcd = wgid % NXCD, off = wgid / NXCD; wgid = (xcd < r ? xcd * (q + 1) : r * (q + 1) + (xcd - r) * q) + off; }
        const int nig = WGM * nN, gid = wgid / nig, fm = gid * WGM, gsz = (nM - fm) < WGM ? (nM - fm) : WGM;
        u.pm = fm + ((wgid % nig) % gsz); u.pn = (wgid % nig) / gsz; return true;
    }
    __device__ __forceinline__ void a_ready(const Unit&) const {}
    __device__ __forceinline__ void done(const Unit&) const {}
};
__device__ __forceinline__ int lane_id_asm() { int l; asm volatile("v_mbcnt_lo_u32_b32 %0, -1, 0\n\tv_mbcnt_hi_u32_b32 %0, -1, %0" : "=v"(l)); return l; }
__device__ __forceinline__ unsigned cvt_pk_bf16(float lo, float hi) { unsigned r; asm volatile("v_cvt_pk_bf16_f32 %0, %1, %2" : "=v"(r) : "v"(lo), "v"(hi)); return r; }
typedef unsigned u32x2 __attribute__((ext_vector_type(2)));
constexpr int DM = 2048;
constexpr int NSSQ = 32;
__device__ __forceinline__ float sigmoid_f(float x) { return __builtin_amdgcn_rcpf(1.0f + __expf(-x)); }
__device__ __forceinline__ float silu_f(float x) { return x * sigmoid_f(x); }
__device__ __forceinline__ float gelu_tanh_f(float x) { return x * sigmoid_f(1.5957691216057308f * (x + 0.044715f * x * x * x)); }
__device__ __forceinline__ f32x4 bf16x4_to_f32(u32x2 w) { f32x4 r; r[0] = __builtin_bit_cast(float, w.x << 16); r[1] = __builtin_bit_cast(float, w.x & 0xffff0000u); r[2] = __builtin_bit_cast(float, w.y << 16); r[3] = __builtin_bit_cast(float, w.y & 0xffff0000u); return r; }
__device__ __forceinline__ void rows_rstd(const float* ssq, int row0, int fq, float (&rs)[2][4]) {
    f32x4 pa[2][4], pb[2][4];
#pragma unroll
    for (int ai = 0; ai < 2; ++ai)
#pragma unroll
        for (int m = 0; m < 4; ++m) { const f32x4* p = (const f32x4*)(ssq + (size_t)(row0 + ai * HALF + m * 16) * NSSQ + fq * 8); pa[ai][m] = p[0]; pb[ai][m] = p[1]; }
#pragma unroll
    for (int ai = 0; ai < 2; ++ai)
#pragma unroll
        for (int m = 0; m < 4; ++m) { const f32x4 a = pa[ai][m], b = pb[ai][m];
            float s = ((a[0] + a[1]) + (a[2] + a[3])) + ((b[0] + b[1]) + (b[2] + b[3]));
            s += __shfl_xor(s, 16); s += __shfl_xor(s, 32);
            rs[ai][m] = 1.0f / sqrtf(s * (1.0f / (float)DM) + 1e-6f); }
}

struct EpiSwiGLU {
    static constexpr bool PERM = true, AFTER_DRAIN = false, INIT_ACC = false;
    bf16_t* O; int ldo; const float* ssq;
    __device__ __forceinline__ void operator()(const f32x4 (&acc)[2][2][4][2], const Unit& u, int wr, int wc, int fr, int fq) const {
        const int row0 = u.pm * BM + wr * 64 + fr, col0 = u.pn * HALF + wc * 32 + 8 * fq;
        float rs[2][4]; rows_rstd(ssq, row0, fq, rs);
#pragma unroll
        for (int ai = 0; ai < 2; ++ai)
#pragma unroll
            for (int m = 0; m < 4; ++m) {
                const int row = row0 + ai * HALF + m * 16; const float r = rs[ai][m];
                float h[8];
#pragma unroll
                for (int n = 0; n < 2; ++n)
#pragma unroll
                    for (int j = 0; j < 4; ++j) { const float g = acc[ai][0][m][n][j] * r, up = acc[ai][1][m][n][j] * r; h[n * 4 + j] = silu_f(g) * up; }
                u32x4 w; w.x = cvt_pk_bf16(h[0], h[1]); w.y = cvt_pk_bf16(h[2], h[3]); w.z = cvt_pk_bf16(h[4], h[5]); w.w = cvt_pk_bf16(h[6], h[7]);
                *(u32x4*)(O + (size_t)row * ldo + col0) = w;
            }
    }
};
struct EpiResid {
    static constexpr bool PERM = false, AFTER_DRAIN = false, INIT_ACC = false;
    const float* src32; bf16_t* xb; float* ssq_out;
    __device__ __forceinline__ void operator()(const f32x4 (&acc)[2][2][4][2], const Unit& u, int wr, int wc, int fr, int fq) const {
        const int row0 = u.pm * BM + wr * 64 + fr, col0 = u.pn * BM + wc * 32 + 4 * fq;
#pragma unroll
        for (int ai = 0; ai < 2; ++ai)
#pragma unroll
            for (int m = 0; m < 4; ++m) {
                const int row = row0 + ai * HALF + m * 16; float ss = 0.f;
                f32x4 sv[2][2];
#pragma unroll
                for (int bj = 0; bj < 2; ++bj)
#pragma unroll
                    for (int n = 0; n < 2; ++n) { const size_t off = (size_t)row * DM + col0 + bj * HALF + n * 16; sv[bj][n] = src32 ? *(const f32x4*)(src32 + off) : bf16x4_to_f32(*(const u32x2*)(xb + off)); }
#pragma unroll
                for (int bj = 0; bj < 2; ++bj)
#pragma unroll
                    for (int n = 0; n < 2; ++n) { const size_t off = (size_t)row * DM + col0 + bj * HALF + n * 16;
                        const f32x4 o = sv[bj][n] + acc[ai][bj][m][n];
                        u32x2 w; w.x = cvt_pk_bf16(o[0], o[1]); w.y = cvt_pk_bf16(o[2], o[3]); *(u32x2*)(xb + off) = w;
                        ss += (o[0] * o[0] + o[1] * o[1]) + (o[2] * o[2] + o[3] * o[3]); }
                ss += __shfl_xor(ss, 16); ss += __shfl_xor(ss, 32);
                if (fq == 0) ssq_out[(size_t)row * NSSQ + u.pn * 4 + wc] = ss;
            }
    }
};
struct EpiResidInit {
    static constexpr bool PERM = false, AFTER_DRAIN = false, INIT_ACC = true;
    const float* src32; bf16_t* xb; float* ssq_out;
    __device__ __forceinline__ void init_acc(f32x4 (&acc)[2][2][4][2], const Unit& u, int wr, int wc, int fr, int fq) const {
        const int row0 = u.pm * BM + wr * 64 + fr, col0 = u.pn * BM + wc * 32 + 4 * fq;
        if (src32) {
#pragma unroll
            for (int ai = 0; ai < 2; ++ai)
#pragma unroll
                for (int m = 0; m < 4; ++m)
#pragma unroll
                    for (int bj = 0; bj < 2; ++bj)
#pragma unroll
                        for (int n = 0; n < 2; ++n) acc[ai][bj][m][n] = __builtin_nontemporal_load((const f32x4*)(src32 + (size_t)(row0 + ai * HALF + m * 16) * DM + col0 + bj * HALF + n * 16));
        } else {
#pragma unroll
            for (int ai = 0; ai < 2; ++ai)
#pragma unroll
                for (int m = 0; m < 4; ++m)
#pragma unroll
                    for (int bj = 0; bj < 2; ++bj)
#pragma unroll
                        for (int n = 0; n < 2; ++n) { const u32x2 h = *(const u32x2*)(xb + (size_t)(row0 + ai * HALF + m * 16) * DM + col0 + bj * HALF + n * 16);
                            acc[ai][bj][m][n] = __builtin_bit_cast(f32x4, (u32x4){h.x, h.y, 0u, 0u}); }
#pragma unroll
            for (int ai = 0; ai < 2; ++ai)
#pragma unroll
                for (int m = 0; m < 4; ++m)
#pragma unroll
                    for (int bj = 0; bj < 2; ++bj)
#pragma unroll
                        for (int n = 0; n < 2; ++n) { const u32x4 r = __builtin_bit_cast(u32x4, acc[ai][bj][m][n]); acc[ai][bj][m][n] = bf16x4_to_f32((u32x2){r.x, r.y}); }
        }
    }
    __device__ __forceinline__ void operator()(const f32x4 (&acc)[2][2][4][2], const Unit& u, int wr, int wc, int fr, int fq) const {
        const int row0 = u.pm * BM + wr * 64 + fr, col0 = u.pn * BM + wc * 32 + 4 * fq;
#pragma unroll
        for (int ai = 0; ai < 2; ++ai)
#pragma unroll
            for (int m = 0; m < 4; ++m) {
                const int row = row0 + ai * HALF + m * 16; float ss = 0.f;
#pragma unroll
                for (int bj = 0; bj < 2; ++bj)
#pragma unroll
                    for (int n = 0; n < 2; ++n) { const size_t off = (size_t)row * DM + col0 + bj * HALF + n * 16;
                        const f32x4 o = acc[ai][bj][m][n];
                        u32x2 w; w.x = cvt_pk_bf16(o[0], o[1]); w.y = cvt_pk_bf16(o[2], o[3]); *(u32x2*)(xb + off) = w;
                        ss += (o[0] * o[0] + o[1] * o[1]) + (o[2] * o[2] + o[3] * o[3]); }
                ss += __shfl_xor(ss, 16); ss += __shfl_xor(ss, 32);
                if (fq == 0) ssq_out[(size_t)row * NSSQ + u.pn * 4 + wc] = ss;
            }
    }
};
struct EpiZ {
    static constexpr bool PERM = true, AFTER_DRAIN = false, INIT_ACC = false;
    const float* ssq; const float* hlb;
    bf16_t* mixa;
    float* logf; bf16_t* vv; bf16_t* sg; bf16_t* lrx;
    __device__ __forceinline__ void operator()(const f32x4 (&acc)[2][2][4][2], const Unit& u, int wr, int wc, int fr, int fq) const {
        const int seg = u.pn >> 2;
        const int row0 = u.pm * BM + wr * 64 + fr, cs0 = (u.pn & 3) * BM + wc * 32 + 8 * fq;
        float rs[2][4]; rows_rstd(ssq, row0, fq, rs);
        float lbv[2][8];
        if (seg == 1) {
#pragma unroll
            for (int bj = 0; bj < 2; ++bj)
#pragma unroll
                for (int e = 0; e < 8; ++e) { const int c = cs0 + bj * HALF + e; lbv[bj][e] = sigmoid_f(hlb[c] - hlb[1024 + c]); }
        }
#pragma unroll
        for (int ai = 0; ai < 2; ++ai)
#pragma unroll
            for (int m = 0; m < 4; ++m) {
                const int row = row0 + ai * HALF + m * 16; const float r = rs[ai][m];
#pragma unroll
                for (int bj = 0; bj < 2; ++bj) {
                    const int cs = cs0 + bj * HALF;
                    float z[8];
#pragma unroll
                    for (int n = 0; n < 2; ++n)
#pragma unroll
                        for (int j = 0; j < 4; ++j) z[n * 4 + j] = acc[ai][bj][m][n][j] * r;
                    if (seg == 1) {
                        float lf[8];
#pragma unroll
                        for (int e = 0; e < 8; ++e) { const float lb = lbv[bj][e]; lf[e] = __logf(lb + (1.0f - lb) * sigmoid_f(z[e])); }
                        float* p = logf + (size_t)row * 1024 + cs;
                        *(f32x4*)p = (f32x4){lf[0], lf[1], lf[2], lf[3]}; *(f32x4*)(p + 4) = (f32x4){lf[4], lf[5], lf[6], lf[7]};
                    } else {
                        if (seg == 3) {
#pragma unroll
                            for (int e = 0; e < 8; ++e) z[e] = silu_f(z[e]);
                        } else if (seg == 5) {
#pragma unroll
                            for (int e = 0; e < 8; ++e) z[e] = gelu_tanh_f(z[e]);
                        }
                        u32x4 w; w.x = cvt_pk_bf16(z[0], z[1]); w.y = cvt_pk_bf16(z[2], z[3]); w.z = cvt_pk_bf16(z[4], z[5]); w.w = cvt_pk_bf16(z[6], z[7]);
                        bf16_t* p;
                        if (seg == 0) p = mixa + (size_t)row * 2048 + cs;
                        else if (seg == 5) p = mixa + (size_t)row * 2048 + 1024 + cs;
                        else if (seg == 2) p = vv + (size_t)row * 1024 + cs;
                        else if (seg == 3) p = sg + (size_t)row * 1024 + cs;
                        else p = lrx + (size_t)row * 1024 + cs;
                        *(u32x4*)p = w;
                    }
                }
            }
    }
};
struct EpiPP {
    static constexpr bool PERM = false, AFTER_DRAIN = false, INIT_ACC = false;
    bf16_t* PP;
    __device__ __forceinline__ void operator()(const f32x4 (&acc)[2][2][4][2], const Unit& u, int wr, int wc, int fr, int fq) const {
        const int row0 = u.pm * BM + wr * 64 + fr, col0 = u.pn * BM + wc * 32 + 4 * fq;
#pragma unroll
        for (int ai = 0; ai < 2; ++ai)
#pragma unroll
            for (int m = 0; m < 4; ++m) { bf16_t* rowp = PP + (size_t)(row0 + ai * HALF + m * 16) * DM + col0;
#pragma unroll
                for (int bj = 0; bj < 2; ++bj)
#pragma unroll
                    for (int n = 0; n < 2; ++n) { const f32x4 a = acc[ai][bj][m][n]; u32x2 w; w.x = cvt_pk_bf16(a[0], a[1]); w.y = cvt_pk_bf16(a[2], a[3]); *(u32x2*)(rowp + bj * HALF + n * 16) = w; } }
    }
};
struct EpiPLE {
    static constexpr bool PERM = false, AFTER_DRAIN = false, INIT_ACC = false;
    const float* ssq_in; const float* bg; const bf16_t* PP; const bf16_t* xb; float* X; float* ssq_out;
    __device__ __forceinline__ void operator()(const f32x4 (&acc)[2][2][4][2], const Unit& u, int wr, int wc, int fr, int fq) const {
        const int row0 = u.pm * BM + wr * 64 + fr, col0 = u.pn * BM + wc * 32 + 4 * fq;
        float rs[2][4]; rows_rstd(ssq_in, row0, fq, rs);
#pragma unroll
        for (int ai = 0; ai < 2; ++ai)
#pragma unroll
            for (int m = 0; m < 4; ++m) {
                const int row = row0 + ai * HALF + m * 16; const float r = rs[ai][m]; float ss = 0.f;
                f32x4 pv[2][2], ov[2][2];
#pragma unroll
                for (int bj = 0; bj < 2; ++bj)
#pragma unroll
                    for (int n = 0; n < 2; ++n) { const size_t off = (size_t)row * DM + col0 + bj * HALF + n * 16; pv[bj][n] = bf16x4_to_f32(*(const u32x2*)(PP + off)); ov[bj][n] = bf16x4_to_f32(*(const u32x2*)(xb + off)); }
#pragma unroll
                for (int bj = 0; bj < 2; ++bj)
#pragma unroll
                    for (int n = 0; n < 2; ++n) { const int c = col0 + bj * HALF + n * 16; const size_t off = (size_t)row * DM + c;
                        const f32x4 b4 = *(const f32x4*)(bg + c), a = acc[ai][bj][m][n]; f32x4 o;
#pragma unroll
                        for (int j = 0; j < 4; ++j) o[j] = ov[bj][n][j] + sigmoid_f(a[j] * r + b4[j]) * pv[bj][n][j];
                        *(f32x4*)(X + off) = o; ss += (o[0] * o[0] + o[1] * o[1]) + (o[2] * o[2] + o[3] * o[3]); }
                ss += __shfl_xor(ss, 16); ss += __shfl_xor(ss, 32);
                if (fq == 0) ssq_out[(size_t)row * NSSQ + u.pn * 4 + wc] = ss;
            }
    }
};

struct EpiPLEFinal {
    static constexpr bool PERM = false, AFTER_DRAIN = true, INIT_ACC = false;
    const float* ssq_in; const float* bg; const bf16_t* PP; const bf16_t* xb; float* X; float* xch; unsigned* cnt; const float* gf;
    __device__ __forceinline__ void operator()(const f32x4 (&)[2][2][4][2], const Unit&, int, int, int, int) const {}
    __device__ __forceinline__ void fused(f32x4 (&acc)[2][2][4][2], const Unit& u, int wr, int wc, int fr, int fq, PG8_LAS unsigned char* lds, int wid, int lane) const {
        const int row0 = u.pm * BM + wr * 64 + fr, col0 = u.pn * BM + wc * 32 + 4 * fq;
        float rs[2][4]; rows_rstd(ssq_in, row0, fq, rs);
        f32x4 b4[2][2];
#pragma unroll
        for (int bj = 0; bj < 2; ++bj)
#pragma unroll
            for (int n = 0; n < 2; ++n) b4[bj][n] = *(const f32x4*)(bg + col0 + bj * HALF + n * 16);
#pragma unroll
        for (int ai = 0; ai < 2; ++ai)
#pragma unroll
          for (int mp = 0; mp < 2; ++mp) {
            u32x2 pv[2][2][2], ov[2][2][2];
#pragma unroll
            for (int mm = 0; mm < 2; ++mm)
#pragma unroll
                for (int bj = 0; bj < 2; ++bj)
#pragma unroll
                    for (int n = 0; n < 2; ++n) { const size_t off = (size_t)(row0 + ai * HALF + (2 * mp + mm) * 16) * DM + col0 + bj * HALF + n * 16; pv[mm][bj][n] = *(const u32x2*)(PP + off); ov[mm][bj][n] = *(const u32x2*)(xb + off); }
#pragma unroll
            for (int mm = 0; mm < 2; ++mm) {
                const int m = 2 * mp + mm, row = row0 + ai * HALF + m * 16; const float r = rs[ai][m]; float ss = 0.f;
#pragma unroll
                for (int bj = 0; bj < 2; ++bj)
#pragma unroll
                    for (int n = 0; n < 2; ++n) { const f32x4 a = acc[ai][bj][m][n], pp = bf16x4_to_f32(pv[mm][bj][n]), xo = bf16x4_to_f32(ov[mm][bj][n]); f32x4 o;
#pragma unroll
                        for (int j = 0; j < 4; ++j) o[j] = xo[j] + sigmoid_f(a[j] * r + b4[bj][n][j]) * pp[j];
                        acc[ai][bj][m][n] = o; ss += (o[0] * o[0] + o[1] * o[1]) + (o[2] * o[2] + o[3] * o[3]); }
                ss += __shfl_xor(ss, 16); ss += __shfl_xor(ss, 32);
                if (fq == 0) __hip_atomic_store(xch + (size_t)row * NSSQ + u.pn * 4 + wc, ss, __ATOMIC_RELAXED, __HIP_MEMORY_SCOPE_AGENT);
            }
          }
        asm volatile("s_waitcnt vmcnt(0)" ::: "memory");
        unsigned* pc = cnt + 64 * u.pm;
        if (lane == 0) __hip_atomic_fetch_add(pc, 1u, __ATOMIC_RELAXED, __HIP_MEMORY_SCOPE_AGENT);
        if (wid == 0) {
            unsigned sp = 0;
            while ((unsigned)__builtin_amdgcn_readfirstlane(__hip_atomic_load(pc, __ATOMIC_RELAXED, __HIP_MEMORY_SCOPE_AGENT)) < 64u) { __builtin_amdgcn_s_sleep(2); if (++sp > (1u << 22)) break; }
            __builtin_amdgcn_fence(__ATOMIC_ACQUIRE, "agent");
        }
        asm volatile("s_waitcnt vmcnt(0) lgkmcnt(0)" ::: "memory"); __builtin_amdgcn_s_barrier(); asm volatile("" ::: "memory");
        float r4[2][4]; rows_rstd(xch, row0, fq, r4);
        f32x4 g4[2][2];
#pragma unroll
        for (int bj = 0; bj < 2; ++bj)
#pragma unroll
            for (int n = 0; n < 2; ++n) g4[bj][n] = *(const f32x4*)(gf + col0 + bj * HALF + n * 16);
#pragma unroll
        for (int ai = 0; ai < 2; ++ai)
#pragma unroll
            for (int m = 0; m < 4; ++m) { float* rowp = X + (size_t)(row0 + ai * HALF + m * 16) * DM + col0; const float r = r4[ai][m];
#pragma unroll
                for (int bj = 0; bj < 2; ++bj)
#pragma unroll
                    for (int n = 0; n < 2; ++n) *(f32x4*)(rowp + bj * HALF + n * 16) = acc[ai][bj][m][n] * r * g4[bj][n]; }
    }
};

template <class Epi, class Sched, bool ALIGN_EPI = false, bool SP2 = false, bool BAL = false>
__device__ __forceinline__ void gemm_phase(PG8_LAS unsigned char* lds, const Gemm g, const Sched& S, const Epi& E, const int wave_s) {
    int tid_ = wave_s * 64 + lane_id_asm();
    const int tid = tid_, wid = wave_s, lane = tid & 63, wr = wid >> 2, wc = wid & 3, fr = lane & 15, fq = lane >> 4;
    const int K = g.K, nt = K / BK;
    unsigned voffA[2], voffB[2];
#pragma unroll
    for (int i = 0; i < 2; ++i) { int R, C; stage_rc(tid * 16 + i * 8192, R, C); const int Rb = Epi::PERM ? ((R & ~31) + perm32(R & 31)) : R;
        voffA[i] = (unsigned)(R * K + C) * 2u; voffB[i] = (unsigned)(Rb * K + C) * 2u; }
    const size_t kstep = (size_t)(BK * 2);
    const size_t hstep = (size_t)HALF * K * 2;
    const size_t tstep = 2 * hstep;
    const unsigned ldsw = (unsigned)wid * 1024u;
    const int aoff = lds_byte(wr * 64 + fr, fq * 8), boff = lds_byte(wc * 32 + fr, fq * 8);
#define PG8_SA(b, h) (((b) * 2 + (h)) * HTB)
#define PG8_SB(b, h) ((4 + (b) * 2 + (h)) * HTB)
#define PG8_STAGE(bufoff, gbase, voff) do { _Pragma("unroll") for (int _i = 0; _i < 2; ++_i) \
        __builtin_amdgcn_global_load_lds((const unsigned*)((const char*)(gbase) + (voff)[_i]), (PG8_LAS unsigned*)(lds + (bufoff) + ldsw + _i * 8192), 16, 0, 0); } while (0)
#define PG8_LDA(dst, b, h) do { _Pragma("unroll") for (int m = 0; m < 4; ++m) _Pragma("unroll") for (int k = 0; k < 2; ++k) dst[m][k] = *(const PG8_LAS bf16x8*)(lds + PG8_SA(b, h) + aoff + m * 2048 + k * 1024); } while (0)
#define PG8_LDB(dst, b, h) do { _Pragma("unroll") for (int n = 0; n < 2; ++n) _Pragma("unroll") for (int k = 0; k < 2; ++k) dst[n][k] = *(const PG8_LAS bf16x8*)(lds + PG8_SB(b, h) + boff + n * 2048 + k * 1024); } while (0)
#define PG8_MMA(ai, bj, At, Bt) do { __builtin_amdgcn_s_setprio(1); _Pragma("unroll") for (int m = 0; m < 4; ++m) _Pragma("unroll") for (int n = 0; n < 2; ++n) _Pragma("unroll") for (int k = 0; k < 2; ++k) \
        acc[ai][bj][m][n] = __builtin_amdgcn_mfma_f32_16x16x32_bf16(Bt[n][k], At[m][k], acc[ai][bj][m][n], 0, 0, 0); __builtin_amdgcn_s_setprio(0); } while (0)
#define PG8_WAIT_V(n) asm volatile("s_waitcnt vmcnt(" #n ")" ::: "memory")
#define PG8_WAIT_L(n) asm volatile("s_waitcnt lgkmcnt(" #n ")" ::: "memory")
#define PG8_BAR __builtin_amdgcn_s_barrier()
#define PG8_SCHED __builtin_amdgcn_sched_barrier(0)
    Unit cur, nxt; int ui = 0;
    if (!S.next(0, cur)) return;
    f32x4 acc[2][2][4][2];
    if constexpr (Epi::INIT_ACC) { E.init_acc(acc, cur, wr, wc, fr, fq); }
    else {
#pragma unroll
    for (int a = 0; a < 2; ++a)
#pragma unroll
        for (int b = 0; b < 2; ++b)
#pragma unroll
            for (int m = 0; m < 4; ++m)
#pragma unroll
                for (int n = 0; n < 2; ++n) acc[a][b][m][n] = (f32x4){0.f, 0.f, 0.f, 0.f};
    }
    bf16x8 At[4][2], B0[2][2], B1[2][2];
    const char* cA = (const char*)g.A + (size_t)cur.pm * tstep; const char* cB = (const char*)g.Bt + (size_t)cur.pn * tstep;
    S.a_ready(cur);
    if constexpr (SP2) {
        PG8_STAGE(PG8_SB(0, 0), cB, voffB); PG8_STAGE(PG8_SB(0, 1), cB + hstep, voffB); PG8_STAGE(PG8_SA(0, 0), cA, voffA); PG8_STAGE(PG8_SA(0, 1), cA + hstep, voffA);
        if (wr == 1) PG8_BAR;
        PG8_WAIT_V(2); PG8_BAR;
        if constexpr (BAL) {
            PG8_STAGE(PG8_SB(1, 0), cB + kstep, voffB); PG8_STAGE(PG8_SB(1, 1), cB + hstep + kstep, voffB);
            PG8_WAIT_V(4); PG8_BAR;
        } else {
        PG8_STAGE(PG8_SB(1, 0), cB + kstep, voffB); PG8_STAGE(PG8_SA(1, 0), cA + kstep, voffA); PG8_STAGE(PG8_SB(1, 1), cB + hstep + kstep, voffB);
        PG8_WAIT_V(6); PG8_BAR;
        }
    } else {
        PG8_STAGE(PG8_SB(0, 0), cB, voffB); PG8_STAGE(PG8_SA(0, 0), cA, voffA); PG8_STAGE(PG8_SB(0, 1), cB + hstep, voffB); PG8_STAGE(PG8_SA(0, 1), cA + hstep, voffA);
        if (wr == 1) PG8_BAR;
        PG8_WAIT_V(4); PG8_BAR;
        PG8_STAGE(PG8_SB(1, 0), cB + kstep, voffB); PG8_STAGE(PG8_SA(1, 0), cA + kstep, voffA); PG8_STAGE(PG8_SB(1, 1), cB + hstep + kstep, voffB);
        PG8_WAIT_V(6); PG8_BAR;
    }
    for (;;) {
        const bool has_next = S.next(ui + 1, nxt);
        const char* nA = has_next ? (const char*)g.A + (size_t)nxt.pm * tstep : cA; const char* nB = has_next ? (const char*)g.Bt + (size_t)nxt.pn * tstep : cB;
        for (int t = 0; t < nt; t += 2) {
            const bool last = (t == nt - 2);
            const char* a1 = cA + (size_t)(t + 1) * kstep;
            const char* a2 = last ? nA : cA + (size_t)(t + 2) * kstep; const char* b2 = last ? nB : cB + (size_t)(t + 2) * kstep;
            const char* a3 = a2 + kstep; const char* b3 = b2 + kstep;
            if (last && has_next) S.a_ready(nxt);
            if constexpr (SP2 && BAL) {
            PG8_LDB(B0, 0, 0); PG8_LDB(B1, 0, 1); PG8_SCHED; PG8_LDA(At, 0, 0); PG8_STAGE(PG8_SA(1, 0), a1, voffA); PG8_STAGE(PG8_SA(1, 1), a1 + hstep, voffA);
            PG8_WAIT_V(4); PG8_WAIT_L(0); PG8_BAR; PG8_MMA(0, 0, At, B0); PG8_MMA(0, 1, At, B1); PG8_BAR; PG8_SCHED;
            PG8_LDA(At, 0, 1); PG8_STAGE(PG8_SB(0, 0), b2, voffB); PG8_STAGE(PG8_SB(0, 1), b2 + hstep, voffB);
            PG8_WAIT_V(4); PG8_WAIT_L(0); PG8_BAR; PG8_MMA(1, 0, At, B0); PG8_MMA(1, 1, At, B1); PG8_BAR; PG8_SCHED;
            PG8_LDB(B0, 1, 0); PG8_LDB(B1, 1, 1); PG8_SCHED; PG8_LDA(At, 1, 0); PG8_STAGE(PG8_SA(0, 0), a2, voffA); PG8_STAGE(PG8_SA(0, 1), a2 + hstep, voffA);
            PG8_WAIT_V(4); PG8_WAIT_L(0); PG8_BAR; PG8_MMA(0, 0, At, B0); PG8_MMA(0, 1, At, B1); PG8_BAR; PG8_SCHED;
            PG8_LDA(At, 1, 1); PG8_STAGE(PG8_SB(1, 0), b3, voffB); PG8_STAGE(PG8_SB(1, 1), b3 + hstep, voffB);
            PG8_WAIT_V(4); PG8_WAIT_L(0); PG8_BAR; PG8_MMA(1, 0, At, B0); PG8_MMA(1, 1, At, B1); PG8_BAR; PG8_SCHED;
            } else if constexpr (SP2) {
            PG8_LDB(B0, 0, 0); PG8_LDB(B1, 0, 1); PG8_SCHED; PG8_LDA(At, 0, 0); PG8_STAGE(PG8_SA(1, 1), a1 + hstep, voffA);
            PG8_WAIT_V(8); PG8_WAIT_L(0); PG8_BAR; PG8_MMA(0, 0, At, B0); PG8_MMA(0, 1, At, B1); PG8_BAR; PG8_SCHED;
            PG8_LDA(At, 0, 1); PG8_STAGE(PG8_SB(0, 0), b2, voffB); PG8_STAGE(PG8_SB(0, 1), b2 + hstep, voffB); PG8_STAGE(PG8_SA(0, 0), a2, voffA);
            PG8_WAIT_V(8); PG8_WAIT_L(0); PG8_BAR; PG8_MMA(1, 0, At, B0); PG8_MMA(1, 1, At, B1); PG8_BAR; PG8_SCHED;
            PG8_LDB(B0, 1, 0); PG8_LDB(B1, 1, 1); PG8_SCHED; PG8_LDA(At, 1, 0); PG8_STAGE(PG8_SA(0, 1), a2 + hstep, voffA);
            PG8_WAIT_V(8); PG8_WAIT_L(0); PG8_BAR; PG8_MMA(0, 0, At, B0); PG8_MMA(0, 1, At, B1); PG8_BAR; PG8_SCHED;
            PG8_LDA(At, 1, 1); PG8_STAGE(PG8_SB(1, 0), b3, voffB); PG8_STAGE(PG8_SB(1, 1), b3 + hstep, voffB); PG8_STAGE(PG8_SA(1, 0), a3, voffA);
            PG8_WAIT_V(8); PG8_WAIT_L(0); PG8_BAR; PG8_MMA(1, 0, At, B0); PG8_MMA(1, 1, At, B1); PG8_BAR; PG8_SCHED;
            } else {
            PG8_LDB(B0, 0, 0); PG8_SCHED; PG8_LDA(At, 0, 0); PG8_STAGE(PG8_SA(1, 1), a1 + hstep, voffA);
            PG8_WAIT_L(8); PG8_BAR; PG8_WAIT_L(0); PG8_MMA(0, 0, At, B0); PG8_BAR; PG8_SCHED;
            PG8_LDB(B1, 0, 1); PG8_STAGE(PG8_SB(0, 0), b2, voffB);
            PG8_BAR; PG8_WAIT_L(0); PG8_MMA(0, 1, At, B1); PG8_BAR;
            PG8_LDA(At, 0, 1); PG8_STAGE(PG8_SA(0, 0), a2, voffA);
            PG8_BAR; PG8_WAIT_L(0); PG8_MMA(1, 0, At, B0); PG8_BAR; PG8_SCHED;
            PG8_STAGE(PG8_SB(0, 1), b2 + hstep, voffB);
            PG8_WAIT_V(6); PG8_BAR; PG8_MMA(1, 1, At, B1); PG8_BAR;
            PG8_LDB(B0, 1, 0); PG8_SCHED; PG8_LDA(At, 1, 0); PG8_STAGE(PG8_SA(0, 1), a2 + hstep, voffA);
            PG8_WAIT_L(8); PG8_BAR; PG8_WAIT_L(0); PG8_MMA(0, 0, At, B0); PG8_BAR; PG8_SCHED;
            PG8_LDB(B1, 1, 1); PG8_STAGE(PG8_SB(1, 0), b3, voffB);
            PG8_BAR; PG8_WAIT_L(0); PG8_MMA(0, 1, At, B1); PG8_BAR;
            PG8_LDA(At, 1, 1); PG8_STAGE(PG8_SA(1, 0), a3, voffA);
            PG8_BAR; PG8_WAIT_L(0); PG8_MMA(1, 0, At, B0); PG8_BAR; PG8_SCHED;
            PG8_STAGE(PG8_SB(1, 1), b3 + hstep, voffB);
            PG8_WAIT_V(6); PG8_BAR; PG8_MMA(1, 1, At, B1); PG8_BAR;
            }
        }
        if constexpr (ALIGN_EPI) { if (wr == 0) PG8_BAR; }
        if constexpr (!Epi::AFTER_DRAIN) { E(acc, cur, wr, wc, fr, fq); S.done(cur); }
        if (!has_next) break;
#pragma unroll
        for (int a = 0; a < 2; ++a)
#pragma unroll
            for (int b = 0; b < 2; ++b)
#pragma unroll
                for (int m = 0; m < 4; ++m)
#pragma unroll
                    for (int n = 0; n < 2; ++n) acc[a][b][m][n] = (f32x4){0.f, 0.f, 0.f, 0.f};
        cur = nxt; cA = nA; cB = nB; ++ui;
        if constexpr (ALIGN_EPI) { if (wr == 1) PG8_BAR; }
    }
    PG8_WAIT_V(0);
    if constexpr (!ALIGN_EPI) { if (wr == 0) PG8_BAR; }
    PG8_BAR;
    if constexpr (Epi::AFTER_DRAIN) { E.fused(acc, cur, wr, wc, fr, fq, lds, wid, lane); S.done(cur); }
#undef PG8_SA
#undef PG8_SB
#undef PG8_STAGE
#undef PG8_LDA
#undef PG8_LDB
#undef PG8_MMA
#undef PG8_WAIT_V
#undef PG8_WAIT_L
#undef PG8_BAR
#undef PG8_SCHED
}
}
#define GAS __attribute__((address_space(1)))
#define LAS __attribute__((address_space(3)))
typedef unsigned short bf16;
typedef unsigned v4u __attribute__((ext_vector_type(4)));
typedef float f32x4 __attribute__((ext_vector_type(4)));
typedef short bf16x8 __attribute__((ext_vector_type(8)));
typedef GAS unsigned gu32;
typedef GAS unsigned long long gu64;
#define RLX_AGENT __ATOMIC_RELAXED, __HIP_MEMORY_SCOPE_AGENT
#define LDS_WAIT() asm volatile("s_waitcnt lgkmcnt(0)" ::: "memory")
#define VM_WAIT() asm volatile("s_waitcnt vmcnt(0)" ::: "memory")
__device__ __forceinline__ unsigned long long rt() { return __builtin_amdgcn_s_memrealtime(); }
__device__ __forceinline__ unsigned f2bf(float f) { unsigned u = __builtin_bit_cast(unsigned, f); return (u + 0x7fffu + ((u >> 16) & 1u)) >> 16; }
__device__ __forceinline__ unsigned pk2(float lo, float hi) { return f2bf(lo) | (f2bf(hi) << 16); }

#define XB_TMO      128
#define XB_XCNT(j)  (256  + 64 * (j))
#define XB_XSUB(j)  (1280 + 64 * (j))
#define XB_XGEN(j)  (2304 + 64 * (j))
#define XB_TOP      3328
#define XB_TOPGEN   3392
#define XCD_BAR_WORDS 3456
#define XB_SPIN_CAP (1u << 18)

__device__ __forceinline__ unsigned xb_ld(unsigned* p)              { return __hip_atomic_load(p, __ATOMIC_RELAXED, __HIP_MEMORY_SCOPE_AGENT); }
__device__ __forceinline__ unsigned xb_add(unsigned* p, unsigned v) { return __hip_atomic_fetch_add(p, v, __ATOMIC_RELAXED, __HIP_MEMORY_SCOPE_AGENT); }
__device__ __forceinline__ unsigned xb_xcc_id() { return (unsigned)__builtin_amdgcn_s_getreg((3 << 11) | 20) & 0xFu; }
#define XB_SPIN(cond, bar) do { unsigned _sp = 0; while (cond) { __builtin_amdgcn_s_sleep(1); \
    if ((++_sp & 255u) == 0u) { if (xb_ld(&(bar)[XB_TMO])) break; if (_sp > XB_SPIN_CAP) { atomicAdd(&(bar)[XB_TMO], 1u); break; } } } } while (0)

struct XcdBarrier {
    unsigned* bar; unsigned x; int wave;
    volatile LAS unsigned* st;
};

__device__ __forceinline__ XcdBarrier xcd_barrier_post(unsigned* bar, volatile LAS unsigned* st, int wave) {
    XcdBarrier b; b.bar = bar; b.x = xb_xcc_id(); b.st = st; b.wave = wave;
    if (wave == 0 && pg8::lane_id_asm() == 0) (void)xb_add(&bar[XB_XCNT(b.x)], 1u);
    return b;
}
__device__ __forceinline__ void xcd_barrier_complete(unsigned* bar, unsigned x, unsigned& nloc, unsigned& nx) {
    const unsigned G = gridDim.x * gridDim.y * gridDim.z;
    unsigned sum, cnt, mine, sp = 0u;
    for (;;) {
        sum = 0u; cnt = 0u; mine = 0u;
#pragma unroll
        for (unsigned j = 0; j < 16; ++j) { const unsigned c = xb_ld(&bar[XB_XCNT(j)]); sum += c; cnt += (c > 0u) ? 1u : 0u; mine = (j == x) ? c : mine; }
        if (sum == G) break;
        __builtin_amdgcn_s_sleep(1);
        if ((++sp & 255u) == 0u) { if (xb_ld(&bar[XB_TMO])) break; if (sp > XB_SPIN_CAP) { atomicAdd(&bar[XB_TMO], 1u); break; } }
    }
    nloc = mine > 0u ? mine : 1u; nx = cnt > 0u ? cnt : 1u;
}

__device__ __forceinline__ void xcd_barrier(const XcdBarrier& b) {
    asm volatile("s_waitcnt vmcnt(0)" ::: "memory");
    __syncthreads();
    if (b.wave == 0 && pg8::lane_id_asm() == 0) {
        unsigned* bar = b.bar;
        __builtin_amdgcn_s_waitcnt(0);
        unsigned nloc = b.st[0], nx = b.st[1];
        if (nloc == 0u) { xcd_barrier_complete(bar, b.x, nloc, nx); b.st[0] = nloc; b.st[1] = nx; }
        const unsigned old = xb_add(&bar[XB_XSUB(b.x)], 1u);
        const unsigned gen = old / nloc;
        if (old + 1u == (gen + 1u) * nloc) {
            __builtin_amdgcn_fence(__ATOMIC_RELEASE, "agent");
            asm volatile("s_waitcnt vmcnt(0)" ::: "memory");
            const unsigned og = xb_add(&bar[XB_TOP], 1u);
            const unsigned tg = og / nx;
            if (og + 1u == (tg + 1u) * nx) xb_add(&bar[XB_TOPGEN], 1u);
            else XB_SPIN(xb_ld(&bar[XB_TOPGEN]) == tg, bar);
            __builtin_amdgcn_fence(__ATOMIC_ACQUIRE, "agent");
            xb_add(&bar[XB_XGEN(b.x)], 1u);
            asm volatile("s_waitcnt vmcnt(0)" ::: "memory");
        } else {
            XB_SPIN(xb_ld(&bar[XB_XGEN(b.x)]) == gen, bar);
            __builtin_amdgcn_fence(__ATOMIC_ACQUIRE, "agent");
            asm volatile("s_waitcnt vmcnt(0)" ::: "memory");
        }
    }
    __syncthreads();
}

constexpr int NWAVES = 8;
constexpr int BATCH = 4, SEQ = 2048, D = 2048, DFF = 5632, NGU = 2 * DFF, NIN = 6144, PLE = 256;
constexpr int HW = 1024, LW = 1024, HEADS = 8, HD = 128, CHUNK = 64, NCH = SEQ / CHUNK;
constexpr int M = BATCH * SEQ;
constexpr float EPS = 1e-6f;
constexpr int N_IN = 27;
enum In { I_X = 0, I_P, I_F1N, I_F1G, I_F1U, I_F1D, I_MIXN, I_WIN, I_HLB, I_HGN, I_CW, I_CB, I_LWA, I_LBA, I_LWX, I_LBX, I_LAM, I_WOUT,
          I_F2N, I_F2G, I_F2U, I_F2D, I_PLN, I_PWG, I_PBG, I_PWP, I_FN };

constexpr size_t MiB = 1u << 20;
constexpr size_t WS_CTL = 0, CTL_ZERO_BYTES = 128 * 1024;
constexpr size_t WS_SSQA = 1 * MiB, WS_SSQB = 2 * MiB, WS_DEC = 3 * MiB;
constexpr size_t WS_WAT = 3 * MiB + 512 * 1024, WS_WXT = 3 * MiB + 768 * 1024;
constexpr size_t WS_WPROJ = 4 * MiB, WS_PB = 5 * MiB;
constexpr size_t WS_WGU1 = 9 * MiB, WS_WD1 = 53 * MiB, WS_WINT = 75 * MiB, WS_WOUT = 99 * MiB, WS_WGU2 = 107 * MiB, WS_WD2 = 151 * MiB, WS_WPG = 173 * MiB;
constexpr size_t WS_XB = 181 * MiB;
constexpr size_t WS_ACT = 213 * MiB;
constexpr size_t WS_LOGF = WS_ACT, WS_V = WS_ACT + 32 * MiB, WS_SG = WS_ACT + 48 * MiB, WS_LRX = WS_ACT + 64 * MiB, WS_PP = 365 * MiB;
constexpr size_t WS_MIXA = 301 * MiB;
constexpr size_t WS_KVT = 333 * MiB;
constexpr size_t WS_XCH = 397 * MiB;
constexpr size_t WS_WAJ = 398 * MiB, WS_WXJ = 399 * MiB;
constexpr size_t WS_BA2 = 400 * MiB;
constexpr size_t WS_END = 401 * MiB;
static_assert(WS_WGU1 + (size_t)NGU * D * 2 <= WS_WD1 && WS_WD1 + (size_t)D * DFF * 2 <= WS_WINT && WS_WINT + (size_t)NIN * D * 2 <= WS_WOUT && WS_WOUT + (size_t)D * D * 2 <= WS_WGU2 &&
              WS_WGU2 + (size_t)NGU * D * 2 <= WS_WD2 && WS_WD2 + (size_t)D * DFF * 2 <= WS_WPG && WS_WPG + (size_t)D * D * 2 <= WS_XB && WS_XB + (size_t)M * D * 2 <= WS_ACT &&
              WS_ACT + (size_t)M * DFF * 2 <= WS_MIXA && WS_MIXA + (size_t)M * 2048 * 2 <= WS_KVT && WS_KVT + (size_t)BATCH * HEADS * NCH * HD * HD * 4 <= WS_XCH &&
              WS_LRX + (size_t)M * 1024 * 2 <= WS_MIXA && WS_PP + (size_t)M * D * 2 <= 397 * MiB && WS_PB + (size_t)M * PLE * 2 <= WS_WGU1 && WS_WPROJ + (size_t)D * PLE * 2 <= WS_PB, "d_ws map");
constexpr int CW_PANEL = 16384;
constexpr int CW_BAR = 4096;

constexpr int RING_OFF = 0, RING_BYTES = 131072;
constexpr int LDSCTL_OFF = 147456 - 512, MISC_OFF = LDSCTL_OFF + 320;
constexpr int LDS_BYTES = 147456;
static_assert(MISC_OFF + 128 <= LDS_BYTES, "LDS map");


struct Frame {
    LAS unsigned char* lds;
    volatile LAS unsigned* MISC;
    gu32* ctl;
    int wave;
    int vcu, G;
    const float* in[N_IN]; float* out; unsigned char* ws;
};
__device__ __forceinline__ float bf2f(bf16 b) { return __builtin_bit_cast(float, (unsigned)b << 16); }
__device__ __forceinline__ float wave_sum(float v) {
#pragma unroll
    for (int o = 1; o < 64; o <<= 1) v += __shfl_xor(v, o);
    return v;
}
__device__ __forceinline__ void p0_transpose_item(const float* W, int ldw, int K, int src_col0, bf16* WT, int dst_row0, const float* gain, LAS float* scr, int kb, int lane, float wscale = 1.0f) {
    const int k0 = 64 * kb, kq = lane >> 4, nq = lane & 15;
    f32x4 v[16];
#pragma unroll
    for (int i = 0; i < 16; ++i) v[i] = __builtin_nontemporal_load((const GAS f32x4*)(W + (size_t)(k0 + 4 * i + kq) * ldw + src_col0 + 4 * nq));
    if (gain) {
#pragma unroll
        for (int i = 0; i < 16; ++i) v[i] = v[i] * gain[k0 + 4 * i + kq];
    }
    if (wscale != 1.0f) {
#pragma unroll
        for (int i = 0; i < 16; ++i) v[i] = v[i] * wscale;
    }
#pragma unroll
    for (int i = 0; i < 16; ++i) { LAS float* s = scr + (4 * i + kq) * 65 + 4 * nq; s[0] = v[i].x; s[1] = v[i].y; s[2] = v[i].z; s[3] = v[i].w; }
    LDS_WAIT(); asm volatile("" ::: "memory");
    const int c = lane & 7;
#pragma unroll
    for (int j = 0; j < 8; ++j) { const int n = (lane >> 3) + 8 * j; const LAS float* s = scr + (8 * c) * 65 + n;
        v4u o; o.x = pk2(s[0 * 65], s[1 * 65]); o.y = pk2(s[2 * 65], s[3 * 65]); o.z = pk2(s[4 * 65], s[5 * 65]); o.w = pk2(s[6 * 65], s[7 * 65]);
        *(GAS v4u*)(WT + (size_t)(dst_row0 + n) * K + k0 + 8 * c) = o; }
    LDS_WAIT(); asm volatile("" ::: "memory");
}
__device__ __forceinline__ bool p0_plain(int& r, const float* W, int K, int N, bf16* WT, const float* gain, LAS float* scr, int lane, float wscale = 1.0f) {
    const int items = (N / 64) * (K / 64);
    if (r < items) { const int nb = r / (K / 64), kb = r % (K / 64); p0_transpose_item(W, N, K, 64 * nb, WT, 64 * nb, gain, scr, kb, lane, wscale); return true; }
    r -= items; return false;
}
__device__ __forceinline__ bool p0_gateup(int& r, const float* Wg, const float* Wu, bf16* WT, const float* gain, LAS float* scr, int lane) {
    const int items = (NGU / 64) * (D / 64);
    if (r < items) { const int rb = r / (D / 64), kb = r % (D / 64), t = rb >> 2, j = rb & 3;
        p0_transpose_item(j < 2 ? Wg : Wu, DFF, D, 128 * t + 64 * (j & 1), WT, 64 * rb, gain, scr, kb, lane); return true; }
    r -= items; return false;
}
enum { J_X = 1, J_P = 2, J_GU1 = 4, J_D1 = 8, J_WIN = 16, J_WOUT = 32, J_GU2 = 64, J_D2 = 128, J_PG = 256, J_PROJ = 512, J_AX = 1024 };
template <int JOBS>
__device__ __forceinline__ void convert_jobs(Frame& F, int rank, int count) {
    const int lane_ = pg8::lane_id_asm(), wave_ = F.wave;
    LAS float* scr = (LAS float*)(F.lds + RING_OFF + wave_ * 16640);
    const int gw = rank * NWAVES + wave_, NGW = count * NWAVES;
    unsigned char* ws = F.ws;
    if (JOBS & J_X) {
        for (int m = gw; m < M; m += NGW) {
            const GAS f32x4* xr = (const GAS f32x4*)(F.in[I_X] + (size_t)m * D) + lane_;
            GAS unsigned long long* o8 = (GAS unsigned long long*)((bf16*)(ws + WS_XB) + (size_t)m * D) + lane_;
            float s = 0.f;
#pragma unroll
            for (int j = 0; j < 8; ++j) { const f32x4 v = __builtin_nontemporal_load(xr + 64 * j); s += (v.x * v.x + v.y * v.y) + (v.z * v.z + v.w * v.w);
                o8[64 * j] = (unsigned long long)pk2(v.x, v.y) | ((unsigned long long)pk2(v.z, v.w) << 32); }
            s = wave_sum(s);
            if (lane_ < 32) ((float*)(ws + WS_SSQA))[(size_t)m * 32 + lane_] = (lane_ == 0) ? s : 0.f;
        }
    }
    if (JOBS & J_P) {
        for (int m = gw; m < M; m += NGW) {
            const f32x4 v = __builtin_nontemporal_load((const GAS f32x4*)(F.in[I_P] + (size_t)m * PLE) + lane_);
            ((GAS unsigned long long*)((bf16*)(ws + WS_PB) + (size_t)m * PLE))[lane_] = (unsigned long long)pk2(v.x, v.y) | ((unsigned long long)pk2(v.z, v.w) << 32);
        }
    }
    constexpr int I_GU = (NGU / 64) * (D / 64), I_DD = (D / 64) * (DFF / 64), I_IN = (NIN / 64) * (D / 64), I_SQ = (D / 64) * (D / 64), I_PJ = (D / 64) * (PLE / 64), I_AX = 16 * 4 * 4;
    constexpr int NITEMS = ((JOBS & J_GU1) ? I_GU : 0) + ((JOBS & J_D1) ? I_DD : 0) + ((JOBS & J_WIN) ? I_IN : 0) + ((JOBS & J_WOUT) ? I_SQ : 0) + ((JOBS & J_GU2) ? I_GU : 0) +
                           ((JOBS & J_D2) ? I_DD : 0) + ((JOBS & J_PG) ? I_SQ : 0) + ((JOBS & J_PROJ) ? I_PJ : 0) + ((JOBS & J_AX) ? I_AX : 0);
    for (int it = gw; it < NITEMS; it += NGW) {
        int r = it;
        if (JOBS & J_GU1) { if (p0_gateup(r, F.in[I_F1G], F.in[I_F1U], (bf16*)(ws + WS_WGU1), F.in[I_F1N], scr, lane_)) continue; }
        if (JOBS & J_D1) { if (p0_plain(r, F.in[I_F1D], DFF, D, (bf16*)(ws + WS_WD1), nullptr, scr, lane_, 0.5f)) continue; }
        if (JOBS & J_WIN) { if (p0_plain(r, F.in[I_WIN], D, NIN, (bf16*)(ws + WS_WINT), F.in[I_MIXN], scr, lane_)) continue; }
        if (JOBS & J_WOUT) { if (p0_plain(r, F.in[I_WOUT], D, D, (bf16*)(ws + WS_WOUT), nullptr, scr, lane_)) continue; }
        if (JOBS & J_GU2) { if (p0_gateup(r, F.in[I_F2G], F.in[I_F2U], (bf16*)(ws + WS_WGU2), F.in[I_F2N], scr, lane_)) continue; }
        if (JOBS & J_D2) { if (p0_plain(r, F.in[I_F2D], DFF, D, (bf16*)(ws + WS_WD2), nullptr, scr, lane_, 0.5f)) continue; }
        if (JOBS & J_PG) { if (p0_plain(r, F.in[I_PWG], D, D, (bf16*)(ws + WS_WPG), F.in[I_PLN], scr, lane_)) continue; }
        if (JOBS & J_PROJ) { if (p0_plain(r, F.in[I_PWP], PLE, D, (bf16*)(ws + WS_WPROJ), nullptr, scr, lane_)) continue; }
        if (JOBS & J_AX) { const int blk = r >> 4, j = (r >> 2) & 3, q = r & 3;
          const int nb = blk & 7;
          const float* W = (blk < 8 ? F.in[I_LWA] : F.in[I_LWX]) + (size_t)nb * 128 * 128;
          bf16* WT = (bf16*)(ws + (blk < 8 ? WS_WAJ : WS_WXJ)) + (size_t)(nb * 4 + j) * 128 * 128;
          p0_transpose_item(W, 128, 128, 64 * (q >> 1), WT, 64 * (q >> 1), F.in[I_CW] + j * 1024 + nb * 128, scr, q & 1, lane_); }
    }
    if (JOBS & J_AX) {
        for (int o = gw * 64 + lane_; o < 2048; o += NGW * 64) { const int which = o >> 10, dg = o & 1023, nb = dg >> 7, dd = dg & 127;
            const float* W = (which ? F.in[I_LWX] : F.in[I_LWA]) + (size_t)nb * 128 * 128 + dd; float s = (which ? F.in[I_LBX] : F.in[I_LBA])[dg];
            for (int c = 0; c < 128; ++c) s += F.in[I_CB][nb * 128 + c] * W[(size_t)c * 128];
            ((float*)(ws + WS_BA2))[o] = s; }
    }
}
__device__ __forceinline__ void side_workers(int nwg, int G, int c, int& rank, int& count) {
    const int rounds = (nwg + G - 1) / G, last = nwg - (rounds - 1) * G;
    if (last == G) { rank = c; count = G; } else if (c >= last) { rank = c - last; count = G - last; } else { rank = -1; count = 0; }
}
__device__ __forceinline__ void final_norm(Frame& F, const float* ssq) {
    const int lane_ = pg8::lane_id_asm(), wave_ = F.wave;
    const int gw = F.vcu * NWAVES + wave_, NGW = F.G * NWAVES;
    const GAS f32x4* gf = (const GAS f32x4*)F.in[I_FN] + lane_;
    for (int m = gw; m < M; m += NGW) {
        float s = (lane_ < 32) ? ssq[(size_t)m * 32 + lane_] : 0.f;
        s = wave_sum(s);
        const float rstd = 1.0f / sqrtf(s * (1.0f / D) + EPS);
        GAS f32x4* xr = (GAS f32x4*)(F.out + (size_t)m * D) + lane_;
#pragma unroll
        for (int j = 0; j < 8; ++j) { f32x4 v = xr[64 * j]; const f32x4 g = gf[64 * j]; v = v * rstd * g; xr[64 * j] = v; }
    }
}


typedef float mf32x4 __attribute__((ext_vector_type(4)));
typedef short mbf16x8 __attribute__((ext_vector_type(8)));
typedef unsigned mu32x2 __attribute__((ext_vector_type(2)));
constexpr int TS = 72;
constexpr int QS = 136;
constexpr int NITEM = BATCH * HEADS * NCH;
__device__ __forceinline__ mbf16x8 lds_frag(const LAS bf16* p) { return *(const LAS mbf16x8*)p; }
__device__ __forceinline__ unsigned bf1(float x) { return pg8::cvt_pk_bf16(x, 0.f) & 0xffffu; }
#define MFMA16(a, b, c) __builtin_amdgcn_mfma_f32_16x16x32_bf16((a), (b), (c), 0, 0, 0)

#define LBAR() do { asm volatile("s_waitcnt lgkmcnt(0)" ::: "memory"); __builtin_amdgcn_s_barrier(); asm volatile("" ::: "memory"); } while (0)

__device__ __forceinline__ void hgrn_local_phase(Frame& F) {
    LAS bf16* kstT = (LAS bf16*)(F.lds);
    LAS bf16* vT = (LAS bf16*)(F.lds + 18432);
    LAS float* qtot = (LAS float*)(F.lds + 36864);
    const int tid_ = F.wave * 64 + pg8::lane_id_asm();
    const int tid = tid_, k = tid & 127, sq = tid >> 7, lane = tid & 63, w = F.wave, fr = lane & 15, fq = lane >> 4;
    const float* LOGF = (const float*)(F.ws + WS_LOGF); const bf16* V = (const bf16*)(F.ws + WS_V);
    bf16* KVT = (bf16*)(F.ws + WS_KVT); float* DEC = (float*)(F.ws + WS_DEC);
    float lf[16]; unsigned vr[16];
    if ((int)blockIdx.x < NITEM) { const int item = blockIdx.x, c = item & 31, bh = item >> 5, h = bh & 7, b = bh >> 3;
        const size_t g0 = ((size_t)b * SEQ + c * 64 + sq * 16) * 1024 + h * 128 + k;
#pragma unroll
        for (int i = 0; i < 16; ++i) { lf[i] = LOGF[g0 + (size_t)i * 1024]; vr[i] = V[g0 + (size_t)i * 1024]; } }
    for (int item = blockIdx.x; item < NITEM; item += F.G) {
        float bb[16]; float run = 0.f;
#pragma unroll
        for (int i = 0; i < 16; ++i) { run += lf[i]; bb[i] = run; }
        qtot[sq * 128 + k] = run;
        LBAR();
        float pre = 0.f, tot = 0.f;
#pragma unroll
        for (int j = 0; j < 4; ++j) { const float tq = qtot[j * 128 + k]; pre += (j < sq) ? tq : 0.f; tot += tq; }
        unsigned pk[8], pv[8];
#pragma unroll
        for (int i = 0; i < 8; ++i) {
            const float e0 = (1.0f - __expf(lf[2 * i])) * __expf(tot - (pre + bb[2 * i])), e1 = (1.0f - __expf(lf[2 * i + 1])) * __expf(tot - (pre + bb[2 * i + 1]));
            pk[i] = pg8::cvt_pk_bf16(e0, e1); pv[i] = vr[2 * i] | (vr[2 * i + 1] << 16); }
        *(LAS v4u*)(kstT + k * TS + sq * 16) = (v4u){pk[0], pk[1], pk[2], pk[3]}; *(LAS v4u*)(kstT + k * TS + sq * 16 + 8) = (v4u){pk[4], pk[5], pk[6], pk[7]};
        *(LAS v4u*)(vT + k * TS + sq * 16) = (v4u){pv[0], pv[1], pv[2], pv[3]}; *(LAS v4u*)(vT + k * TS + sq * 16 + 8) = (v4u){pv[4], pv[5], pv[6], pv[7]};
        if (sq == 0) DEC[(size_t)item * 128 + k] = __expf(tot);
        if (item + F.G < NITEM) { const int it2 = item + F.G, c = it2 & 31, bh = it2 >> 5, h = bh & 7, b = bh >> 3;
            const size_t g0 = ((size_t)b * SEQ + c * 64 + sq * 16) * 1024 + h * 128 + k;
#pragma unroll
            for (int i = 0; i < 16; ++i) { lf[i] = LOGF[g0 + (size_t)i * 1024]; vr[i] = V[g0 + (size_t)i * 1024]; } }
        LBAR();
        const mbf16x8 b0 = lds_frag(vT + (16 * w + fr) * TS + 8 * fq), b1 = lds_frag(vT + (16 * w + fr) * TS + 32 + 8 * fq);
        bf16* outp = KVT + (size_t)item * 16384 + (size_t)(16 * w + fr) * 128 + 4 * fq;
#pragma unroll
        for (int kt = 0; kt < 8; ++kt) {
            mf32x4 acc = {0.f, 0.f, 0.f, 0.f};
            acc = MFMA16(lds_frag(kstT + (16 * kt + fr) * TS + 8 * fq), b0, acc);
            acc = MFMA16(lds_frag(kstT + (16 * kt + fr) * TS + 32 + 8 * fq), b1, acc);
            asm volatile("s_nop 7\n\ts_nop 7" : "+v"(acc));
            mu32x2 o; o.x = pg8::cvt_pk_bf16(acc[0], acc[1]); o.y = pg8::cvt_pk_bf16(acc[2], acc[3]);
            *(mu32x2*)(outp + 16 * kt) = o;
        }
        LBAR();
    }
}

__device__ __forceinline__ void hgrn_scan_phase(Frame& F) {
    const bf16* KVT = (const bf16*)(F.ws + WS_KVT); const float* DEC = (const float*)(F.ws + WS_DEC); bf16* ST = (bf16*)F.out;
    const int tid_ = F.wave * 64 + pg8::lane_id_asm();
    for (int idx = blockIdx.x * (NWAVES * 64) + tid_; idx < BATCH * HEADS * 128 * 32; idx += F.G * NWAVES * 64) {
        const int k4 = idx & 31, v = (idx >> 5) & 127, bh = idx >> 12;
        mf32x4 S = {0.f, 0.f, 0.f, 0.f};
#pragma unroll 1
        for (int half = 0; half < 2; ++half) {
            const size_t off0 = (size_t)(bh * NCH + half * 16) * 16384 + v * 128 + 4 * k4; const size_t d0 = (size_t)(bh * NCH + half * 16) * 128 + 4 * k4;
            mu32x2 kv[16]; mf32x4 dd[16];
#pragma unroll
            for (int c = 0; c < 16; ++c) { kv[c] = *(const mu32x2*)(KVT + off0 + (size_t)c * 16384); dd[c] = *(const mf32x4*)(DEC + d0 + (size_t)c * 128); }
#pragma unroll
            for (int c = 0; c < 16; ++c) {
                mu32x2 o; o.x = pg8::cvt_pk_bf16(S[0], S[1]); o.y = pg8::cvt_pk_bf16(S[2], S[3]); *(mu32x2*)(ST + off0 + (size_t)c * 16384) = o;
                S = dd[c] * S + pg8::bf16x4_to_f32(kv[c]);
            }
        }
    }
}

__device__ __forceinline__ void hgrn_out_phase(Frame& F, bool dummy = false) {
    LAS bf16* QT = (LAS bf16*)(F.lds);
    LAS bf16* KT = (LAS bf16*)(F.lds + 17408);
    LAS bf16* QI = (LAS bf16*)(F.lds + 34816);
    LAS bf16* vT = (LAS bf16*)(F.lds + 52224);
    LAS bf16* P = (LAS bf16*)(F.lds + 70656);
    LAS float* qtot = (LAS float*)(F.lds + 79872);
    LAS float* ssq = (LAS float*)(F.lds + 81920);
    const int tid_ = F.wave * 64 + pg8::lane_id_asm();
    const int tid = tid_, k = tid & 127, sq = tid >> 7, lane = tid & 63, w = F.wave, fr = lane & 15, fq = lane >> 4, rb = w & 3, ch = w >> 2;
    const float* LOGF = (const float*)(F.ws + WS_LOGF); const bf16* V = (const bf16*)(F.ws + WS_V); const bf16* SG = (const bf16*)(F.ws + WS_SG);
    const bf16* ST = (const bf16*)F.out; bf16* MIXA = (bf16*)(F.ws + WS_MIXA);
    const int t0 = 16 * rb;
    float lf[16]; unsigned vr[16], qr[16];
    if ((int)blockIdx.x < NITEM) { const int item = blockIdx.x, c = item & 31, bh = item >> 5, h = bh & 7, b = bh >> 3;
        const size_t r0 = (size_t)b * SEQ + c * 64, g0 = (r0 + sq * 16) * 1024 + h * 128 + k, gq = (r0 + sq * 16) * 2048 + h * 128 + k;
#pragma unroll
        for (int i = 0; i < 16; ++i) { lf[i] = LOGF[g0 + (size_t)i * 1024]; vr[i] = V[g0 + (size_t)i * 1024]; qr[i] = MIXA[gq + (size_t)i * 2048]; } }
    for (int item = blockIdx.x; item < NITEM; item += F.G) {
        const int c = item & 31, bh = item >> 5, h = bh & 7, b = bh >> 3;
        const size_t r0 = (size_t)b * SEQ + c * 64;
        float bb[16]; float run = 0.f;
#pragma unroll
        for (int i = 0; i < 16; ++i) { run += lf[i]; bb[i] = run; }
        qtot[sq * 128 + k] = run;
        LBAR();
        {
            float pre = 0.f;
#pragma unroll
            for (int j = 0; j < 4; ++j) { const float tq = qtot[j * 128 + k]; pre += (j < sq) ? tq : 0.f; }
            const float bm = qtot[k] + qtot[128 + k], ebm = __expf(bm);
            unsigned pv[8];
#pragma unroll
            for (int i = 0; i < 16; ++i) {
                const float d = fminf(fmaxf(pre + bb[i] - bm, -60.f), 60.f), e1 = __expf(d), e2 = __builtin_amdgcn_rcpf(e1);
                const float qf = bf2f((bf16)qr[i]), qt = qf * e1, kk = (1.0f - __expf(lf[i])) * e2;
                const int s = sq * 16 + i;
                QT[s * QS + k] = (bf16)bf1(qt); QI[s * QS + k] = (bf16)bf1(qt * ebm); KT[s * QS + k] = (bf16)bf1(kk);
            }
#pragma unroll
            for (int i = 0; i < 8; ++i) pv[i] = vr[2 * i] | (vr[2 * i + 1] << 16);
            *(LAS v4u*)(vT + k * TS + sq * 16) = (v4u){pv[0], pv[1], pv[2], pv[3]}; *(LAS v4u*)(vT + k * TS + sq * 16 + 8) = (v4u){pv[4], pv[5], pv[6], pv[7]};
        }
        if (item + F.G < NITEM) { const int it2 = item + F.G, c2 = it2 & 31, bh2 = it2 >> 5, h2 = bh2 & 7, b2 = bh2 >> 3;
            const size_t r2 = (size_t)b2 * SEQ + c2 * 64, g0 = (r2 + sq * 16) * 1024 + h2 * 128 + k, gq = (r2 + sq * 16) * 2048 + h2 * 128 + k;
#pragma unroll
            for (int i = 0; i < 16; ++i) { lf[i] = LOGF[g0 + (size_t)i * 1024]; vr[i] = V[g0 + (size_t)i * 1024]; qr[i] = MIXA[gq + (size_t)i * 2048]; } }
        mbf16x8 stf[4][4]; mu32x2 sgp[4];
#pragma unroll
        for (int j = 0; j < 4; ++j) { const bf16* sp = ST + (size_t)item * 16384 + (size_t)(64 * ch + 16 * j + fr) * 128 + 8 * fq;
#pragma unroll
            for (int ks = 0; ks < 4; ++ks) stf[j][ks] = *(const mbf16x8*)(sp + 32 * ks);
            sgp[j] = *(const mu32x2*)(SG + (r0 + t0 + fr) * 1024 + h * 128 + 64 * ch + 16 * j + 4 * fq); }
        LBAR();
        {
            mbf16x8 bq[4];
#pragma unroll
            for (int ks = 0; ks < 4; ++ks) bq[ks] = lds_frag(QT + (t0 + fr) * QS + 32 * ks + 8 * fq);
#pragma unroll
            for (int j = 0; j < 2; ++j) {
                const int s0 = 32 * ch + 16 * j; mf32x4 acc = {0.f, 0.f, 0.f, 0.f};
#pragma unroll
                for (int ks = 0; ks < 4; ++ks) acc = MFMA16(lds_frag(KT + (s0 + fr) * QS + 32 * ks + 8 * fq), bq[ks], acc);
                const int t = t0 + fr, sb = s0 + 4 * fq;
#pragma unroll
                for (int r = 0; r < 4; ++r) acc[r] = (sb + r <= t) ? acc[r] : 0.f;
                mu32x2 o; o.x = pg8::cvt_pk_bf16(acc[0], acc[1]); o.y = pg8::cvt_pk_bf16(acc[2], acc[3]);
                *(LAS mu32x2*)(P + t * TS + sb) = o;
            }
        }
        LBAR();
        mf32x4 o4[4];
        {
            mbf16x8 bqi[4], bp[2];
#pragma unroll
            for (int ks = 0; ks < 4; ++ks) bqi[ks] = lds_frag(QI + (t0 + fr) * QS + 32 * ks + 8 * fq);
#pragma unroll
            for (int ss = 0; ss < 2; ++ss) bp[ss] = lds_frag(P + (t0 + fr) * TS + 32 * ss + 8 * fq);
            float sum = 0.f;
#pragma unroll
            for (int j = 0; j < 4; ++j) {
                const int v0 = 64 * ch + 16 * j; mf32x4 acc = {0.f, 0.f, 0.f, 0.f};
#pragma unroll
                for (int ks = 0; ks < 4; ++ks) acc = MFMA16(stf[j][ks], bqi[ks], acc);
#pragma unroll
                for (int ss = 0; ss < 2; ++ss) acc = MFMA16(lds_frag(vT + (v0 + fr) * TS + 32 * ss + 8 * fq), bp[ss], acc);
                o4[j] = acc; sum += (acc[0] * acc[0] + acc[1] * acc[1]) + (acc[2] * acc[2] + acc[3] * acc[3]);
            }
            sum += __shfl_xor(sum, 16); sum += __shfl_xor(sum, 32);
            if (fq == 0) ssq[ch * 64 + t0 + fr] = sum;
        }
        LBAR();
        {
            const float rn = 1.0f / sqrtf((ssq[t0 + fr] + ssq[64 + t0 + fr]) * (1.0f / 128.0f) + EPS);
            const size_t row = r0 + t0 + fr;
#pragma unroll
            for (int j = 0; j < 4; ++j) {
                const int v = 64 * ch + 16 * j + 4 * fq;
                const mf32x4 gn = *(const mf32x4*)(F.in[I_HGN] + v);
                const float s0 = bf2f((bf16)(sgp[j].x & 0xffffu)), s1 = bf2f((bf16)(sgp[j].x >> 16)), s2 = bf2f((bf16)(sgp[j].y & 0xffffu)), s3 = bf2f((bf16)(sgp[j].y >> 16));
                mu32x2 o; o.x = pg8::cvt_pk_bf16(o4[j][0] * rn * gn[0] * s0, o4[j][1] * rn * gn[1] * s1); o.y = pg8::cvt_pk_bf16(o4[j][2] * rn * gn[2] * s2, o4[j][3] * rn * gn[3] * s3);
                *(mu32x2*)((dummy ? (bf16*)(F.ws + WS_KVT) : MIXA) + row * 2048 + h * 128 + v) = o;
            }
        }
        LBAR();
    }
}

#define GLDS16(gp, lp) __builtin_amdgcn_global_load_lds((const unsigned*)(gp), (LAS unsigned*)(lp), 16, 0, 0)
template <int VAR = 0, bool FUSE_SCAN = false, bool dummy = false>
__device__ __forceinline__ void lru_phase(Frame& F) {
    LAS unsigned char* Ab = F.lds;
    LAS float* LAt = (LAS float*)(F.lds + 66560);
    LAS float* LUt = (LAS float*)(F.lds + 66560 + 18560);
    LAS bf16* GG = (LAS bf16*)(F.lds + 103680);
    LAS bf16* GGt = (LAS bf16*)(F.lds + 111872);
    LAS bf16* YYt = (LAS bf16*)(F.lds + 121344);
    const int tid_ = F.wave * 64 + pg8::lane_id_asm();
    const int tid = tid_, lane = tid & 63, w = F.wave, fr = lane & 15, fq = lane >> 4;
    const int seg = lane & 31, d = 2 * w + (lane >> 5);
    const int grow = tid >> 1, ghalf = tid & 1;
    const bf16* LRX = (const bf16*)(F.ws + WS_LRX); bf16* MIXA = (bf16*)(F.ws + WS_MIXA);
    const bf16* WAJ = (const bf16*)(F.ws + WS_WAJ); const bf16* WXJ = (const bf16*)(F.ws + WS_WXJ);
    for (int item = blockIdx.x; item < BATCH * 64; item += F.G) {
        const int b = item >> 6, n = (item >> 3) & 7, sl = item & 7;
        int tid = tid_; asm volatile("" : "+v"(tid));
        const int lane = tid & 63, fr = lane & 15, fq = lane >> 4, grow = tid >> 1, ghalf = tid & 1;
        mbf16x8 waf[4][4], wxf[4][4];
#pragma unroll
        for (int j = 0; j < 4; ++j)
#pragma unroll
            for (int ks = 0; ks < 4; ++ks) { const size_t o = ((size_t)(n * 4 + j) * 128 + sl * 16 + fr) * 128 + 32 * ks + 8 * fq; waf[j][ks] = *(const mbf16x8*)(WAJ + o); wxf[j][ks] = *(const mbf16x8*)(WXJ + o); }
        const bf16* xsrc0 = LRX + (size_t)b * SEQ * 1024 + n * 128;
        bf16* const gbase = MIXA + (size_t)b * SEQ * 2048 + 1024 + n * 128 + sl * 16 + 8 * ghalf;
        bf16* const obase = dummy ? (bf16*)(F.ws + WS_END) + (size_t)item * 2048 * 16 + 8 * ghalf : gbase;
        const size_t ostr = dummy ? 16 : 2048;
#pragma unroll
        for (int i = 0; i < 9; ++i) { const int p = tid + 512 * i, row = p >> 4, cp = p & 15;
            if (p < 259 * 16 && row >= 3) GLDS16(xsrc0 + (size_t)(row - 3) * 1024 + 8 * (cp ^ (row & 15)), Ab + (w * 64 + 512 * i) * 16); }
        if (tid < 48) *(LAS v4u*)(Ab + tid * 16) = (v4u){0u, 0u, 0u, 0u};
        GLDS16(gbase + (size_t)grow * 2048, (LAS unsigned char*)GG + w * 1024);
        __syncthreads();
        float carry = 0.f;
        mf32x4 S = {0.f, 0.f, 0.f, 0.f};
        for (int mc = 0; mc < 8; ++mc) {
            int tid = tid_; asm volatile("" : "+v"(tid));
            const int lane = tid & 63, fr = lane & 15, fq = lane >> 4, seg = lane & 31, d = 2 * w + (lane >> 5), grow = tid >> 1, ghalf = tid & 1;
            const bf16* xsrc = LRX + (size_t)b * SEQ * 1024 + n * 128;
            bf16* const gbase = MIXA + (size_t)b * SEQ * 2048 + 1024 + n * 128 + sl * 16 + 8 * ghalf;
            bf16* const obase = dummy ? (bf16*)(F.ws + WS_END) + (size_t)item * 2048 * 16 + 8 * ghalf : gbase;
            const int sidx = blockIdx.x * (NWAVES * 64) + tid;
            const unsigned soff = (unsigned)((sidx >> 12) * NCH + 4 * mc) * 16384u + ((sidx >> 5) & 127) * 128 + 4 * (sidx & 31), sdo = (unsigned)((sidx >> 12) * NCH + 4 * mc) * 128u + 4 * (sidx & 31);
            mu32x2 skv[2]; mf32x4 sdd[2];
            if (FUSE_SCAN) {
#pragma unroll
                for (int c = 0; c < 2; ++c) { skv[c] = *(const mu32x2*)((const bf16*)(F.ws + WS_KVT) + soff + c * 16384u); sdd[c] = *(const mf32x4*)((const float*)(F.ws + WS_DEC) + sdo + c * 128u); }
            }
            mf32x4 ar[2], ai[2]; float xv[2][7];
#pragma unroll
            for (int rt = 0; rt < 2; ++rt) {
                const int rowt = 32 * w + 16 * rt; ar[rt] = (mf32x4){0.f, 0.f, 0.f, 0.f}; ai[rt] = (mf32x4){0.f, 0.f, 0.f, 0.f};
#pragma unroll
                for (int j = 0; j < 4; ++j) { const int R = rowt + fr + j;
#pragma unroll
                    for (int ks = 0; ks < 4; ++ks) { const mbf16x8 a = *(const LAS mbf16x8*)(Ab + R * 256 + (((4 * ks + fq) ^ (R & 15)) << 4)); ar[rt] = MFMA16(a, waf[j][ks], ar[rt]); ai[rt] = MFMA16(a, wxf[j][ks], ai[rt]); } }
#pragma unroll
                for (int q = 0; q < 7; ++q) { const int R = rowt + 4 * fq + q; xv[rt][q] = bf2f(*(const LAS bf16*)(Ab + R * 256 + (((2 * sl + (fr >> 3)) ^ (R & 15)) << 4) + 2 * (fr & 7))); }
            }
            __syncthreads();
            if (mc < 7) {
#pragma unroll
                for (int i = 0; i < 9; ++i) { const int p = tid + 512 * i, row = p >> 4, cp = p & 15;
                    if (p < 259 * 16) GLDS16(xsrc + (size_t)((mc + 1) * 256 - 3 + row) * 1024 + 8 * (cp ^ (row & 15)), Ab + (w * 64 + 512 * i) * 16); }
            }
            {
                const v4u g = *(const LAS v4u*)(GG + tid * 8); const unsigned gw4[4] = {g.x, g.y, g.z, g.w};
                const int tb = (8 * ghalf) * 296 + (grow >> 3) * 9 + (grow & 7);
#pragma unroll
                for (int e = 0; e < 8; ++e) GGt[tb + e * 296] = (bf16)((e & 1) ? (gw4[e >> 1] >> 16) : (gw4[e >> 1] & 0xffffu));
                if (mc > 0) { unsigned yv[8];
#pragma unroll
                    for (int e = 0; e < 8; ++e) yv[e] = YYt[tb + e * 296];
                    *(v4u*)(obase + (size_t)((mc - 1) * 256 + grow) * ostr) = (v4u){yv[0] | (yv[1] << 16), yv[2] | (yv[3] << 16), yv[4] | (yv[5] << 16), yv[6] | (yv[7] << 16)}; }
                if (mc < 7) { asm volatile("s_waitcnt lgkmcnt(0)" ::: "memory"); GLDS16(gbase + (size_t)((mc + 1) * 256 + grow) * 2048, (LAS unsigned char*)GG + w * 1024); }
            }
            {
                const int cgl = n * 128 + sl * 16 + fr;
                const float ba2 = ((const float*)(F.ws + WS_BA2))[cgl], bx2 = ((const float*)(F.ws + WS_BA2))[1024 + cgl], spl = log1pf(__expf(-F.in[I_LAM][cgl])), cbv = F.in[I_CB][cgl];
                float cw4[4];
#pragma unroll
                for (int j = 0; j < 4; ++j) cw4[j] = F.in[I_CW][j * 1024 + cgl];
#pragma unroll
                for (int rt = 0; rt < (VAR == 2 ? 0 : 2); ++rt)
#pragma unroll
                    for (int r = 0; r < 4; ++r) { const int row = 32 * w + 16 * rt + 4 * fq + r;
                        const float xc = cbv + ((cw4[0] * xv[rt][r] + cw4[1] * xv[rt][r + 1]) + (cw4[2] * xv[rt][r + 2] + cw4[3] * xv[rt][r + 3]));
                        const float rg = pg8::sigmoid_f(ar[rt][r] + ba2), ig = pg8::sigmoid_f(ai[rt][r] + bx2), la = -8.0f * rg * spl;
                        const float a = __expf(la), om = fmaxf(__builtin_fmaf(-a, a, 1.0f), 0.f);
                        const int o = fr * 289 + (row >> 3) * 9 + (row & 7);
                        LAt[o] = a; LUt[o] = __builtin_amdgcn_sqrtf(om) * ig * xc; }
            }
            if (FUSE_SCAN) {
#pragma unroll
                for (int c = 0; c < 2; ++c) { mu32x2 o; o.x = pg8::cvt_pk_bf16(S[0], S[1]); o.y = pg8::cvt_pk_bf16(S[2], S[3]); *(mu32x2*)((bf16*)F.out + soff + c * 16384u) = o;
                    S = sdd[c] * S + pg8::bf16x4_to_f32(skv[c]); }
#pragma unroll
                for (int c = 0; c < 2; ++c) { skv[c] = *(const mu32x2*)((const bf16*)(F.ws + WS_KVT) + soff + (2 + c) * 16384u); sdd[c] = *(const mf32x4*)((const float*)(F.ws + WS_DEC) + sdo + (2 + c) * 128u); }
            }
            __syncthreads();
            if (VAR != 3) {
                float aa[8], uu[8]; float Ap = 1.f, Hp = 0.f;
#pragma unroll
                for (int i = 0; i < 8; ++i) { aa[i] = LAt[d * 289 + seg * 9 + i]; uu[i] = LUt[d * 289 + seg * 9 + i]; Hp = aa[i] * Hp + uu[i]; Ap *= aa[i]; }
#pragma unroll
                for (int off = 1; off < 32; off <<= 1) { const float Aq = __shfl_up(Ap, off, 32), Hq = __shfl_up(Hp, off, 32); if (seg >= off) { Hp = Ap * Hq + Hp; Ap = Ap * Aq; } }
                float Ae = __shfl_up(Ap, 1, 32), He = __shfl_up(Hp, 1, 32); if (seg == 0) { Ae = 1.f; He = 0.f; }
                float hin = Ae * carry + He;
                carry = __shfl(Ap, 31, 32) * carry + __shfl(Hp, 31, 32);
                const LAS bf16* gp = GGt + d * 296 + seg * 9; LAS bf16* yq = YYt + d * 296 + seg * 9;
#pragma unroll
                for (int i = 0; i < 8; ++i) { hin = aa[i] * hin + uu[i]; yq[i] = (bf16)bf1(hin * bf2f(gp[i])); }
            }
            if (FUSE_SCAN) {
#pragma unroll
                for (int c = 0; c < 2; ++c) { mu32x2 o; o.x = pg8::cvt_pk_bf16(S[0], S[1]); o.y = pg8::cvt_pk_bf16(S[2], S[3]); *(mu32x2*)((bf16*)F.out + soff + (2 + c) * 16384u) = o;
                    S = sdd[c] * S + pg8::bf16x4_to_f32(skv[c]); }
            }
        }
        __syncthreads();
        { const int tb = (8 * ghalf) * 296 + (grow >> 3) * 9 + (grow & 7); unsigned yv[8];
#pragma unroll
          for (int e = 0; e < 8; ++e) yv[e] = YYt[tb + e * 296];
          *(v4u*)(obase + (size_t)(7 * 256 + grow) * ostr) = (v4u){yv[0] | (yv[1] << 16), yv[2] | (yv[3] << 16), yv[4] | (yv[5] << 16), yv[6] | (yv[7] << 16)}; }
        __syncthreads();
    }
}
constexpr int N_PHASES = 12;
struct Args { const float* in[N_IN]; float* out; unsigned char* ws; int ph_lo, ph_hi, li, pad; };
__global__ void __launch_bounds__(NWAVES * 64, 2) mega_fwd(Args args) {
    extern __shared__ __attribute__((aligned(16))) unsigned char lds[];
    Frame F;
    F.lds = (LAS unsigned char*)lds;
    F.MISC = (volatile LAS unsigned*)(F.lds + MISC_OFF);
    F.wave = __builtin_amdgcn_readfirstlane((int)threadIdx.x >> 6);
    F.G = gridDim.x; { const int bx = blockIdx.x; F.vcu = (F.G % 8 == 0) ? (bx % 8) * (F.G / 8) + bx / 8 : bx; }
#pragma unroll
    for (int i = 0; i < N_IN; ++i) F.in[i] = args.in[i];
    F.out = args.out; F.ws = args.ws;
    unsigned char* ws = args.ws;
    F.ctl = (gu32*)(ws + WS_CTL);
    for (int u = F.wave * 64 + pg8::lane_id_asm(); u < (LDS_BYTES - LDSCTL_OFF) / 4; u += NWAVES * 64) ((LAS unsigned*)(F.lds + LDSCTL_OFF))[u] = 0u;
    __syncthreads();
    const int lo = args.ph_lo, hi = args.ph_hi;
    const bool multi = (hi - lo) > 1;
    XcdBarrier bar; bar.bar = (unsigned*)(F.ctl + CW_BAR) + args.li * XCD_BAR_WORDS; bar.x = 0; bar.st = nullptr; bar.wave = F.wave;
    if (multi) bar = xcd_barrier_post((unsigned*)(F.ctl + CW_BAR) + args.li * XCD_BAR_WORDS, F.MISC + 8, F.wave);

    bf16* const XB = (bf16*)(ws + WS_XB); bf16* const ACT = (bf16*)(ws + WS_ACT); bf16* const MIXA = (bf16*)(ws + WS_MIXA);
    float* const SSQA = (float*)(ws + WS_SSQA); float* const SSQB = (float*)(ws + WS_SSQB);


#define IN(k) (lo <= (k) && (k) < hi)
#ifdef PROBE_PHASE
#define SEAM(k) do { if (IN(k) && ((k) + 1 < N_PHASES ? IN((k) + 1) : true)) { xcd_barrier(bar); \
        if ((k) + 1 == PROBE_PHASE) { if (blockIdx.x == 0 && F.wave == 0 && pg8::lane_id_asm() == 0) __hip_atomic_store((unsigned long long*)(F.ctl + 30000), (unsigned long long)__builtin_amdgcn_s_memrealtime(), RLX_AGENT); } \
        if ((k) == PROBE_PHASE) { if (blockIdx.x == 0 && F.wave == 0 && pg8::lane_id_asm() == 0) { const unsigned long long t1 = __builtin_amdgcn_s_memrealtime(), t0 = __hip_atomic_load((unsigned long long*)(F.ctl + 30000), RLX_AGENT); \
                __hip_atomic_store((unsigned long long*)(F.ctl + 30064), t1 - t0, RLX_AGENT); } \
            xcd_barrier(bar); \
            { const unsigned long long dt = __hip_atomic_load((unsigned long long*)(F.ctl + 30064), RLX_AGENT), s0 = __builtin_amdgcn_s_memrealtime(); while (__builtin_amdgcn_s_memrealtime() - s0 < 4ull * dt) __builtin_amdgcn_s_sleep(32); } } } } while (0)
#else
#define SEAM(k) do { if (IN(k) && IN((k) + 1)) xcd_barrier(bar); } while (0)
#endif
#define GEMM_SWIGLU(WOFF) do { pg8::Gemm g{XB, (const bf16*)(ws + (WOFF)), M, NGU, D}; pg8::StaticOrder S; S.init(M, NGU, F.G, (int)blockIdx.x); \
        pg8::EpiSwiGLU E{ACT, DFF, SSQA}; pg8::gemm_phase<pg8::EpiSwiGLU, pg8::StaticOrder, true, true>(F.lds + RING_OFF, g, S, E, F.wave); } while (0)
#define GEMM_RESID(AP, WOFF, KK, SRC32, SSQO) do { pg8::Gemm g{(AP), (const bf16*)(ws + (WOFF)), M, D, (KK)}; pg8::StaticOrder S; S.init(M, D, F.G, (int)blockIdx.x); \
        if ((M / 256) * (D / 256) <= F.G) { pg8::EpiResidInit E{(SRC32), XB, (SSQO)}; pg8::gemm_phase<pg8::EpiResidInit, pg8::StaticOrder, true, true>(F.lds + RING_OFF, g, S, E, F.wave); } \
        else { pg8::EpiResid E{(SRC32), XB, (SSQO)}; pg8::gemm_phase<pg8::EpiResid, pg8::StaticOrder, true, true>(F.lds + RING_OFF, g, S, E, F.wave); } } while (0)

    if (IN(0)) { convert_jobs<J_X | J_P | J_GU1 | J_GU2 | J_PROJ | J_AX | J_PG>(F, (int)blockIdx.x, F.G); SEAM(0); }
    if (IN(1)) { GEMM_SWIGLU(WS_WGU1);
        { int rank, count; side_workers((M / 256) * (NGU / 256), F.G, (int)blockIdx.x, rank, count); if (rank >= 0) convert_jobs<J_D1 | J_WIN | J_WOUT>(F, rank, count); }
        SEAM(1); }
    if (IN(2)) { GEMM_RESID(ACT, WS_WD1, DFF, F.in[I_X], SSQB); SEAM(2); }
    if (IN(3)) {
        pg8::Gemm g{XB, (const bf16*)(ws + WS_WINT), M, NIN, D}; pg8::StaticOrder S; S.init(M, NIN, F.G, (int)blockIdx.x);
        pg8::EpiZ E{SSQB, F.in[I_HLB], MIXA, (float*)(ws + WS_LOGF), (bf16*)(ws + WS_V), (bf16*)(ws + WS_SG), (bf16*)(ws + WS_LRX)};
        pg8::gemm_phase<pg8::EpiZ, pg8::StaticOrder, true, true>(F.lds + RING_OFF, g, S, E, F.wave);
        SEAM(3); }
    if (IN(4)) { MIXER_PHASE_4 SEAM(4); }
    if (IN(5)) { MIXER_PHASE_5 SEAM(5); }
    if (IN(6)) { MIXER_PHASE_6 SEAM(6); }
    if (IN(7)) { GEMM_RESID(MIXA, WS_WOUT, D, (const float*)nullptr, SSQA); SEAM(7); }
    if (IN(8)) { GEMM_SWIGLU(WS_WGU2);
        { int rank, count; side_workers((M / 256) * (NGU / 256), F.G, (int)blockIdx.x, rank, count);
          if (rank >= 0) {
              pg8::Gemm g{(const bf16*)(ws + WS_PB), (const bf16*)(ws + WS_WPROJ), M, D, PLE}; pg8::StaticOrder S; S.init(M, D, count, rank);
              pg8::EpiPP E{(bf16*)(ws + WS_PP)};
              pg8::gemm_phase<pg8::EpiPP, pg8::StaticOrder, true, true>(F.lds + RING_OFF, g, S, E, F.wave);
              convert_jobs<J_D2>(F, rank, count); } }
        SEAM(8); }
    if (IN(9)) { GEMM_RESID(ACT, WS_WD2, DFF, (const float*)nullptr, SSQB); SEAM(9); }
    if (IN(10)) {
        { pg8::Gemm g{XB, (const bf16*)(ws + WS_WPG), M, D, D}; pg8::StaticOrder S; S.init(M, D, F.G, (int)blockIdx.x);
          if (F.G == (M / 256) * (D / 256)) {
              pg8::EpiPLEFinal E{SSQB, F.in[I_PBG], (const bf16*)(ws + WS_PP), XB, F.out, (float*)(ws + WS_XCH), (unsigned*)(F.ctl + CW_PANEL), F.in[I_FN]};
              pg8::gemm_phase<pg8::EpiPLEFinal, pg8::StaticOrder, false, true>(F.lds + RING_OFF, g, S, E, F.wave);
          } else {
              pg8::EpiPLE E{SSQB, F.in[I_PBG], (const bf16*)(ws + WS_PP), XB, F.out, SSQA};
              pg8::gemm_phase<pg8::EpiPLE, pg8::StaticOrder, true, true>(F.lds + RING_OFF, g, S, E, F.wave); } }
        SEAM(10); }
    if (IN(11)) { if (F.G != (M / 256) * (D / 256)) final_norm(F, SSQA); SEAM(11); }
#undef IN
#undef SEAM
}

#if SIMPLE_HGRN
__global__ void __launch_bounds__(64) k_simple_hgrn(const float* logf, const bf16* mixa, const bf16* vv, float* oh) {
    __shared__ float sf[128], sk[128], sq[128];
    const int bh = blockIdx.x >> 1, vh = blockIdx.x & 1, b = bh >> 3, h = bh & 7, lane = threadIdx.x, v = vh * 64 + lane;
    float S[128];
#pragma unroll
    for (int k = 0; k < 128; ++k) S[k] = 0.f;
    for (int t = 0; t < SEQ; ++t) {
        const size_t row = (size_t)b * SEQ + t;
        for (int kk = lane; kk < 128; kk += 64) { const float f = __expf(logf[row * 1024 + h * 128 + kk]); sf[kk] = f; sk[kk] = 1.f - f; sq[kk] = bf2f(mixa[row * 2048 + h * 128 + kk]); }
        __syncthreads();
        const float vt = bf2f(vv[row * 1024 + h * 128 + v]); float o = 0.f;
#pragma unroll
        for (int k = 0; k < 128; ++k) { S[k] = sf[k] * S[k] + sk[k] * vt; o += S[k] * sq[k]; }
        oh[row * 1024 + h * 128 + v] = o;
        __syncthreads();
    }
}
__global__ void __launch_bounds__(256) k_simple_hnorm(const float* oh, const bf16* sg, const float* gn, bf16* mixa) {
    const int gw = (blockIdx.x * 256 + threadIdx.x) >> 6, lane = threadIdx.x & 63;
    if (gw >= M * HEADS) return;
    const int row = gw >> 3, h = gw & 7;
    const float o0 = oh[(size_t)row * 1024 + h * 128 + lane], o1 = oh[(size_t)row * 1024 + h * 128 + 64 + lane];
    const float ss = wave_sum(o0 * o0 + o1 * o1);
    const float r = 1.0f / sqrtf(ss * (1.0f / 128.0f) + EPS);
    mixa[(size_t)row * 2048 + h * 128 + lane] = (bf16)f2bf(o0 * r * gn[lane] * bf2f(sg[(size_t)row * 1024 + h * 128 + lane]));
    mixa[(size_t)row * 2048 + h * 128 + 64 + lane] = (bf16)f2bf(o1 * r * gn[64 + lane] * bf2f(sg[(size_t)row * 1024 + h * 128 + 64 + lane]));
}
#endif
#if SIMPLE_LRU
__global__ void __launch_bounds__(256) k_simple_lru_a(const bf16* lrx, const float* cw, const float* cb, const float* wa, const float* ba, const float* wx, const float* bx, const float* lam, float* LA, float* LU) {
    __shared__ float xc[1024];
    const int row = blockIdx.x, tt = row % SEQ, tid = threadIdx.x;
    for (int c = tid; c < 1024; c += 256) { float s = cb[c];
        for (int j = 0; j < 4; ++j) { const int ts = tt - 3 + j; if (ts >= 0) s += cw[j * 1024 + c] * bf2f(lrx[(size_t)(row - 3 + j) * 1024 + c]); }
        xc[c] = s; }
    __syncthreads();
    for (int d = tid; d < 1024; d += 256) { const int n = d >> 7, dd = d & 127; float r = ba[d], g = bx[d];
        for (int c = 0; c < 128; ++c) { const float x = xc[n * 128 + c]; r += x * wa[((size_t)n * 128 + c) * 128 + dd]; g += x * wx[((size_t)n * 128 + c) * 128 + dd]; }
        r = 1.0f / (1.0f + __expf(-r)); g = 1.0f / (1.0f + __expf(-g));
        const float log_a = -8.0f * r * log1pf(__expf(-lam[d]));
        LA[(size_t)row * 1024 + d] = __expf(log_a); LU[(size_t)row * 1024 + d] = sqrtf(-expm1f(2.0f * log_a)) * g * xc[d]; }
}
__global__ void __launch_bounds__(256) k_simple_lru_b(const float* LA, const float* LU, bf16* mixa) {
    const int gi = blockIdx.x * 256 + threadIdx.x, b = gi >> 10, c = gi & 1023; float h = 0.f;
#pragma unroll 8
    for (int t = 0; t < SEQ; ++t) { const size_t row = (size_t)b * SEQ + t; h = LA[row * 1024 + c] * h + LU[row * 1024 + c];
        bf16* p = mixa + row * 2048 + 1024 + c; *p = (bf16)f2bf(h * bf2f(*p)); }
}
#endif

extern "C" void kernel_launch(void* const* d_in, const int* in_sizes, int n_in, void* d_out, int out_size, void* d_ws, size_t ws_size, hipStream_t stream) {
    static int grid = 0;
    if (grid == 0) {
        if (n_in != N_IN || in_sizes[0] != M * D || out_size != M * D || ws_size < WS_END) { fprintf(stderr, "kernel_launch: unexpected problem (n_in %d, in0 %d, out %d, ws %zu); nothing launched\n", n_in, n_in > 0 ? in_sizes[0] : -1, out_size, ws_size); grid = -1; return; }
        int dev = 0, cus = 0, per_cu = 0;
        if (hipGetDevice(&dev) != hipSuccess || hipDeviceGetAttribute(&cus, hipDeviceAttributeMultiprocessorCount, dev) != hipSuccess) { grid = -1; return; }
        if (hipFuncSetAttribute((const void*)mega_fwd, hipFuncAttributeMaxDynamicSharedMemorySize, LDS_BYTES) != hipSuccess) { fprintf(stderr, "kernel_launch: hipFuncSetAttribute failed\n"); grid = -1; return; }
        if (hipOccupancyMaxActiveBlocksPerMultiprocessor(&per_cu, (const void*)mega_fwd, NWAVES * 64, LDS_BYTES) != hipSuccess || per_cu < 1)
            fprintf(stderr, "kernel_launch: note: occupancy query reports %d workgroups per CU\n", per_cu);
        (void)hipGetLastError();
        grid = cus;
    }
    if (grid < 0) return;
    if (hipMemsetAsync((char*)d_ws + WS_CTL, 0, CTL_ZERO_BYTES, stream) != hipSuccess) return;
    Args a{};
    for (int i = 0; i < N_IN; ++i) a.in[i] = (const float*)d_in[i];
    a.out = (float*)d_out; a.ws = (unsigned char*)d_ws;
    unsigned char* ws = (unsigned char*)d_ws;
    auto launch = [&](int lo, int hi, int li) { a.ph_lo = lo; a.ph_hi = hi; a.li = li; hipLaunchKernelGGL(mega_fwd, dim3(grid), dim3(NWAVES * 64), LDS_BYTES, stream, a); };
#if SIMPLE_HGRN || SIMPLE_LRU
    launch(0, 4, 0);
#if SIMPLE_HGRN
    {   float* OH = (float*)(ws + WS_XB);
        hipLaunchKernelGGL(k_simple_hgrn, dim3(64), dim3(64), 0, stream, (const float*)(ws + WS_LOGF), (const bf16*)(ws + WS_MIXA), (const bf16*)(ws + WS_V), OH);
        hipLaunchKernelGGL(k_simple_hnorm, dim3(M * HEADS / 4), dim3(256), 0, stream, (const float*)OH, (const bf16*)(ws + WS_SG), (const float*)d_in[I_HGN], (bf16*)(ws + WS_MIXA)); }
#endif
#if SIMPLE_LRU
    {   float* LA = (float*)(ws + WS_KVT); float* LU = LA + (size_t)M * 1024;
        hipLaunchKernelGGL(k_simple_lru_a, dim3(M), dim3(256), 0, stream, (const bf16*)(ws + WS_LRX), (const float*)d_in[I_CW], (const float*)d_in[I_CB], (const float*)d_in[I_LWA], (const float*)d_in[I_LBA],
                           (const float*)d_in[I_LWX], (const float*)d_in[I_LBX], (const float*)d_in[I_LAM], LA, LU);
        hipLaunchKernelGGL(k_simple_lru_b, dim3(BATCH * 1024 / 256), dim3(256), 0, stream, (const float*)LA, (const float*)LU, (bf16*)(ws + WS_MIXA)); }
#endif
    launch(4, N_PHASES, 1);
#else
#if N_LAUNCHES == 1
    launch(0, N_PHASES, 0);
#else
    for (int ph = 0; ph < N_PHASES; ++ph) launch(ph, ph + 1, 0);
#endif
#endif
}
```

```cpp
#include <hip/hip_runtime.h>
#include <cstdio>
#include <cstdint>
#ifndef HOST_GU2
#define HOST_GU2 0
#endif
#ifndef SIMPLE_HGRN
#define SIMPLE_HGRN 0
#endif
#ifndef SIMPLE_LRU
#define SIMPLE_LRU 0
#endif
#ifndef N_LAUNCHES
#define N_LAUNCHES 1
#endif
#if SIMPLE_HGRN
#define MIXER_PHASE_4
#define MIXER_PHASE_6
#define MIXER_SCAN
#else
#define MIXER_PHASE_4 hgrn_local_phase(F);
#ifdef PROBE_H3
#define MIXER_PHASE_6 hgrn_out_phase(F, true); xcd_barrier(bar); hgrn_out_phase(F);
#else
#define MIXER_PHASE_6 hgrn_out_phase(F);
#endif
#ifdef PROBE_SCAN
#define MIXER_SCAN hgrn_scan_phase(F); xcd_barrier(bar); hgrn_scan_phase(F);
#else
#define MIXER_SCAN hgrn_scan_phase(F);
#endif
#endif
#if SIMPLE_LRU
#define MIXER_LRU
#else
#ifdef PROBE_LRU
#define MIXER_LRU lru_phase<PROBE_LRU, false, true>(F); xcd_barrier(bar); lru_phase<0>(F);
#else
#define MIXER_LRU lru_phase<0>(F);
#endif
#endif
#if !SIMPLE_HGRN && !SIMPLE_LRU && !defined(PROBE_LRU) && !defined(PROBE_SCAN)
#define MIXER_PHASE_5 if (F.G * NWAVES * 64 == BATCH * HEADS * 128 * 32 && F.G == BATCH * 64) { lru_phase<0, true>(F); } else { hgrn_scan_phase(F); lru_phase<0, false>(F); }
#else
#define MIXER_PHASE_5 MIXER_SCAN MIXER_LRU
#endif
namespace pg8 {
#define PG8_LAS __attribute__((address_space(3)))
typedef unsigned short bf16_t;
typedef short bf16x8 __attribute__((ext_vector_type(8)));
typedef float f32x4 __attribute__((ext_vector_type(4)));
typedef unsigned u32x4 __attribute__((ext_vector_type(4)));
constexpr int BM = 256, BK = 64, HALF = 128, HTB = HALF * BK * 2  , STAGE_BYTES = 8 * HTB, NXCD = 8, WGM = 8;

__host__ __device__ __forceinline__ int lds_byte(int r, int c) { const int st = (r >> 4) * 2 + (c >> 5), rr = r & 15, cc = c & 31, ob = rr * 64 + cc * 2; return st * 1024 + (ob ^ (((ob >> 9) & 1) << 5)); }
__host__ __device__ __forceinline__ void stage_rc(int b, int& R, int& C) { const int st = b / 1024, sb = b % 1024, swz = sb ^ (((sb >> 9) & 1) << 5); R = (st >> 1) * 16 + swz / 64; C = (st & 1) * 32 + (swz % 64) / 2; }
__host__ __device__ __forceinline__ int perm32(int rho) { const int n = rho >> 4, i = rho & 15; return 8 * (i >> 2) + 4 * n + (i & 3); }

struct Unit { int pm, pn; };
struct Gemm { const bf16_t* A; const bf16_t* Bt; int M, N, K; };

struct StaticOrder {
    int nM, nN, nwg, G, c;
    __host__ __device__ void init(int M, int N, int G_, int c_) { nM = M / BM; nN = N / BM; nwg = nM * nN; G = G_; c = c_; }
    __host__ __device__ bool next(int i, Unit& u) const {
        const long L = (long)i * G + c; if (L >= nwg) return false;
        int wgid = (int)L; { const int q = nwg / NXCD, r = nwg % NXCD, xcd = wgid % NXCD, off = wgid / NXCD; wgid = (xcd < r ? xcd * (q + 1) : r * (q + 1) + (xcd - r) * q) + off; }
        const int nig = WGM * nN, gid = wgid / nig, fm = gid * WGM, gsz = (nM - fm) < WGM ? (nM - fm) : WGM;
        u.pm = fm + ((wgid % nig) % gsz); u.pn = (wgid % nig) / gsz; return true;
    }
    __device__ __forceinline__ void a_ready(const Unit&) const {}
    __device__ __forceinline__ void done(const Unit&) const {}
};
__device__ __forceinline__ int lane_id_asm() { int l; asm volatile("v_mbcnt_lo_u32_b32 %0, -1, 0\n\tv_mbcnt_hi_u32_b32 %0, -1, %0" : "=v"(l)); return l; }
__device__ __forceinline__ unsigned cvt_pk_bf16(float lo, float hi) { unsigned r; asm volatile("v_cvt_pk_bf16_f32 %0, %1, %2" : "=v"(r) : "v"(lo), "v"(hi)); return r; }
typedef unsigned u32x2 __attribute__((ext_vector_type(2)));
constexpr int DM = 2048;
constexpr int NSSQ = 32;
__device__ __forceinline__ float sigmoid_f(float x) { return __builtin_amdgcn_rcpf(1.0f + __expf(-x)); }
__device__ __forceinline__ float silu_f(float x) { return x * sigmoid_f(x); }
__device__ __forceinline__ float gelu_tanh_f(float x) { return x * sigmoid_f(1.5957691216057308f * (x + 0.044715f * x * x * x)); }
__device__ __forceinline__ f32x4 bf16x4_to_f32(u32x2 w) { f32x4 r; r[0] = __builtin_bit_cast(float, w.x << 16); r[1] = __builtin_bit_cast(float, w.x & 0xffff0000u); r[2] = __builtin_bit_cast(float, w.y << 16); r[3] = __builtin_bit_cast(float, w.y & 0xffff0000u); return r; }
__device__ __forceinline__ void rows_rstd(const float* ssq, int row0, int fq, float (&rs)[2][4]) {
    f32x4 pa[2][4], pb[2][4];
#pragma unroll
    for (int ai = 0; ai < 2; ++ai)
#pragma unroll
        for (int m = 0; m < 4; ++m) { const f32x4* p = (const f32x4*)(ssq + (size_t)(row0 + ai * HALF + m * 16) * NSSQ + fq * 8); pa[ai][m] = p[0]; pb[ai][m] = p[1]; }
#pragma unroll
    for (int ai = 0; ai < 2; ++ai)
#pragma unroll
        for (int m = 0; m < 4; ++m) { const f32x4 a = pa[ai][m], b = pb[ai][m];
            float s = ((a[0] + a[1]) + (a[2] + a[3])) + ((b[0] + b[1]) + (b[2] + b[3]));
            s += __shfl_xor(s, 16); s += __shfl_xor(s, 32);
            rs[ai][m] = 1.0f / sqrtf(s * (1.0f / (float)DM) + 1e-6f); }
}

struct EpiSwiGLU {
    static constexpr bool PERM = true, AFTER_DRAIN = false, INIT_ACC = false;
    bf16_t* O; int ldo; const float* ssq;
    __device__ __forceinline__ void operator()(const f32x4 (&acc)[2][2][4][2], const Unit& u, int wr, int wc, int fr, int fq) const {
        const int row0 = u.pm * BM + wr * 64 + fr, col0 = u.pn * HALF + wc * 32 + 8 * fq;
        float rs[2][4]; rows_rstd(ssq, row0, fq, rs);
#pragma unroll
        for (int ai = 0; ai < 2; ++ai)
#pragma unroll
            for (int m = 0; m < 4; ++m) {
                const int row = row0 + ai * HALF + m * 16; const float r = rs[ai][m];
                float h[8];
#pragma unroll
                for (int n = 0; n < 2; ++n)
#pragma unroll
                    for (int j = 0; j < 4; ++j) { const float g = acc[ai][0][m][n][j] * r, up = acc[ai][1][m][n][j] * r; h[n * 4 + j] = silu_f(g) * up; }
                u32x4 w; w.x = cvt_pk_bf16(h[0], h[1]); w.y = cvt_pk_bf16(h[2], h[3]); w.z = cvt_pk_bf16(h[4], h[5]); w.w = cvt_pk_bf16(h[6], h[7]);
                *(u32x4*)(O + (size_t)row * ldo + col0) = w;
            }
    }
};
struct EpiResid {
    static constexpr bool PERM = false, AFTER_DRAIN = false, INIT_ACC = false;
    const float* src32; bf16_t* xb; float* ssq_out;
    __device__ __forceinline__ void operator()(const f32x4 (&acc)[2][2][4][2], const Unit& u, int wr, int wc, int fr, int fq) const {
        const int row0 = u.pm * BM + wr * 64 + fr, col0 = u.pn * BM + wc * 32 + 4 * fq;
#pragma unroll
        for (int ai = 0; ai < 2; ++ai)
#pragma unroll
            for (int m = 0; m < 4; ++m) {
                const int row = row0 + ai * HALF + m * 16; float ss = 0.f;
                f32x4 sv[2][2];
#pragma unroll
                for (int bj = 0; bj < 2; ++bj)
#pragma unroll
                    for (int n = 0; n < 2; ++n) { const size_t off = (size_t)row * DM + col0 + bj * HALF + n * 16; sv[bj][n] = src32 ? *(const f32x4*)(src32 + off) : bf16x4_to_f32(*(const u32x2*)(xb + off)); }
#pragma unroll
                for (int bj = 0; bj < 2; ++bj)
#pragma unroll
                    for (int n = 0; n < 2; ++n) { const size_t off = (size_t)row * DM + col0 + bj * HALF + n * 16;
                        const f32x4 o = sv[bj][n] + acc[ai][bj][m][n];
                        u32x2 w; w.x = cvt_pk_bf16(o[0], o[1]); w.y = cvt_pk_bf16(o[2], o[3]); *(u32x2*)(xb + off) = w;
                        ss += (o[0] * o[0] + o[1] * o[1]) + (o[2] * o[2] + o[3] * o[3]); }
                ss += __shfl_xor(ss, 16); ss += __shfl_xor(ss, 32);
                if (fq == 0) ssq_out[(size_t)row * NSSQ + u.pn * 4 + wc] = ss;
            }
    }
};
struct EpiResidInit {
    static constexpr bool PERM = true, AFTER_DRAIN = false, INIT_ACC = true;
    const float* src32; bf16_t* xb; float* ssq_out;
    __device__ __forceinline__ void init_acc(f32x4 (&acc)[2][2][4][2], const Unit& u, int wr, int wc, int fr, int fq) const {
        const int row0 = u.pm * BM + wr * 64 + fr, col0 = u.pn * BM + wc * 32 + 8 * fq;
        if (src32) {
#pragma unroll
            for (int ai = 0; ai < 2; ++ai)
#pragma unroll
                for (int m = 0; m < 4; ++m)
#pragma unroll
                    for (int bj = 0; bj < 2; ++bj)
#pragma unroll
                        for (int n = 0; n < 2; ++n) acc[ai][bj][m][n] = __builtin_nontemporal_load((const f32x4*)(src32 + (size_t)(row0 + ai * HALF + m * 16) * DM + col0 + bj * HALF + n * 4));
        } else {
#pragma unroll
            for (int ai = 0; ai < 2; ++ai)
#pragma unroll
                for (int m = 0; m < 4; ++m)
#pragma unroll
                    for (int bj = 0; bj < 2; ++bj) { const u32x4 h = *(const u32x4*)(xb + (size_t)(row0 + ai * HALF + m * 16) * DM + col0 + bj * HALF); acc[ai][bj][m][0] = __builtin_bit_cast(f32x4, h); }
#pragma unroll
            for (int ai = 0; ai < 2; ++ai)
#pragma unroll
                for (int m = 0; m < 4; ++m)
#pragma unroll
                    for (int bj = 0; bj < 2; ++bj) { const u32x4 r = __builtin_bit_cast(u32x4, acc[ai][bj][m][0]); acc[ai][bj][m][0] = bf16x4_to_f32((u32x2){r.x, r.y}); acc[ai][bj][m][1] = bf16x4_to_f32((u32x2){r.z, r.w}); }
        }
    }
    __device__ __forceinline__ void operator()(const f32x4 (&acc)[2][2][4][2], const Unit& u, int wr, int wc, int fr, int fq) const {
        const int row0 = u.pm * BM + wr * 64 + fr, col0 = u.pn * BM + wc * 32 + 8 * fq;
#pragma unroll
        for (int ai = 0; ai < 2; ++ai)
#pragma unroll
            for (int m = 0; m < 4; ++m) {
                const int row = row0 + ai * HALF + m * 16; float ss = 0.f;
#pragma unroll
                for (int bj = 0; bj < 2; ++bj) { const size_t off = (size_t)row * DM + col0 + bj * HALF;
                    const f32x4 o = acc[ai][bj][m][0], p = acc[ai][bj][m][1];
                    u32x4 w; w.x = cvt_pk_bf16(o[0], o[1]); w.y = cvt_pk_bf16(o[2], o[3]); w.z = cvt_pk_bf16(p[0], p[1]); w.w = cvt_pk_bf16(p[2], p[3]); *(u32x4*)(xb + off) = w;
                    ss += ((o[0] * o[0] + o[1] * o[1]) + (o[2] * o[2] + o[3] * o[3])) + ((p[0] * p[0] + p[1] * p[1]) + (p[2] * p[2] + p[3] * p[3])); }
                ss += __shfl_xor(ss, 16); ss += __shfl_xor(ss, 32);
                if (fq == 0) ssq_out[(size_t)row * NSSQ + u.pn * 4 + wc] = ss;
            }
    }
};
struct EpiZ {
    static constexpr bool PERM = true, AFTER_DRAIN = false, INIT_ACC = false;
    const float* ssq; const float* hlb;
    bf16_t* mixa;
    float* logf; bf16_t* vv; bf16_t* sg; bf16_t* lrx;
    __device__ __forceinline__ void operator()(const f32x4 (&acc)[2][2][4][2], const Unit& u, int wr, int wc, int fr, int fq) const {
        const int seg = u.pn >> 2;
        const int row0 = u.pm * BM + wr * 64 + fr, cs0 = (u.pn & 3) * BM + wc * 32 + 8 * fq;
        float rs[2][4]; rows_rstd(ssq, row0, fq, rs);
        float lbv[2][8];
        if (seg == 1) {
#pragma unroll
            for (int bj = 0; bj < 2; ++bj)
#pragma unroll
                for (int e = 0; e < 8; ++e) { const int c = cs0 + bj * HALF + e; lbv[bj][e] = sigmoid_f(hlb[c] - hlb[1024 + c]); }
        }
#pragma unroll
        for (int ai = 0; ai < 2; ++ai)
#pragma unroll
            for (int m = 0; m < 4; ++m) {
                const int row = row0 + ai * HALF + m * 16; const float r = rs[ai][m];
#pragma unroll
                for (int bj = 0; bj < 2; ++bj) {
                    const int cs = cs0 + bj * HALF;
                    float z[8];
#pragma unroll
                    for (int n = 0; n < 2; ++n)
#pragma unroll
                        for (int j = 0; j < 4; ++j) z[n * 4 + j] = acc[ai][bj][m][n][j] * r;
                    if (seg == 1) {
                        float lf[8];
#pragma unroll
                        for (int e = 0; e < 8; ++e) { const float lb = lbv[bj][e]; lf[e] = __logf(lb + (1.0f - lb) * sigmoid_f(z[e])); }
                        float* p = logf + (size_t)row * 1024 + cs;
                        *(f32x4*)p = (f32x4){lf[0], lf[1], lf[2], lf[3]}; *(f32x4*)(p + 4) = (f32x4){lf[4], lf[5], lf[6], lf[7]};
                    } else {
                        if (seg == 3) {
#pragma unroll
                            for (int e = 0; e < 8; ++e) z[e] = silu_f(z[e]);
                        } else if (seg == 5) {
#pragma unroll
                            for (int e = 0; e < 8; ++e) z[e] = gelu_tanh_f(z[e]);
                        }
                        u32x4 w; w.x = cvt_pk_bf16(z[0], z[1]); w.y = cvt_pk_bf16(z[2], z[3]); w.z = cvt_pk_bf16(z[4], z[5]); w.w = cvt_pk_bf16(z[6], z[7]);
                        bf16_t* p;
                        if (seg == 0) p = mixa + (size_t)row * 2048 + cs;
                        else if (seg == 5) p = mixa + (size_t)row * 2048 + 1024 + cs;
                        else if (seg == 2) p = vv + (size_t)row * 1024 + cs;
                        else if (seg == 3) p = sg + (size_t)row * 1024 + cs;
                        else p = lrx + (size_t)row * 1024 + cs;
                        *(u32x4*)p = w;
                    }
                }
            }
    }
};
struct EpiPP {
    static constexpr bool PERM = false, AFTER_DRAIN = false, INIT_ACC = false;
    bf16_t* PP;
    __device__ __forceinline__ void operator()(const f32x4 (&acc)[2][2][4][2], const Unit& u, int wr, int wc, int fr, int fq) const {
        const int row0 = u.pm * BM + wr * 64 + fr, col0 = u.pn * BM + wc * 32 + 4 * fq;
#pragma unroll
        for (int ai = 0; ai < 2; ++ai)
#pragma unroll
            for (int m = 0; m < 4; ++m) { bf16_t* rowp = PP + (size_t)(row0 + ai * HALF + m * 16) * DM + col0;
#pragma unroll
                for (int bj = 0; bj < 2; ++bj)
#pragma unroll
                    for (int n = 0; n < 2; ++n) { const f32x4 a = acc[ai][bj][m][n]; u32x2 w; w.x = cvt_pk_bf16(a[0], a[1]); w.y = cvt_pk_bf16(a[2], a[3]); *(u32x2*)(rowp + bj * HALF + n * 16) = w; } }
    }
};
struct EpiPLE {
    static constexpr bool PERM = false, AFTER_DRAIN = false, INIT_ACC = false;
    const float* ssq_in; const float* bg; const bf16_t* PP; const bf16_t* xb; float* X; float* ssq_out;
    __device__ __forceinline__ void operator()(const f32x4 (&acc)[2][2][4][2], const Unit& u, int wr, int wc, int fr, int fq) const {
        const int row0 = u.pm * BM + wr * 64 + fr, col0 = u.pn * BM + wc * 32 + 4 * fq;
        float rs[2][4]; rows_rstd(ssq_in, row0, fq, rs);
#pragma unroll
        for (int ai = 0; ai < 2; ++ai)
#pragma unroll
            for (int m = 0; m < 4; ++m) {
                const int row = row0 + ai * HALF + m * 16; const float r = rs[ai][m]; float ss = 0.f;
                f32x4 pv[2][2], ov[2][2];
#pragma unroll
                for (int bj = 0; bj < 2; ++bj)
#pragma unroll
                    for (int n = 0; n < 2; ++n) { const size_t off = (size_t)row * DM + col0 + bj * HALF + n * 16; pv[bj][n] = bf16x4_to_f32(*(const u32x2*)(PP + off)); ov[bj][n] = bf16x4_to_f32(*(const u32x2*)(xb + off)); }
#pragma unroll
                for (int bj = 0; bj < 2; ++bj)
#pragma unroll
                    for (int n = 0; n < 2; ++n) { const int c = col0 + bj * HALF + n * 16; const size_t off = (size_t)row * DM + c;
                        const f32x4 b4 = *(const f32x4*)(bg + c), a = acc[ai][bj][m][n]; f32x4 o;
#pragma unroll
                        for (int j = 0; j < 4; ++j) o[j] = ov[bj][n][j] + sigmoid_f(a[j] * r + b4[j]) * pv[bj][n][j];
                        *(f32x4*)(X + off) = o; ss += (o[0] * o[0] + o[1] * o[1]) + (o[2] * o[2] + o[3] * o[3]); }
                ss += __shfl_xor(ss, 16); ss += __shfl_xor(ss, 32);
                if (fq == 0) ssq_out[(size_t)row * NSSQ + u.pn * 4 + wc] = ss;
            }
    }
};

struct EpiPLEFinal {
    static constexpr bool PERM = true, AFTER_DRAIN = true, INIT_ACC = false;
    const float* ssq_in; const float* bg; const bf16_t* PP; const bf16_t* xb; float* X; float* xch; unsigned* cnt; const float* gf;
    __device__ __forceinline__ void operator()(const f32x4 (&)[2][2][4][2], const Unit&, int, int, int, int) const {}
    __device__ __forceinline__ void fused(f32x4 (&acc)[2][2][4][2], const Unit& u, int wr, int wc, int fr, int fq, PG8_LAS unsigned char* lds, int wid, int lane) const {
        const int row0 = u.pm * BM + wr * 64 + fr, col0 = u.pn * BM + wc * 32 + 8 * fq;
        float rs[2][4]; rows_rstd(ssq_in, row0, fq, rs);
        f32x4 b4[2][2];
#pragma unroll
        for (int bj = 0; bj < 2; ++bj)
#pragma unroll
            for (int n = 0; n < 2; ++n) b4[bj][n] = *(const f32x4*)(bg + col0 + bj * HALF + n * 4);
#pragma unroll
        for (int ai = 0; ai < 2; ++ai)
#pragma unroll
          for (int mp = 0; mp < 2; ++mp) {
            u32x4 pv[2][2], ov[2][2];
#pragma unroll
            for (int mm = 0; mm < 2; ++mm)
#pragma unroll
                for (int bj = 0; bj < 2; ++bj) { const size_t off = (size_t)(row0 + ai * HALF + (2 * mp + mm) * 16) * DM + col0 + bj * HALF; pv[mm][bj] = *(const u32x4*)(PP + off); ov[mm][bj] = *(const u32x4*)(xb + off); }
#pragma unroll
            for (int mm = 0; mm < 2; ++mm) {
                const int m = 2 * mp + mm, row = row0 + ai * HALF + m * 16; const float r = rs[ai][m]; float ss = 0.f;
#pragma unroll
                for (int bj = 0; bj < 2; ++bj)
#pragma unroll
                    for (int n = 0; n < 2; ++n) { const f32x4 a = acc[ai][bj][m][n], pp = bf16x4_to_f32(n ? (u32x2){pv[mm][bj].z, pv[mm][bj].w} : (u32x2){pv[mm][bj].x, pv[mm][bj].y}), xo = bf16x4_to_f32(n ? (u32x2){ov[mm][bj].z, ov[mm][bj].w} : (u32x2){ov[mm][bj].x, ov[mm][bj].y}); f32x4 o;
#pragma unroll
                        for (int j = 0; j < 4; ++j) o[j] = xo[j] + sigmoid_f(a[j] * r + b4[bj][n][j]) * pp[j];
                        acc[ai][bj][m][n] = o; ss += (o[0] * o[0] + o[1] * o[1]) + (o[2] * o[2] + o[3] * o[3]); }
                ss += __shfl_xor(ss, 16); ss += __shfl_xor(ss, 32);
                if (fq == 0) __hip_atomic_store(xch + (size_t)row * NSSQ + u.pn * 4 + wc, ss, __ATOMIC_RELAXED, __HIP_MEMORY_SCOPE_AGENT);
            }
          }
        asm volatile("s_waitcnt vmcnt(0)" ::: "memory");
        unsigned* pc = cnt + 64 * u.pm;
        if (lane == 0) __hip_atomic_fetch_add(pc, 1u, __ATOMIC_RELAXED, __HIP_MEMORY_SCOPE_AGENT);
        if (wid == 0) {
            unsigned sp = 0;
            while ((unsigned)__builtin_amdgcn_readfirstlane(__hip_atomic_load(pc, __ATOMIC_RELAXED, __HIP_MEMORY_SCOPE_AGENT)) < 64u) { __builtin_amdgcn_s_sleep(2); if (++sp > (1u << 22)) break; }
            __builtin_amdgcn_fence(__ATOMIC_ACQUIRE, "agent");
        }
        asm volatile("s_waitcnt vmcnt(0) lgkmcnt(0)" ::: "memory"); __builtin_amdgcn_s_barrier(); asm volatile("" ::: "memory");
        float r4[2][4]; rows_rstd(xch, row0, fq, r4);
        f32x4 g4[2][2];
#pragma unroll
        for (int bj = 0; bj < 2; ++bj)
#pragma unroll
            for (int n = 0; n < 2; ++n) g4[bj][n] = *(const f32x4*)(gf + col0 + bj * HALF + n * 4);
#pragma unroll
        for (int ai = 0; ai < 2; ++ai)
#pragma unroll
            for (int m = 0; m < 4; ++m) { float* rowp = X + (size_t)(row0 + ai * HALF + m * 16) * DM + col0; const float r = r4[ai][m];
#pragma unroll
                for (int bj = 0; bj < 2; ++bj)
#pragma unroll
                    for (int n = 0; n < 2; ++n) *(f32x4*)(rowp + bj * HALF + n * 4) = acc[ai][bj][m][n] * r * g4[bj][n]; }
    }
};

template <class Epi, class Sched, bool ALIGN_EPI = false, bool SP2 = false, bool BAL = false>
__device__ __forceinline__ void gemm_phase(PG8_LAS unsigned char* lds, const Gemm g, const Sched& S, const Epi& E, const int wave_s) {
    int tid_ = wave_s * 64 + lane_id_asm();
    const int tid = tid_, wid = wave_s, lane = tid & 63, wr = wid >> 2, wc = wid & 3, fr = lane & 15, fq = lane >> 4;
    const int K = g.K, nt = K / BK;
    unsigned voffA[2], voffB[2];
#pragma unroll
    for (int i = 0; i < 2; ++i) { int R, C; stage_rc(tid * 16 + i * 8192, R, C); const int Rb = Epi::PERM ? ((R & ~31) + perm32(R & 31)) : R;
        voffA[i] = (unsigned)(R * K + C) * 2u; voffB[i] = (unsigned)(Rb * K + C) * 2u; }
    const size_t kstep = (size_t)(BK * 2);
    const size_t hstep = (size_t)HALF * K * 2;
    const size_t tstep = 2 * hstep;
    const unsigned ldsw = (unsigned)wid * 1024u;
    const int aoff = lds_byte(wr * 64 + fr, fq * 8), boff = lds_byte(wc * 32 + fr, fq * 8);
#define PG8_SA(b, h) (((b) * 2 + (h)) * HTB)
#define PG8_SB(b, h) ((4 + (b) * 2 + (h)) * HTB)
#define PG8_STAGE(bufoff, gbase, voff) do { _Pragma("unroll") for (int _i = 0; _i < 2; ++_i) \
        __builtin_amdgcn_global_load_lds((const unsigned*)((const char*)(gbase) + (voff)[_i]), (PG8_LAS unsigned*)(lds + (bufoff) + ldsw + _i * 8192), 16, 0, 0); } while (0)
#define PG8_LDA(dst, b, h) do { _Pragma("unroll") for (int m = 0; m < 4; ++m) _Pragma("unroll") for (int k = 0; k < 2; ++k) dst[m][k] = *(const PG8_LAS bf16x8*)(lds + PG8_SA(b, h) + aoff + m * 2048 + k * 1024); } while (0)
#define PG8_LDB(dst, b, h) do { _Pragma("unroll") for (int n = 0; n < 2; ++n) _Pragma("unroll") for (int k = 0; k < 2; ++k) dst[n][k] = *(const PG8_LAS bf16x8*)(lds + PG8_SB(b, h) + boff + n * 2048 + k * 1024); } while (0)
#define PG8_MMA(ai, bj, At, Bt) do { __builtin_amdgcn_s_setprio(1); _Pragma("unroll") for (int m = 0; m < 4; ++m) _Pragma("unroll") for (int n = 0; n < 2; ++n) _Pragma("unroll") for (int k = 0; k < 2; ++k) \
        acc[ai][bj][m][n] = __builtin_amdgcn_mfma_f32_16x16x32_bf16(Bt[n][k], At[m][k], acc[ai][bj][m][n], 0, 0, 0); __builtin_amdgcn_s_setprio(0); } while (0)
#define PG8_WAIT_V(n) asm volatile("s_waitcnt vmcnt(" #n ")" ::: "memory")
#define PG8_WAIT_L(n) asm volatile("s_waitcnt lgkmcnt(" #n ")" ::: "memory")
#define PG8_BAR __builtin_amdgcn_s_barrier()
#define PG8_SCHED __builtin_amdgcn_sched_barrier(0)
    Unit cur, nxt; int ui = 0;
    if (!S.next(0, cur)) return;
    f32x4 acc[2][2][4][2];
    if constexpr (Epi::INIT_ACC) { E.init_acc(acc, cur, wr, wc, fr, fq); }
    else {
#pragma unroll
    for (int a = 0; a < 2; ++a)
#pragma unroll
        for (int b = 0; b < 2; ++b)
#pragma unroll
            for (int m = 0; m < 4; ++m)
#pragma unroll
                for (int n = 0; n < 2; ++n) acc[a][b][m][n] = (f32x4){0.f, 0.f, 0.f, 0.f};
    }
    bf16x8 At[4][2], B0[2][2], B1[2][2];
    const char* cA = (const char*)g.A + (size_t)cur.pm * tstep; const char* cB = (const char*)g.Bt + (size_t)cur.pn * tstep;
    S.a_ready(cur);
    if constexpr (SP2) {
        PG8_STAGE(PG8_SB(0, 0), cB, voffB); PG8_STAGE(PG8_SB(0, 1), cB + hstep, voffB); PG8_STAGE(PG8_SA(0, 0), cA, voffA); PG8_STAGE(PG8_SA(0, 1), cA + hstep, voffA);
        if (wr == 1) PG8_BAR;
        PG8_WAIT_V(2); PG8_BAR;
        if constexpr (BAL) {
            PG8_STAGE(PG8_SB(1, 0), cB + kstep, voffB); PG8_STAGE(PG8_SB(1, 1), cB + hstep + kstep, voffB);
            PG8_WAIT_V(4); PG8_BAR;
        } else {
        PG8_STAGE(PG8_SB(1, 0), cB + kstep, voffB); PG8_STAGE(PG8_SA(1, 0), cA + kstep, voffA); PG8_STAGE(PG8_SB(1, 1), cB + hstep + kstep, voffB);
        PG8_WAIT_V(6); PG8_BAR;
        }
    } else {
        PG8_STAGE(PG8_SB(0, 0), cB, voffB); PG8_STAGE(PG8_SA(0, 0), cA, voffA); PG8_STAGE(PG8_SB(0, 1), cB + hstep, voffB); PG8_STAGE(PG8_SA(0, 1), cA + hstep, voffA);
        if (wr == 1) PG8_BAR;
        PG8_WAIT_V(4); PG8_BAR;
        PG8_STAGE(PG8_SB(1, 0), cB + kstep, voffB); PG8_STAGE(PG8_SA(1, 0), cA + kstep, voffA); PG8_STAGE(PG8_SB(1, 1), cB + hstep + kstep, voffB);
        PG8_WAIT_V(6); PG8_BAR;
    }
    for (;;) {
        const bool has_next = S.next(ui + 1, nxt);
        const char* nA = has_next ? (const char*)g.A + (size_t)nxt.pm * tstep : cA; const char* nB = has_next ? (const char*)g.Bt + (size_t)nxt.pn * tstep : cB;
        for (int t = 0; t < nt; t += 2) {
            const bool last = (t == nt - 2);
            const char* a1 = cA + (size_t)(t + 1) * kstep;
            const char* a2 = last ? nA : cA + (size_t)(t + 2) * kstep; const char* b2 = last ? nB : cB + (size_t)(t + 2) * kstep;
            const char* a3 = a2 + kstep; const char* b3 = b2 + kstep;
            if (last && has_next) S.a_ready(nxt);
            if constexpr (SP2 && BAL) {
            PG8_LDB(B0, 0, 0); PG8_LDB(B1, 0, 1); PG8_SCHED; PG8_LDA(At, 0, 0); PG8_STAGE(PG8_SA(1, 0), a1, voffA); PG8_STAGE(PG8_SA(1, 1), a1 + hstep, voffA);
            PG8_WAIT_V(4); PG8_WAIT_L(0); PG8_BAR; PG8_MMA(0, 0, At, B0); PG8_MMA(0, 1, At, B1); PG8_BAR; PG8_SCHED;
            PG8_LDA(At, 0, 1); PG8_STAGE(PG8_SB(0, 0), b2, voffB); PG8_STAGE(PG8_SB(0, 1), b2 + hstep, voffB);
            PG8_WAIT_V(4); PG8_WAIT_L(0); PG8_BAR; PG8_MMA(1, 0, At, B0); PG8_MMA(1, 1, At, B1); PG8_BAR; PG8_SCHED;
            PG8_LDB(B0, 1, 0); PG8_LDB(B1, 1, 1); PG8_SCHED; PG8_LDA(At, 1, 0); PG8_STAGE(PG8_SA(0, 0), a2, voffA); PG8_STAGE(PG8_SA(0, 1), a2 + hstep, voffA);
            PG8_WAIT_V(4); PG8_WAIT_L(0); PG8_BAR; PG8_MMA(0, 0, At, B0); PG8_MMA(0, 1, At, B1); PG8_BAR; PG8_SCHED;
            PG8_LDA(At, 1, 1); PG8_STAGE(PG8_SB(1, 0), b3, voffB); PG8_STAGE(PG8_SB(1, 1), b3 + hstep, voffB);
            PG8_WAIT_V(4); PG8_WAIT_L(0); PG8_BAR; PG8_MMA(1, 0, At, B0); PG8_MMA(1, 1, At, B1); PG8_BAR; PG8_SCHED;
            } else if constexpr (SP2) {
            PG8_LDB(B0, 0, 0); PG8_LDB(B1, 0, 1); PG8_SCHED; PG8_LDA(At, 0, 0); PG8_STAGE(PG8_SA(1, 1), a1 + hstep, voffA);
            PG8_WAIT_V(8); PG8_WAIT_L(0); PG8_BAR; PG8_MMA(0, 0, At, B0); PG8_MMA(0, 1, At, B1); PG8_BAR; PG8_SCHED;
            PG8_LDA(At, 0, 1); PG8_STAGE(PG8_SB(0, 0), b2, voffB); PG8_STAGE(PG8_SB(0, 1), b2 + hstep, voffB); PG8_STAGE(PG8_SA(0, 0), a2, voffA);
            PG8_WAIT_V(8); PG8_WAIT_L(0); PG8_BAR; PG8_MMA(1, 0, At, B0); PG8_MMA(1, 1, At, B1); PG8_BAR; PG8_SCHED;
            PG8_LDB(B0, 1, 0); PG8_LDB(B1, 1, 1); PG8_SCHED; PG8_LDA(At, 1, 0); PG8_STAGE(PG8_SA(0, 1), a2 + hstep, voffA);
            PG8_WAIT_V(8); PG8_WAIT_L(0); PG8_BAR; PG8_MMA(0, 0, At, B0); PG8_MMA(0, 1, At, B1); PG8_BAR; PG8_SCHED;
            PG8_LDA(At, 1, 1); PG8_STAGE(PG8_SB(1, 0), b3, voffB); PG8_STAGE(PG8_SB(1, 1), b3 + hstep, voffB); PG8_STAGE(PG8_SA(1, 0), a3, voffA);
            PG8_WAIT_V(8); PG8_WAIT_L(0); PG8_BAR; PG8_MMA(1, 0, At, B0); PG8_MMA(1, 1, At, B1); PG8_BAR; PG8_SCHED;
            } else {
            PG8_LDB(B0, 0, 0); PG8_SCHED; PG8_LDA(At, 0, 0); PG8_STAGE(PG8_SA(1, 1), a1 + hstep, voffA);
            PG8_WAIT_L(8); PG8_BAR; PG8_WAIT_L(0); PG8_MMA(0, 0, At, B0); PG8_BAR; PG8_SCHED;
            PG8_LDB(B1, 0, 1); PG8_STAGE(PG8_SB(0, 0), b2, voffB);
            PG8_BAR; PG8_WAIT_L(0); PG8_MMA(0, 1, At, B1); PG8_BAR;
            PG8_LDA(At, 0, 1); PG8_STAGE(PG8_SA(0, 0), a2, voffA);
            PG8_BAR; PG8_WAIT_L(0); PG8_MMA(1, 0, At, B0); PG8_BAR; PG8_SCHED;
            PG8_STAGE(PG8_SB(0, 1), b2 + hstep, voffB);
            PG8_WAIT_V(6); PG8_BAR; PG8_MMA(1, 1, At, B1); PG8_BAR;
            PG8_LDB(B0, 1, 0); PG8_SCHED; PG8_LDA(At, 1, 0); PG8_STAGE(PG8_SA(0, 1), a2 + hstep, voffA);
            PG8_WAIT_L(8); PG8_BAR; PG8_WAIT_L(0); PG8_MMA(0, 0, At, B0); PG8_BAR; PG8_SCHED;
            PG8_LDB(B1, 1, 1); PG8_STAGE(PG8_SB(1, 0), b3, voffB);
            PG8_BAR; PG8_WAIT_L(0); PG8_MMA(0, 1, At, B1); PG8_BAR;
            PG8_LDA(At, 1, 1); PG8_STAGE(PG8_SA(1, 0), a3, voffA);
            PG8_BAR; PG8_WAIT_L(0); PG8_MMA(1, 0, At, B0); PG8_BAR; PG8_SCHED;
            PG8_STAGE(PG8_SB(1, 1), b3 + hstep, voffB);
            PG8_WAIT_V(6); PG8_BAR; PG8_MMA(1, 1, At, B1); PG8_BAR;
            }
        }
        if constexpr (ALIGN_EPI) { if (wr == 0) PG8_BAR; }
        if constexpr (!Epi::AFTER_DRAIN) { E(acc, cur, wr, wc, fr, fq); S.done(cur); }
        if (!has_next) break;
#pragma unroll
        for (int a = 0; a < 2; ++a)
#pragma unroll
            for (int b = 0; b < 2; ++b)
#pragma unroll
                for (int m = 0; m < 4; ++m)
#pragma unroll
                    for (int n = 0; n < 2; ++n) acc[a][b][m][n] = (f32x4){0.f, 0.f, 0.f, 0.f};
        cur = nxt; cA = nA; cB = nB; ++ui;
        if constexpr (ALIGN_EPI) { if (wr == 1) PG8_BAR; }
    }
    PG8_WAIT_V(0);
    if constexpr (!ALIGN_EPI) { if (wr == 0) PG8_BAR; }
    PG8_BAR;
    if constexpr (Epi::AFTER_DRAIN) { E.fused(acc, cur, wr, wc, fr, fq, lds, wid, lane); S.done(cur); }
#undef PG8_SA
#undef PG8_SB
#undef PG8_STAGE
#undef PG8_LDA
#undef PG8_LDB
#undef PG8_MMA
#undef PG8_WAIT_V
#undef PG8_WAIT_L
#undef PG8_BAR
#undef PG8_SCHED
}
}
#define GAS __attribute__((address_space(1)))
#define LAS __attribute__((address_space(3)))
typedef unsigned short bf16;
typedef unsigned v4u __attribute__((ext_vector_type(4)));
typedef float f32x4 __attribute__((ext_vector_type(4)));
typedef short bf16x8 __attribute__((ext_vector_type(8)));
typedef GAS unsigned gu32;
typedef GAS unsigned long long gu64;
#define RLX_AGENT __ATOMIC_RELAXED, __HIP_MEMORY_SCOPE_AGENT
#define LDS_WAIT() asm volatile("s_waitcnt lgkmcnt(0)" ::: "memory")
#define VM_WAIT() asm volatile("s_waitcnt vmcnt(0)" ::: "memory")
__device__ __forceinline__ unsigned long long rt() { return __builtin_amdgcn_s_memrealtime(); }
__device__ __forceinline__ unsigned f2bf(float f) { unsigned u = __builtin_bit_cast(unsigned, f); return (u + 0x7fffu + ((u >> 16) & 1u)) >> 16; }
__device__ __forceinline__ unsigned pk2(float lo, float hi) { return f2bf(lo) | (f2bf(hi) << 16); }

#define XB_TMO      128
#define XB_XCNT(j)  (256  + 64 * (j))
#define XB_XSUB(j)  (1280 + 64 * (j))
#define XB_XGEN(j)  (2304 + 64 * (j))
#define XB_TOP      3328
#define XB_TOPGEN   3392
#define XCD_BAR_WORDS 3456
#define XB_SPIN_CAP (1u << 18)

__device__ __forceinline__ unsigned xb_ld(unsigned* p)              { return __hip_atomic_load(p, __ATOMIC_RELAXED, __HIP_MEMORY_SCOPE_AGENT); }
__device__ __forceinline__ unsigned xb_add(unsigned* p, unsigned v) { return __hip_atomic_fetch_add(p, v, __ATOMIC_RELAXED, __HIP_MEMORY_SCOPE_AGENT); }
__device__ __forceinline__ unsigned xb_xcc_id() { return (unsigned)__builtin_amdgcn_s_getreg((3 << 11) | 20) & 0xFu; }
#define XB_SPIN(cond, bar) do { unsigned _sp = 0; while (cond) { __builtin_amdgcn_s_sleep(1); \
    if ((++_sp & 255u) == 0u) { if (xb_ld(&(bar)[XB_TMO])) break; if (_sp > XB_SPIN_CAP) { atomicAdd(&(bar)[XB_TMO], 1u); break; } } } } while (0)

struct XcdBarrier {
    unsigned* bar; unsigned x; int wave;
    volatile LAS unsigned* st;
};

__device__ __forceinline__ XcdBarrier xcd_barrier_post(unsigned* bar, volatile LAS unsigned* st, int wave) {
    XcdBarrier b; b.bar = bar; b.x = xb_xcc_id(); b.st = st; b.wave = wave;
    if (wave == 0 && pg8::lane_id_asm() == 0) (void)xb_add(&bar[XB_XCNT(b.x)], 1u);
    return b;
}
__device__ __forceinline__ void xcd_barrier_complete(unsigned* bar, unsigned x, unsigned& nloc, unsigned& nx) {
    const unsigned G = gridDim.x * gridDim.y * gridDim.z;
    unsigned sum, cnt, mine, sp = 0u;
    for (;;) {
        sum = 0u; cnt = 0u; mine = 0u;
#pragma unroll
        for (unsigned j = 0; j < 16; ++j) { const unsigned c = xb_ld(&bar[XB_XCNT(j)]); sum += c; cnt += (c > 0u) ? 1u : 0u; mine = (j == x) ? c : mine; }
        if (sum == G) break;
        __builtin_amdgcn_s_sleep(1);
        if ((++sp & 255u) == 0u) { if (xb_ld(&bar[XB_TMO])) break; if (sp > XB_SPIN_CAP) { atomicAdd(&bar[XB_TMO], 1u); break; } }
    }
    nloc = mine > 0u ? mine : 1u; nx = cnt > 0u ? cnt : 1u;
}

__device__ __forceinline__ void xcd_barrier(const XcdBarrier& b) {
    asm volatile("s_waitcnt vmcnt(0)" ::: "memory");
    __syncthreads();
    if (b.wave == 0 && pg8::lane_id_asm() == 0) {
        unsigned* bar = b.bar;
        __builtin_amdgcn_s_waitcnt(0);
        unsigned nloc = b.st[0], nx = b.st[1];
        if (nloc == 0u) { xcd_barrier_complete(bar, b.x, nloc, nx); b.st[0] = nloc; b.st[1] = nx; }
        const unsigned old = xb_add(&bar[XB_XSUB(b.x)], 1u);
        const unsigned gen = old / nloc;
        if (old + 1u == (gen + 1u) * nloc) {
            __builtin_amdgcn_fence(__ATOMIC_RELEASE, "agent");
            asm volatile("s_waitcnt vmcnt(0)" ::: "memory");
            const unsigned og = xb_add(&bar[XB_TOP], 1u);
            const unsigned tg = og / nx;
            if (og + 1u == (tg + 1u) * nx) xb_add(&bar[XB_TOPGEN], 1u);
            else XB_SPIN(xb_ld(&bar[XB_TOPGEN]) == tg, bar);
            __builtin_amdgcn_fence(__ATOMIC_ACQUIRE, "agent");
            xb_add(&bar[XB_XGEN(b.x)], 1u);
            asm volatile("s_waitcnt vmcnt(0)" ::: "memory");
        } else {
            XB_SPIN(xb_ld(&bar[XB_XGEN(b.x)]) == gen, bar);
            __builtin_amdgcn_fence(__ATOMIC_ACQUIRE, "agent");
            asm volatile("s_waitcnt vmcnt(0)" ::: "memory");
        }
    }
    __syncthreads();
}

constexpr int NWAVES = 8;
constexpr int BATCH = 4, SEQ = 2048, D = 2048, DFF = 5632, NGU = 2 * DFF, NIN = 6144, PLE = 256;
constexpr int HW = 1024, LW = 1024, HEADS = 8, HD = 128, CHUNK = 64, NCH = SEQ / CHUNK;
constexpr int M = BATCH * SEQ;
constexpr float EPS = 1e-6f;
constexpr int N_IN = 27;
enum In { I_X = 0, I_P, I_F1N, I_F1G, I_F1U, I_F1D, I_MIXN, I_WIN, I_HLB, I_HGN, I_CW, I_CB, I_LWA, I_LBA, I_LWX, I_LBX, I_LAM, I_WOUT,
          I_F2N, I_F2G, I_F2U, I_F2D, I_PLN, I_PWG, I_PBG, I_PWP, I_FN };

constexpr size_t MiB = 1u << 20;
constexpr size_t WS_CTL = 0, CTL_ZERO_BYTES = 128 * 1024;
constexpr size_t WS_SSQA = 1 * MiB, WS_SSQB = 2 * MiB, WS_DEC = 3 * MiB;
constexpr size_t WS_WAT = 3 * MiB + 512 * 1024, WS_WXT = 3 * MiB + 768 * 1024;
constexpr size_t WS_WPROJ = 4 * MiB, WS_PB = 5 * MiB;
constexpr size_t WS_WGU1 = 9 * MiB, WS_WD1 = 53 * MiB, WS_WINT = 75 * MiB, WS_WOUT = 99 * MiB, WS_WGU2 = 107 * MiB, WS_WD2 = 151 * MiB, WS_WPG = 173 * MiB;
constexpr size_t WS_XB = 181 * MiB;
constexpr size_t WS_ACT = 213 * MiB;
constexpr size_t WS_LOGF = WS_ACT, WS_V = WS_ACT + 32 * MiB, WS_SG = WS_ACT + 48 * MiB, WS_LRX = WS_ACT + 64 * MiB, WS_PP = 365 * MiB;
constexpr size_t WS_MIXA = 301 * MiB;
constexpr size_t WS_KVT = 333 * MiB;
constexpr size_t WS_XCH = 397 * MiB;
constexpr size_t WS_WAJ = 398 * MiB, WS_WXJ = 399 * MiB;
constexpr size_t WS_BA2 = 400 * MiB;
constexpr size_t WS_END = 401 * MiB;
static_assert(WS_WGU1 + (size_t)NGU * D * 2 <= WS_WD1 && WS_WD1 + (size_t)D * DFF * 2 <= WS_WINT && WS_WINT + (size_t)NIN * D * 2 <= WS_WOUT && WS_WOUT + (size_t)D * D * 2 <= WS_WGU2 &&
              WS_WGU2 + (size_t)NGU * D * 2 <= WS_WD2 && WS_WD2 + (size_t)D * DFF * 2 <= WS_WPG && WS_WPG + (size_t)D * D * 2 <= WS_XB && WS_XB + (size_t)M * D * 2 <= WS_ACT &&
              WS_ACT + (size_t)M * DFF * 2 <= WS_MIXA && WS_MIXA + (size_t)M * 2048 * 2 <= WS_KVT && WS_KVT + (size_t)BATCH * HEADS * NCH * HD * HD * 4 <= WS_XCH &&
              WS_LRX + (size_t)M * 1024 * 2 <= WS_MIXA && WS_PP + (size_t)M * D * 2 <= 397 * MiB && WS_PB + (size_t)M * PLE * 2 <= WS_WGU1 && WS_WPROJ + (size_t)D * PLE * 2 <= WS_PB, "d_ws map");
constexpr int CW_PANEL = 16384;
constexpr int CW_BAR = 4096;

constexpr int RING_OFF = 0, RING_BYTES = 131072;
constexpr int LDSCTL_OFF = 147456 - 512, MISC_OFF = LDSCTL_OFF + 320;
constexpr int LDS_BYTES = 147456;
static_assert(MISC_OFF + 128 <= LDS_BYTES, "LDS map");


struct Frame {
    LAS unsigned char* lds;
    volatile LAS unsigned* MISC;
    gu32* ctl;
    int wave;
    int vcu, G;
    const float* in[N_IN]; float* out; unsigned char* ws;
};
__device__ __forceinline__ float bf2f(bf16 b) { return __builtin_bit_cast(float, (unsigned)b << 16); }
__device__ __forceinline__ float wave_sum(float v) {
#pragma unroll
    for (int o = 1; o < 64; o <<= 1) v += __shfl_xor(v, o);
    return v;
}
__device__ __forceinline__ void p0_transpose_item(const float* W, int ldw, int K, int src_col0, bf16* WT, int dst_row0, const float* gain, LAS float* scr, int kb, int lane, float wscale = 1.0f) {
    const int k0 = 64 * kb, kq = lane >> 4, nq = lane & 15;
    f32x4 v[16];
#pragma unroll
    for (int i = 0; i < 16; ++i) v[i] = __builtin_nontemporal_load((const GAS f32x4*)(W + (size_t)(k0 + 4 * i + kq) * ldw + src_col0 + 4 * nq));
    if (gain) {
#pragma unroll
        for (int i = 0; i < 16; ++i) v[i] = v[i] * gain[k0 + 4 * i + kq];
    }
    if (wscale != 1.0f) {
#pragma unroll
        for (int i = 0; i < 16; ++i) v[i] = v[i] * wscale;
    }
#pragma unroll
    for (int i = 0; i < 16; ++i) { LAS float* s = scr + (4 * i + kq) * 65 + 4 * nq; s[0] = v[i].x; s[1] = v[i].y; s[2] = v[i].z; s[3] = v[i].w; }
    LDS_WAIT(); asm volatile("" ::: "memory");
    const int c = lane & 7;
#pragma unroll
    for (int j = 0; j < 8; ++j) { const int n = (lane >> 3) + 8 * j; const LAS float* s = scr + (8 * c) * 65 + n;
        v4u o; o.x = pk2(s[0 * 65], s[1 * 65]); o.y = pk2(s[2 * 65], s[3 * 65]); o.z = pk2(s[4 * 65], s[5 * 65]); o.w = pk2(s[6 * 65], s[7 * 65]);
        *(GAS v4u*)(WT + (size_t)(dst_row0 + n) * K + k0 + 8 * c) = o; }
    LDS_WAIT(); asm volatile("" ::: "memory");
}
__device__ __forceinline__ bool p0_plain(int& r, const float* W, int K, int N, bf16* WT, const float* gain, LAS float* scr, int lane, float wscale = 1.0f) {
    const int items = (N / 64) * (K / 64);
    if (r < items) { const int nb = r / (K / 64), kb = r % (K / 64); p0_transpose_item(W, N, K, 64 * nb, WT, 64 * nb, gain, scr, kb, lane, wscale); return true; }
    r -= items; return false;
}
__device__ __forceinline__ bool p0_gateup(int& r, const float* Wg, const float* Wu, bf16* WT, const float* gain, LAS float* scr, int lane) {
    const int items = (NGU / 64) * (D / 64);
    if (r < items) { const int rb = r / (D / 64), kb = r % (D / 64), t = rb >> 2, j = rb & 3;
        p0_transpose_item(j < 2 ? Wg : Wu, DFF, D, 128 * t + 64 * (j & 1), WT, 64 * rb, gain, scr, kb, lane); return true; }
    r -= items; return false;
}
constexpr int NITEM_MIX = BATCH * HEADS * NCH;
__device__ __forceinline__ void cv_load(f32x4 (&v)[8], f32x4 (&g)[2], const float* W, int ldw, int k0, int src_col0, const float* gain, int lane) {
    const float* p = W + (size_t)(k0 + 8 * (lane >> 3)) * ldw + src_col0 + 4 * (lane & 7);
#pragma unroll
    for (int i = 0; i < 8; ++i) v[i] = __builtin_nontemporal_load((const GAS f32x4*)(p + (size_t)i * ldw));
    g[0] = *(const f32x4*)(gain + k0 + 8 * (lane >> 3)); g[1] = *(const f32x4*)(gain + k0 + 8 * (lane >> 3) + 4);
}
__device__ __forceinline__ void cv_pack(unsigned (&o)[16], const f32x4 (&v)[8], const f32x4 (&g)[2]) {
#pragma unroll
    for (int e = 0; e < 4; ++e)
#pragma unroll
        for (int j = 0; j < 4; ++j) o[4 * e + j] = pg8::cvt_pk_bf16(v[2 * j][e] * g[(2 * j) >> 2][(2 * j) & 3], v[2 * j + 1][e] * g[(2 * j + 1) >> 2][(2 * j + 1) & 3]);
}
__device__ __forceinline__ void cv_store(const unsigned (&o)[16], bf16* WT, int K, int dst_row0, int k0, int lane) {
    bf16* p = WT + (size_t)(dst_row0 + 4 * (lane & 7)) * K + k0 + 8 * (lane >> 3);
#pragma unroll
    for (int e = 0; e < 4; ++e) *(GAS v4u*)(p + (size_t)e * K) = (v4u){o[4 * e], o[4 * e + 1], o[4 * e + 2], o[4 * e + 3]};
}
constexpr int CV_GU2_ITEMS = (NGU / 32) * (D / 64), CV_H1_ITEMS = CV_GU2_ITEMS - NITEM_MIX * 8;
__device__ __forceinline__ void cv_gu2_decode(int cid, const float* const* in, const float*& W, int& k0, int& src_col0, int& dst_row0) {
    const int rb = cid >> 5, kb = cid & 31, t = rb >> 3, j = rb & 7;
    W = (j < 4) ? in[I_F2G] : in[I_F2U]; k0 = 64 * kb; src_col0 = 128 * t + 32 * (j & 3); dst_row0 = 32 * rb;
}
enum { J_X = 1, J_P = 2, J_GU1 = 4, J_D1 = 8, J_WIN = 16, J_WOUT = 32, J_GU2 = 64, J_D2 = 128, J_PG = 256, J_PROJ = 512, J_AX = 1024 };
template <int JOBS>
__device__ __forceinline__ void convert_jobs(Frame& F, int rank, int count) {
    const int lane_ = pg8::lane_id_asm(), wave_ = F.wave;
    LAS float* scr = (LAS float*)(F.lds + RING_OFF + wave_ * 16640);
    const int gw = rank * NWAVES + wave_, NGW = count * NWAVES;
    unsigned char* ws = F.ws;
    if (JOBS & J_X) {
        for (int m = gw; m < M; m += NGW) {
            const GAS f32x4* xr = (const GAS f32x4*)(F.in[I_X] + (size_t)m * D) + lane_;
            GAS unsigned long long* o8 = (GAS unsigned long long*)((bf16*)(ws + WS_XB) + (size_t)m * D) + lane_;
            float s = 0.f;
#pragma unroll
            for (int j = 0; j < 8; ++j) { const f32x4 v = __builtin_nontemporal_load(xr + 64 * j); s += (v.x * v.x + v.y * v.y) + (v.z * v.z + v.w * v.w);
                o8[64 * j] = (unsigned long long)pk2(v.x, v.y) | ((unsigned long long)pk2(v.z, v.w) << 32); }
            s = wave_sum(s);
            if (lane_ < 32) ((float*)(ws + WS_SSQA))[(size_t)m * 32 + lane_] = (lane_ == 0) ? s : 0.f;
        }
    }
    if (JOBS & J_P) {
        for (int m = gw; m < M; m += NGW) {
            const f32x4 v = __builtin_nontemporal_load((const GAS f32x4*)(F.in[I_P] + (size_t)m * PLE) + lane_);
            ((GAS unsigned long long*)((bf16*)(ws + WS_PB) + (size_t)m * PLE))[lane_] = (unsigned long long)pk2(v.x, v.y) | ((unsigned long long)pk2(v.z, v.w) << 32);
        }
    }
    constexpr int I_GU = (NGU / 64) * (D / 64), I_DD = (D / 64) * (DFF / 64), I_IN = (NIN / 64) * (D / 64), I_SQ = (D / 64) * (D / 64), I_PJ = (D / 64) * (PLE / 64), I_AX = 16 * 4 * 4;
    constexpr int NITEMS = ((JOBS & J_GU1) ? I_GU : 0) + ((JOBS & J_D1) ? I_DD : 0) + ((JOBS & J_WIN) ? I_IN : 0) + ((JOBS & J_WOUT) ? I_SQ : 0) + ((JOBS & J_GU2) ? I_GU : 0) +
                           ((JOBS & J_D2) ? I_DD : 0) + ((JOBS & J_PG) ? I_SQ : 0) + ((JOBS & J_PROJ) ? I_PJ : 0) + ((JOBS & J_AX) ? I_AX : 0);
    for (int it = gw; it < NITEMS; it += NGW) {
        int r = it;
        if (JOBS & J_GU1) { if (p0_gateup(r, F.in[I_F1G], F.in[I_F1U], (bf16*)(ws + WS_WGU1), F.in[I_F1N], scr, lane_)) continue; }
        if (JOBS & J_D1) { if (p0_plain(r, F.in[I_F1D], DFF, D, (bf16*)(ws + WS_WD1), nullptr, scr, lane_, 0.5f)) continue; }
        if (JOBS & J_WIN) { if (p0_plain(r, F.in[I_WIN], D, NIN, (bf16*)(ws + WS_WINT), F.in[I_MIXN], scr, lane_)) continue; }
        if (JOBS & J_WOUT) { if (p0_plain(r, F.in[I_WOUT], D, D, (bf16*)(ws + WS_WOUT), nullptr, scr, lane_)) continue; }
        if (JOBS & J_GU2) { if (p0_gateup(r, F.in[I_F2G], F.in[I_F2U], (bf16*)(ws + WS_WGU2), F.in[I_F2N], scr, lane_)) continue; }
        if (JOBS & J_D2) { if (p0_plain(r, F.in[I_F2D], DFF, D, (bf16*)(ws + WS_WD2), nullptr, scr, lane_, 0.5f)) continue; }
        if (JOBS & J_PG) { if (p0_plain(r, F.in[I_PWG], D, D, (bf16*)(ws + WS_WPG), F.in[I_PLN], scr, lane_)) continue; }
        if (JOBS & J_PROJ) { if (p0_plain(r, F.in[I_PWP], PLE, D, (bf16*)(ws + WS_WPROJ), nullptr, scr, lane_)) continue; }
        if (JOBS & J_AX) { const int blk = r >> 4, j = (r >> 2) & 3, q = r & 3;
          const int nb = blk & 7;
          const float* W = (blk < 8 ? F.in[I_LWA] : F.in[I_LWX]) + (size_t)nb * 128 * 128;
          bf16* WT = (bf16*)(ws + (blk < 8 ? WS_WAJ : WS_WXJ)) + (size_t)(nb * 4 + j) * 128 * 128;
          p0_transpose_item(W, 128, 128, 64 * (q >> 1), WT, 64 * (q >> 1), F.in[I_CW] + j * 1024 + nb * 128, scr, q & 1, lane_); }
    }
    if (JOBS & J_AX) {
        for (int o = gw * 64 + lane_; o < 2048; o += NGW * 64) { const int which = o >> 10, dg = o & 1023, nb = dg >> 7, dd = dg & 127;
            const float* W = (which ? F.in[I_LWX] : F.in[I_LWA]) + (size_t)nb * 128 * 128 + dd; float s = (which ? F.in[I_LBX] : F.in[I_LBA])[dg];
            for (int c = 0; c < 128; ++c) s += F.in[I_CB][nb * 128 + c] * W[(size_t)c * 128];
            ((float*)(ws + WS_BA2))[o] = s; }
    }
}
__device__ __forceinline__ void side_workers(int nwg, int G, int c, int& rank, int& count) {
    const int rounds = (nwg + G - 1) / G, last = nwg - (rounds - 1) * G;
    if (last == G) { rank = c; count = G; } else if (c >= last) { rank = c - last; count = G - last; } else { rank = -1; count = 0; }
}
__device__ __forceinline__ void final_norm(Frame& F, const float* ssq) {
    const int lane_ = pg8::lane_id_asm(), wave_ = F.wave;
    const int gw = F.vcu * NWAVES + wave_, NGW = F.G * NWAVES;
    const GAS f32x4* gf = (const GAS f32x4*)F.in[I_FN] + lane_;
    for (int m = gw; m < M; m += NGW) {
        float s = (lane_ < 32) ? ssq[(size_t)m * 32 + lane_] : 0.f;
        s = wave_sum(s);
        const float rstd = 1.0f / sqrtf(s * (1.0f / D) + EPS);
        GAS f32x4* xr = (GAS f32x4*)(F.out + (size_t)m * D) + lane_;
#pragma unroll
        for (int j = 0; j < 8; ++j) { f32x4 v = xr[64 * j]; const f32x4 g = gf[64 * j]; v = v * rstd * g; xr[64 * j] = v; }
    }
}


typedef float mf32x4 __attribute__((ext_vector_type(4)));
typedef short mbf16x8 __attribute__((ext_vector_type(8)));
typedef unsigned mu32x2 __attribute__((ext_vector_type(2)));
constexpr int TS = 72;
constexpr int QS = 136;
constexpr int NITEM = BATCH * HEADS * NCH;
__device__ __forceinline__ mbf16x8 lds_frag(const LAS bf16* p) { return *(const LAS mbf16x8*)p; }
__device__ __forceinline__ unsigned bf1(float x) { return pg8::cvt_pk_bf16(x, 0.f) & 0xffffu; }
#define MFMA16(a, b, c) __builtin_amdgcn_mfma_f32_16x16x32_bf16((a), (b), (c), 0, 0, 0)

#define LBAR() do { asm volatile("s_waitcnt lgkmcnt(0)" ::: "memory"); __builtin_amdgcn_s_barrier(); asm volatile("" ::: "memory"); } while (0)

__device__ __forceinline__ void hgrn_local_phase(Frame& F) {
    LAS bf16* kstT = (LAS bf16*)(F.lds);
    LAS bf16* vT = (LAS bf16*)(F.lds + 18432);
    LAS float* qtot = (LAS float*)(F.lds + 36864);
    const int tid_ = F.wave * 64 + pg8::lane_id_asm();
    const int tid = tid_, k = tid & 127, sq = tid >> 7, lane = tid & 63, w = F.wave, fr = lane & 15, fq = lane >> 4;
    const float* LOGF = (const float*)(F.ws + WS_LOGF); const bf16* V = (const bf16*)(F.ws + WS_V);
    bf16* KVT = (bf16*)(F.ws + WS_KVT); float* DEC = (float*)(F.ws + WS_DEC);
    float lf[16]; unsigned vr[16];
    if ((int)blockIdx.x < NITEM) { const int item = blockIdx.x, c = item & 31, bh = item >> 5, h = bh & 7, b = bh >> 3;
        const size_t g0 = ((size_t)b * SEQ + c * 64 + sq * 16) * 1024 + h * 128 + k;
#pragma unroll
        for (int i = 0; i < 16; ++i) { lf[i] = LOGF[g0 + (size_t)i * 1024]; vr[i] = V[g0 + (size_t)i * 1024]; } }
    for (int item = blockIdx.x; item < NITEM; item += F.G) {
        f32x4 cvv[8], cvg[2]; const int cid = item * 8 + w; const bool cvh = (HOST_GU2 == 2) && cid < CV_H1_ITEMS;
        if (cvh) { const float* W_; int k0_, sc_, dr_; cv_gu2_decode(cid, F.in, W_, k0_, sc_, dr_); cv_load(cvv, cvg, W_, DFF, k0_, sc_, F.in[I_F2N], lane); }
        float bb[16]; float run = 0.f;
#pragma unroll
        for (int i = 0; i < 16; ++i) { run += lf[i]; bb[i] = run; }
        qtot[sq * 128 + k] = run;
        LBAR();
        float pre = 0.f, tot = 0.f;
#pragma unroll
        for (int j = 0; j < 4; ++j) { const float tq = qtot[j * 128 + k]; pre += (j < sq) ? tq : 0.f; tot += tq; }
        unsigned pk[8], pv[8];
#pragma unroll
        for (int i = 0; i < 8; ++i) {
            const float e0 = (1.0f - __expf(lf[2 * i])) * __expf(tot - (pre + bb[2 * i])), e1 = (1.0f - __expf(lf[2 * i + 1])) * __expf(tot - (pre + bb[2 * i + 1]));
            pk[i] = pg8::cvt_pk_bf16(e0, e1); pv[i] = vr[2 * i] | (vr[2 * i + 1] << 16); }
        *(LAS v4u*)(kstT + k * TS + sq * 16) = (v4u){pk[0], pk[1], pk[2], pk[3]}; *(LAS v4u*)(kstT + k * TS + sq * 16 + 8) = (v4u){pk[4], pk[5], pk[6], pk[7]};
        *(LAS v4u*)(vT + k * TS + sq * 16) = (v4u){pv[0], pv[1], pv[2], pv[3]}; *(LAS v4u*)(vT + k * TS + sq * 16 + 8) = (v4u){pv[4], pv[5], pv[6], pv[7]};
        if (sq == 0) DEC[(size_t)item * 128 + k] = __expf(tot);
        if (item + F.G < NITEM) { const int it2 = item + F.G, c = it2 & 31, bh = it2 >> 5, h = bh & 7, b = bh >> 3;
            const size_t g0 = ((size_t)b * SEQ + c * 64 + sq * 16) * 1024 + h * 128 + k;
#pragma unroll
            for (int i = 0; i < 16; ++i) { lf[i] = LOGF[g0 + (size_t)i * 1024]; vr[i] = V[g0 + (size_t)i * 1024]; } }
        LBAR();
        const mbf16x8 b0 = lds_frag(vT + (16 * w + fr) * TS + 8 * fq), b1 = lds_frag(vT + (16 * w + fr) * TS + 32 + 8 * fq);
        bf16* outp = KVT + (size_t)item * 16384 + (size_t)(16 * w + fr) * 128 + 4 * fq;
#pragma unroll
        for (int kt = 0; kt < 8; ++kt) {
            mf32x4 acc = {0.f, 0.f, 0.f, 0.f};
            acc = MFMA16(lds_frag(kstT + (16 * kt + fr) * TS + 8 * fq), b0, acc);
            acc = MFMA16(lds_frag(kstT + (16 * kt + fr) * TS + 32 + 8 * fq), b1, acc);
            asm volatile("s_nop 7\n\ts_nop 7" : "+v"(acc));
            mu32x2 o; o.x = pg8::cvt_pk_bf16(acc[0], acc[1]); o.y = pg8::cvt_pk_bf16(acc[2], acc[3]);
            *(mu32x2*)(outp + 16 * kt) = o;
        }
        if (cvh) { unsigned cvo[16]; const float* W_; int k0_, sc_, dr_; cv_gu2_decode(cid, F.in, W_, k0_, sc_, dr_); cv_pack(cvo, cvv, cvg); cv_store(cvo, (bf16*)(F.ws + WS_WGU2), D, dr_, k0_, lane); }
        LBAR();
    }
}

__device__ __forceinline__ void hgrn_scan_phase(Frame& F) {
    const bf16* KVT = (const bf16*)(F.ws + WS_KVT); const float* DEC = (const float*)(F.ws + WS_DEC); bf16* ST = (bf16*)F.out;
    const int tid_ = F.wave * 64 + pg8::lane_id_asm();
    for (int idx = blockIdx.x * (NWAVES * 64) + tid_; idx < BATCH * HEADS * 128 * 32; idx += F.G * NWAVES * 64) {
        const int k4 = idx & 31, v = (idx >> 5) & 127, bh = idx >> 12;
        mf32x4 S = {0.f, 0.f, 0.f, 0.f};
#pragma unroll 1
        for (int half = 0; half < 2; ++half) {
            const size_t off0 = (size_t)(bh * NCH + half * 16) * 16384 + v * 128 + 4 * k4; const size_t d0 = (size_t)(bh * NCH + half * 16) * 128 + 4 * k4;
            mu32x2 kv[16]; mf32x4 dd[16];
#pragma unroll
            for (int c = 0; c < 16; ++c) { kv[c] = *(const mu32x2*)(KVT + off0 + (size_t)c * 16384); dd[c] = *(const mf32x4*)(DEC + d0 + (size_t)c * 128); }
#pragma unroll
            for (int c = 0; c < 16; ++c) {
                mu32x2 o; o.x = pg8::cvt_pk_bf16(S[0], S[1]); o.y = pg8::cvt_pk_bf16(S[2], S[3]); *(mu32x2*)(ST + off0 + (size_t)c * 16384) = o;
                S = dd[c] * S + pg8::bf16x4_to_f32(kv[c]);
            }
        }
    }
}

__device__ __forceinline__ void hgrn_out_phase(Frame& F, bool dummy = false) {
    LAS bf16* QT = (LAS bf16*)(F.lds);
    LAS bf16* KT = (LAS bf16*)(F.lds + 17408);
    LAS bf16* QI = (LAS bf16*)(F.lds + 34816);
    LAS bf16* vT = (LAS bf16*)(F.lds + 52224);
    LAS bf16* P = (LAS bf16*)(F.lds + 70656);
    LAS float* qtot = (LAS float*)(F.lds + 79872);
    LAS float* ssq = (LAS float*)(F.lds + 81920);
    const int tid_ = F.wave * 64 + pg8::lane_id_asm();
    const int tid = tid_, k = tid & 127, sq = tid >> 7, lane = tid & 63, w = F.wave, fr = lane & 15, fq = lane >> 4, rb = w & 3, ch = w >> 2;
    const float* LOGF = (const float*)(F.ws + WS_LOGF); const bf16* V = (const bf16*)(F.ws + WS_V); const bf16* SG = (const bf16*)(F.ws + WS_SG);
    const bf16* ST = (const bf16*)F.out; bf16* MIXA = (bf16*)(F.ws + WS_MIXA);
    const int t0 = 16 * rb;
    float lf[16]; unsigned vr[16], qr[16];
    if ((int)blockIdx.x < NITEM) { const int item = blockIdx.x, c = item & 31, bh = item >> 5, h = bh & 7, b = bh >> 3;
        const size_t r0 = (size_t)b * SEQ + c * 64, g0 = (r0 + sq * 16) * 1024 + h * 128 + k, gq = (r0 + sq * 16) * 2048 + h * 128 + k;
#pragma unroll
        for (int i = 0; i < 16; ++i) { lf[i] = LOGF[g0 + (size_t)i * 1024]; vr[i] = V[g0 + (size_t)i * 1024]; qr[i] = MIXA[gq + (size_t)i * 2048]; } }
    for (int item = blockIdx.x; item < NITEM; item += F.G) {
        const int c = item & 31, bh = item >> 5, h = bh & 7, b = bh >> 3;
        const size_t r0 = (size_t)b * SEQ + c * 64;
        f32x4 cvv[8], cvg[2]; const int cid = CV_H1_ITEMS + item * 8 + w; const bool cvh = (HOST_GU2 == 2) && !dummy && cid < CV_GU2_ITEMS;
        if (cvh) { const float* W_; int k0_, sc_, dr_; cv_gu2_decode(cid, F.in, W_, k0_, sc_, dr_); cv_load(cvv, cvg, W_, DFF, k0_, sc_, F.in[I_F2N], lane); }
        float bb[16]; float run = 0.f;
#pragma unroll
        for (int i = 0; i < 16; ++i) { run += lf[i]; bb[i] = run; }
        qtot[sq * 128 + k] = run;
        LBAR();
        {
            float pre = 0.f;
#pragma unroll
            for (int j = 0; j < 4; ++j) { const float tq = qtot[j * 128 + k]; pre += (j < sq) ? tq : 0.f; }
            const float bm = qtot[k] + qtot[128 + k], ebm = __expf(bm);
            unsigned pv[8];
#pragma unroll
            for (int i = 0; i < 16; ++i) {
                const float d = fminf(fmaxf(pre + bb[i] - bm, -60.f), 60.f), e1 = __expf(d), e2 = __builtin_amdgcn_rcpf(e1);
                const float qf = bf2f((bf16)qr[i]), qt = qf * e1, kk = (1.0f - __expf(lf[i])) * e2;
                const int s = sq * 16 + i;
                QT[s * QS + k] = (bf16)bf1(qt); QI[s * QS + k] = (bf16)bf1(qt * ebm); KT[s * QS + k] = (bf16)bf1(kk);
            }
#pragma unroll
            for (int i = 0; i < 8; ++i) pv[i] = vr[2 * i] | (vr[2 * i + 1] << 16);
            *(LAS v4u*)(vT + k * TS + sq * 16) = (v4u){pv[0], pv[1], pv[2], pv[3]}; *(LAS v4u*)(vT + k * TS + sq * 16 + 8) = (v4u){pv[4], pv[5], pv[6], pv[7]};
        }
        if (item + F.G < NITEM) { const int it2 = item + F.G, c2 = it2 & 31, bh2 = it2 >> 5, h2 = bh2 & 7, b2 = bh2 >> 3;
            const size_t r2 = (size_t)b2 * SEQ + c2 * 64, g0 = (r2 + sq * 16) * 1024 + h2 * 128 + k, gq = (r2 + sq * 16) * 2048 + h2 * 128 + k;
#pragma unroll
            for (int i = 0; i < 16; ++i) { lf[i] = LOGF[g0 + (size_t)i * 1024]; vr[i] = V[g0 + (size_t)i * 1024]; qr[i] = MIXA[gq + (size_t)i * 2048]; } }
        mbf16x8 stf[4][4]; mu32x2 sgp[4];
#pragma unroll
        for (int j = 0; j < 4; ++j) { const bf16* sp = ST + (size_t)item * 16384 + (size_t)(64 * ch + 16 * j + fr) * 128 + 8 * fq;
#pragma unroll
            for (int ks = 0; ks < 4; ++ks) stf[j][ks] = *(const mbf16x8*)(sp + 32 * ks);
            sgp[j] = *(const mu32x2*)(SG + (r0 + t0 + fr) * 1024 + h * 128 + 64 * ch + 16 * j + 4 * fq); }
        LBAR();
        {
            mbf16x8 bq[4];
#pragma unroll
            for (int ks = 0; ks < 4; ++ks) bq[ks] = lds_frag(QT + (t0 + fr) * QS + 32 * ks + 8 * fq);
#pragma unroll
            for (int j = 0; j < 2; ++j) {
                const int s0 = 32 * ch + 16 * j; mf32x4 acc = {0.f, 0.f, 0.f, 0.f};
#pragma unroll
                for (int ks = 0; ks < 4; ++ks) acc = MFMA16(lds_frag(KT + (s0 + fr) * QS + 32 * ks + 8 * fq), bq[ks], acc);
                const int t = t0 + fr, sb = s0 + 4 * fq;
#pragma unroll
                for (int r = 0; r < 4; ++r) acc[r] = (sb + r <= t) ? acc[r] : 0.f;
                mu32x2 o; o.x = pg8::cvt_pk_bf16(acc[0], acc[1]); o.y = pg8::cvt_pk_bf16(acc[2], acc[3]);
                *(LAS mu32x2*)(P + t * TS + sb) = o;
            }
        }
        LBAR();
        mf32x4 o4[4];
        {
            mbf16x8 bqi[4], bp[2];
#pragma unroll
            for (int ks = 0; ks < 4; ++ks) bqi[ks] = lds_frag(QI + (t0 + fr) * QS + 32 * ks + 8 * fq);
#pragma unroll
            for (int ss = 0; ss < 2; ++ss) bp[ss] = lds_frag(P + (t0 + fr) * TS + 32 * ss + 8 * fq);
            float sum = 0.f;
#pragma unroll
            for (int j = 0; j < 4; ++j) {
                const int v0 = 64 * ch + 16 * j; mf32x4 acc = {0.f, 0.f, 0.f, 0.f};
#pragma unroll
                for (int ks = 0; ks < 4; ++ks) acc = MFMA16(stf[j][ks], bqi[ks], acc);
#pragma unroll
                for (int ss = 0; ss < 2; ++ss) acc = MFMA16(lds_frag(vT + (v0 + fr) * TS + 32 * ss + 8 * fq), bp[ss], acc);
                o4[j] = acc; sum += (acc[0] * acc[0] + acc[1] * acc[1]) + (acc[2] * acc[2] + acc[3] * acc[3]);
            }
            sum += __shfl_xor(sum, 16); sum += __shfl_xor(sum, 32);
            if (fq == 0) ssq[ch * 64 + t0 + fr] = sum;
        }
        LBAR();
        {
            const float rn = 1.0f / sqrtf((ssq[t0 + fr] + ssq[64 + t0 + fr]) * (1.0f / 128.0f) + EPS);
            const size_t row = r0 + t0 + fr;
#pragma unroll
            for (int j = 0; j < 4; ++j) {
                const int v = 64 * ch + 16 * j + 4 * fq;
                const mf32x4 gn = *(const mf32x4*)(F.in[I_HGN] + v);
                const float s0 = bf2f((bf16)(sgp[j].x & 0xffffu)), s1 = bf2f((bf16)(sgp[j].x >> 16)), s2 = bf2f((bf16)(sgp[j].y & 0xffffu)), s3 = bf2f((bf16)(sgp[j].y >> 16));
                mu32x2 o; o.x = pg8::cvt_pk_bf16(o4[j][0] * rn * gn[0] * s0, o4[j][1] * rn * gn[1] * s1); o.y = pg8::cvt_pk_bf16(o4[j][2] * rn * gn[2] * s2, o4[j][3] * rn * gn[3] * s3);
                *(mu32x2*)((dummy ? (bf16*)(F.ws + WS_KVT) : MIXA) + row * 2048 + h * 128 + v) = o;
            }
        }
        if (cvh) { unsigned cvo[16]; const float* W_; int k0_, sc_, dr_; cv_gu2_decode(cid, F.in, W_, k0_, sc_, dr_); cv_pack(cvo, cvv, cvg); cv_store(cvo, (bf16*)(F.ws + WS_WGU2), D, dr_, k0_, lane); }
        LBAR();
    }
}

#define GLDS16(gp, lp) __builtin_amdgcn_global_load_lds((const unsigned*)(gp), (LAS unsigned*)(lp), 16, 0, 0)
template <int VAR = 0, bool FUSE_SCAN = false, bool dummy = false, bool HOST = (HOST_GU2 == 1) && !dummy>
__device__ __forceinline__ void lru_phase(Frame& F) {
    LAS unsigned char* Ab = F.lds;
    LAS float* LAt = (LAS float*)(F.lds + 66560);
    LAS float* LUt = (LAS float*)(F.lds + 66560 + 18560);
    LAS bf16* GG = (LAS bf16*)(F.lds + 103680);
    LAS bf16* GGt = (LAS bf16*)(F.lds + 111872);
    LAS bf16* YYt = (LAS bf16*)(F.lds + 121344);
    const int tid_ = F.wave * 64 + pg8::lane_id_asm();
    const int tid = tid_, lane = tid & 63, w = F.wave, fr = lane & 15, fq = lane >> 4;
    const int seg = lane & 31, d = 2 * w + (lane >> 5);
    const int grow = tid >> 1, ghalf = tid & 1;
    const bf16* LRX = (const bf16*)(F.ws + WS_LRX); bf16* MIXA = (bf16*)(F.ws + WS_MIXA);
    const bf16* WAJ = (const bf16*)(F.ws + WS_WAJ); const bf16* WXJ = (const bf16*)(F.ws + WS_WXJ);
    for (int item = blockIdx.x; item < BATCH * 64; item += F.G) {
        const int b = item >> 6, n = (item >> 3) & 7, sl = item & 7;
        int tid = tid_; asm volatile("" : "+v"(tid));
        const int lane = tid & 63, fr = lane & 15, fq = lane >> 4, grow = tid >> 1, ghalf = tid & 1;
        mbf16x8 waf[4][4], wxf[4][4];
#pragma unroll
        for (int j = 0; j < 4; ++j)
#pragma unroll
            for (int ks = 0; ks < 4; ++ks) { const size_t o = ((size_t)(n * 4 + j) * 128 + sl * 16 + fr) * 128 + 32 * ks + 8 * fq; waf[j][ks] = *(const mbf16x8*)(WAJ + o); wxf[j][ks] = *(const mbf16x8*)(WXJ + o); }
        const bf16* xsrc0 = LRX + (size_t)b * SEQ * 1024 + n * 128;
        bf16* const gbase = MIXA + (size_t)b * SEQ * 2048 + 1024 + n * 128 + sl * 16 + 8 * ghalf;
        bf16* const obase = dummy ? (bf16*)(F.ws + WS_END) + (size_t)item * 2048 * 16 + 8 * ghalf : gbase;
        const size_t ostr = dummy ? 16 : 2048;
#pragma unroll
        for (int i = 0; i < 9; ++i) { const int p = tid + 512 * i, row = p >> 4, cp = p & 15;
            if (p < 259 * 16 && row >= 3) GLDS16(xsrc0 + (size_t)(row - 3) * 1024 + 8 * (cp ^ (row & 15)), Ab + (w * 64 + 512 * i) * 16); }
        if (tid < 48) *(LAS v4u*)(Ab + tid * 16) = (v4u){0u, 0u, 0u, 0u};
        GLDS16(gbase + (size_t)grow * 2048, (LAS unsigned char*)GG + w * 1024);
        __syncthreads();
        float carry = 0.f;
        mf32x4 S = {0.f, 0.f, 0.f, 0.f};
        for (int mc = 0; mc < 8; ++mc) {
            int tid = tid_; asm volatile("" : "+v"(tid));
            const int lane = tid & 63, fr = lane & 15, fq = lane >> 4, seg = lane & 31, d = 2 * w + (lane >> 5), grow = tid >> 1, ghalf = tid & 1;
            const bf16* xsrc = LRX + (size_t)b * SEQ * 1024 + n * 128;
            bf16* const gbase = MIXA + (size_t)b * SEQ * 2048 + 1024 + n * 128 + sl * 16 + 8 * ghalf;
            bf16* const obase = dummy ? (bf16*)(F.ws + WS_END) + (size_t)item * 2048 * 16 + 8 * ghalf : gbase;
            const int sidx = blockIdx.x * (NWAVES * 64) + tid;
            const unsigned soff = (unsigned)((sidx >> 12) * NCH + 4 * mc) * 16384u + ((sidx >> 5) & 127) * 128 + 4 * (sidx & 31), sdo = (unsigned)((sidx >> 12) * NCH + 4 * mc) * 128u + 4 * (sidx & 31);
            mu32x2 skv[2]; mf32x4 sdd[2];
            if (FUSE_SCAN) {
#pragma unroll
                for (int c = 0; c < 2; ++c) { skv[c] = *(const mu32x2*)((const bf16*)(F.ws + WS_KVT) + soff + c * 16384u); sdd[c] = *(const mf32x4*)((const float*)(F.ws + WS_DEC) + sdo + c * 128u); }
            }
            mf32x4 ar[2], ai[2]; float xv[2][7];
#pragma unroll
            for (int rt = 0; rt < 2; ++rt) {
                const int rowt = 32 * w + 16 * rt; ar[rt] = (mf32x4){0.f, 0.f, 0.f, 0.f}; ai[rt] = (mf32x4){0.f, 0.f, 0.f, 0.f};
#pragma unroll
                for (int j = 0; j < 4; ++j) { const int R = rowt + fr + j;
#pragma unroll
                    for (int ks = 0; ks < 4; ++ks) { const mbf16x8 a = *(const LAS mbf16x8*)(Ab + R * 256 + (((4 * ks + fq) ^ (R & 15)) << 4)); ar[rt] = MFMA16(a, waf[j][ks], ar[rt]); ai[rt] = MFMA16(a, wxf[j][ks], ai[rt]); } }
#pragma unroll
                for (int q = 0; q < 7; ++q) { const int R = rowt + 4 * fq + q; xv[rt][q] = bf2f(*(const LAS bf16*)(Ab + R * 256 + (((2 * sl + (fr >> 3)) ^ (R & 15)) << 4) + 2 * (fr & 7))); }
            }
            __syncthreads();
            if (mc < 7) {
#pragma unroll
                for (int i = 0; i < 9; ++i) { const int p = tid + 512 * i, row = p >> 4, cp = p & 15;
                    if (p < 259 * 16) GLDS16(xsrc + (size_t)((mc + 1) * 256 - 3 + row) * 1024 + 8 * (cp ^ (row & 15)), Ab + (w * 64 + 512 * i) * 16); }
            }
            f32x4 cvv[8], cvg[2]; unsigned cvo[16];
            const int cid = mc * 2048 + item * 8 + w;
            if (HOST) {
                if (cid < CV_GU2_ITEMS) { const float* W_; int k0_, sc_, dr_; cv_gu2_decode(cid, F.in, W_, k0_, sc_, dr_); cv_load(cvv, cvg, W_, DFF, k0_, sc_, F.in[I_F2N], lane); }
            }
            {
                const v4u g = *(const LAS v4u*)(GG + tid * 8); const unsigned gw4[4] = {g.x, g.y, g.z, g.w};
                const int tb = (8 * ghalf) * 296 + (grow >> 3) * 9 + (grow & 7);
#pragma unroll
                for (int e = 0; e < 8; ++e) GGt[tb + e * 296] = (bf16)((e & 1) ? (gw4[e >> 1] >> 16) : (gw4[e >> 1] & 0xffffu));
                if (mc > 0) { unsigned yv[8];
#pragma unroll
                    for (int e = 0; e < 8; ++e) yv[e] = YYt[tb + e * 296];
                    *(v4u*)(obase + (size_t)((mc - 1) * 256 + grow) * ostr) = (v4u){yv[0] | (yv[1] << 16), yv[2] | (yv[3] << 16), yv[4] | (yv[5] << 16), yv[6] | (yv[7] << 16)}; }
                if (mc < 7) { asm volatile("s_waitcnt lgkmcnt(0)" ::: "memory"); GLDS16(gbase + (size_t)((mc + 1) * 256 + grow) * 2048, (LAS unsigned char*)GG + w * 1024); }
            }
            {
                const int cgl = n * 128 + sl * 16 + fr;
                const float ba2 = ((const float*)(F.ws + WS_BA2))[cgl], bx2 = ((const float*)(F.ws + WS_BA2))[1024 + cgl], spl = log1pf(__expf(-F.in[I_LAM][cgl])), cbv = F.in[I_CB][cgl];
                float cw4[4];
#pragma unroll
                for (int j = 0; j < 4; ++j) cw4[j] = F.in[I_CW][j * 1024 + cgl];
#pragma unroll
                for (int rt = 0; rt < (VAR == 2 ? 0 : 2); ++rt)
#pragma unroll
                    for (int r = 0; r < 4; ++r) { const int row = 32 * w + 16 * rt + 4 * fq + r;
                        const float xc = cbv + ((cw4[0] * xv[rt][r] + cw4[1] * xv[rt][r + 1]) + (cw4[2] * xv[rt][r + 2] + cw4[3] * xv[rt][r + 3]));
                        const float rg = pg8::sigmoid_f(ar[rt][r] + ba2), ig = pg8::sigmoid_f(ai[rt][r] + bx2), la = -8.0f * rg * spl;
                        const float a = __expf(la), om = fmaxf(__builtin_fmaf(-a, a, 1.0f), 0.f);
                        const int o = fr * 289 + (row >> 3) * 9 + (row & 7);
                        LAt[o] = a; LUt[o] = __builtin_amdgcn_sqrtf(om) * ig * xc; }
            }
            if (FUSE_SCAN) {
#pragma unroll
                for (int c = 0; c < 2; ++c) { mu32x2 o; o.x = pg8::cvt_pk_bf16(S[0], S[1]); o.y = pg8::cvt_pk_bf16(S[2], S[3]); *(mu32x2*)((bf16*)F.out + soff + c * 16384u) = o;
                    S = sdd[c] * S + pg8::bf16x4_to_f32(skv[c]); }
#pragma unroll
                for (int c = 0; c < 2; ++c) { skv[c] = *(const mu32x2*)((const bf16*)(F.ws + WS_KVT) + soff + (2 + c) * 16384u); sdd[c] = *(const mf32x4*)((const float*)(F.ws + WS_DEC) + sdo + (2 + c) * 128u); }
            }
            if (HOST) { if (cid < CV_GU2_ITEMS) { cv_pack(cvo, cvv, cvg); const float* W_; int k0_, sc_, dr_; cv_gu2_decode(cid, F.in, W_, k0_, sc_, dr_); cv_store(cvo, (bf16*)(F.ws + WS_WGU2), D, dr_, k0_, lane); } }
            __syncthreads();
            if (VAR != 3) {
                float aa[8], uu[8]; float Ap = 1.f, Hp = 0.f;
#pragma unroll
                for (int i = 0; i < 8; ++i) { aa[i] = LAt[d * 289 + seg * 9 + i]; uu[i] = LUt[d * 289 + seg * 9 + i]; Hp = aa[i] * Hp + uu[i]; Ap *= aa[i]; }
#pragma unroll
                for (int off = 1; off < 32; off <<= 1) { const float Aq = __shfl_up(Ap, off, 32), Hq = __shfl_up(Hp, off, 32); if (seg >= off) { Hp = Ap * Hq + Hp; Ap = Ap * Aq; } }
                float Ae = __shfl_up(Ap, 1, 32), He = __shfl_up(Hp, 1, 32); if (seg == 0) { Ae = 1.f; He = 0.f; }
                float hin = Ae * carry + He;
                carry = __shfl(Ap, 31, 32) * carry + __shfl(Hp, 31, 32);
                const LAS bf16* gp = GGt + d * 296 + seg * 9; LAS bf16* yq = YYt + d * 296 + seg * 9;
#pragma unroll
                for (int i = 0; i < 8; ++i) { hin = aa[i] * hin + uu[i]; yq[i] = (bf16)bf1(hin * bf2f(gp[i])); }
            }
            if (FUSE_SCAN) {
#pragma unroll
                for (int c = 0; c < 2; ++c) { mu32x2 o; o.x = pg8::cvt_pk_bf16(S[0], S[1]); o.y = pg8::cvt_pk_bf16(S[2], S[3]); *(mu32x2*)((bf16*)F.out + soff + (2 + c) * 16384u) = o;
                    S = sdd[c] * S + pg8::bf16x4_to_f32(skv[c]); }
            }
        }
        __syncthreads();
        { const int tb = (8 * ghalf) * 296 + (grow >> 3) * 9 + (grow & 7); unsigned yv[8];
#pragma unroll
          for (int e = 0; e < 8; ++e) yv[e] = YYt[tb + e * 296];
          *(v4u*)(obase + (size_t)(7 * 256 + grow) * ostr) = (v4u){yv[0] | (yv[1] << 16), yv[2] | (yv[3] << 16), yv[4] | (yv[5] << 16), yv[6] | (yv[7] << 16)}; }
        __syncthreads();
    }
}
constexpr int N_PHASES = 12;
struct Args { const float* in[N_IN]; float* out; unsigned char* ws; int ph_lo, ph_hi, li, pad; };
__global__ void __launch_bounds__(NWAVES * 64, 2) mega_fwd(Args args) {
    extern __shared__ __attribute__((aligned(16))) unsigned char lds[];
    Frame F;
    F.lds = (LAS unsigned char*)lds;
    F.MISC = (volatile LAS unsigned*)(F.lds + MISC_OFF);
    F.wave = __builtin_amdgcn_readfirstlane((int)threadIdx.x >> 6);
    F.G = gridDim.x; { const int bx = blockIdx.x; F.vcu = (F.G % 8 == 0) ? (bx % 8) * (F.G / 8) + bx / 8 : bx; }
#pragma unroll
    for (int i = 0; i < N_IN; ++i) F.in[i] = args.in[i];
    F.out = args.out; F.ws = args.ws;
    unsigned char* ws = args.ws;
    F.ctl = (gu32*)(ws + WS_CTL);
    for (int u = F.wave * 64 + pg8::lane_id_asm(); u < (LDS_BYTES - LDSCTL_OFF) / 4; u += NWAVES * 64) ((LAS unsigned*)(F.lds + LDSCTL_OFF))[u] = 0u;
    __syncthreads();
    const int lo = args.ph_lo, hi = args.ph_hi;
    const bool multi = (hi - lo) > 1;
    XcdBarrier bar; bar.bar = (unsigned*)(F.ctl + CW_BAR) + args.li * XCD_BAR_WORDS; bar.x = 0; bar.st = nullptr; bar.wave = F.wave;
    if (multi) bar = xcd_barrier_post((unsigned*)(F.ctl + CW_BAR) + args.li * XCD_BAR_WORDS, F.MISC + 8, F.wave);

    bf16* const XB = (bf16*)(ws + WS_XB); bf16* const ACT = (bf16*)(ws + WS_ACT); bf16* const MIXA = (bf16*)(ws + WS_MIXA);
    float* const SSQA = (float*)(ws + WS_SSQA); float* const SSQB = (float*)(ws + WS_SSQB);


#define IN(k) (lo <= (k) && (k) < hi)
#ifdef PROBE_PHASE
#define SEAM(k) do { if (IN(k) && ((k) + 1 < N_PHASES ? IN((k) + 1) : true)) { xcd_barrier(bar); \
        if ((k) + 1 == PROBE_PHASE) { if (blockIdx.x == 0 && F.wave == 0 && pg8::lane_id_asm() == 0) __hip_atomic_store((unsigned long long*)(F.ctl + 30000), (unsigned long long)__builtin_amdgcn_s_memrealtime(), RLX_AGENT); } \
        if ((k) == PROBE_PHASE) { if (blockIdx.x == 0 && F.wave == 0 && pg8::lane_id_asm() == 0) { const unsigned long long t1 = __builtin_amdgcn_s_memrealtime(), t0 = __hip_atomic_load((unsigned long long*)(F.ctl + 30000), RLX_AGENT); \
                __hip_atomic_store((unsigned long long*)(F.ctl + 30064), t1 - t0, RLX_AGENT); } \
            xcd_barrier(bar); \
            { const unsigned long long dt = __hip_atomic_load((unsigned long long*)(F.ctl + 30064), RLX_AGENT), s0 = __builtin_amdgcn_s_memrealtime(); while (__builtin_amdgcn_s_memrealtime() - s0 < 4ull * dt) __builtin_amdgcn_s_sleep(32); } } } } while (0)
#else
#define SEAM(k) do { if (IN(k) && IN((k) + 1)) xcd_barrier(bar); } while (0)
#endif
#define GEMM_SWIGLU(WOFF) do { pg8::Gemm g{XB, (const bf16*)(ws + (WOFF)), M, NGU, D}; pg8::StaticOrder S; S.init(M, NGU, F.G, (int)blockIdx.x); \
        pg8::EpiSwiGLU E{ACT, DFF, SSQA}; pg8::gemm_phase<pg8::EpiSwiGLU, pg8::StaticOrder, true, true>(F.lds + RING_OFF, g, S, E, F.wave); } while (0)
#define GEMM_RESID(AP, WOFF, KK, SRC32, SSQO) do { pg8::Gemm g{(AP), (const bf16*)(ws + (WOFF)), M, D, (KK)}; pg8::StaticOrder S; S.init(M, D, F.G, (int)blockIdx.x); \
        if ((M / 256) * (D / 256) <= F.G) { pg8::EpiResidInit E{(SRC32), XB, (SSQO)}; pg8::gemm_phase<pg8::EpiResidInit, pg8::StaticOrder, true, true>(F.lds + RING_OFF, g, S, E, F.wave); } \
        else { pg8::EpiResid E{(SRC32), XB, (SSQO)}; pg8::gemm_phase<pg8::EpiResid, pg8::StaticOrder, true, true>(F.lds + RING_OFF, g, S, E, F.wave); } } while (0)

    if (IN(0)) { convert_jobs<J_X | J_P | J_GU1 | (HOST_GU2 ? 0 : J_GU2) | J_PROJ | J_AX | J_PG>(F, (int)blockIdx.x, F.G); SEAM(0); }
    if (IN(1)) { GEMM_SWIGLU(WS_WGU1);
        { int rank, count; side_workers((M / 256) * (NGU / 256), F.G, (int)blockIdx.x, rank, count); if (rank >= 0) convert_jobs<J_D1 | J_WIN | J_WOUT>(F, rank, count); }
        SEAM(1); }
    if (IN(2)) { GEMM_RESID(ACT, WS_WD1, DFF, F.in[I_X], SSQB); SEAM(2); }
    if (IN(3)) {
        pg8::Gemm g{XB, (const bf16*)(ws + WS_WINT), M, NIN, D}; pg8::StaticOrder S; S.init(M, NIN, F.G, (int)blockIdx.x);
        pg8::EpiZ E{SSQB, F.in[I_HLB], MIXA, (float*)(ws + WS_LOGF), (bf16*)(ws + WS_V), (bf16*)(ws + WS_SG), (bf16*)(ws + WS_LRX)};
        pg8::gemm_phase<pg8::EpiZ, pg8::StaticOrder, true, true>(F.lds + RING_OFF, g, S, E, F.wave);
        SEAM(3); }
    if (IN(4)) { MIXER_PHASE_4 SEAM(4); }
    if (IN(5)) { MIXER_PHASE_5 SEAM(5); }
    if (IN(6)) { MIXER_PHASE_6 SEAM(6); }
    if (IN(7)) { GEMM_RESID(MIXA, WS_WOUT, D, (const float*)nullptr, SSQA); SEAM(7); }
    if (IN(8)) { GEMM_SWIGLU(WS_WGU2);
        { int rank, count; side_workers((M / 256) * (NGU / 256), F.G, (int)blockIdx.x, rank, count);
          if (rank >= 0) {
              pg8::Gemm g{(const bf16*)(ws + WS_PB), (const bf16*)(ws + WS_WPROJ), M, D, PLE}; pg8::StaticOrder S; S.init(M, D, count, rank);
              pg8::EpiPP E{(bf16*)(ws + WS_PP)};
              pg8::gemm_phase<pg8::EpiPP, pg8::StaticOrder, true, true>(F.lds + RING_OFF, g, S, E, F.wave);
              convert_jobs<J_D2>(F, rank, count); } }
        SEAM(8); }
    if (IN(9)) { GEMM_RESID(ACT, WS_WD2, DFF, (const float*)nullptr, SSQB); SEAM(9); }
    if (IN(10)) {
        { pg8::Gemm g{XB, (const bf16*)(ws + WS_WPG), M, D, D}; pg8::StaticOrder S; S.init(M, D, F.G, (int)blockIdx.x);
          if (F.G == (M / 256) * (D / 256)) {
              pg8::EpiPLEFinal E{SSQB, F.in[I_PBG], (const bf16*)(ws + WS_PP), XB, F.out, (float*)(ws + WS_XCH), (unsigned*)(F.ctl + CW_PANEL), F.in[I_FN]};
              pg8::gemm_phase<pg8::EpiPLEFinal, pg8::StaticOrder, false, true>(F.lds + RING_OFF, g, S, E, F.wave);
          } else {
              pg8::EpiPLE E{SSQB, F.in[I_PBG], (const bf16*)(ws + WS_PP), XB, F.out, SSQA};
              pg8::gemm_phase<pg8::EpiPLE, pg8::StaticOrder, true, true>(F.lds + RING_OFF, g, S, E, F.wave); } }
        SEAM(10); }
    if (IN(11)) { if (F.G != (M / 256) * (D / 256)) final_norm(F, SSQA); SEAM(11); }
#undef IN
#undef SEAM
}

#if SIMPLE_HGRN
__global__ void __launch_bounds__(64) k_simple_hgrn(const float* logf, const bf16* mixa, const bf16* vv, float* oh) {
    __shared__ float sf[128], sk[128], sq[128];
    const int bh = blockIdx.x >> 1, vh = blockIdx.x & 1, b = bh >> 3, h = bh & 7, lane = threadIdx.x, v = vh * 64 + lane;
    float S[128];
#pragma unroll
    for (int k = 0; k < 128; ++k) S[k] = 0.f;
    for (int t = 0; t < SEQ; ++t) {
        const size_t row = (size_t)b * SEQ + t;
        for (int kk = lane; kk < 128; kk += 64) { const float f = __expf(logf[row * 1024 + h * 128 + kk]); sf[kk] = f; sk[kk] = 1.f - f; sq[kk] = bf2f(mixa[row * 2048 + h * 128 + kk]); }
        __syncthreads();
        const float vt = bf2f(vv[row * 1024 + h * 128 + v]); float o = 0.f;
#pragma unroll
        for (int k = 0; k < 128; ++k) { S[k] = sf[k] * S[k] + sk[k] * vt; o += S[k] * sq[k]; }
        oh[row * 1024 + h * 128 + v] = o;
        __syncthreads();
    }
}
__global__ void __launch_bounds__(256) k_simple_hnorm(const float* oh, const bf16* sg, const float* gn, bf16* mixa) {
    const int gw = (blockIdx.x * 256 + threadIdx.x) >> 6, lane = threadIdx.x & 63;
    if (gw >= M * HEADS) return;
    const int row = gw >> 3, h = gw & 7;
    const float o0 = oh[(size_t)row * 1024 + h * 128 + lane], o1 = oh[(size_t)row * 1024 + h * 128 + 64 + lane];
    const float ss = wave_sum(o0 * o0 + o1 * o1);
    const float r = 1.0f / sqrtf(ss * (1.0f / 128.0f) + EPS);
    mixa[(size_t)row * 2048 + h * 128 + lane] = (bf16)f2bf(o0 * r * gn[lane] * bf2f(sg[(size_t)row * 1024 + h * 128 + lane]));
    mixa[(size_t)row * 2048 + h * 128 + 64 + lane] = (bf16)f2bf(o1 * r * gn[64 + lane] * bf2f(sg[(size_t)row * 1024 + h * 128 + 64 + lane]));
}
#endif
#if SIMPLE_LRU
__global__ void __launch_bounds__(256) k_simple_lru_a(const bf16* lrx, const float* cw, const float* cb, const float* wa, const float* ba, const float* wx, const float* bx, const float* lam, float* LA, float* LU) {
    __shared__ float xc[1024];
    const int row = blockIdx.x, tt = row % SEQ, tid = threadIdx.x;
    for (int c = tid; c < 1024; c += 256) { float s = cb[c];
        for (int j = 0; j < 4; ++j) { const int ts = tt - 3 + j; if (ts >= 0) s += cw[j * 1024 + c] * bf2f(lrx[(size_t)(row - 3 + j) * 1024 + c]); }
        xc[c] = s; }
    __syncthreads();
    for (int d = tid; d < 1024; d += 256) { const int n = d >> 7, dd = d & 127; float r = ba[d], g = bx[d];
        for (int c = 0; c < 128; ++c) { const float x = xc[n * 128 + c]; r += x * wa[((size_t)n * 128 + c) * 128 + dd]; g += x * wx[((size_t)n * 128 + c) * 128 + dd]; }
        r = 1.0f / (1.0f + __expf(-r)); g = 1.0f / (1.0f + __expf(-g));
        const float log_a = -8.0f * r * log1pf(__expf(-lam[d]));
        LA[(size_t)row * 1024 + d] = __expf(log_a); LU[(size_t)row * 1024 + d] = sqrtf(-expm1f(2.0f * log_a)) * g * xc[d]; }
}
__global__ void __launch_bounds__(256) k_simple_lru_b(const float* LA, const float* LU, bf16* mixa) {
    const int gi = blockIdx.x * 256 + threadIdx.x, b = gi >> 10, c = gi & 1023; float h = 0.f;
#pragma unroll 8
    for (int t = 0; t < SEQ; ++t) { const size_t row = (size_t)b * SEQ + t; h = LA[row * 1024 + c] * h + LU[row * 1024 + c];
        bf16* p = mixa + row * 2048 + 1024 + c; *p = (bf16)f2bf(h * bf2f(*p)); }
}
#endif

extern "C" void kernel_launch(void* const* d_in, const int* in_sizes, int n_in, void* d_out, int out_size, void* d_ws, size_t ws_size, hipStream_t stream) {
    static int grid = 0;
    if (grid == 0) {
        if (n_in != N_IN || in_sizes[0] != M * D || out_size != M * D || ws_size < WS_END) { fprintf(stderr, "kernel_launch: unexpected problem (n_in %d, in0 %d, out %d, ws %zu); nothing launched\n", n_in, n_in > 0 ? in_sizes[0] : -1, out_size, ws_size); grid = -1; return; }
        int dev = 0, cus = 0, per_cu = 0;
        if (hipGetDevice(&dev) != hipSuccess || hipDeviceGetAttribute(&cus, hipDeviceAttributeMultiprocessorCount, dev) != hipSuccess) { grid = -1; return; }
        if (hipFuncSetAttribute((const void*)mega_fwd, hipFuncAttributeMaxDynamicSharedMemorySize, LDS_BYTES) != hipSuccess) { fprintf(stderr, "kernel_launch: hipFuncSetAttribute failed\n"); grid = -1; return; }
        if (hipOccupancyMaxActiveBlocksPerMultiprocessor(&per_cu, (const void*)mega_fwd, NWAVES * 64, LDS_BYTES) != hipSuccess || per_cu < 1)
            fprintf(stderr, "kernel_launch: note: occupancy query reports %d workgroups per CU\n", per_cu);
        (void)hipGetLastError();
        grid = cus;
    }
    if (grid < 0) return;
    if (hipMemsetAsync((char*)d_ws + WS_CTL, 0, CTL_ZERO_BYTES, stream) != hipSuccess) return;
    Args a{};
    for (int i = 0; i < N_IN; ++i) a.in[i] = (const float*)d_in[i];
    a.out = (float*)d_out; a.ws = (unsigned char*)d_ws;
    unsigned char* ws = (unsigned char*)d_ws;
    auto launch = [&](int lo, int hi, int li) { a.ph_lo = lo; a.ph_hi = hi; a.li = li; hipLaunchKernelGGL(mega_fwd, dim3(grid), dim3(NWAVES * 64), LDS_BYTES, stream, a); };
#if SIMPLE_HGRN || SIMPLE_LRU
    launch(0, 4, 0);
#if SIMPLE_HGRN
    {   float* OH = (float*)(ws + WS_XB);
        hipLaunchKernelGGL(k_simple_hgrn, dim3(64), dim3(64), 0, stream, (const float*)(ws + WS_LOGF), (const bf16*)(ws + WS_MIXA), (const bf16*)(ws + WS_V), OH);
        hipLaunchKernelGGL(k_simple_hnorm, dim3(M * HEADS / 4), dim3(256), 0, stream, (const float*)OH, (const bf16*)(ws + WS_SG), (const float*)d_in[I_HGN], (bf16*)(ws + WS_MIXA)); }
#endif
#if SIMPLE_LRU
    {   float* LA = (float*)(ws + WS_KVT); float* LU = LA + (size_t)M * 1024;
        hipLaunchKernelGGL(k_simple_lru_a, dim3(M), dim3(256), 0, stream, (const bf16*)(ws + WS_LRX), (const float*)d_in[I_CW], (const float*)d_in[I_CB], (const float*)d_in[I_LWA], (const float*)d_in[I_LBA],
                           (const float*)d_in[I_LWX], (const float*)d_in[I_LBX], (const float*)d_in[I_LAM], LA, LU);
        hipLaunchKernelGGL(k_simple_lru_b, dim3(BATCH * 1024 / 256), dim3(256), 0, stream, (const float*)LA, (const float*)LU, (bf16*)(ws + WS_MIXA)); }
#endif
    launch(4, N_PHASES, 1);
#else
#if N_LAUNCHES == 1
    launch(0, N_PHASES, 0);
#else
    for (int ph = 0; ph < N_PHASES; ++ph) launch(ph, ph + 1, 0);
#endif
#endif
}
```

```cpp
#include <hip/hip_runtime.h>
#include <cstdio>
#include <cstdint>
#ifndef WT_EPIZ
#define WT_EPIZ 0
#endif
#ifndef WT_RESID
#define WT_RESID 0
#endif
#ifndef STAGGER_SIDE
#define STAGGER_SIDE 1
#endif
#ifndef STAGGER_G3
#define STAGGER_G3 1
#endif
#ifndef HOST_GU2
#define HOST_GU2 0
#endif
#ifndef SIMPLE_HGRN
#define SIMPLE_HGRN 0
#endif
#ifndef SIMPLE_LRU
#define SIMPLE_LRU 0
#endif
#ifndef N_LAUNCHES
#define N_LAUNCHES 1
#endif
#if SIMPLE_HGRN
#define MIXER_PHASE_4
#define MIXER_PHASE_6
#define MIXER_SCAN
#else
#define MIXER_PHASE_4 hgrn_local_phase(F);
#ifdef PROBE_H3
#define MIXER_PHASE_6 hgrn_out_phase(F, true); xcd_barrier(bar); hgrn_out_phase(F);
#else
#define MIXER_PHASE_6 hgrn_out_phase(F);
#endif
#ifdef PROBE_SCAN
#define MIXER_SCAN hgrn_scan_phase(F); xcd_barrier(bar); hgrn_scan_phase(F);
#else
#define MIXER_SCAN hgrn_scan_phase(F);
#endif
#endif
#if SIMPLE_LRU
#define MIXER_LRU
#else
#ifdef PROBE_LRU
#define MIXER_LRU lru_phase<PROBE_LRU, false, true>(F); xcd_barrier(bar); lru_phase<0>(F);
#else
#define MIXER_LRU lru_phase<0>(F);
#endif
#endif
#if !SIMPLE_HGRN && !SIMPLE_LRU && !defined(PROBE_LRU) && !defined(PROBE_SCAN)
#define MIXER_PHASE_5 if (F.G * NWAVES * 64 == BATCH * HEADS * 128 * 32 && F.G == BATCH * 64) { lru_phase<0, true>(F); } else { hgrn_scan_phase(F); lru_phase<0, false>(F); }
#else
#define MIXER_PHASE_5 MIXER_SCAN MIXER_LRU
#endif
namespace pg8 {
#define PG8_LAS __attribute__((address_space(3)))
typedef unsigned short bf16_t;
typedef short bf16x8 __attribute__((ext_vector_type(8)));
typedef float f32x4 __attribute__((ext_vector_type(4)));
typedef unsigned u32x4 __attribute__((ext_vector_type(4)));
constexpr int BM = 256, BK = 64, HALF = 128, HTB = HALF * BK * 2  , STAGE_BYTES = 8 * HTB, NXCD = 8, WGM = 4;

__host__ __device__ __forceinline__ int lds_byte(int r, int c) { const int st = (r >> 4) * 2 + (c >> 5), rr = r & 15, cc = c & 31, ob = rr * 64 + cc * 2; return st * 1024 + (ob ^ (((ob >> 9) & 1) << 5)); }
__host__ __device__ __forceinline__ void stage_rc(int b, int& R, int& C) { const int st = b / 1024, sb = b % 1024, swz = sb ^ (((sb >> 9) & 1) << 5); R = (st >> 1) * 16 + swz / 64; C = (st & 1) * 32 + (swz % 64) / 2; }
__host__ __device__ __forceinline__ int perm32(int rho) { const int n = rho >> 4, i = rho & 15; return 8 * (i >> 2) + 4 * n + (i & 3); }

struct Unit { int pm, pn; };
struct Gemm { const bf16_t* A; const bf16_t* Bt; int M, N, K; };

struct StaticOrder {
    int nM, nN, nwg, G, c;
    __host__ __device__ __forceinline__ void init(int M, int N, int G_, int c_) { nM = M / BM; nN = N / BM; nwg = nM * nN; G = G_; c = c_; }
    __host__ __device__ __forceinline__ bool next(int i, Unit& u) const {
        const long L = (long)i * G + c; if (L >= nwg) return false;
        int wgid = (int)L; { const int q = nwg / NXCD, r = nwg % NXCD, xcd = wgid % NXCD, off = wgid / NXCD; wgid = (xcd < r ? xcd * (q + 1) : r * (q + 1) + (xcd - r) * q) + off; }
        const int nig = WGM * nN, gid = wgid / nig, fm = gid * WGM, gsz = (nM - fm) < WGM ? (nM - fm) : WGM;
        u.pm = fm + ((wgid % nig) % gsz); u.pn = (wgid % nig) / gsz; return true;
    }
    __device__ __forceinline__ void a_ready(const Unit&) const {}
    __device__ __forceinline__ void done(const Unit&) const {}
};
struct SegMixOrder {
    StaticOrder S;
    __host__ __device__ __forceinline__ void init(int M, int N, int G_, int c_) { S.init(M, N, G_, c_); }
    __host__ __device__ __forceinline__ bool next(int i, Unit& u) const { if (!S.next(i, u)) return false; int sg = u.pn >> 2; sg ^= (sg >= 2) ? 1 : 0; u.pn = (sg << 2) | (u.pn & 3); return true; }
    __device__ __forceinline__ void a_ready(const Unit&) const {}
    __device__ __forceinline__ void done(const Unit&) const {}
};
struct RangeOrder {
    StaticOrder S; int base, n, count, rank;
    __host__ __device__ __forceinline__ void init(int M, int N, int base_, int n_, int count_, int rank_) { S.init(M, N, 1, 0); base = base_; n = n_; count = count_; rank = rank_; }
    __host__ __device__ __forceinline__ bool next(int i, Unit& u) const { const int l = i * count + rank; return l < n && S.next(base + l, u); }
    __device__ __forceinline__ void a_ready(const Unit&) const {}
    __device__ __forceinline__ void done(const Unit&) const {}
};
__device__ __forceinline__ int lane_id_asm() { int l; asm volatile("v_mbcnt_lo_u32_b32 %0, -1, 0\n\tv_mbcnt_hi_u32_b32 %0, -1, %0" : "=v"(l)); return l; }
__device__ __forceinline__ unsigned cvt_pk_bf16(float lo, float hi) { unsigned r; asm volatile("v_cvt_pk_bf16_f32 %0, %1, %2" : "=v"(r) : "v"(lo), "v"(hi)); return r; }
typedef unsigned u32x2 __attribute__((ext_vector_type(2)));
__device__ __forceinline__ void store16_sc1(void* p, u32x4 v) { asm volatile("global_store_dwordx4 %0, %1, off sc1\n\ts_nop 1" :: "v"(p), "v"(v) : "memory"); }
__device__ __forceinline__ void store16_wt(void* p, u32x4 v) {
#if WT_RESID
    asm volatile("global_store_dwordx4 %0, %1, off sc1\n\ts_nop 1" :: "v"(p), "v"(v) : "memory");
#else
    *(u32x4*)p = v;
#endif
}
constexpr int DM = 2048;
constexpr int NSSQ = 32;
__device__ __forceinline__ float sigmoid_f(float x) { return __builtin_amdgcn_rcpf(1.0f + __expf(-x)); }
__device__ __forceinline__ float silu_f(float x) { return x * sigmoid_f(x); }
__device__ __forceinline__ float gelu_tanh_f(float x) { return x * sigmoid_f(1.5957691216057308f * (x + 0.044715f * x * x * x)); }
__device__ __forceinline__ f32x4 bf16x4_to_f32(u32x2 w) { f32x4 r; r[0] = __builtin_bit_cast(float, w.x << 16); r[1] = __builtin_bit_cast(float, w.x & 0xffff0000u); r[2] = __builtin_bit_cast(float, w.y << 16); r[3] = __builtin_bit_cast(float, w.y & 0xffff0000u); return r; }
__device__ __forceinline__ void rows_rstd(const float* ssq, int row0, int fq, float (&rs)[2][4]) {
    f32x4 pa[2][4], pb[2][4];
#pragma unroll
    for (int ai = 0; ai < 2; ++ai)
#pragma unroll
        for (int m = 0; m < 4; ++m) { const f32x4* p = (const f32x4*)(ssq + (size_t)(row0 + ai * HALF + m * 16) * NSSQ + fq * 8); pa[ai][m] = p[0]; pb[ai][m] = p[1]; }
#pragma unroll
    for (int ai = 0; ai < 2; ++ai)
#pragma unroll
        for (int m = 0; m < 4; ++m) { const f32x4 a = pa[ai][m], b = pb[ai][m];
            float s = ((a[0] + a[1]) + (a[2] + a[3])) + ((b[0] + b[1]) + (b[2] + b[3]));
            s += __shfl_xor(s, 16); s += __shfl_xor(s, 32);
            rs[ai][m] = 1.0f / sqrtf(s * (1.0f / (float)DM) + 1e-6f); }
}

__device__ __forceinline__ void build_rstd_tab(const float* ssq, PG8_LAS float* rtab, int pm, int tid) {
    if (pm < 0) return;
    const int row = tid >> 1, half = tid & 1;
    const f32x4* p = (const f32x4*)(ssq + (size_t)(pm * 256 + row) * NSSQ + half * 16);
    const f32x4 a = p[0], b = p[1], c = p[2], d = p[3];
    float s = (((a[0] + a[1]) + (a[2] + a[3])) + ((b[0] + b[1]) + (b[2] + b[3]))) + (((c[0] + c[1]) + (c[2] + c[3])) + ((d[0] + d[1]) + (d[2] + d[3])));
    s += __shfl_xor(s, 1);
    if (!half) rtab[row] = 1.0f / sqrtf(s * (1.0f / (float)DM) + 1e-6f);
    asm volatile("s_waitcnt lgkmcnt(0)" ::: "memory");
}
__device__ __forceinline__ void rows_rstd_tab(const float* ssq, const PG8_LAS float* rtab, int rtab_pm, const Unit& u, int row0, int wr, int fr, int fq, float (&rs)[2][4]) {
    if (u.pm == rtab_pm) {
#pragma unroll
        for (int ai = 0; ai < 2; ++ai)
#pragma unroll
            for (int m = 0; m < 4; ++m) rs[ai][m] = rtab[wr * 64 + fr + ai * HALF + m * 16];
    } else rows_rstd(ssq, row0, fq, rs);
}

struct EpiSwiGLU {
    static constexpr bool PERM = true, AFTER_DRAIN = false, INIT_ACC = false, PRO_HOOK = true; static constexpr int NSTORES = 8;
    __device__ __forceinline__ void pro_hook(int tid) const { build_rstd_tab(ssq, (PG8_LAS float*)rtab, rtab_pm, tid); }
    bf16_t* O; int ldo; const float* ssq; const PG8_LAS float* rtab; int rtab_pm;
    __device__ __forceinline__ void operator()(const f32x4 (&acc)[2][2][4][2], const Unit& u, int wr, int wc, int fr, int fq) const {
        const int row0 = u.pm * BM + wr * 64 + fr, col0 = u.pn * HALF + wc * 32 + 8 * fq;
        float rs[2][4]; rows_rstd_tab(ssq, rtab, rtab_pm, u, row0, wr, fr, fq, rs);
#pragma unroll
        for (int ai = 0; ai < 2; ++ai)
#pragma unroll
            for (int m = 0; m < 4; ++m) {
                const int row = row0 + ai * HALF + m * 16; const float r = rs[ai][m];
                float h[8];
#pragma unroll
                for (int n = 0; n < 2; ++n)
#pragma unroll
                    for (int j = 0; j < 4; ++j) { const float g = acc[ai][0][m][n][j] * r, up = acc[ai][1][m][n][j] * r; h[n * 4 + j] = silu_f(g) * up; }
                u32x4 w; w.x = cvt_pk_bf16(h[0], h[1]); w.y = cvt_pk_bf16(h[2], h[3]); w.z = cvt_pk_bf16(h[4], h[5]); w.w = cvt_pk_bf16(h[6], h[7]);
                *(u32x4*)(O + (size_t)row * ldo + col0) = w;
            }
    }
};
struct EpiResid {
    static constexpr bool PERM = false, AFTER_DRAIN = false, INIT_ACC = false, PRO_HOOK = false; static constexpr int NSTORES = 0;
    const float* src32; bf16_t* xb; float* ssq_out;
    __device__ __forceinline__ void operator()(const f32x4 (&acc)[2][2][4][2], const Unit& u, int wr, int wc, int fr, int fq) const {
        const int row0 = u.pm * BM + wr * 64 + fr, col0 = u.pn * BM + wc * 32 + 4 * fq;
#pragma unroll
        for (int ai = 0; ai < 2; ++ai)
#pragma unroll
            for (int m = 0; m < 4; ++m) {
                const int row = row0 + ai * HALF + m * 16; float ss = 0.f;
                f32x4 sv[2][2];
#pragma unroll
                for (int bj = 0; bj < 2; ++bj)
#pragma unroll
                    for (int n = 0; n < 2; ++n) { const size_t off = (size_t)row * DM + col0 + bj * HALF + n * 16; sv[bj][n] = src32 ? *(const f32x4*)(src32 + off) : bf16x4_to_f32(*(const u32x2*)(xb + off)); }
#pragma unroll
                for (int bj = 0; bj < 2; ++bj)
#pragma unroll
                    for (int n = 0; n < 2; ++n) { const size_t off = (size_t)row * DM + col0 + bj * HALF + n * 16;
                        const f32x4 o = sv[bj][n] + acc[ai][bj][m][n];
                        u32x2 w; w.x = cvt_pk_bf16(o[0], o[1]); w.y = cvt_pk_bf16(o[2], o[3]); *(u32x2*)(xb + off) = w;
                        ss += (o[0] * o[0] + o[1] * o[1]) + (o[2] * o[2] + o[3] * o[3]); }
                ss += __shfl_xor(ss, 16); ss += __shfl_xor(ss, 32);
                if (fq == 0) ssq_out[(size_t)row * NSSQ + u.pn * 4 + wc] = ss;
            }
    }
};
struct EpiResidInit {
    static constexpr bool PERM = true, AFTER_DRAIN = false, INIT_ACC = true, PRO_HOOK = false; static constexpr int NSTORES = 0;
    const float* src32; bf16_t* xb; float* ssq_out;
    unsigned* cnt;
    __device__ __forceinline__ void init_acc(f32x4 (&acc)[2][2][4][2], const Unit& u, int wr, int wc, int fr, int fq) const {
        const int row0 = u.pm * BM + wr * 64 + fr, col0 = u.pn * BM + wc * 32 + 8 * fq;
        if (src32) {
#pragma unroll
            for (int ai = 0; ai < 2; ++ai)
#pragma unroll
                for (int m = 0; m < 4; ++m)
#pragma unroll
                    for (int bj = 0; bj < 2; ++bj)
#pragma unroll
                        for (int n = 0; n < 2; ++n) acc[ai][bj][m][n] = __builtin_nontemporal_load((const f32x4*)(src32 + (size_t)(row0 + ai * HALF + m * 16) * DM + col0 + bj * HALF + n * 4));
        } else {
#pragma unroll
            for (int ai = 0; ai < 2; ++ai)
#pragma unroll
                for (int m = 0; m < 4; ++m)
#pragma unroll
                    for (int bj = 0; bj < 2; ++bj) { const u32x4 h = __builtin_nontemporal_load((const u32x4*)(xb + (size_t)(row0 + ai * HALF + m * 16) * DM + col0 + bj * HALF)); acc[ai][bj][m][0] = __builtin_bit_cast(f32x4, h); }
#pragma unroll
            for (int ai = 0; ai < 2; ++ai)
#pragma unroll
                for (int m = 0; m < 4; ++m)
#pragma unroll
                    for (int bj = 0; bj < 2; ++bj) { const u32x4 r = __builtin_bit_cast(u32x4, acc[ai][bj][m][0]); acc[ai][bj][m][0] = bf16x4_to_f32((u32x2){r.x, r.y}); acc[ai][bj][m][1] = bf16x4_to_f32((u32x2){r.z, r.w}); }
        }
    }
    __device__ __forceinline__ void operator()(const f32x4 (&acc)[2][2][4][2], const Unit& u, int wr, int wc, int fr, int fq) const {
        const int row0 = u.pm * BM + wr * 64 + fr, col0 = u.pn * BM + wc * 32 + 8 * fq;
#pragma unroll
        for (int ai = 0; ai < 2; ++ai)
#pragma unroll
            for (int m = 0; m < 4; ++m) {
                const int row = row0 + ai * HALF + m * 16; float ss = 0.f;
#pragma unroll
                for (int bj = 0; bj < 2; ++bj) { const size_t off = (size_t)row * DM + col0 + bj * HALF;
                    const f32x4 o = acc[ai][bj][m][0], p = acc[ai][bj][m][1];
                    u32x4 w; w.x = cvt_pk_bf16(o[0], o[1]); w.y = cvt_pk_bf16(o[2], o[3]); w.z = cvt_pk_bf16(p[0], p[1]); w.w = cvt_pk_bf16(p[2], p[3]); if (cnt) store16_sc1(xb + off, w); else *(u32x4*)(xb + off) = w;
                    ss += ((o[0] * o[0] + o[1] * o[1]) + (o[2] * o[2] + o[3] * o[3])) + ((p[0] * p[0] + p[1] * p[1]) + (p[2] * p[2] + p[3] * p[3])); }
                ss += __shfl_xor(ss, 16); ss += __shfl_xor(ss, 32);
                if (fq == 0) { if (cnt) __hip_atomic_store(ssq_out + (size_t)row * NSSQ + u.pn * 4 + wc, ss, __ATOMIC_RELAXED, __HIP_MEMORY_SCOPE_AGENT); else ssq_out[(size_t)row * NSSQ + u.pn * 4 + wc] = ss; }
            }
        if (cnt) {
            asm volatile("s_waitcnt vmcnt(0)" ::: "memory");
            if (fr == 0 && fq == 0) __hip_atomic_fetch_add(cnt + 64 * u.pm, 1u, __ATOMIC_RELAXED, __HIP_MEMORY_SCOPE_AGENT);
        }
    }
};
struct EpiZ {
    static constexpr bool PERM = true, AFTER_DRAIN = false, INIT_ACC = false, PRO_HOOK = true; static constexpr int NSTORES = 16;
    __device__ __forceinline__ void pro_hook(int tid) const { build_rstd_tab(ssq, (PG8_LAS float*)rtab, rtab_pm, tid); }
    const float* ssq; const float* hlb;
    bf16_t* mixa;
    float* logf; bf16_t* vv; bf16_t* sg; bf16_t* lrx;
    const PG8_LAS float* rtab; int rtab_pm;
    __device__ __forceinline__ void operator()(const f32x4 (&acc)[2][2][4][2], const Unit& u, int wr, int wc, int fr, int fq) const {
        const int seg = u.pn >> 2;
        const int row0 = u.pm * BM + wr * 64 + fr, cs0 = (u.pn & 3) * BM + wc * 32 + 8 * fq;
        float rs[2][4]; rows_rstd_tab(ssq, rtab, rtab_pm, u, row0, wr, fr, fq, rs);
        float lbv[2][8];
        if (seg == 1) {
#pragma unroll
            for (int bj = 0; bj < 2; ++bj)
#pragma unroll
                for (int e = 0; e < 8; ++e) { const int c = cs0 + bj * HALF + e; lbv[bj][e] = sigmoid_f(hlb[c] - hlb[1024 + c]); }
        }
#pragma unroll
        for (int ai = 0; ai < 2; ++ai)
#pragma unroll
            for (int m = 0; m < 4; ++m) {
                const int row = row0 + ai * HALF + m * 16; const float r = rs[ai][m];
#pragma unroll
                for (int bj = 0; bj < 2; ++bj) {
                    const int cs = cs0 + bj * HALF;
                    float z[8];
#pragma unroll
                    for (int n = 0; n < 2; ++n)
#pragma unroll
                        for (int j = 0; j < 4; ++j) z[n * 4 + j] = acc[ai][bj][m][n][j] * r;
                    if (seg == 1) {
                        float lf[8];
#pragma unroll
                        for (int e = 0; e < 8; ++e) { const float lb = lbv[bj][e]; lf[e] = __logf(lb + (1.0f - lb) * sigmoid_f(z[e])); }
                        float* p = logf + (size_t)row * 1024 + cs;
                        *(f32x4*)p = (f32x4){lf[0], lf[1], lf[2], lf[3]}; *(f32x4*)(p + 4) = (f32x4){lf[4], lf[5], lf[6], lf[7]};
                    } else {
                        if (seg == 3) {
#pragma unroll
                            for (int e = 0; e < 8; ++e) z[e] = silu_f(z[e]);
                        } else if (seg == 5) {
#pragma unroll
                            for (int e = 0; e < 8; ++e) z[e] = gelu_tanh_f(z[e]);
                        }
                        u32x4 w; w.x = cvt_pk_bf16(z[0], z[1]); w.y = cvt_pk_bf16(z[2], z[3]); w.z = cvt_pk_bf16(z[4], z[5]); w.w = cvt_pk_bf16(z[6], z[7]);
                        bf16_t* p;
                        if (seg == 0) p = mixa + (size_t)row * 2048 + cs;
                        else if (seg == 5) p = mixa + (size_t)row * 2048 + 1024 + cs;
                        else if (seg == 2) p = vv + (size_t)row * 1024 + cs;
                        else if (seg == 3) p = sg + (size_t)row * 1024 + cs;
                        else p = lrx + (size_t)row * 1024 + cs;
                        if (WT_EPIZ) store16_sc1(p, w); else *(u32x4*)p = w;
                    }
                }
            }
    }
};
struct EpiPP {
    static constexpr bool PERM = true, AFTER_DRAIN = false, INIT_ACC = false, PRO_HOOK = false; static constexpr int NSTORES = 0;
    bf16_t* PP;
    __device__ __forceinline__ void operator()(const f32x4 (&acc)[2][2][4][2], const Unit& u, int wr, int wc, int fr, int fq) const {
        const int row0 = u.pm * BM + wr * 64 + fr, col0 = u.pn * BM + wc * 32 + 8 * fq;
#pragma unroll
        for (int ai = 0; ai < 2; ++ai)
#pragma unroll
            for (int m = 0; m < 4; ++m) { bf16_t* rowp = PP + (size_t)(row0 + ai * HALF + m * 16) * DM + col0;
#pragma unroll
                for (int bj = 0; bj < 2; ++bj) { const f32x4 a = acc[ai][bj][m][0], b = acc[ai][bj][m][1];
                    u32x4 w; w.x = cvt_pk_bf16(a[0], a[1]); w.y = cvt_pk_bf16(a[2], a[3]); w.z = cvt_pk_bf16(b[0], b[1]); w.w = cvt_pk_bf16(b[2], b[3]); *(u32x4*)(rowp + bj * HALF) = w; } }
    }
};
struct EpiPLE {
    static constexpr bool PERM = false, AFTER_DRAIN = false, INIT_ACC = false, PRO_HOOK = false; static constexpr int NSTORES = 0;
    const float* ssq_in; const float* bg; const bf16_t* PP; const bf16_t* xb; float* X; float* ssq_out;
    __device__ __forceinline__ void operator()(const f32x4 (&acc)[2][2][4][2], const Unit& u, int wr, int wc, int fr, int fq) const {
        const int row0 = u.pm * BM + wr * 64 + fr, col0 = u.pn * BM + wc * 32 + 4 * fq;
        float rs[2][4]; rows_rstd(ssq_in, row0, fq, rs);
#pragma unroll
        for (int ai = 0; ai < 2; ++ai)
#pragma unroll
            for (int m = 0; m < 4; ++m) {
                const int row = row0 + ai * HALF + m * 16; const float r = rs[ai][m]; float ss = 0.f;
                f32x4 pv[2][2], ov[2][2];
#pragma unroll
                for (int bj = 0; bj < 2; ++bj)
#pragma unroll
                    for (int n = 0; n < 2; ++n) { const size_t off = (size_t)row * DM + col0 + bj * HALF + n * 16; pv[bj][n] = bf16x4_to_f32(*(const u32x2*)(PP + off)); ov[bj][n] = bf16x4_to_f32(*(const u32x2*)(xb + off)); }
#pragma unroll
                for (int bj = 0; bj < 2; ++bj)
#pragma unroll
                    for (int n = 0; n < 2; ++n) { const int c = col0 + bj * HALF + n * 16; const size_t off = (size_t)row * DM + c;
                        const f32x4 b4 = *(const f32x4*)(bg + c), a = acc[ai][bj][m][n]; f32x4 o;
#pragma unroll
                        for (int j = 0; j < 4; ++j) o[j] = ov[bj][n][j] + sigmoid_f(a[j] * r + b4[j]) * pv[bj][n][j];
                        *(f32x4*)(X + off) = o; ss += (o[0] * o[0] + o[1] * o[1]) + (o[2] * o[2] + o[3] * o[3]); }
                ss += __shfl_xor(ss, 16); ss += __shfl_xor(ss, 32);
                if (fq == 0) ssq_out[(size_t)row * NSSQ + u.pn * 4 + wc] = ss;
            }
    }
};

struct EpiPLEFinal {
    static constexpr bool PERM = true, AFTER_DRAIN = true, INIT_ACC = false, PRO_HOOK = true; static constexpr int NSTORES = 0;
    __device__ __forceinline__ void pro_hook(int tid) const { build_rstd_tab(ssq_in, (PG8_LAS float*)rtab, rtab_pm, tid); }
    const float* ssq_in; const float* bg; const bf16_t* PP; const bf16_t* xb; float* X; float* xch; unsigned* cnt; const float* gf; const PG8_LAS float* rtab; int rtab_pm;
    __device__ __forceinline__ void operator()(const f32x4 (&)[2][2][4][2], const Unit&, int, int, int, int) const {}
    __device__ __forceinline__ void fused(f32x4 (&acc)[2][2][4][2], const Unit& u, int wr, int wc, int fr, int fq, PG8_LAS unsigned char* lds, int wid, int lane) const {
        const int row0 = u.pm * BM + wr * 64 + fr, col0 = u.pn * BM + wc * 32 + 8 * fq;
        float rs[2][4]; rows_rstd_tab(ssq_in, rtab, rtab_pm, u, row0, wr, fr, fq, rs);
        f32x4 b4[2][2];
#pragma unroll
        for (int bj = 0; bj < 2; ++bj)
#pragma unroll
            for (int n = 0; n < 2; ++n) b4[bj][n] = *(const f32x4*)(bg + col0 + bj * HALF + n * 4);
#pragma unroll
        for (int ai = 0; ai < 2; ++ai)
#pragma unroll
          for (int mp = 0; mp < 2; ++mp) {
            u32x4 pv[2][2], ov[2][2];
#pragma unroll
            for (int mm = 0; mm < 2; ++mm)
#pragma unroll
                for (int bj = 0; bj < 2; ++bj) { const size_t off = (size_t)(row0 + ai * HALF + (2 * mp + mm) * 16) * DM + col0 + bj * HALF; pv[mm][bj] = *(const u32x4*)(PP + off); ov[mm][bj] = *(const u32x4*)(xb + off); }
#pragma unroll
            for (int mm = 0; mm < 2; ++mm) {
                const int m = 2 * mp + mm, row = row0 + ai * HALF + m * 16; const float r = rs[ai][m]; float ss = 0.f;
#pragma unroll
                for (int bj = 0; bj < 2; ++bj)
#pragma unroll
                    for (int n = 0; n < 2; ++n) { const f32x4 a = acc[ai][bj][m][n], pp = bf16x4_to_f32(n ? (u32x2){pv[mm][bj].z, pv[mm][bj].w} : (u32x2){pv[mm][bj].x, pv[mm][bj].y}), xo = bf16x4_to_f32(n ? (u32x2){ov[mm][bj].z, ov[mm][bj].w} : (u32x2){ov[mm][bj].x, ov[mm][bj].y}); f32x4 o;
#pragma unroll
                        for (int j = 0; j < 4; ++j) o[j] = xo[j] + sigmoid_f(a[j] * r + b4[bj][n][j]) * pp[j];
                        acc[ai][bj][m][n] = o; ss += (o[0] * o[0] + o[1] * o[1]) + (o[2] * o[2] + o[3] * o[3]); }
                ss += __shfl_xor(ss, 16); ss += __shfl_xor(ss, 32);
                if (fq == 0) __hip_atomic_store(xch + (size_t)row * NSSQ + u.pn * 4 + wc, ss, __ATOMIC_RELAXED, __HIP_MEMORY_SCOPE_AGENT);
            }
          }
        f32x4 g4[2][2];
#pragma unroll
        for (int bj = 0; bj < 2; ++bj)
#pragma unroll
            for (int n = 0; n < 2; ++n) g4[bj][n] = *(const f32x4*)(gf + col0 + bj * HALF + n * 4);
        asm volatile("s_waitcnt vmcnt(0)" ::: "memory");
        unsigned* pc = cnt + 64 * u.pm;
        if (lane == 0) __hip_atomic_fetch_add(pc, 1u, __ATOMIC_RELAXED, __HIP_MEMORY_SCOPE_AGENT);
        if (wid == 0) {
            unsigned sp = 0;
            while ((unsigned)__builtin_amdgcn_readfirstlane(__hip_atomic_load(pc, __ATOMIC_RELAXED, __HIP_MEMORY_SCOPE_AGENT)) < 64u) { __builtin_amdgcn_s_sleep(2); if (++sp > (1u << 22)) break; }
            __builtin_amdgcn_fence(__ATOMIC_ACQUIRE, "agent");
        }
        asm volatile("s_waitcnt vmcnt(0) lgkmcnt(0)" ::: "memory"); __builtin_amdgcn_s_barrier(); asm volatile("" ::: "memory");
        float r4[2][4]; rows_rstd(xch, row0, fq, r4);
#pragma unroll
        for (int ai = 0; ai < 2; ++ai)
#pragma unroll
            for (int m = 0; m < 4; ++m) { float* rowp = X + (size_t)(row0 + ai * HALF + m * 16) * DM + col0; const float r = r4[ai][m];
#pragma unroll
                for (int bj = 0; bj < 2; ++bj)
#pragma unroll
                    for (int n = 0; n < 2; ++n) *(f32x4*)(rowp + bj * HALF + n * 4) = acc[ai][bj][m][n] * r * g4[bj][n]; }
    }
};

template <class Epi, class Sched, bool ALIGN_EPI = false, bool SP2 = false, bool BAL = false>
__device__ __forceinline__ void gemm_phase(PG8_LAS unsigned char* lds, const Gemm g, const Sched& S, const Epi& E, const int wave_s) {
    int tid_ = wave_s * 64 + lane_id_asm();
    const int tid = tid_, wid = wave_s, lane = tid & 63, wr = wid >> 2, wc = wid & 3, fr = lane & 15, fq = lane >> 4;
    const int K = g.K, nt = K / BK;
    unsigned voffA[2], voffB[2];
#pragma unroll
    for (int i = 0; i < 2; ++i) { int R, C; stage_rc(tid * 16 + i * 8192, R, C); const int Rb = Epi::PERM ? ((R & ~31) + perm32(R & 31)) : R;
        voffA[i] = (unsigned)(R * K + C) * 2u; voffB[i] = (unsigned)(Rb * K + C) * 2u; }
    const size_t kstep = (size_t)(BK * 2);
    const size_t hstep = (size_t)HALF * K * 2;
    const size_t tstep = 2 * hstep;
    const unsigned ldsw = (unsigned)wid * 1024u;
    const int aoff = lds_byte(wr * 64 + fr, fq * 8), boff = lds_byte(wc * 32 + fr, fq * 8);
#define PG8_SA(b, h) (((b) * 2 + (h)) * HTB)
#define PG8_SB(b, h) ((4 + (b) * 2 + (h)) * HTB)
#define PG8_STAGE(bufoff, gbase, voff) do { _Pragma("unroll") for (int _i = 0; _i < 2; ++_i) \
        __builtin_amdgcn_global_load_lds((const unsigned*)((const char*)(gbase) + (voff)[_i]), (PG8_LAS unsigned*)(lds + (bufoff) + ldsw + _i * 8192), 16, 0, 0); } while (0)
#define PG8_LDA(dst, b, h) do { _Pragma("unroll") for (int m = 0; m < 4; ++m) _Pragma("unroll") for (int k = 0; k < 2; ++k) dst[m][k] = *(const PG8_LAS bf16x8*)(lds + PG8_SA(b, h) + aoff + m * 2048 + k * 1024); } while (0)
#define PG8_LDB(dst, b, h) do { _Pragma("unroll") for (int n = 0; n < 2; ++n) _Pragma("unroll") for (int k = 0; k < 2; ++k) dst[n][k] = *(const PG8_LAS bf16x8*)(lds + PG8_SB(b, h) + boff + n * 2048 + k * 1024); } while (0)
#define PG8_MMA(ai, bj, At, Bt) do { __builtin_amdgcn_s_setprio(1); _Pragma("unroll") for (int m = 0; m < 4; ++m) _Pragma("unroll") for (int n = 0; n < 2; ++n) _Pragma("unroll") for (int k = 0; k < 2; ++k) \
        acc[ai][bj][m][n] = __builtin_amdgcn_mfma_f32_16x16x32_bf16(Bt[n][k], At[m][k], acc[ai][bj][m][n], 0, 0, 0); __builtin_amdgcn_s_setprio(0); } while (0)
#define PG8_WAIT_V(n) asm volatile("s_waitcnt vmcnt(" #n ")" ::: "memory")
#define PG8_WAIT_L(n) asm volatile("s_waitcnt lgkmcnt(" #n ")" ::: "memory")
#define PG8_BAR __builtin_amdgcn_s_barrier()
#define PG8_SCHED __builtin_amdgcn_sched_barrier(0)
    Unit cur, nxt; int ui = 0;
    if (!S.next(0, cur)) return;
    f32x4 acc[2][2][4][2];
    if constexpr (Epi::INIT_ACC) { E.init_acc(acc, cur, wr, wc, fr, fq); }
    else {
#pragma unroll
    for (int a = 0; a < 2; ++a)
#pragma unroll
        for (int b = 0; b < 2; ++b)
#pragma unroll
            for (int m = 0; m < 4; ++m)
#pragma unroll
                for (int n = 0; n < 2; ++n) acc[a][b][m][n] = (f32x4){0.f, 0.f, 0.f, 0.f};
    }
    bf16x8 At[4][2], B0[2][2], B1[2][2];
    const char* cA = (const char*)g.A + (size_t)cur.pm * tstep; const char* cB = (const char*)g.Bt + (size_t)cur.pn * tstep;
    S.a_ready(cur);
    if constexpr (SP2) {
        PG8_STAGE(PG8_SB(0, 0), cB, voffB); PG8_STAGE(PG8_SB(0, 1), cB + hstep, voffB); PG8_STAGE(PG8_SA(0, 0), cA, voffA); PG8_STAGE(PG8_SA(0, 1), cA + hstep, voffA);
        if constexpr (Epi::PRO_HOOK) E.pro_hook(tid);
        if (wr == 1) PG8_BAR;
        PG8_WAIT_V(2); PG8_BAR;
        if constexpr (BAL) {
            PG8_STAGE(PG8_SB(1, 0), cB + kstep, voffB); PG8_STAGE(PG8_SB(1, 1), cB + hstep + kstep, voffB);
            PG8_WAIT_V(4); PG8_BAR;
        } else {
        PG8_STAGE(PG8_SB(1, 0), cB + kstep, voffB); PG8_STAGE(PG8_SA(1, 0), cA + kstep, voffA); PG8_STAGE(PG8_SB(1, 1), cB + hstep + kstep, voffB);
        PG8_WAIT_V(6); PG8_BAR;
        }
    } else {
        PG8_STAGE(PG8_SB(0, 0), cB, voffB); PG8_STAGE(PG8_SA(0, 0), cA, voffA); PG8_STAGE(PG8_SB(0, 1), cB + hstep, voffB); PG8_STAGE(PG8_SA(0, 1), cA + hstep, voffA);
        if (wr == 1) PG8_BAR;
        PG8_WAIT_V(4); PG8_BAR;
        PG8_STAGE(PG8_SB(1, 0), cB + kstep, voffB); PG8_STAGE(PG8_SA(1, 0), cA + kstep, voffA); PG8_STAGE(PG8_SB(1, 1), cB + hstep + kstep, voffB);
        PG8_WAIT_V(6); PG8_BAR;
    }
    for (;;) {
        const bool has_next = S.next(ui + 1, nxt);
        const char* nA = has_next ? (const char*)g.A + (size_t)nxt.pm * tstep : cA; const char* nB = has_next ? (const char*)g.Bt + (size_t)nxt.pn * tstep : cB;
        for (int t = 0; t < nt; t += 2) {
            const bool last = (t == nt - 2);
            const char* a1 = cA + (size_t)(t + 1) * kstep;
            const char* a2 = last ? nA : cA + (size_t)(t + 2) * kstep; const char* b2 = last ? nB : cB + (size_t)(t + 2) * kstep;
            const char* a3 = a2 + kstep; const char* b3 = b2 + kstep;
            if (last && has_next) S.a_ready(nxt);
            if constexpr (SP2 && BAL) {
            PG8_LDB(B0, 0, 0); PG8_LDB(B1, 0, 1); PG8_SCHED; PG8_LDA(At, 0, 0); PG8_STAGE(PG8_SA(1, 0), a1, voffA); PG8_STAGE(PG8_SA(1, 1), a1 + hstep, voffA);
            PG8_WAIT_V(4); PG8_WAIT_L(0); PG8_BAR; PG8_MMA(0, 0, At, B0); PG8_MMA(0, 1, At, B1); PG8_BAR; PG8_SCHED;
            PG8_LDA(At, 0, 1); PG8_STAGE(PG8_SB(0, 0), b2, voffB); PG8_STAGE(PG8_SB(0, 1), b2 + hstep, voffB);
            PG8_WAIT_V(4); PG8_WAIT_L(0); PG8_BAR; PG8_MMA(1, 0, At, B0); PG8_MMA(1, 1, At, B1); PG8_BAR; PG8_SCHED;
            PG8_LDB(B0, 1, 0); PG8_LDB(B1, 1, 1); PG8_SCHED; PG8_LDA(At, 1, 0); PG8_STAGE(PG8_SA(0, 0), a2, voffA); PG8_STAGE(PG8_SA(0, 1), a2 + hstep, voffA);
            PG8_WAIT_V(4); PG8_WAIT_L(0); PG8_BAR; PG8_MMA(0, 0, At, B0); PG8_MMA(0, 1, At, B1); PG8_BAR; PG8_SCHED;
            PG8_LDA(At, 1, 1); PG8_STAGE(PG8_SB(1, 0), b3, voffB); PG8_STAGE(PG8_SB(1, 1), b3 + hstep, voffB);
            PG8_WAIT_V(4); PG8_WAIT_L(0); PG8_BAR; PG8_MMA(1, 0, At, B0); PG8_MMA(1, 1, At, B1); PG8_BAR; PG8_SCHED;
            } else if constexpr (SP2) {
            PG8_LDB(B0, 0, 0); PG8_LDB(B1, 0, 1); PG8_SCHED; PG8_LDA(At, 0, 0); PG8_STAGE(PG8_SA(1, 1), a1 + hstep, voffA);
            PG8_WAIT_V(8); PG8_WAIT_L(0); PG8_BAR; PG8_MMA(0, 0, At, B0); PG8_MMA(0, 1, At, B1); PG8_BAR; PG8_SCHED;
            PG8_LDA(At, 0, 1); PG8_STAGE(PG8_SB(0, 0), b2, voffB); PG8_STAGE(PG8_SB(0, 1), b2 + hstep, voffB); PG8_STAGE(PG8_SA(0, 0), a2, voffA);
            PG8_WAIT_V(8); PG8_WAIT_L(0); PG8_BAR; PG8_MMA(1, 0, At, B0); PG8_MMA(1, 1, At, B1); PG8_BAR; PG8_SCHED;
            PG8_LDB(B0, 1, 0); PG8_LDB(B1, 1, 1); PG8_SCHED; PG8_LDA(At, 1, 0); PG8_STAGE(PG8_SA(0, 1), a2 + hstep, voffA);
            PG8_WAIT_V(8); PG8_WAIT_L(0); PG8_BAR; PG8_MMA(0, 0, At, B0); PG8_MMA(0, 1, At, B1); PG8_BAR; PG8_SCHED;
            PG8_LDA(At, 1, 1); PG8_STAGE(PG8_SB(1, 0), b3, voffB); PG8_STAGE(PG8_SB(1, 1), b3 + hstep, voffB); PG8_STAGE(PG8_SA(1, 0), a3, voffA);
            PG8_WAIT_V(8); PG8_WAIT_L(0); PG8_BAR; PG8_MMA(1, 0, At, B0); PG8_MMA(1, 1, At, B1); PG8_BAR; PG8_SCHED;
            } else {
            PG8_LDB(B0, 0, 0); PG8_SCHED; PG8_LDA(At, 0, 0); PG8_STAGE(PG8_SA(1, 1), a1 + hstep, voffA);
            PG8_WAIT_L(8); PG8_BAR; PG8_WAIT_L(0); PG8_MMA(0, 0, At, B0); PG8_BAR; PG8_SCHED;
            PG8_LDB(B1, 0, 1); PG8_STAGE(PG8_SB(0, 0), b2, voffB);
            PG8_BAR; PG8_WAIT_L(0); PG8_MMA(0, 1, At, B1); PG8_BAR;
            PG8_LDA(At, 0, 1); PG8_STAGE(PG8_SA(0, 0), a2, voffA);
            PG8_BAR; PG8_WAIT_L(0); PG8_MMA(1, 0, At, B0); PG8_BAR; PG8_SCHED;
            PG8_STAGE(PG8_SB(0, 1), b2 + hstep, voffB);
            PG8_WAIT_V(6); PG8_BAR; PG8_MMA(1, 1, At, B1); PG8_BAR;
            PG8_LDB(B0, 1, 0); PG8_SCHED; PG8_LDA(At, 1, 0); PG8_STAGE(PG8_SA(0, 1), a2 + hstep, voffA);
            PG8_WAIT_L(8); PG8_BAR; PG8_WAIT_L(0); PG8_MMA(0, 0, At, B0); PG8_BAR; PG8_SCHED;
            PG8_LDB(B1, 1, 1); PG8_STAGE(PG8_SB(1, 0), b3, voffB);
            PG8_BAR; PG8_WAIT_L(0); PG8_MMA(0, 1, At, B1); PG8_BAR;
            PG8_LDA(At, 1, 1); PG8_STAGE(PG8_SA(1, 0), a3, voffA);
            PG8_BAR; PG8_WAIT_L(0); PG8_MMA(1, 0, At, B0); PG8_BAR; PG8_SCHED;
            PG8_STAGE(PG8_SB(1, 1), b3 + hstep, voffB);
            PG8_WAIT_V(6); PG8_BAR; PG8_MMA(1, 1, At, B1); PG8_BAR;
            }
        }
        if constexpr (ALIGN_EPI) { if (wr == 0) PG8_BAR; }
        if constexpr (!Epi::AFTER_DRAIN) { E(acc, cur, wr, wc, fr, fq); S.done(cur); }
        if (!has_next) break;
#pragma unroll
        for (int a = 0; a < 2; ++a)
#pragma unroll
            for (int b = 0; b < 2; ++b)
#pragma unroll
                for (int m = 0; m < 4; ++m)
#pragma unroll
                    for (int n = 0; n < 2; ++n) acc[a][b][m][n] = (f32x4){0.f, 0.f, 0.f, 0.f};
        cur = nxt; cA = nA; cB = nB; ++ui;
        if constexpr (ALIGN_EPI) { if (wr == 1) PG8_BAR; }
    }
    PG8_WAIT_V(0);
    if constexpr (!ALIGN_EPI) { if (wr == 0) PG8_BAR; }
    PG8_BAR;
    if constexpr (Epi::AFTER_DRAIN) { E.fused(acc, cur, wr, wc, fr, fq, lds, wid, lane); S.done(cur); }
#undef PG8_SA
#undef PG8_SB
#undef PG8_STAGE
#undef PG8_LDA
#undef PG8_LDB
#undef PG8_MMA
#undef PG8_WAIT_V
#undef PG8_WAIT_L
#undef PG8_BAR
#undef PG8_SCHED
}
}
#define GAS __attribute__((address_space(1)))
#define LAS __attribute__((address_space(3)))
typedef unsigned short bf16;
typedef unsigned v4u __attribute__((ext_vector_type(4)));
typedef float f32x4 __attribute__((ext_vector_type(4)));
typedef short bf16x8 __attribute__((ext_vector_type(8)));
typedef GAS unsigned gu32;
typedef GAS unsigned long long gu64;
#define RLX_AGENT __ATOMIC_RELAXED, __HIP_MEMORY_SCOPE_AGENT
#define LDS_WAIT() asm volatile("s_waitcnt lgkmcnt(0)" ::: "memory")
#define VM_WAIT() asm volatile("s_waitcnt vmcnt(0)" ::: "memory")
__device__ __forceinline__ unsigned long long rt() { return __builtin_amdgcn_s_memrealtime(); }
__device__ __forceinline__ unsigned f2bf(float f) { unsigned u = __builtin_bit_cast(unsigned, f); return (u + 0x7fffu + ((u >> 16) & 1u)) >> 16; }
__device__ __forceinline__ unsigned pk2(float lo, float hi) { return f2bf(lo) | (f2bf(hi) << 16); }

#define XB_TMO      128
#define XB_XCNT(j)  (256  + 64 * (j))
#define XB_XSUB(j)  (1280 + 64 * (j))
#define XB_XGEN(j)  (2304 + 64 * (j))
#define XB_TOP      3328
#define XB_TOPGEN   3392
#define XCD_BAR_WORDS 3456
#define XB_SPIN_CAP (1u << 18)

__device__ __forceinline__ unsigned xb_ld(unsigned* p)              { return __hip_atomic_load(p, __ATOMIC_RELAXED, __HIP_MEMORY_SCOPE_AGENT); }
__device__ __forceinline__ unsigned xb_add(unsigned* p, unsigned v) { return __hip_atomic_fetch_add(p, v, __ATOMIC_RELAXED, __HIP_MEMORY_SCOPE_AGENT); }
__device__ __forceinline__ unsigned xb_xcc_id() { return (unsigned)__builtin_amdgcn_s_getreg((3 << 11) | 20) & 0xFu; }
#define XB_SPIN(cond, bar) do { unsigned _sp = 0; while (cond) { __builtin_amdgcn_s_sleep(1); \
    if ((++_sp & 255u) == 0u) { if (xb_ld(&(bar)[XB_TMO])) break; if (_sp > XB_SPIN_CAP) { atomicAdd(&(bar)[XB_TMO], 1u); break; } } } } while (0)

struct XcdBarrier {
    unsigned* bar; unsigned x; int wave;
    volatile LAS unsigned* st;
};

__device__ __forceinline__ XcdBarrier xcd_barrier_post(unsigned* bar, volatile LAS unsigned* st, int wave) {
    XcdBarrier b; b.bar = bar; b.x = xb_xcc_id(); b.st = st; b.wave = wave;
    if (wave == 0 && pg8::lane_id_asm() == 0) (void)xb_add(&bar[XB_XCNT(b.x)], 1u);
    return b;
}
__device__ __forceinline__ void xcd_barrier_complete(unsigned* bar, unsigned x, unsigned& nloc, unsigned& nx) {
    const unsigned G = gridDim.x * gridDim.y * gridDim.z;
    unsigned sum, cnt, mine, sp = 0u;
    for (;;) {
        sum = 0u; cnt = 0u; mine = 0u;
#pragma unroll
        for (unsigned j = 0; j < 16; ++j) { const unsigned c = xb_ld(&bar[XB_XCNT(j)]); sum += c; cnt += (c > 0u) ? 1u : 0u; mine = (j == x) ? c : mine; }
        if (sum == G) break;
        __builtin_amdgcn_s_sleep(1);
        if ((++sp & 255u) == 0u) { if (xb_ld(&bar[XB_TMO])) break; if (sp > XB_SPIN_CAP) { atomicAdd(&bar[XB_TMO], 1u); break; } }
    }
    nloc = mine > 0u ? mine : 1u; nx = cnt > 0u ? cnt : 1u;
}

__device__ __forceinline__ void xcd_barrier(const XcdBarrier& b) {
    asm volatile("s_waitcnt vmcnt(0)" ::: "memory");
    __syncthreads();
    if (b.wave == 0 && pg8::lane_id_asm() == 0) {
        unsigned* bar = b.bar;
        __builtin_amdgcn_s_waitcnt(0);
        unsigned nloc = b.st[0], nx = b.st[1];
        if (nloc == 0u) { xcd_barrier_complete(bar, b.x, nloc, nx); b.st[0] = nloc; b.st[1] = nx; }
        const unsigned old = xb_add(&bar[XB_XSUB(b.x)], 1u);
        const unsigned gen = old / nloc;
        if (old + 1u == (gen + 1u) * nloc) {
            __builtin_amdgcn_fence(__ATOMIC_RELEASE, "agent");
            asm volatile("s_waitcnt vmcnt(0)" ::: "memory");
            const unsigned og = xb_add(&bar[XB_TOP], 1u);
            const unsigned tg = og / nx;
            if (og + 1u == (tg + 1u) * nx) xb_add(&bar[XB_TOPGEN], 1u);
        }
        XB_SPIN(xb_ld(&bar[XB_TOPGEN]) == gen, bar);
        __builtin_amdgcn_fence(__ATOMIC_ACQUIRE, "agent");
        asm volatile("s_waitcnt vmcnt(0)" ::: "memory");
    }
    __syncthreads();
}

constexpr int NWAVES = 8;
constexpr int BATCH = 4, SEQ = 2048, D = 2048, DFF = 5632, NGU = 2 * DFF, NIN = 6144, PLE = 256;
constexpr int HW = 1024, LW = 1024, HEADS = 8, HD = 128, CHUNK = 64, NCH = SEQ / CHUNK;
constexpr int M = BATCH * SEQ;
constexpr float EPS = 1e-6f;
constexpr int N_IN = 27;
enum In { I_X = 0, I_P, I_F1N, I_F1G, I_F1U, I_F1D, I_MIXN, I_WIN, I_HLB, I_HGN, I_CW, I_CB, I_LWA, I_LBA, I_LWX, I_LBX, I_LAM, I_WOUT,
          I_F2N, I_F2G, I_F2U, I_F2D, I_PLN, I_PWG, I_PBG, I_PWP, I_FN };

constexpr size_t MiB = 1u << 20;
constexpr size_t WS_CTL = 0, CTL_ZERO_BYTES = 128 * 1024;
constexpr size_t WS_SSQA = 1 * MiB, WS_SSQB = 2 * MiB, WS_DEC = 3 * MiB;
constexpr size_t WS_WAT = 3 * MiB + 512 * 1024, WS_WXT = 3 * MiB + 768 * 1024;
constexpr size_t WS_WPROJ = 4 * MiB, WS_PB = 5 * MiB;
constexpr size_t WS_WGU1 = 9 * MiB, WS_WD1 = 53 * MiB, WS_WINT = 75 * MiB, WS_WOUT = 99 * MiB, WS_WGU2 = 107 * MiB, WS_WD2 = 151 * MiB, WS_WPG = 173 * MiB;
constexpr size_t WS_XB = 181 * MiB;
constexpr size_t WS_ACT = 213 * MiB;
constexpr size_t WS_PP = 365 * MiB, WS_LOGF = WS_WGU1, WS_V = WS_PP, WS_SG = WS_PP + 16 * MiB, WS_LRX = WS_WD2;
constexpr size_t WS_MIXA = 301 * MiB;
constexpr size_t WS_KVT = 333 * MiB;
constexpr size_t WS_XCH = 397 * MiB;
constexpr size_t WS_WAJ = 398 * MiB, WS_WXJ = 399 * MiB;
constexpr size_t WS_BA2 = 400 * MiB;
constexpr size_t WS_END = 401 * MiB;
static_assert(WS_WGU1 + (size_t)NGU * D * 2 <= WS_WD1 && WS_WD1 + (size_t)D * DFF * 2 <= WS_WINT && WS_WINT + (size_t)NIN * D * 2 <= WS_WOUT && WS_WOUT + (size_t)D * D * 2 <= WS_WGU2 &&
              WS_WGU2 + (size_t)NGU * D * 2 <= WS_WD2 && WS_WD2 + (size_t)D * DFF * 2 <= WS_WPG && WS_WPG + (size_t)D * D * 2 <= WS_XB && WS_XB + (size_t)M * D * 2 <= WS_ACT &&
              WS_ACT + (size_t)M * DFF * 2 <= WS_MIXA && WS_MIXA + (size_t)M * 2048 * 2 <= WS_KVT && WS_KVT + (size_t)BATCH * HEADS * NCH * HD * HD * 4 <= WS_XCH &&
              WS_LRX + (size_t)M * 1024 * 2 <= WS_WPG && WS_LOGF + (size_t)M * 1024 * 4 <= WS_WD1 && WS_SG + (size_t)M * 1024 * 2 <= 397 * MiB && WS_PP + (size_t)M * D * 2 <= 397 * MiB && WS_PB + (size_t)M * PLE * 2 <= WS_WGU1 && WS_WPROJ + (size_t)D * PLE * 2 <= WS_PB, "d_ws map");
constexpr int CW_PANEL2 = 16384 + 2048;
constexpr int CW_PANEL = 16384;
constexpr int CW_BAR = 4096;

constexpr int RING_OFF = 0, RING_BYTES = 131072;
constexpr int LDSCTL_OFF = 147456 - 512, MISC_OFF = LDSCTL_OFF + 320;
constexpr int LDS_BYTES = 147456;
static_assert(MISC_OFF + 128 <= LDS_BYTES, "LDS map");


struct Frame {
    LAS unsigned char* lds;
    volatile LAS unsigned* MISC;
    gu32* ctl;
    int wave;
    int vcu, G;
    const float* in[N_IN]; float* out; unsigned char* ws;
};
__device__ __forceinline__ float bf2f(bf16 b) { return __builtin_bit_cast(float, (unsigned)b << 16); }
__device__ __forceinline__ float wave_sum(float v) {
#pragma unroll
    for (int o = 1; o < 64; o <<= 1) v += __shfl_xor(v, o);
    return v;
}
__device__ __forceinline__ void p0_transpose_item(const float* W, int ldw, int K, int src_col0, bf16* WT, int dst_row0, const float* gain, LAS float* scr, int kb, int lane, float wscale = 1.0f) {
    const int k0 = 64 * kb, kq = lane >> 4, nq = lane & 15;
    f32x4 v[16];
#pragma unroll
    for (int i = 0; i < 16; ++i) v[i] = __builtin_nontemporal_load((const GAS f32x4*)(W + (size_t)(k0 + 4 * i + kq) * ldw + src_col0 + 4 * nq));
    if (gain) {
#pragma unroll
        for (int i = 0; i < 16; ++i) v[i] = v[i] * gain[k0 + 4 * i + kq];
    }
    if (wscale != 1.0f) {
#pragma unroll
        for (int i = 0; i < 16; ++i) v[i] = v[i] * wscale;
    }
#pragma unroll
    for (int i = 0; i < 16; ++i) { LAS float* s = scr + (4 * i + kq) * 65 + 4 * nq; s[0] = v[i].x; s[1] = v[i].y; s[2] = v[i].z; s[3] = v[i].w; }
    LDS_WAIT(); asm volatile("" ::: "memory");
    const int c = lane & 7;
#pragma unroll
    for (int j = 0; j < 8; ++j) { const int n = (lane >> 3) + 8 * j; const LAS float* s = scr + (8 * c) * 65 + n;
        v4u o; o.x = pk2(s[0 * 65], s[1 * 65]); o.y = pk2(s[2 * 65], s[3 * 65]); o.z = pk2(s[4 * 65], s[5 * 65]); o.w = pk2(s[6 * 65], s[7 * 65]);
        *(GAS v4u*)(WT + (size_t)(dst_row0 + n) * K + k0 + 8 * c) = o; }
    LDS_WAIT(); asm volatile("" ::: "memory");
}
__device__ __forceinline__ bool p0_plain(int& r, const float* W, int K, int N, bf16* WT, const float* gain, LAS float* scr, int lane, float wscale = 1.0f) {
    const int items = (N / 64) * (K / 64);
    if (r < items) { const int nb = r / (K / 64), kb = r % (K / 64); p0_transpose_item(W, N, K, 64 * nb, WT, 64 * nb, gain, scr, kb, lane, wscale); return true; }
    r -= items; return false;
}
__device__ __forceinline__ bool p0_gateup(int& r, const float* Wg, const float* Wu, bf16* WT, const float* gain, LAS float* scr, int lane, int first = 0, int items = (NGU / 64) * (D / 64)) {
    if (r < items) { const int rr = r + first, rb = rr / (D / 64), kb = rr % (D / 64), t = rb >> 2, j = rb & 3;
        p0_transpose_item(j < 2 ? Wg : Wu, DFF, D, 128 * t + 64 * (j & 1), WT, 64 * rb, gain, scr, kb, lane); return true; }
    r -= items; return false;
}
constexpr int NITEM_MIX = BATCH * HEADS * NCH;
__device__ __forceinline__ void cv_load(f32x4 (&v)[8], f32x4 (&g)[2], const float* W, int ldw, int k0, int src_col0, const float* gain, int lane) {
    const float* p = W + (size_t)(k0 + 8 * (lane >> 3)) * ldw + src_col0 + 4 * (lane & 7);
#pragma unroll
    for (int i = 0; i < 8; ++i) v[i] = __builtin_nontemporal_load((const GAS f32x4*)(p + (size_t)i * ldw));
    g[0] = *(const f32x4*)(gain + k0 + 8 * (lane >> 3)); g[1] = *(const f32x4*)(gain + k0 + 8 * (lane >> 3) + 4);
}
__device__ __forceinline__ void cv_pack(unsigned (&o)[16], const f32x4 (&v)[8], const f32x4 (&g)[2]) {
#pragma unroll
    for (int e = 0; e < 4; ++e)
#pragma unroll
        for (int j = 0; j < 4; ++j) o[4 * e + j] = pg8::cvt_pk_bf16(v[2 * j][e] * g[(2 * j) >> 2][(2 * j) & 3], v[2 * j + 1][e] * g[(2 * j + 1) >> 2][(2 * j + 1) & 3]);
}
__device__ __forceinline__ void cv_store(const unsigned (&o)[16], bf16* WT, int K, int dst_row0, int k0, int lane) {
    bf16* p = WT + (size_t)(dst_row0 + 4 * (lane & 7)) * K + k0 + 8 * (lane >> 3);
#pragma unroll
    for (int e = 0; e < 4; ++e) *(GAS v4u*)(p + (size_t)e * K) = (v4u){o[4 * e], o[4 * e + 1], o[4 * e + 2], o[4 * e + 3]};
}
constexpr int CV_GU2_ITEMS = (NGU / 32) * (D / 64), CV_H1_ITEMS = CV_GU2_ITEMS - NITEM_MIX * 8;
__device__ __forceinline__ void cv_gu2_decode(int cid, const float* const* in, const float*& W, int& k0, int& src_col0, int& dst_row0) {
    const int rb = cid >> 5, kb = cid & 31, t = rb >> 3, j = rb & 7;
    W = (j < 4) ? in[I_F2G] : in[I_F2U]; k0 = 64 * kb; src_col0 = 128 * t + 32 * (j & 3); dst_row0 = 32 * rb;
}
enum { J_X = 1, J_P = 2, J_GU1 = 4, J_D1 = 8, J_WIN = 16, J_WOUT = 32, J_GU2 = 64, J_D2 = 128, J_PG = 256, J_PROJ = 512, J_AX = 1024, J_GU2A = 2048, J_GU2B = 4096 };
template <int JOBS>
__device__ __forceinline__ void convert_jobs(Frame& F, int rank, int count) {
    const int lane_ = pg8::lane_id_asm(), wave_ = F.wave;
    LAS float* scr = (LAS float*)(F.lds + RING_OFF + wave_ * 16640);
    const int gw = wave_ * count + rank, NGW = count * NWAVES;
    unsigned char* ws = F.ws;
    if (JOBS & J_X) {
        constexpr int I_GU_ = (NGU / 64) * (D / 64), I_DD_ = (D / 64) * (DFF / 64), I_IN_ = (NIN / 64) * (D / 64), I_SQ_ = (D / 64) * (D / 64), I_PJ_ = (D / 64) * (PLE / 64), I_AX_ = 16 * 4 * 4;
        constexpr int NIT_ = ((JOBS & J_GU1) ? I_GU_ : 0) + ((JOBS & J_D1) ? I_DD_ : 0) + ((JOBS & J_WIN) ? I_IN_ : 0) + ((JOBS & J_WOUT) ? I_SQ_ : 0) + ((JOBS & J_GU2) ? I_GU_ : 0) + ((JOBS & J_GU2A) ? I_GU_ / 2 : 0) +
                             ((JOBS & J_GU2B) ? I_GU_ - I_GU_ / 2 : 0) + ((JOBS & J_D2) ? I_DD_ : 0) + ((JOBS & J_PG) ? I_SQ_ : 0) + ((JOBS & J_PROJ) ? I_PJ_ : 0) + ((JOBS & J_AX) ? I_AX_ : 0);
        const int extra_ = NIT_ - (NIT_ / NGW) * NGW, ra_ = (M - 2 * (NGW - extra_)) / NGW, left_ = M - (extra_ * ra_ + (NGW - extra_) * (ra_ + 2));
        int m0 = gw, mstep = NGW, mend = M;
        if (ra_ >= 0 && left_ >= 0 && left_ <= NGW) { const int cnt_ = (gw < extra_ ? ra_ : ra_ + 2) + (gw < left_ ? 1 : 0);
            m0 = (gw < extra_ ? gw * ra_ : extra_ * ra_ + (gw - extra_) * (ra_ + 2)) + (gw < left_ ? gw : left_); mstep = 1; mend = m0 + cnt_; }
        for (int m = m0; m < mend; m += mstep) {
            const GAS f32x4* xr = (const GAS f32x4*)(F.in[I_X] + (size_t)m * D) + lane_;
            GAS unsigned long long* o8 = (GAS unsigned long long*)((bf16*)(ws + WS_XB) + (size_t)m * D) + lane_;
            float s = 0.f;
#pragma unroll
            for (int j = 0; j < 8; ++j) { const f32x4 v = __builtin_nontemporal_load(xr + 64 * j); s += (v.x * v.x + v.y * v.y) + (v.z * v.z + v.w * v.w);
                o8[64 * j] = (unsigned long long)pk2(v.x, v.y) | ((unsigned long long)pk2(v.z, v.w) << 32); }
            s = wave_sum(s);
            if (lane_ < 32) ((float*)(ws + WS_SSQA))[(size_t)m * 32 + lane_] = (lane_ == 0) ? s : 0.f;
        }
    }
    if (JOBS & J_P) {
        for (int m = gw; m < M; m += NGW) {
            const f32x4 v = __builtin_nontemporal_load((const GAS f32x4*)(F.in[I_P] + (size_t)m * PLE) + lane_);
            ((GAS unsigned long long*)((bf16*)(ws + WS_PB) + (size_t)m * PLE))[lane_] = (unsigned long long)pk2(v.x, v.y) | ((unsigned long long)pk2(v.z, v.w) << 32);
        }
    }
    constexpr int I_GU = (NGU / 64) * (D / 64), I_DD = (D / 64) * (DFF / 64), I_IN = (NIN / 64) * (D / 64), I_SQ = (D / 64) * (D / 64), I_PJ = (D / 64) * (PLE / 64), I_AX = 16 * 4 * 4;
    constexpr int NITEMS = ((JOBS & J_GU1) ? I_GU : 0) + ((JOBS & J_D1) ? I_DD : 0) + ((JOBS & J_WIN) ? I_IN : 0) + ((JOBS & J_WOUT) ? I_SQ : 0) + ((JOBS & J_GU2) ? I_GU : 0) + ((JOBS & J_GU2A) ? I_GU / 2 : 0) + ((JOBS & J_GU2B) ? I_GU - I_GU / 2 : 0) +
                           ((JOBS & J_D2) ? I_DD : 0) + ((JOBS & J_PG) ? I_SQ : 0) + ((JOBS & J_PROJ) ? I_PJ : 0) + ((JOBS & J_AX) ? I_AX : 0);
    for (int it = gw; it < NITEMS; it += NGW) {
        int r = it;
        if (JOBS & J_GU1) { if (p0_gateup(r, F.in[I_F1G], F.in[I_F1U], (bf16*)(ws + WS_WGU1), F.in[I_F1N], scr, lane_)) continue; }
        if (JOBS & J_D1) { if (p0_plain(r, F.in[I_F1D], DFF, D, (bf16*)(ws + WS_WD1), nullptr, scr, lane_, 0.5f)) continue; }
        if (JOBS & J_WIN) { if (p0_plain(r, F.in[I_WIN], D, NIN, (bf16*)(ws + WS_WINT), F.in[I_MIXN], scr, lane_)) continue; }
        if (JOBS & J_WOUT) { if (p0_plain(r, F.in[I_WOUT], D, D, (bf16*)(ws + WS_WOUT), nullptr, scr, lane_)) continue; }
        if (JOBS & J_GU2) { if (p0_gateup(r, F.in[I_F2G], F.in[I_F2U], (bf16*)(ws + WS_WGU2), F.in[I_F2N], scr, lane_)) continue; }
        if (JOBS & J_GU2A) { if (p0_gateup(r, F.in[I_F2G], F.in[I_F2U], (bf16*)(ws + WS_WGU2), F.in[I_F2N], scr, lane_, 0, I_GU / 2)) continue; }
        if (JOBS & J_GU2B) { if (p0_gateup(r, F.in[I_F2G], F.in[I_F2U], (bf16*)(ws + WS_WGU2), F.in[I_F2N], scr, lane_, I_GU / 2, I_GU - I_GU / 2)) continue; }
        if (JOBS & J_D2) { if (p0_plain(r, F.in[I_F2D], DFF, D, (bf16*)(ws + WS_WD2), nullptr, scr, lane_, 0.5f)) continue; }
        if (JOBS & J_PG) { if (p0_plain(r, F.in[I_PWG], D, D, (bf16*)(ws + WS_WPG), F.in[I_PLN], scr, lane_)) continue; }
        if (JOBS & J_PROJ) { if (p0_plain(r, F.in[I_PWP], PLE, D, (bf16*)(ws + WS_WPROJ), nullptr, scr, lane_)) continue; }
        if (JOBS & J_AX) { const int blk = r >> 4, j = (r >> 2) & 3, q = r & 3;
          const int nb = blk & 7;
          const float* W = (blk < 8 ? F.in[I_LWA] : F.in[I_LWX]) + (size_t)nb * 128 * 128;
          bf16* WT = (bf16*)(ws + (blk < 8 ? WS_WAJ : WS_WXJ)) + (size_t)(nb * 4 + j) * 128 * 128;
          p0_transpose_item(W, 128, 128, 64 * (q >> 1), WT, 64 * (q >> 1), F.in[I_CW] + j * 1024 + nb * 128, scr, q & 1, lane_); }
    }
    if (JOBS & J_AX) {
        for (int o = gw * 64 + lane_; o < 2048; o += NGW * 64) { const int which = o >> 10, dg = o & 1023, nb = dg >> 7, dd = dg & 127;
            const float* W = (which ? F.in[I_LWX] : F.in[I_LWA]) + (size_t)nb * 128 * 128 + dd; float s = (which ? F.in[I_LBX] : F.in[I_LBA])[dg];
            for (int c = 0; c < 128; ++c) s += F.in[I_CB][nb * 128 + c] * W[(size_t)c * 128];
            ((float*)(ws + WS_BA2))[o] = s; }
    }
}
__device__ __forceinline__ void side_workers(int nwg, int G, int c, int& rank, int& count) {
    const int rounds = (nwg + G - 1) / G, last = nwg - (rounds - 1) * G;
    if (last == G) { rank = c; count = G; } else if (c >= last) { rank = c - last; count = G - last; } else { rank = -1; count = 0; }
}
__device__ __forceinline__ void stagger_group(int G, int c, int& grp, int& rank, int& count) {
    grp = (c >> 3) & 1; rank = (c >> 4) * 8 + (c & 7);
    const int tail = (G & 15) - 8 * grp; count = (G >> 4) * 8 + (tail < 0 ? 0 : (tail > 8 ? 8 : tail));
}
__device__ __forceinline__ int panel_rstd_table(Frame& F, const float* ssq, int pm) {
    if (pm < 0) return -1;
    const int tid = F.wave * 64 + pg8::lane_id_asm(), row = tid >> 1, half = tid & 1;
    const f32x4* p = (const f32x4*)(ssq + (size_t)(pm * 256 + row) * 32 + half * 16);
    const f32x4 a = p[0], b = p[1], c = p[2], d = p[3];
    float s = (((a[0] + a[1]) + (a[2] + a[3])) + ((b[0] + b[1]) + (b[2] + b[3]))) + (((c[0] + c[1]) + (c[2] + c[3])) + ((d[0] + d[1]) + (d[2] + d[3])));
    s += __shfl_xor(s, 1);
    if (!half) ((LAS float*)(F.lds + RING_BYTES))[row] = 1.0f / sqrtf(s * (1.0f / (float)D) + EPS);
    __syncthreads();
    return pm;
}
__device__ __forceinline__ void final_norm(Frame& F, const float* ssq) {
    const int lane_ = pg8::lane_id_asm(), wave_ = F.wave;
    const int gw = F.vcu * NWAVES + wave_, NGW = F.G * NWAVES;
    const GAS f32x4* gf = (const GAS f32x4*)F.in[I_FN] + lane_;
    for (int m = gw; m < M; m += NGW) {
        float s = (lane_ < 32) ? ssq[(size_t)m * 32 + lane_] : 0.f;
        s = wave_sum(s);
        const float rstd = 1.0f / sqrtf(s * (1.0f / D) + EPS);
        GAS f32x4* xr = (GAS f32x4*)(F.out + (size_t)m * D) + lane_;
#pragma unroll
        for (int j = 0; j < 8; ++j) { f32x4 v = xr[64 * j]; const f32x4 g = gf[64 * j]; v = v * rstd * g; xr[64 * j] = v; }
    }
}


typedef float mf32x4 __attribute__((ext_vector_type(4)));
typedef short mbf16x8 __attribute__((ext_vector_type(8)));
typedef unsigned mu32x2 __attribute__((ext_vector_type(2)));
constexpr int TS = 72;
constexpr int QS = 136;
constexpr int NITEM = BATCH * HEADS * NCH;
__device__ __forceinline__ mbf16x8 lds_frag(const LAS bf16* p) { return *(const LAS mbf16x8*)p; }
__device__ __forceinline__ unsigned bf1(float x) { return pg8::cvt_pk_bf16(x, 0.f) & 0xffffu; }
#define MFMA16(a, b, c) __builtin_amdgcn_mfma_f32_16x16x32_bf16((a), (b), (c), 0, 0, 0)

#ifndef MIX_AFFINE
#define MIX_AFFINE 1
#endif
__device__ __forceinline__ int mix_item(int i) { return MIX_AFFINE ? (((i & 7) + 8 * (i >> 8)) << 5) + ((i >> 3) & 31) : i; }
__device__ __forceinline__ int scan_group(int g) { return MIX_AFFINE ? (((g & 7) + 8 * ((g >> 3) & 3)) << 3) + (g >> 5) : g; }
__device__ __forceinline__ unsigned st_native(int v, int k) {
    const int ch = v >> 6, p = (v >> 5) & 1, q = (v >> 3) & 3, rem = v & 7, j = 2 * p + (rem >> 2), fr = 4 * q + (rem & 3);
    return (unsigned)((((ch * 4 + j) * 4 + (k >> 5)) * 64 + ((k >> 3) & 3) * 16 + fr) * 8 + (k & 7));
}
#define LBAR() do { asm volatile("s_waitcnt lgkmcnt(0)" ::: "memory"); __builtin_amdgcn_s_barrier(); asm volatile("" ::: "memory"); } while (0)

__device__ __forceinline__ void hgrn_local_phase(Frame& F) {
    LAS bf16* kstT = (LAS bf16*)(F.lds);
    LAS bf16* vT = (LAS bf16*)(F.lds + 18432);
    LAS float* qtot = (LAS float*)(F.lds + 36864);
    const int tid_ = F.wave * 64 + pg8::lane_id_asm();
    const int tid = tid_, k = tid & 127, sq = tid >> 7, lane = tid & 63, w = F.wave, fr = lane & 15, fq = lane >> 4;
    const float* LOGF = (const float*)(F.ws + WS_LOGF); const bf16* V = (const bf16*)(F.ws + WS_V);
    bf16* KVT = (bf16*)(F.ws + WS_KVT); float* DEC = (float*)(F.ws + WS_DEC);
    float lf[16]; unsigned vr[16];
    if ((int)blockIdx.x < NITEM) { const int item = mix_item(blockIdx.x), c = item & 31, bh = item >> 5, h = bh & 7, b = bh >> 3;
        const size_t g0 = ((size_t)b * SEQ + c * 64 + sq * 16) * 1024 + h * 128 + k;
#pragma unroll
        for (int i = 0; i < 16; ++i) { lf[i] = LOGF[g0 + (size_t)i * 1024]; vr[i] = V[g0 + (size_t)i * 1024]; } }
    for (int item_ = blockIdx.x; item_ < NITEM; item_ += F.G) {
        const int item = mix_item(item_);
        f32x4 cvv[8], cvg[2]; const int cid = item * 8 + w; const bool cvh = (HOST_GU2 == 2) && cid < CV_H1_ITEMS;
        if (cvh) { const float* W_; int k0_, sc_, dr_; cv_gu2_decode(cid, F.in, W_, k0_, sc_, dr_); cv_load(cvv, cvg, W_, DFF, k0_, sc_, F.in[I_F2N], lane); }
        float bb[16]; float run = 0.f;
#pragma unroll
        for (int i = 0; i < 16; ++i) { run += lf[i]; bb[i] = run; }
        qtot[sq * 128 + k] = run;
        LBAR();
        float pre = 0.f, tot = 0.f;
#pragma unroll
        for (int j = 0; j < 4; ++j) { const float tq = qtot[j * 128 + k]; pre += (j < sq) ? tq : 0.f; tot += tq; }
        unsigned pk[8], pv[8];
#pragma unroll
        for (int i = 0; i < 8; ++i) {
            const float e0 = (1.0f - __expf(lf[2 * i])) * __expf(tot - (pre + bb[2 * i])), e1 = (1.0f - __expf(lf[2 * i + 1])) * __expf(tot - (pre + bb[2 * i + 1]));
            pk[i] = pg8::cvt_pk_bf16(e0, e1); pv[i] = vr[2 * i] | (vr[2 * i + 1] << 16); }
        *(LAS v4u*)(kstT + k * TS + sq * 16) = (v4u){pk[0], pk[1], pk[2], pk[3]}; *(LAS v4u*)(kstT + k * TS + sq * 16 + 8) = (v4u){pk[4], pk[5], pk[6], pk[7]};
        *(LAS v4u*)(vT + k * TS + sq * 16) = (v4u){pv[0], pv[1], pv[2], pv[3]}; *(LAS v4u*)(vT + k * TS + sq * 16 + 8) = (v4u){pv[4], pv[5], pv[6], pv[7]};
        if (sq == 0) DEC[(size_t)item * 128 + k] = __expf(tot);
        if (item_ + F.G < NITEM) { const int it2 = mix_item(item_ + F.G), c = it2 & 31, bh = it2 >> 5, h = bh & 7, b = bh >> 3;
            const size_t g0 = ((size_t)b * SEQ + c * 64 + sq * 16) * 1024 + h * 128 + k;
#pragma unroll
            for (int i = 0; i < 16; ++i) { lf[i] = LOGF[g0 + (size_t)i * 1024]; vr[i] = V[g0 + (size_t)i * 1024]; } }
        LBAR();
        const mbf16x8 b0 = lds_frag(vT + (16 * w + fr) * TS + 8 * fq), b1 = lds_frag(vT + (16 * w + fr) * TS + 32 + 8 * fq);
        bf16* outp = KVT + (size_t)item * 16384 + (size_t)(16 * w + fr) * 128 + 8 * fq;
        const int kr = 8 * (fr >> 2) + (fr & 3);
#pragma unroll
        for (int kp = 0; kp < 4; ++kp) {
            mf32x4 acc = {0.f, 0.f, 0.f, 0.f}, acd = {0.f, 0.f, 0.f, 0.f};
            acc = MFMA16(lds_frag(kstT + (32 * kp + kr) * TS + 8 * fq), b0, acc);
            acc = MFMA16(lds_frag(kstT + (32 * kp + kr) * TS + 32 + 8 * fq), b1, acc);
            acd = MFMA16(lds_frag(kstT + (32 * kp + 4 + kr) * TS + 8 * fq), b0, acd);
            acd = MFMA16(lds_frag(kstT + (32 * kp + 4 + kr) * TS + 32 + 8 * fq), b1, acd);
            asm volatile("s_nop 7\n\ts_nop 7" : "+v"(acc), "+v"(acd));
            v4u o; o.x = pg8::cvt_pk_bf16(acc[0], acc[1]); o.y = pg8::cvt_pk_bf16(acc[2], acc[3]); o.z = pg8::cvt_pk_bf16(acd[0], acd[1]); o.w = pg8::cvt_pk_bf16(acd[2], acd[3]);
            *(v4u*)(outp + 32 * kp) = o;
        }
        if (cvh) { unsigned cvo[16]; const float* W_; int k0_, sc_, dr_; cv_gu2_decode(cid, F.in, W_, k0_, sc_, dr_); cv_pack(cvo, cvv, cvg); cv_store(cvo, (bf16*)(F.ws + WS_WGU2), D, dr_, k0_, lane); }
    }
}

__device__ __forceinline__ void hgrn_scan_phase(Frame& F) {
    const bf16* KVT = (const bf16*)(F.ws + WS_KVT); const float* DEC = (const float*)(F.ws + WS_DEC); bf16* ST = (bf16*)F.out;
    const int tid_ = F.wave * 64 + pg8::lane_id_asm();
    for (int idx_ = blockIdx.x * (NWAVES * 64) + tid_; idx_ < BATCH * HEADS * 128 * 32; idx_ += F.G * NWAVES * 64) {
        const int idx = (scan_group(idx_ >> 9) << 9) + (idx_ & 511);
        const int k4 = idx & 31, v = (idx >> 5) & 127, bh = idx >> 12;
        mf32x4 S = {0.f, 0.f, 0.f, 0.f};
#pragma unroll 1
        for (int half = 0; half < 2; ++half) {
            const size_t off0 = (size_t)(bh * NCH + half * 16) * 16384 + v * 128 + 4 * k4; const size_t d0 = (size_t)(bh * NCH + half * 16) * 128 + 4 * k4;
            mu32x2 kv[16]; mf32x4 dd[16];
#pragma unroll
            for (int c = 0; c < 16; ++c) { kv[c] = *(const mu32x2*)(KVT + off0 + (size_t)c * 16384); dd[c] = *(const mf32x4*)(DEC + d0 + (size_t)c * 128); }
#pragma unroll
            for (int c = 0; c < 16; ++c) {
                mu32x2 o; o.x = pg8::cvt_pk_bf16(S[0], S[1]); o.y = pg8::cvt_pk_bf16(S[2], S[3]); *(mu32x2*)(ST + (size_t)(bh * NCH + half * 16 + c) * 16384 + st_native(v, 4 * k4)) = o;
                S = dd[c] * S + pg8::bf16x4_to_f32(kv[c]);
            }
        }
    }
}

__device__ __forceinline__ void hgrn_out_phase(Frame& F, bool dummy = false) {
    LAS bf16* QT = (LAS bf16*)(F.lds);
    LAS bf16* KT = (LAS bf16*)(F.lds + 17408);
    LAS bf16* QI = (LAS bf16*)(F.lds + 34816);
    LAS bf16* vT = (LAS bf16*)(F.lds + 52224);
    LAS bf16* P = (LAS bf16*)(F.lds + 70656);
    LAS float* qtot = (LAS float*)(F.lds + 79872);
    LAS float* ssq = (LAS float*)(F.lds + 81920);
    const int tid_ = F.wave * 64 + pg8::lane_id_asm();
    const int tid = tid_, k = tid & 127, sq = tid >> 7, lane = tid & 63, w = F.wave, fr = lane & 15, fq = lane >> 4, rb = w & 3, ch = w >> 2;
    const float* LOGF = (const float*)(F.ws + WS_LOGF); const bf16* V = (const bf16*)(F.ws + WS_V); const bf16* SG = (const bf16*)(F.ws + WS_SG);
    const bf16* ST = (const bf16*)F.out; bf16* MIXA = (bf16*)(F.ws + WS_MIXA);
    const int t0 = 16 * rb;
    mf32x4 gnv[2][2];
#pragma unroll
    for (int pj = 0; pj < 2; ++pj)
#pragma unroll
        for (int jj = 0; jj < 2; ++jj) gnv[pj][jj] = *(const mf32x4*)(F.in[I_HGN] + 64 * ch + 32 * pj + 8 * fq + 4 * jj);
    float lf[16]; unsigned vr[16], qr[16];
    if ((int)blockIdx.x < NITEM) { const int item = mix_item(blockIdx.x), c = item & 31, bh = item >> 5, h = bh & 7, b = bh >> 3;
        const size_t r0 = (size_t)b * SEQ + c * 64, g0 = (r0 + sq * 16) * 1024 + h * 128 + k, gq = (r0 + sq * 16) * 2048 + h * 128 + k;
#pragma unroll
        for (int i = 0; i < 16; ++i) { lf[i] = LOGF[g0 + (size_t)i * 1024]; vr[i] = V[g0 + (size_t)i * 1024]; qr[i] = MIXA[gq + (size_t)i * 2048]; } }
    for (int item_ = blockIdx.x; item_ < NITEM; item_ += F.G) {
        const int item = mix_item(item_);
        const int c = item & 31, bh = item >> 5, h = bh & 7, b = bh >> 3;
        const size_t r0 = (size_t)b * SEQ + c * 64;
        f32x4 cvv[8], cvg[2]; const int cid = CV_H1_ITEMS + item * 8 + w; const bool cvh = (HOST_GU2 == 2) && !dummy && cid < CV_GU2_ITEMS;
        if (cvh) { const float* W_; int k0_, sc_, dr_; cv_gu2_decode(cid, F.in, W_, k0_, sc_, dr_); cv_load(cvv, cvg, W_, DFF, k0_, sc_, F.in[I_F2N], lane); }
        float bb[16]; float run = 0.f;
#pragma unroll
        for (int i = 0; i < 16; ++i) { run += lf[i]; bb[i] = run; }
        qtot[sq * 128 + k] = run;
        LBAR();
        {
            float pre = 0.f;
#pragma unroll
            for (int j = 0; j < 4; ++j) { const float tq = qtot[j * 128 + k]; pre += (j < sq) ? tq : 0.f; }
            const float bm = qtot[k] + qtot[128 + k], ebm = __expf(bm);
            unsigned pv[8];
#pragma unroll
            for (int i = 0; i < 16; ++i) {
                const float d = fminf(fmaxf(pre + bb[i] - bm, -60.f), 60.f), e1 = __expf(d), e2 = __builtin_amdgcn_rcpf(e1);
                const float qf = bf2f((bf16)qr[i]), qt = qf * e1, kk = (1.0f - __expf(lf[i])) * e2;
                const int s = sq * 16 + i;
                QT[s * QS + k] = (bf16)bf1(qt); QI[s * QS + k] = (bf16)bf1(qt * ebm); KT[s * QS + k] = (bf16)bf1(kk);
            }
#pragma unroll
            for (int i = 0; i < 8; ++i) pv[i] = vr[2 * i] | (vr[2 * i + 1] << 16);
            *(LAS v4u*)(vT + k * TS + sq * 16) = (v4u){pv[0], pv[1], pv[2], pv[3]}; *(LAS v4u*)(vT + k * TS + sq * 16 + 8) = (v4u){pv[4], pv[5], pv[6], pv[7]};
        }
        if (item_ + F.G < NITEM) { const int it2 = mix_item(item_ + F.G), c2 = it2 & 31, bh2 = it2 >> 5, h2 = bh2 & 7, b2 = bh2 >> 3;
            const size_t r2 = (size_t)b2 * SEQ + c2 * 64, g0 = (r2 + sq * 16) * 1024 + h2 * 128 + k, gq = (r2 + sq * 16) * 2048 + h2 * 128 + k;
#pragma unroll
            for (int i = 0; i < 16; ++i) { lf[i] = LOGF[g0 + (size_t)i * 1024]; vr[i] = V[g0 + (size_t)i * 1024]; qr[i] = MIXA[gq + (size_t)i * 2048]; } }
        mbf16x8 stf[4][4]; v4u sgp[2];
        const int vr8 = 8 * (fr >> 2) + (fr & 3);
#pragma unroll
        for (int j = 0; j < 4; ++j) { const bf16* sp = ST + (size_t)item * 16384 + (size_t)((ch * 4 + j) * 256 + lane) * 8;
#pragma unroll
            for (int ks = 0; ks < 4; ++ks) stf[j][ks] = *(const mbf16x8*)(sp + 512 * ks); }
#pragma unroll
        for (int pj = 0; pj < 2; ++pj) sgp[pj] = *(const v4u*)(SG + (r0 + t0 + fr) * 1024 + h * 128 + 64 * ch + 32 * pj + 8 * fq);
        LBAR();
        {
            mbf16x8 bq[4];
#pragma unroll
            for (int ks = 0; ks < 4; ++ks) bq[ks] = lds_frag(QT + (t0 + fr) * QS + 32 * ks + 8 * fq);
#pragma unroll
            for (int j = 0; j < 2; ++j) {
                const int s0 = 32 * ch + 16 * j; mf32x4 acc = {0.f, 0.f, 0.f, 0.f};
#pragma unroll
                for (int ks = 0; ks < 4; ++ks) acc = MFMA16(lds_frag(KT + (s0 + fr) * QS + 32 * ks + 8 * fq), bq[ks], acc);
                const int t = t0 + fr, sb = s0 + 4 * fq;
#pragma unroll
                for (int r = 0; r < 4; ++r) acc[r] = (sb + r <= t) ? acc[r] : 0.f;
                mu32x2 o; o.x = pg8::cvt_pk_bf16(acc[0], acc[1]); o.y = pg8::cvt_pk_bf16(acc[2], acc[3]);
                *(LAS mu32x2*)(P + t * TS + sb) = o;
            }
        }
        LBAR();
        mf32x4 o4[4];
        {
            mbf16x8 bqi[4], bp[2];
#pragma unroll
            for (int ks = 0; ks < 4; ++ks) bqi[ks] = lds_frag(QI + (t0 + fr) * QS + 32 * ks + 8 * fq);
#pragma unroll
            for (int ss = 0; ss < 2; ++ss) bp[ss] = lds_frag(P + (t0 + fr) * TS + 32 * ss + 8 * fq);
            float sum = 0.f;
#pragma unroll
            for (int j = 0; j < 4; ++j) {
                const int vrow = 64 * ch + 32 * (j >> 1) + 4 * (j & 1) + vr8; mf32x4 acc = {0.f, 0.f, 0.f, 0.f};
#pragma unroll
                for (int ks = 0; ks < 4; ++ks) acc = MFMA16(stf[j][ks], bqi[ks], acc);
#pragma unroll
                for (int ss = 0; ss < 2; ++ss) acc = MFMA16(lds_frag(vT + vrow * TS + 32 * ss + 8 * fq), bp[ss], acc);
                o4[j] = acc; sum += (acc[0] * acc[0] + acc[1] * acc[1]) + (acc[2] * acc[2] + acc[3] * acc[3]);
            }
            sum += __shfl_xor(sum, 16); sum += __shfl_xor(sum, 32);
            if (fq == 0) ssq[ch * 64 + t0 + fr] = sum;
        }
        LBAR();
        {
            const float rn = 1.0f / sqrtf((ssq[t0 + fr] + ssq[64 + t0 + fr]) * (1.0f / 128.0f) + EPS);
            const size_t row = r0 + t0 + fr;
#pragma unroll
            for (int pj = 0; pj < 2; ++pj) {
                const int v = 64 * ch + 32 * pj + 8 * fq;
                const unsigned sgw[4] = {sgp[pj].x, sgp[pj].y, sgp[pj].z, sgp[pj].w}; unsigned ow[4];
#pragma unroll
                for (int jj = 0; jj < 2; ++jj) { const int j = 2 * pj + jj;
                    const mf32x4 gn = gnv[pj][jj];
                    const float s0 = bf2f((bf16)(sgw[2 * jj] & 0xffffu)), s1 = bf2f((bf16)(sgw[2 * jj] >> 16)), s2 = bf2f((bf16)(sgw[2 * jj + 1] & 0xffffu)), s3 = bf2f((bf16)(sgw[2 * jj + 1] >> 16));
                    ow[2 * jj] = pg8::cvt_pk_bf16(o4[j][0] * rn * gn[0] * s0, o4[j][1] * rn * gn[1] * s1); ow[2 * jj + 1] = pg8::cvt_pk_bf16(o4[j][2] * rn * gn[2] * s2, o4[j][3] * rn * gn[3] * s3); }
                *(v4u*)((dummy ? (bf16*)(F.ws + WS_KVT) : MIXA) + row * 2048 + h * 128 + v) = (v4u){ow[0], ow[1], ow[2], ow[3]};
            }
        }
        if (cvh) { unsigned cvo[16]; const float* W_; int k0_, sc_, dr_; cv_gu2_decode(cid, F.in, W_, k0_, sc_, dr_); cv_pack(cvo, cvv, cvg); cv_store(cvo, (bf16*)(F.ws + WS_WGU2), D, dr_, k0_, lane); }
    }
}

template <int CTRL, int ROWMASK>
__device__ __forceinline__ float dpp_f(float old, float src) {
    return __builtin_bit_cast(float, __builtin_amdgcn_update_dpp(__builtin_bit_cast(int, old), __builtin_bit_cast(int, src), CTRL, ROWMASK, 0xf, false));
}
__device__ __forceinline__ float lane_f(float v, int l) { return __builtin_bit_cast(float, __builtin_amdgcn_readlane(__builtin_bit_cast(int, v), l)); }
#define GLDS16(gp, lp) __builtin_amdgcn_global_load_lds((const unsigned*)(gp), (LAS unsigned*)(lp), 16, 0, 0)
template <int VAR = 0, bool FUSE_SCAN = false, bool dummy = false, bool HOST = (HOST_GU2 == 1) && !dummy>
__device__ __forceinline__ void lru_phase(Frame& F) {
    LAS unsigned char* Ab = F.lds;
    LAS float* LAt = (LAS float*)(F.lds + 66560);
    LAS float* LUt = (LAS float*)(F.lds + 66560 + 18560);
    LAS bf16* GG = (LAS bf16*)(F.lds + 103680);
    LAS float* HHt = (LAS float*)(F.lds + 111872);
    LAS float* CST = (LAS float*)(F.lds + 130816);
    const int tid_ = F.wave * 64 + pg8::lane_id_asm();
    const int tid = tid_, lane = tid & 63, w = F.wave, fr = lane & 15, fq = lane >> 4;
    const int seg = lane & 31, d = 2 * w + (lane >> 5);
    const int grow = tid >> 1, ghalf = tid & 1;
    const bf16* LRX = (const bf16*)(F.ws + WS_LRX); bf16* MIXA = (bf16*)(F.ws + WS_MIXA);
    const bf16* WAJ = (const bf16*)(F.ws + WS_WAJ); const bf16* WXJ = (const bf16*)(F.ws + WS_WXJ);
    if (VAR == 9) return;
    for (int item_ = blockIdx.x; item_ < BATCH * 64; item_ += F.G) {
        const int item = (((item_ & 7) * 4 + (item_ >> 6)) << 3) + ((item_ >> 3) & 7);
        const int b = item >> 6, n = (item >> 3) & 7, sl = item & 7;
        int tid = tid_; asm volatile("" : "+v"(tid));
        const int lane = tid & 63, fr = lane & 15, fq = lane >> 4, grow = tid >> 1, ghalf = tid & 1;
        mbf16x8 waf[4][4], wxf[4][4];
#pragma unroll
        for (int j = 0; j < 4; ++j)
#pragma unroll
            for (int ks = 0; ks < 4; ++ks) { const size_t o = ((size_t)(n * 4 + j) * 128 + sl * 16 + fr) * 128 + 32 * ks + 8 * fq; waf[j][ks] = *(const mbf16x8*)(WAJ + o); wxf[j][ks] = *(const mbf16x8*)(WXJ + o); }
        const bf16* xsrc0 = LRX + (size_t)b * SEQ * 1024 + n * 128;
        bf16* const gbase = MIXA + (size_t)b * SEQ * 2048 + 1024 + n * 128 + sl * 16 + 8 * ghalf;
        bf16* const obase = dummy ? (bf16*)(F.ws + WS_END) + (size_t)item * 2048 * 16 + 8 * ghalf : gbase;
        const size_t ostr = dummy ? 16 : 2048;
#pragma unroll
        for (int i = 0; i < 9; ++i) { const int p = tid + 512 * i, row = p >> 4, cp = p & 15;
            if (p < 259 * 16 && row >= 3) GLDS16(xsrc0 + (size_t)(row - 3) * 1024 + 8 * (cp ^ (row & 15)), Ab + (w * 64 + 512 * i) * 16); }
        if (tid < 48) *(LAS v4u*)(Ab + tid * 16) = (v4u){0u, 0u, 0u, 0u};
        GLDS16(gbase + (size_t)grow * 2048, (LAS unsigned char*)GG + w * 1024);
        if (tid < 16) { const int cgl = n * 128 + sl * 16 + tid; LAS float* cp = CST + tid * 8;
            cp[0] = ((const float*)(F.ws + WS_BA2))[cgl]; cp[1] = ((const float*)(F.ws + WS_BA2))[1024 + cgl]; cp[2] = log1pf(__expf(-F.in[I_LAM][cgl])); cp[3] = F.in[I_CB][cgl];
#pragma unroll
            for (int j = 0; j < 4; ++j) cp[4 + j] = F.in[I_CW][j * 1024 + cgl]; }
        __syncthreads();
        float carry = 0.f;
        v4u gprev = {0u, 0u, 0u, 0u};
        mf32x4 S = {0.f, 0.f, 0.f, 0.f};
        for (int mc = 0; mc < 8; ++mc) {
            int tid = tid_; asm volatile("" : "+v"(tid));
            const int lane = tid & 63, fr = lane & 15, fq = lane >> 4, seg = lane & 31, d = 2 * w + (lane >> 5), grow = tid >> 1, ghalf = tid & 1;
            const bf16* xsrc = LRX + (size_t)b * SEQ * 1024 + n * 128;
            bf16* const gbase = MIXA + (size_t)b * SEQ * 2048 + 1024 + n * 128 + sl * 16 + 8 * ghalf;
            bf16* const obase = dummy ? (bf16*)(F.ws + WS_END) + (size_t)item * 2048 * 16 + 8 * ghalf : gbase;
            const int sidx = scan_group(blockIdx.x) * (NWAVES * 64) + tid;
            const unsigned ssto = (unsigned)((sidx >> 12) * NCH + 4 * mc) * 16384u + st_native((sidx >> 5) & 127, 4 * (sidx & 31));
            const unsigned soff = (unsigned)((sidx >> 12) * NCH + 4 * mc) * 16384u + ((sidx >> 5) & 127) * 128 + 4 * (sidx & 31), sdo = (unsigned)((sidx >> 12) * NCH + 4 * mc) * 128u + 4 * (sidx & 31);
            mu32x2 skv[2]; mf32x4 sdd[2];
            if (FUSE_SCAN) {
#pragma unroll
                for (int c = 0; c < 2; ++c) { skv[c] = *(const mu32x2*)((const bf16*)(F.ws + WS_KVT) + soff + c * 16384u); sdd[c] = *(const mf32x4*)((const float*)(F.ws + WS_DEC) + sdo + c * 128u); }
            }
            mf32x4 ar[2], ai[2]; float xv[2][7];
#pragma unroll
            for (int rt = 0; rt < 2; ++rt) {
                const int rowt = 32 * w + 16 * rt; ar[rt] = (mf32x4){0.f, 0.f, 0.f, 0.f}; ai[rt] = (mf32x4){0.f, 0.f, 0.f, 0.f};
#pragma unroll
                for (int j = 0; j < (VAR == 6 ? 0 : 4); ++j) { const int R = rowt + fr + j;
#pragma unroll
                    for (int ks = 0; ks < 4; ++ks) { const mbf16x8 a = *(const LAS mbf16x8*)(Ab + R * 256 + (((4 * ks + fq) ^ (R & 15)) << 4)); ar[rt] = MFMA16(a, waf[j][ks], ar[rt]); ai[rt] = MFMA16(a, wxf[j][ks], ai[rt]); } }
#pragma unroll
                for (int q = 0; q < 7; ++q) { const int R = rowt + 4 * fq + q; xv[rt][q] = bf2f(*(const LAS bf16*)(Ab + R * 256 + (((2 * sl + (fr >> 3)) ^ (R & 15)) << 4) + 2 * (fr & 7))); }
            }
            LBAR();
            if (mc < 7 && VAR != 4) {
#pragma unroll
                for (int i = 0; i < 9; ++i) { const int p = tid + 512 * i, row = p >> 4, cp = p & 15;
                    if (p < 259 * 16) GLDS16(xsrc + (size_t)((mc + 1) * 256 - 3 + row) * 1024 + 8 * (cp ^ (row & 15)), Ab + (w * 64 + 512 * i) * 16); }
            }
            f32x4 cvv[8], cvg[2]; unsigned cvo[16];
            const int cid = mc * 2048 + item * 8 + w;
            if (HOST) {
                if (cid < CV_GU2_ITEMS) { const float* W_; int k0_, sc_, dr_; cv_gu2_decode(cid, F.in, W_, k0_, sc_, dr_); cv_load(cvv, cvg, W_, DFF, k0_, sc_, F.in[I_F2N], lane); }
            }
            if (VAR != 5) {
                const v4u g = *(const LAS v4u*)(GG + tid * 8);
                const int tb = (8 * ghalf) * 296 + (grow >> 3) * 9 + (grow & 7);
                if (mc > 0) { const unsigned gw4[4] = {gprev.x, gprev.y, gprev.z, gprev.w}; float yv[8];
#pragma unroll
                    for (int e = 0; e < 8; ++e) yv[e] = HHt[tb + e * 296] * bf2f((bf16)((e & 1) ? (gw4[e >> 1] >> 16) : (gw4[e >> 1] & 0xffffu)));
                    *(v4u*)(obase + (size_t)((mc - 1) * 256 + grow) * ostr) = (v4u){pg8::cvt_pk_bf16(yv[0], yv[1]), pg8::cvt_pk_bf16(yv[2], yv[3]), pg8::cvt_pk_bf16(yv[4], yv[5]), pg8::cvt_pk_bf16(yv[6], yv[7])}; }
                gprev = g;
                if (mc < 7) { asm volatile("s_waitcnt lgkmcnt(0)" ::: "memory"); GLDS16(gbase + (size_t)((mc + 1) * 256 + grow) * 2048, (LAS unsigned char*)GG + w * 1024); }
            }
            {
                const f32x4 c0 = *(const LAS f32x4*)(CST + fr * 8), c1 = *(const LAS f32x4*)(CST + fr * 8 + 4);
                const float ba2 = c0[0], bx2 = c0[1], spl = c0[2], cbv = c0[3];
                const float cw4[4] = {c1[0], c1[1], c1[2], c1[3]};
#pragma unroll
                for (int rt = 0; rt < (VAR == 2 ? 0 : 2); ++rt)
#pragma unroll
                    for (int r = 0; r < 4; ++r) { const int row = 32 * w + 16 * rt + 4 * fq + r;
                        const float xc = cbv + ((cw4[0] * xv[rt][r] + cw4[1] * xv[rt][r + 1]) + (cw4[2] * xv[rt][r + 2] + cw4[3] * xv[rt][r + 3]));
                        const float rg = pg8::sigmoid_f(ar[rt][r] + ba2), ig = pg8::sigmoid_f(ai[rt][r] + bx2), la = -8.0f * rg * spl;
                        const float a = __expf(la), om = fmaxf(__builtin_fmaf(-a, a, 1.0f), 0.f);
                        const int o = fr * 289 + (row >> 3) * 9 + (row & 7);
                        LAt[o] = a; LUt[o] = __builtin_amdgcn_sqrtf(om) * ig * xc; }
            }
            if (FUSE_SCAN) {
#pragma unroll
                for (int c = 0; c < 2; ++c) { mu32x2 o; o.x = pg8::cvt_pk_bf16(S[0], S[1]); o.y = pg8::cvt_pk_bf16(S[2], S[3]); *(mu32x2*)((bf16*)F.out + ssto + c * 16384u) = o;
                    S = sdd[c] * S + pg8::bf16x4_to_f32(skv[c]); }
#pragma unroll
                for (int c = 0; c < 2; ++c) { skv[c] = *(const mu32x2*)((const bf16*)(F.ws + WS_KVT) + soff + (2 + c) * 16384u); sdd[c] = *(const mf32x4*)((const float*)(F.ws + WS_DEC) + sdo + (2 + c) * 128u); }
            }
            if (HOST) { if (cid < CV_GU2_ITEMS) { cv_pack(cvo, cvv, cvg); const float* W_; int k0_, sc_, dr_; cv_gu2_decode(cid, F.in, W_, k0_, sc_, dr_); cv_store(cvo, (bf16*)(F.ws + WS_WGU2), D, dr_, k0_, lane); } }
            __syncthreads();
            if (VAR != 3) {
                float aa[8], uu[8]; float Ap = 1.f, Hp = 0.f;
#pragma unroll
                for (int i = 0; i < 8; ++i) { aa[i] = LAt[d * 289 + seg * 9 + i]; uu[i] = LUt[d * 289 + seg * 9 + i]; Hp = aa[i] * Hp + uu[i]; Ap *= aa[i]; }
#pragma unroll
#define LRU_PFX(CTRL, RM) do { const float Aq = dpp_f<CTRL, RM>(1.f, Ap), Hq = dpp_f<CTRL, RM>(0.f, Hp); Hp = Ap * Hq + Hp; Ap = Ap * Aq; } while (0)
                LRU_PFX(0x111, 0xf); LRU_PFX(0x112, 0xf); LRU_PFX(0x114, 0xf); LRU_PFX(0x118, 0xf);
                LRU_PFX(0x142, 0xa);
#undef LRU_PFX
                float Ae = dpp_f<0x138, 0xf>(1.f, Ap), He = dpp_f<0x138, 0xf>(0.f, Hp); if (seg == 0) { Ae = 1.f; He = 0.f; }
                float hin = Ae * carry + He;
                { const bool up = (lane & 32) != 0; const float A31 = up ? lane_f(Ap, 63) : lane_f(Ap, 31), H31 = up ? lane_f(Hp, 63) : lane_f(Hp, 31); carry = A31 * carry + H31; }
                LAS float* hq = HHt + d * 296 + seg * 9;
#pragma unroll
                for (int i = 0; i < 8; ++i) { hin = aa[i] * hin + uu[i]; hq[i] = hin; }
            }
            if (FUSE_SCAN) {
#pragma unroll
                for (int c = 0; c < 2; ++c) { mu32x2 o; o.x = pg8::cvt_pk_bf16(S[0], S[1]); o.y = pg8::cvt_pk_bf16(S[2], S[3]); *(mu32x2*)((bf16*)F.out + ssto + (2 + c) * 16384u) = o;
                    S = sdd[c] * S + pg8::bf16x4_to_f32(skv[c]); }
            }
        }
        __syncthreads();
        { const int tb = (8 * ghalf) * 296 + (grow >> 3) * 9 + (grow & 7); const unsigned gw4[4] = {gprev.x, gprev.y, gprev.z, gprev.w}; float yv[8];
#pragma unroll
          for (int e = 0; e < 8; ++e) yv[e] = HHt[tb + e * 296] * bf2f((bf16)((e & 1) ? (gw4[e >> 1] >> 16) : (gw4[e >> 1] & 0xffffu)));
          *(v4u*)(obase + (size_t)(7 * 256 + grow) * ostr) = (v4u){pg8::cvt_pk_bf16(yv[0], yv[1]), pg8::cvt_pk_bf16(yv[2], yv[3]), pg8::cvt_pk_bf16(yv[4], yv[5]), pg8::cvt_pk_bf16(yv[6], yv[7])}; }
        __syncthreads();
    }
}
constexpr int N_PHASES = 12;
struct Args { const float* in[N_IN]; float* out; unsigned char* ws; int ph_lo, ph_hi, li, pad; };
__global__ void __launch_bounds__(NWAVES * 64, 2) mega_fwd(Args args) {
    extern __shared__ __attribute__((aligned(16))) unsigned char lds[];
    Frame F;
    F.lds = (LAS unsigned char*)lds;
    F.MISC = (volatile LAS unsigned*)(F.lds + MISC_OFF);
    F.wave = __builtin_amdgcn_readfirstlane((int)threadIdx.x >> 6);
    F.G = gridDim.x; { const int bx = blockIdx.x; F.vcu = (F.G % 8 == 0) ? (bx % 8) * (F.G / 8) + bx / 8 : bx; }
#pragma unroll
    for (int i = 0; i < N_IN; ++i) F.in[i] = args.in[i];
    F.out = args.out; F.ws = args.ws;
    unsigned char* ws = args.ws;
    F.ctl = (gu32*)(ws + WS_CTL);
    for (int u = F.wave * 64 + pg8::lane_id_asm(); u < (LDS_BYTES - LDSCTL_OFF) / 4; u += NWAVES * 64) ((LAS unsigned*)(F.lds + LDSCTL_OFF))[u] = 0u;
    __syncthreads();
    const int lo = args.ph_lo, hi = args.ph_hi;
    const bool multi = (hi - lo) > 1;
    XcdBarrier bar; bar.bar = (unsigned*)(F.ctl + CW_BAR) + args.li * XCD_BAR_WORDS; bar.x = 0; bar.st = nullptr; bar.wave = F.wave;
    if (multi) bar = xcd_barrier_post((unsigned*)(F.ctl + CW_BAR) + args.li * XCD_BAR_WORDS, F.MISC + 8, F.wave);

    bf16* const XB = (bf16*)(ws + WS_XB); bf16* const ACT = (bf16*)(ws + WS_ACT); bf16* const MIXA = (bf16*)(ws + WS_MIXA);
    float* const SSQA = (float*)(ws + WS_SSQA); float* const SSQB = (float*)(ws + WS_SSQB);


#define IN(k) (lo <= (k) && (k) < hi)
#ifdef PROBE_PHASE
#define SEAM(k) do { if (IN(k) && ((k) + 1 < N_PHASES ? IN((k) + 1) : true)) { xcd_barrier(bar); \
        if ((k) + 1 == PROBE_PHASE) { if (blockIdx.x == 0 && F.wave == 0 && pg8::lane_id_asm() == 0) __hip_atomic_store((unsigned long long*)(F.ctl + 30000), (unsigned long long)__builtin_amdgcn_s_memrealtime(), RLX_AGENT); } \
        if ((k) == PROBE_PHASE) { if (blockIdx.x == 0 && F.wave == 0 && pg8::lane_id_asm() == 0) { const unsigned long long t1 = __builtin_amdgcn_s_memrealtime(), t0 = __hip_atomic_load((unsigned long long*)(F.ctl + 30000), RLX_AGENT); \
                __hip_atomic_store((unsigned long long*)(F.ctl + 30064), t1 - t0, RLX_AGENT); } \
            xcd_barrier(bar); \
            { const unsigned long long dt = __hip_atomic_load((unsigned long long*)(F.ctl + 30064), RLX_AGENT), s0 = __builtin_amdgcn_s_memrealtime(); while (__builtin_amdgcn_s_memrealtime() - s0 < 4ull * dt) __builtin_amdgcn_s_sleep(32); } } } } while (0)
#else
#ifdef PROBE_BARX
#define SEAM(k) do { if (IN(k) && IN((k) + 1)) { xcd_barrier(bar); if ((k) == PROBE_BARX) { for (int e_ = 0; e_ < 16; ++e_) xcd_barrier(bar); } } } while (0)
#else
#define SEAM(k) do { if (IN(k) && IN((k) + 1)) xcd_barrier(bar); } while (0)
#endif
#endif
#if !defined(PROBE_PHASE) && !defined(PROBE_BARX) && N_LAUNCHES == 1 && !SIMPLE_HGRN && !SIMPLE_LRU && !defined(NO_PANEL)
#define PANEL_MODE (F.G == (M / 256) * (D / 256))
#else
#define PANEL_MODE false
#endif
#define PANEL_CNT(s) ((unsigned*)(F.ctl + CW_PANEL2 + (s) * 2048))
#define PANEL_WAIT(s, pm) do { if (PANEL_MODE && (pm) >= 0) { unsigned* pc_ = PANEL_CNT(s) + 64 * (pm); \
        if (F.wave == 0) { unsigned sp_ = 0; while ((unsigned)__builtin_amdgcn_readfirstlane(__hip_atomic_load(pc_, __ATOMIC_RELAXED, __HIP_MEMORY_SCOPE_AGENT)) < 64u) { __builtin_amdgcn_s_sleep(2); if (++sp_ > (1u << 22)) break; } \
            __builtin_amdgcn_fence(__ATOMIC_ACQUIRE, "agent"); } \
        asm volatile("s_waitcnt vmcnt(0) lgkmcnt(0)" ::: "memory"); __syncthreads(); } } while (0)
#define SEAM_PANEL(k) do { if (!PANEL_MODE) SEAM(k); } while (0)
#define GEMM_SWIGLU(WOFF, WSEAM) do { pg8::Gemm g{XB, (const bf16*)(ws + (WOFF)), M, NGU, D}; pg8::StaticOrder S; S.init(M, NGU, F.G, (int)blockIdx.x); \
        pg8::Unit u0_; const int tpm_ = S.next(0, u0_) ? u0_.pm : -1; if ((WSEAM) >= 0) PANEL_WAIT((WSEAM) < 0 ? 0 : (WSEAM), tpm_); \
        pg8::EpiSwiGLU E{ACT, DFF, SSQA, (const LAS float*)(F.lds + RING_BYTES), tpm_}; pg8::gemm_phase<pg8::EpiSwiGLU, pg8::StaticOrder, true, true>(F.lds + RING_OFF, g, S, E, F.wave); } while (0)
#define GEMM_RESID(AP, WOFF, KK, SRC32, SSQO, PSEAM) do { pg8::Gemm g{(AP), (const bf16*)(ws + (WOFF)), M, D, (KK)}; pg8::StaticOrder S; S.init(M, D, F.G, (int)blockIdx.x); \
        if ((M / 256) * (D / 256) <= F.G) { pg8::EpiResidInit E{(SRC32), XB, (SSQO), PANEL_MODE ? PANEL_CNT(PSEAM) : (unsigned*)nullptr}; pg8::gemm_phase<pg8::EpiResidInit, pg8::StaticOrder, true, true>(F.lds + RING_OFF, g, S, E, F.wave); } \
        else { pg8::EpiResid E{(SRC32), XB, (SSQO)}; pg8::gemm_phase<pg8::EpiResid, pg8::StaticOrder, true, true>(F.lds + RING_OFF, g, S, E, F.wave); } } while (0)

    if (IN(0)) { convert_jobs<J_X | J_P | J_GU1 | ((HOST_GU2 || STAGGER_G3 == 1) ? 0 : J_GU2) | J_PROJ | J_AX | (STAGGER_G3 == 2 ? 0 : J_PG)>(F, (int)blockIdx.x, F.G); SEAM(0); }
    if (IN(1)) {
#if STAGGER_SIDE
        { int rank, count; side_workers((M / 256) * (NGU / 256), F.G, (int)blockIdx.x, rank, count); if (rank >= 0 && count < F.G) { convert_jobs<J_D1>(F, rank, count); __syncthreads(); } }
        GEMM_SWIGLU(WS_WGU1, -1);
        { int rank, count; side_workers((M / 256) * (NGU / 256), F.G, (int)blockIdx.x, rank, count); if (rank >= 0) { if (count < F.G) convert_jobs<J_WIN | J_WOUT>(F, rank, count); else convert_jobs<J_D1 | J_WIN | J_WOUT>(F, rank, count); } }
#else
        GEMM_SWIGLU(WS_WGU1, -1);
        { int rank, count; side_workers((M / 256) * (NGU / 256), F.G, (int)blockIdx.x, rank, count); if (rank >= 0) convert_jobs<J_D1 | J_WIN | J_WOUT>(F, rank, count); }
#endif
        SEAM(1); }
    if (IN(2)) { GEMM_RESID(ACT, WS_WD1, DFF, (const float*)nullptr, SSQB, 0); SEAM_PANEL(2); }
    if (IN(3)) {
        pg8::Gemm g{XB, (const bf16*)(ws + WS_WINT), M, NIN, D}; pg8::SegMixOrder S; S.init(M, NIN, F.G, (int)blockIdx.x);
        pg8::EpiZ E{SSQB, F.in[I_HLB], MIXA, (float*)(ws + WS_LOGF), (bf16*)(ws + WS_V), (bf16*)(ws + WS_SG), (bf16*)(ws + WS_LRX), (const LAS float*)(F.lds + RING_BYTES), -1};
#if STAGGER_G3
        int sgrp, srank, scount; stagger_group(F.G, (int)blockIdx.x, sgrp, srank, scount);
        const bool stag = F.G >= 16;
#define PP_GEMM_RANGE(BASE, NN) do { pg8::Gemm gp{(const bf16*)(ws + WS_PB), (const bf16*)(ws + WS_WPROJ), M, D, PLE}; pg8::RangeOrder Sp; Sp.init(M, D, (BASE), (NN), scount, srank); \
            pg8::EpiPP Ep{(bf16*)(ws + WS_PP)}; pg8::gemm_phase<pg8::EpiPP, pg8::RangeOrder, true, true>(F.lds + RING_OFF, gp, Sp, Ep, F.wave); } while (0)
        constexpr int PP_TILES = (M / 256) * (D / 256);
        if (stag && sgrp == 1) { if (STAGGER_G3 == 2) { PP_GEMM_RANGE(0, PP_TILES / 2); } else { convert_jobs<J_GU2A>(F, srank, scount); __syncthreads(); } }
#endif
        { pg8::Unit u0_; E.rtab_pm = S.next(0, u0_) ? u0_.pm : -1; PANEL_WAIT(0, E.rtab_pm); }
        pg8::gemm_phase<pg8::EpiZ, pg8::SegMixOrder, true, true>(F.lds + RING_OFF, g, S, E, F.wave);
#if STAGGER_G3
        if (STAGGER_G3 == 2) { if (stag) { if (sgrp == 0) { PP_GEMM_RANGE(PP_TILES / 2, PP_TILES - PP_TILES / 2); } } else { const int srank = (int)blockIdx.x, scount = F.G; PP_GEMM_RANGE(0, PP_TILES); } }
        else { if (stag) { if (sgrp == 0) convert_jobs<J_GU2B>(F, srank, scount); } else convert_jobs<J_GU2A | J_GU2B>(F, (int)blockIdx.x, F.G); }
#undef PP_GEMM_RANGE
#endif
        SEAM(3); }
    if (IN(4)) { MIXER_PHASE_4 SEAM(4); }
    if (IN(5)) { MIXER_PHASE_5 SEAM(5); }
    if (IN(6)) { MIXER_PHASE_6 SEAM(6); }
    if (IN(7)) { GEMM_RESID(MIXA, WS_WOUT, D, (const float*)nullptr, SSQA, 1); SEAM_PANEL(7); }
    if (IN(8)) {
#define PP_GEMM_SIDE() do { pg8::Gemm g{(const bf16*)(ws + WS_PB), (const bf16*)(ws + WS_WPROJ), M, D, PLE}; pg8::StaticOrder S; S.init(M, D, count, rank); \
              pg8::EpiPP E{(bf16*)(ws + WS_PP)}; pg8::gemm_phase<pg8::EpiPP, pg8::StaticOrder, true, true>(F.lds + RING_OFF, g, S, E, F.wave); } while (0)
#if STAGGER_SIDE && STAGGER_G3 != 2
        { int rank, count; side_workers((M / 256) * (NGU / 256), F.G, (int)blockIdx.x, rank, count); if (rank >= 0 && count < F.G) { PP_GEMM_SIDE(); } }
#endif
        GEMM_SWIGLU(WS_WGU2, 1);
        { int rank, count; side_workers((M / 256) * (NGU / 256), F.G, (int)blockIdx.x, rank, count);
          if (rank >= 0) {
#if STAGGER_G3 != 2
              if (!STAGGER_SIDE || count == F.G) { PP_GEMM_SIDE(); }
              convert_jobs<J_D2>(F, rank, count);
#else
              convert_jobs<J_D2 | J_PG>(F, rank, count);
#endif
          } }
#undef PP_GEMM_SIDE
        SEAM(8); }
    if (IN(9)) { GEMM_RESID(ACT, WS_WD2, DFF, (const float*)nullptr, SSQB, 2); SEAM_PANEL(9); }
    if (IN(10)) {
        { pg8::Gemm g{XB, (const bf16*)(ws + WS_WPG), M, D, D}; pg8::StaticOrder S; S.init(M, D, F.G, (int)blockIdx.x);
          if (F.G == (M / 256) * (D / 256)) {
              pg8::Unit u0_; const int tpm_ = S.next(0, u0_) ? u0_.pm : -1; PANEL_WAIT(2, tpm_);
              pg8::EpiPLEFinal E{SSQB, F.in[I_PBG], (const bf16*)(ws + WS_PP), XB, F.out, (float*)(ws + WS_XCH), (unsigned*)(F.ctl + CW_PANEL), F.in[I_FN], (const LAS float*)(F.lds + RING_BYTES), tpm_};
              pg8::gemm_phase<pg8::EpiPLEFinal, pg8::StaticOrder, false, true>(F.lds + RING_OFF, g, S, E, F.wave);
          } else {
              pg8::EpiPLE E{SSQB, F.in[I_PBG], (const bf16*)(ws + WS_PP), XB, F.out, SSQA};
              pg8::gemm_phase<pg8::EpiPLE, pg8::StaticOrder, true, true>(F.lds + RING_OFF, g, S, E, F.wave); } }
        if (F.G != (M / 256) * (D / 256)) SEAM(10); }
    if (IN(11)) { if (F.G != (M / 256) * (D / 256)) final_norm(F, SSQA); SEAM(11); }
#undef IN
#undef SEAM
}

#if SIMPLE_HGRN
__global__ void __launch_bounds__(64) k_simple_hgrn(const float* logf, const bf16* mixa, const bf16* vv, float* oh) {
    __shared__ float sf[128], sk[128], sq[128];
    const int bh = blockIdx.x >> 1, vh = blockIdx.x & 1, b = bh >> 3, h = bh & 7, lane = threadIdx.x, v = vh * 64 + lane;
    float S[128];
#pragma unroll
    for (int k = 0; k < 128; ++k) S[k] = 0.f;
    for (int t = 0; t < SEQ; ++t) {
        const size_t row = (size_t)b * SEQ + t;
        for (int kk = lane; kk < 128; kk += 64) { const float f = __expf(logf[row * 1024 + h * 128 + kk]); sf[kk] = f; sk[kk] = 1.f - f; sq[kk] = bf2f(mixa[row * 2048 + h * 128 + kk]); }
        __syncthreads();
        const float vt = bf2f(vv[row * 1024 + h * 128 + v]); float o = 0.f;
#pragma unroll
        for (int k = 0; k < 128; ++k) { S[k] = sf[k] * S[k] + sk[k] * vt; o += S[k] * sq[k]; }
        oh[row * 1024 + h * 128 + v] = o;
        __syncthreads();
    }
}
__global__ void __launch_bounds__(256) k_simple_hnorm(const float* oh, const bf16* sg, const float* gn, bf16* mixa) {
    const int gw = (blockIdx.x * 256 + threadIdx.x) >> 6, lane = threadIdx.x & 63;
    if (gw >= M * HEADS) return;
    const int row = gw >> 3, h = gw & 7;
    const float o0 = oh[(size_t)row * 1024 + h * 128 + lane], o1 = oh[(size_t)row * 1024 + h * 128 + 64 + lane];
    const float ss = wave_sum(o0 * o0 + o1 * o1);
    const float r = 1.0f / sqrtf(ss * (1.0f / 128.0f) + EPS);
    mixa[(size_t)row * 2048 + h * 128 + lane] = (bf16)f2bf(o0 * r * gn[lane] * bf2f(sg[(size_t)row * 1024 + h * 128 + lane]));
    mixa[(size_t)row * 2048 + h * 128 + 64 + lane] = (bf16)f2bf(o1 * r * gn[64 + lane] * bf2f(sg[(size_t)row * 1024 + h * 128 + 64 + lane]));
}
#endif
#if SIMPLE_LRU
__global__ void __launch_bounds__(256) k_simple_lru_a(const bf16* lrx, const float* cw, const float* cb, const float* wa, const float* ba, const float* wx, const float* bx, const float* lam, float* LA, float* LU) {
    __shared__ float xc[1024];
    const int row = blockIdx.x, tt = row % SEQ, tid = threadIdx.x;
    for (int c = tid; c < 1024; c += 256) { float s = cb[c];
        for (int j = 0; j < 4; ++j) { const int ts = tt - 3 + j; if (ts >= 0) s += cw[j * 1024 + c] * bf2f(lrx[(size_t)(row - 3 + j) * 1024 + c]); }
        xc[c] = s; }
    __syncthreads();
    for (int d = tid; d < 1024; d += 256) { const int n = d >> 7, dd = d & 127; float r = ba[d], g = bx[d];
        for (int c = 0; c < 128; ++c) { const float x = xc[n * 128 + c]; r += x * wa[((size_t)n * 128 + c) * 128 + dd]; g += x * wx[((size_t)n * 128 + c) * 128 + dd]; }
        r = 1.0f / (1.0f + __expf(-r)); g = 1.0f / (1.0f + __expf(-g));
        const float log_a = -8.0f * r * log1pf(__expf(-lam[d]));
        LA[(size_t)row * 1024 + d] = __expf(log_a); LU[(size_t)row * 1024 + d] = sqrtf(-expm1f(2.0f * log_a)) * g * xc[d]; }
}
__global__ void __launch_bounds__(256) k_simple_lru_b(const float* LA, const float* LU, bf16* mixa) {
    const int gi = blockIdx.x * 256 + threadIdx.x, b = gi >> 10, c = gi & 1023; float h = 0.f;
#pragma unroll 8
    for (int t = 0; t < SEQ; ++t) { const size_t row = (size_t)b * SEQ + t; h = LA[row * 1024 + c] * h + LU[row * 1024 + c];
        bf16* p = mixa + row * 2048 + 1024 + c; *p = (bf16)f2bf(h * bf2f(*p)); }
}
#endif

extern "C" void kernel_launch(void* const* d_in, const int* in_sizes, int n_in, void* d_out, int out_size, void* d_ws, size_t ws_size, hipStream_t stream) {
    static int grid = 0;
    if (grid == 0) {
        if (n_in != N_IN || in_sizes[0] != M * D || out_size != M * D || ws_size < WS_END) { fprintf(stderr, "kernel_launch: unexpected problem (n_in %d, in0 %d, out %d, ws %zu); nothing launched\n", n_in, n_in > 0 ? in_sizes[0] : -1, out_size, ws_size); grid = -1; return; }
        int dev = 0, cus = 0, per_cu = 0;
        if (hipGetDevice(&dev) != hipSuccess || hipDeviceGetAttribute(&cus, hipDeviceAttributeMultiprocessorCount, dev) != hipSuccess) { grid = -1; return; }
        if (hipFuncSetAttribute((const void*)mega_fwd, hipFuncAttributeMaxDynamicSharedMemorySize, LDS_BYTES) != hipSuccess) { fprintf(stderr, "kernel_launch: hipFuncSetAttribute failed\n"); grid = -1; return; }
        if (hipOccupancyMaxActiveBlocksPerMultiprocessor(&per_cu, (const void*)mega_fwd, NWAVES * 64, LDS_BYTES) != hipSuccess || per_cu < 1)
            fprintf(stderr, "kernel_launch: note: occupancy query reports %d workgroups per CU\n", per_cu);
        (void)hipGetLastError();
        grid = cus;
    }
    if (grid < 0) return;
    if (hipMemsetAsync((char*)d_ws + WS_CTL, 0, CTL_ZERO_BYTES, stream) != hipSuccess) return;
    Args a{};
    for (int i = 0; i < N_IN; ++i) a.in[i] = (const float*)d_in[i];
    a.out = (float*)d_out; a.ws = (unsigned char*)d_ws;
    unsigned char* ws = (unsigned char*)d_ws;
    auto launch = [&](int lo, int hi, int li) { a.ph_lo = lo; a.ph_hi = hi; a.li = li; hipLaunchKernelGGL(mega_fwd, dim3(grid), dim3(NWAVES * 64), LDS_BYTES, stream, a); };
#if SIMPLE_HGRN || SIMPLE_LRU
    launch(0, 4, 0);
#if SIMPLE_HGRN
    {   float* OH = (float*)(ws + WS_XB);
        hipLaunchKernelGGL(k_simple_hgrn, dim3(64), dim3(64), 0, stream, (const float*)(ws + WS_LOGF), (const bf16*)(ws + WS_MIXA), (const bf16*)(ws + WS_V), OH);
        hipLaunchKernelGGL(k_simple_hnorm, dim3(M * HEADS / 4), dim3(256), 0, stream, (const float*)OH, (const bf16*)(ws + WS_SG), (const float*)d_in[I_HGN], (bf16*)(ws + WS_MIXA)); }
#endif
#if SIMPLE_LRU
    {   float* LA = (float*)(ws + WS_KVT); float* LU = LA + (size_t)M * 1024;
        hipLaunchKernelGGL(k_simple_lru_a, dim3(M), dim3(256), 0, stream, (const bf16*)(ws + WS_LRX), (const float*)d_in[I_CW], (const float*)d_in[I_CB], (const float*)d_in[I_LWA], (const float*)d_in[I_LBA],
                           (const float*)d_in[I_LWX], (const float*)d_in[I_LBX], (const float*)d_in[I_LAM], LA, LU);
        hipLaunchKernelGGL(k_simple_lru_b, dim3(BATCH * 1024 / 256), dim3(256), 0, stream, (const float*)LA, (const float*)LU, (bf16*)(ws + WS_MIXA)); }
#endif
    launch(4, N_PHASES, 1);
#else
#if N_LAUNCHES == 1
    launch(0, N_PHASES, 0);
#else
    for (int ph = 0; ph < N_PHASES; ++ph) launch(ph, ph + 1, 0);
#endif
#endif
}
```
